# Optimizing an MI355X kernel written in HIP

```python
import jax
import jax.numpy as jnp
from jax import lax
import numpy as np

D_MODEL = 1024
BATCH = 4
SEQ = 4096
DEPTH = 2

MEM_LEN = 256
N_MIXERS = 4
GROUP_WIDTH = D_MODEL // N_MIXERS
HEAD_DIM = 64
GROUP_HEADS = GROUP_WIDTH // HEAD_DIM
Q_BLOCK = 128
RET_CHUNK = 128
RET_THETA = 10000.0
CONV_WIDTH = 4
LRU_C = 8.0
RWKV_W_RANK = 64
RWKV_A_RANK = 64
RWKV_V_RANK = 32
RWKV_G_RANK = 128
RWKV_GN_EPS = 64e-5
XATTN_HEADS = 4
XATTN_HEAD_DIM = D_MODEL // XATTN_HEADS
D_FF = 4 * D_MODEL
NORM_EPS = 1e-6

FOX_WIDTH = 3 * GROUP_WIDTH + GROUP_HEADS
LRU_WIDTH = 2 * GROUP_WIDTH
RWKV_WIDTH = 3 * GROUP_WIDTH + RWKV_W_RANK + RWKV_A_RANK + RWKV_G_RANK
RET_WIDTH = 4 * GROUP_WIDTH
FOX_OFF = 0
LRU_OFF = FOX_OFF + FOX_WIDTH
RWKV_OFF = LRU_OFF + LRU_WIDTH
RET_OFF = RWKV_OFF + RWKV_WIDTH
IN_WIDTH = RET_OFF + RET_WIDTH

kernel_name = 'hybrid_parallel_heads_decoder'

F32 = jnp.float32


def rms_norm(x, g):
    xf = x.astype(F32)
    y = xf * lax.rsqrt(jnp.mean(xf * xf, axis=-1, keepdims=True) + NORM_EPS)
    return (y * g.astype(F32)).astype(x.dtype)


def split_heads(t):
    return t.reshape(t.shape[0], t.shape[1], GROUP_HEADS, HEAD_DIM)


def head_layer_norm(y, w, b, eps):
    mu = jnp.mean(y, axis=-1, keepdims=True)
    var = jnp.mean(jnp.square(y - mu), axis=-1, keepdims=True)
    y = ((y - mu) * lax.rsqrt(var + eps)).reshape(y.shape[0], y.shape[1], -1)
    return y * w.astype(F32) + b.astype(F32)


def head_rms_norm(y, w):
    y = (y * lax.rsqrt(jnp.mean(y * y, axis=-1, keepdims=True) + NORM_EPS)).reshape(y.shape[0], y.shape[1], -1)
    return y * w.astype(F32)


def fox_mixer(q, k, v, f_logit, f_bias):
    B, S, _ = q.shape
    q = split_heads(q).transpose(0, 2, 1, 3)
    k = split_heads(k).transpose(0, 2, 1, 3)
    v = split_heads(v).transpose(0, 2, 1, 3)
    log_f = jax.nn.log_sigmoid(f_logit.astype(F32) + f_bias.astype(F32))
    cum = jnp.cumsum(log_f, axis=1).transpose(0, 2, 1)
    nb = S // Q_BLOCK
    q_blocks = q.reshape(B, GROUP_HEADS, nb, Q_BLOCK, HEAD_DIM).transpose(2, 0, 1, 3, 4)
    c_blocks = cum.reshape(B, GROUP_HEADS, nb, Q_BLOCK).transpose(2, 0, 1, 3)
    q_pos = jnp.arange(S).reshape(nb, Q_BLOCK)
    k_pos = jnp.arange(S)
    scale = HEAD_DIM ** -0.5

    def block(args):
        q_i, c_i, p_i = args
        s = jnp.einsum('bhqd,bhkd->bhqk', q_i, k).astype(F32) * scale
        s = s + c_i[..., :, None] - cum[..., None, :]
        s = jnp.where(k_pos[None, :] <= p_i[:, None], s, -jnp.inf)
        p = jax.nn.softmax(s, axis=-1)
        return jnp.einsum('bhqk,bhkd->bhqd', p.astype(v.dtype), v)

    o = lax.map(block, (q_blocks, c_blocks, q_pos))
    return o.transpose(1, 0, 3, 2, 4).reshape(B, S, GROUP_WIDTH)


def rglru_mixer(xb, yb, conv_w, conv_b, ra_w, ra_b, ri_w, ri_b, lam):
    B, S, W = xb.shape
    xp = jnp.pad(xb, ((0, 0), (CONV_WIDTH - 1, 0), (0, 0)))
    xc = conv_b + xp[:, 0:S] * conv_w[0]
    for j in range(1, CONV_WIDTH):
        xc = xc + xp[:, j:j + S] * conv_w[j]
    xh = split_heads(xc)
    r = jax.nn.sigmoid(jnp.einsum('bshi,hij->bshj', xh, ra_w).reshape(B, S, W) + ra_b)
    i = jax.nn.sigmoid(jnp.einsum('bshi,hij->bshj', xh, ri_w).reshape(B, S, W) + ri_b)
    log_a = LRU_C * r.astype(F32) * jax.nn.log_sigmoid(lam.astype(F32))
    a = jnp.exp(log_a)
    mult = jnp.sqrt(jnp.maximum(-jnp.expm1(2.0 * log_a), 0.0))
    u = mult * (i * xc).astype(F32)

    def combine(left, right):
        a1, b1 = left
        a2, b2 = right
        return a1 * a2, a2 * b1 + b2

    _, h = lax.associative_scan(combine, (a, u), axis=1)
    return (h * jax.nn.gelu(yb.astype(F32))).astype(xb.dtype)


def rwkv7_mixer(slab, v_first, mu, w0, w2, a0, a2, g2, k_k, k_a, r_k, gn_w, gn_b, vres):
    out_dtype = slab.dtype
    s = slab.astype(F32)
    B, S, _ = s.shape
    shifted = jnp.pad(s, ((0, 0), (1, 0), (0, 0)))[:, :-1]
    s = s + (shifted - s) * mu.astype(F32)
    G = GROUP_WIDTH
    r = s[..., 0:G]
    k = s[..., G:2 * G]
    v = s[..., 2 * G:3 * G]
    o = 3 * G
    wd = s[..., o:o + RWKV_W_RANK]
    o = o + RWKV_W_RANK
    ad = s[..., o:o + RWKV_A_RANK]
    o = o + RWKV_A_RANK
    gd = s[..., o:o + RWKV_G_RANK]
    w_log = -jax.nn.softplus(-(w0.astype(F32) + jnp.tanh(wd) @ w2.astype(F32))) - 0.5
    decay = jnp.exp(-jnp.exp(w_log))
    a = jax.nn.sigmoid(a0.astype(F32) + ad @ a2.astype(F32))
    g = jax.nn.sigmoid(gd) @ g2.astype(F32)
    if vres is not None:
        v0, v1, v2 = vres
        v = v + (v_first - v) * jax.nn.sigmoid(v0.astype(F32) + (v @ v1.astype(F32)) @ v2.astype(F32))
    v_out = v
    kk = split_heads(k * k_k.astype(F32))
    kk = kk / jnp.maximum(jnp.sqrt(jnp.sum(kk * kk, axis=-1, keepdims=True)), 1e-12)
    k = k * (1.0 + (a - 1.0) * k_a.astype(F32))
    rh, wh, kh, vh, ah = (split_heads(t) for t in (r, decay, k, v, a))
    a_vec = -kk
    b_vec = kk * ah

    def step(state, inp):
        r_t, w_t, k_t, v_t, a_t, b_t = inp
        sa = jnp.einsum('bhij,bhj->bhi', state, a_t)
        state = state * w_t[:, :, None, :] + sa[..., None] * b_t[:, :, None, :] + v_t[..., None] * k_t[:, :, None, :]
        return state, jnp.einsum('bhij,bhj->bhi', state, r_t)

    xs = tuple(t.transpose(1, 0, 2, 3) for t in (rh, wh, kh, vh, a_vec, b_vec))
    state0 = jnp.zeros((B, GROUP_HEADS, HEAD_DIM, HEAD_DIM), F32)
    _, y = lax.scan(step, state0, xs)
    y = head_layer_norm(y.transpose(1, 0, 2, 3), gn_w, gn_b, RWKV_GN_EPS)
    bonus = jnp.sum(rh * kh * r_k.astype(F32), axis=-1, keepdims=True) * vh
    y = y + bonus.reshape(B, S, G)
    return (y * g).astype(out_dtype), v_out


def rotary(t):
    half = HEAD_DIM // 2
    inv = 1.0 / (RET_THETA ** jnp.linspace(0.0, 1.0, half, dtype=F32))
    ang = jnp.arange(t.shape[2], dtype=F32)[:, None] * inv[None, :]
    cos, sin = jnp.cos(ang), jnp.sin(ang)
    t1, t2 = t[..., :half], t[..., half:]
    return jnp.concatenate([t1 * cos - t2 * sin, t1 * sin + t2 * cos], axis=-1)


def retention_mixer(q, k, v, g, gn_w):
    B, S, _ = q.shape
    H, C = GROUP_HEADS, RET_CHUNK
    nc = S // C
    qh = rotary(split_heads(q).astype(F32).transpose(0, 2, 1, 3))
    kh = rotary(split_heads(k).astype(F32).transpose(0, 2, 1, 3)) * (HEAD_DIM ** -0.5)
    vh = split_heads(v).astype(F32).transpose(0, 2, 1, 3)
    qc = qh.reshape(B, H, nc, C, HEAD_DIM)
    kc = kh.reshape(B, H, nc, C, HEAD_DIM)
    vc = vh.reshape(B, H, nc, C, HEAD_DIM)
    lg = jnp.log(1.0 - 2.0 ** (-5.0 - jnp.arange(H, dtype=F32)))
    n = jnp.arange(C, dtype=F32)
    diff = n[:, None] - n[None, :]
    dmat = jnp.where(diff >= 0, jnp.exp(lg[:, None, None] * jnp.maximum(diff, 0.0)), 0.0)
    inner = jnp.einsum('bhcnd,bhcmd->bhcnm', qc, kc) * dmat[None, :, None]
    intra = jnp.einsum('bhcnm,bhcme->bhcne', inner, vc)
    zeta = jnp.exp(lg[:, None] * (C - 1.0 - n)[None, :])
    kv = jnp.einsum('bhcmd,bhcme->bhcde', kc * zeta[None, :, None, :, None], vc)
    chunk_decay = jnp.exp(lg * C)[None, :, None, None]

    def step(R, kv_c):
        return R * chunk_decay + kv_c, R

    _, r_prev = lax.scan(step, jnp.zeros((B, H, HEAD_DIM, HEAD_DIM), F32), kv.transpose(2, 0, 1, 3, 4))
    xi = jnp.exp(lg[:, None] * (n + 1.0)[None, :])
    cross = jnp.einsum('bhcnd,cbhde->bhcne', qc * xi[None, :, None, :, None], r_prev)
    o = (intra + cross).transpose(0, 2, 3, 1, 4).reshape(B, S, H, HEAD_DIM)
    o = head_rms_norm(o, gn_w)
    return (o * jax.nn.silu(g.astype(F32))).astype(q.dtype)


def cross_attention(xn, memn, wq, wk, wv, wo):
    B, S, _ = xn.shape
    M = memn.shape[1]
    q = (xn @ wq).reshape(B, S, XATTN_HEADS, XATTN_HEAD_DIM)
    k = (memn @ wk).reshape(B, M, XATTN_HEADS, XATTN_HEAD_DIM)
    v = (memn @ wv).reshape(B, M, XATTN_HEADS, XATTN_HEAD_DIM)
    s = jnp.einsum('bshd,bmhd->bhsm', q, k).astype(F32) * (XATTN_HEAD_DIM ** -0.5)
    p = jax.nn.softmax(s, axis=-1)
    o = jnp.einsum('bhsm,bmhd->bshd', p.astype(v.dtype), v).reshape(B, S, D_MODEL)
    return o @ wo


def setup_inputs(seed: int = 0) -> dict:
    key = jax.random.key(seed)
    ks = iter(jax.random.split(key, 64))
    nrm = lambda shape, scale: jax.random.normal(next(ks), shape, F32) * scale
    gain = lambda shape: 1.0 + nrm(shape, 0.05)
    L, D, G, H, N = DEPTH, D_MODEL, GROUP_WIDTH, GROUP_HEADS, HEAD_DIM
    a8 = jax.random.uniform(next(ks), (L, G), F32, minval=0.9, maxval=0.999)
    a_lru = a8 ** (1.0 / LRU_C)
    return {
        'x': nrm((BATCH, SEQ, D), 1.0),
        'mem': nrm((BATCH, MEM_LEN, D), 1.0),
        'norm_mix_pre': gain((L, D)),
        'norm_mix_post': gain((L, D)),
        'norm_xa_pre': gain((L, D)),
        'norm_xa_post': gain((L, D)),
        'norm_mem': gain((L, D)),
        'norm_mlp_pre': gain((L, D)),
        'norm_mlp_post': gain((L, D)),
        'w_in': nrm((L, D, IN_WIDTH), D ** -0.5),
        'w_out': nrm((L, D, D), D ** -0.5),
        'fox_f_bias': 2.0 + nrm((L, H), 0.1),
        'lru_conv_w': nrm((L, CONV_WIDTH, G), CONV_WIDTH ** -0.5),
        'lru_conv_b': nrm((L, G), 0.01),
        'lru_ra_w': nrm((L, H, N, N), N ** -0.5),
        'lru_ra_b': nrm((L, G), 0.01),
        'lru_ri_w': nrm((L, H, N, N), N ** -0.5),
        'lru_ri_b': nrm((L, G), 0.01),
        'lru_lambda': jnp.log(a_lru) - jnp.log1p(-a_lru),
        'rwkv_mu': jax.random.uniform(next(ks), (L, RWKV_WIDTH), F32),
        'rwkv_w0': jnp.linspace(-6.5, -1.5, G, dtype=F32)[None, :] + nrm((L, G), 0.3),
        'rwkv_w2': nrm((L, RWKV_W_RANK, G), RWKV_W_RANK ** -0.5),
        'rwkv_a0': nrm((L, G), 0.1),
        'rwkv_a2': nrm((L, RWKV_A_RANK, G), RWKV_A_RANK ** -0.5),
        'rwkv_g2': nrm((L, RWKV_G_RANK, G), RWKV_G_RANK ** -0.5),
        'rwkv_k_k': 0.85 + nrm((L, G), 0.05),
        'rwkv_k_a': gain((L, G)),
        'rwkv_r_k': nrm((L, H, N), 0.1),
        'rwkv_gn_w': gain((L, G)),
        'rwkv_gn_b': nrm((L, G), 0.01),
        'rwkv_v0': nrm((L - 1, G), 0.1),
        'rwkv_v1': nrm((L - 1, G, RWKV_V_RANK), G ** -0.5),
        'rwkv_v2': nrm((L - 1, RWKV_V_RANK, G), RWKV_V_RANK ** -0.5),
        'ret_gn_w': gain((L, G)),
        'xa_wq': nrm((L, D, D), D ** -0.5),
        'xa_wk': nrm((L, D, D), D ** -0.5),
        'xa_wv': nrm((L, D, D), D ** -0.5),
        'xa_wo': nrm((L, D, D), D ** -0.5),
        'mlp_w1': nrm((L, D, D_FF), D ** -0.5),
        'mlp_w2': nrm((L, D_FF, D), D_FF ** -0.5),
    }


def reference(x, mem, norm_mix_pre, norm_mix_post, norm_xa_pre, norm_xa_post, norm_mem, norm_mlp_pre, norm_mlp_post,
              w_in, w_out, fox_f_bias, lru_conv_w, lru_conv_b, lru_ra_w, lru_ra_b, lru_ri_w, lru_ri_b, lru_lambda,
              rwkv_mu, rwkv_w0, rwkv_w2, rwkv_a0, rwkv_a2, rwkv_g2, rwkv_k_k, rwkv_k_a, rwkv_r_k, rwkv_gn_w, rwkv_gn_b,
              rwkv_v0, rwkv_v1, rwkv_v2, ret_gn_w, xa_wq, xa_wk, xa_wv, xa_wo, mlp_w1, mlp_w2):
    G = GROUP_WIDTH
    v_first = None
    for l in range(DEPTH):
        h = rms_norm(x, norm_mix_pre[l])
        proj = h @ w_in[l]
        fox_out = fox_mixer(proj[..., FOX_OFF:FOX_OFF + G], proj[..., FOX_OFF + G:FOX_OFF + 2 * G],
                            proj[..., FOX_OFF + 2 * G:FOX_OFF + 3 * G], proj[..., FOX_OFF + 3 * G:FOX_OFF + FOX_WIDTH],
                            fox_f_bias[l])
        lru_out = rglru_mixer(proj[..., LRU_OFF:LRU_OFF + G], proj[..., LRU_OFF + G:LRU_OFF + 2 * G],
                              lru_conv_w[l], lru_conv_b[l], lru_ra_w[l], lru_ra_b[l], lru_ri_w[l], lru_ri_b[l],
                              lru_lambda[l])
        vres = None if l == 0 else (rwkv_v0[l - 1], rwkv_v1[l - 1], rwkv_v2[l - 1])
        rwkv_out, v_l = rwkv7_mixer(proj[..., RWKV_OFF:RWKV_OFF + RWKV_WIDTH], v_first, rwkv_mu[l], rwkv_w0[l],
                                    rwkv_w2[l], rwkv_a0[l], rwkv_a2[l], rwkv_g2[l], rwkv_k_k[l], rwkv_k_a[l],
                                    rwkv_r_k[l], rwkv_gn_w[l], rwkv_gn_b[l], vres)
        if l == 0:
            v_first = v_l
        ret_out = retention_mixer(proj[..., RET_OFF:RET_OFF + G], proj[..., RET_OFF + G:RET_OFF + 2 * G],
                                  proj[..., RET_OFF + 2 * G:RET_OFF + 3 * G], proj[..., RET_OFF + 3 * G:RET_OFF + 4 * G],
                                  ret_gn_w[l])
        mixed = jnp.concatenate([fox_out, lru_out, rwkv_out, ret_out], axis=-1) @ w_out[l]
        x = x + rms_norm(mixed, norm_mix_post[l])
        xa = cross_attention(rms_norm(x, norm_xa_pre[l]), rms_norm(mem, norm_mem[l]),
                             xa_wq[l], xa_wk[l], xa_wv[l], xa_wo[l])
        x = x + rms_norm(xa, norm_xa_post[l])
        hid = jnp.square(jax.nn.relu(rms_norm(x, norm_mlp_pre[l]) @ mlp_w1[l]))
        x = x + rms_norm(hid @ mlp_w2[l], norm_mlp_post[l])
    return x
```

```cpp
#include <hip/hip_runtime.h>
#include <cstdint>
#include <cmath>

constexpr int D = 1024, BATCH = 4, SEQ = 4096, DEPTH = 2, T = BATCH * SEQ;
constexpr int MEM = 256, TM = BATCH * MEM;
constexpr int G = 256, HD = 64, GH = 4;
constexpr int FOX_OFF = 0, LRU_OFF = 772, RWKV_OFF = 1284, RET_OFF = 2308, INW = 3332;
constexpr int DFF = 4096;
constexpr float EPS = 1e-6f;

__device__ __forceinline__ float wave_sum(float v) {
#pragma unroll
  for (int o = 1; o < 64; o <<= 1) v += __shfl_xor(v, o);
  return v;
}
__device__ __forceinline__ float sigmoidf_(float x) { return 1.f / (1.f + __expf(-x)); }
__device__ __forceinline__ float log_sigmoidf_(float x) { return fminf(x, 0.f) - log1pf(__expf(-fabsf(x))); }
__device__ __forceinline__ float softplusf_(float x) { return fmaxf(x, 0.f) + log1pf(__expf(-fabsf(x))); }
__device__ __forceinline__ float gelu_tanh(float x) { return 0.5f * x * (1.f + tanhf(0.7978845608028654f * (x + 0.044715f * x * x * x))); }

__global__ void __launch_bounds__(256) k_norm(const float* __restrict__ y, const float* __restrict__ g, const float* base, float* out, int rows) {
  int row = blockIdx.x * 4 + (threadIdx.x >> 6), lane = threadIdx.x & 63;
  if (row >= rows) return;
  const float4* yr = (const float4*)(y + (size_t)row * D);
  float4 v[4]; float s = 0.f;
#pragma unroll
  for (int j = 0; j < 4; ++j) { v[j] = yr[lane + 64 * j]; s += v[j].x * v[j].x + v[j].y * v[j].y + v[j].z * v[j].z + v[j].w * v[j].w; }
  s = wave_sum(s);
  float rs = rsqrtf(s * (1.f / D) + EPS);
#pragma unroll
  for (int j = 0; j < 4; ++j) {
    float4 gg = ((const float4*)g)[lane + 64 * j];
    float4 o = {v[j].x * rs * gg.x, v[j].y * rs * gg.y, v[j].z * rs * gg.z, v[j].w * rs * gg.w};
    if (base) { float4 b = ((const float4*)(base + (size_t)row * D))[lane + 64 * j]; o.x += b.x; o.y += b.y; o.z += b.z; o.w += b.w; }
    ((float4*)(out + (size_t)row * D))[lane + 64 * j] = o;
  }
}

struct GemmP { const float* A; const float* B; float* C; int M, N, K, lda, ldbk, ldbn, ldc; long sA1, sA2, sB1, sB2, sC1, sC2; int nb2, act; float scale; int pad; };
__global__ void __launch_bounds__(256) k_gemm(GemmP p) {
  __shared__ float As[16][65], Bs[16][65];
  int z = blockIdx.z, z1 = z / p.nb2, z2 = z % p.nb2;
  const float* A = p.A + z1 * p.sA1 + z2 * p.sA2; const float* B = p.B + z1 * p.sB1 + z2 * p.sB2; float* C = p.C + z1 * p.sC1 + z2 * p.sC2;
  int m0 = blockIdx.y * 64, n0 = blockIdx.x * 64, tx = threadIdx.x & 15, ty = threadIdx.x >> 4;
  float acc[4][4] = {};
  for (int k0 = 0; k0 < p.K; k0 += 16) {
    for (int e = threadIdx.x; e < 1024; e += 256) {
      int kk = e & 15, mm = e >> 4; int m = m0 + mm;
      As[kk][mm] = (m < p.M) ? A[(size_t)m * p.lda + k0 + kk] : 0.f;
    }
    if (p.ldbn == 1) { for (int e = threadIdx.x; e < 1024; e += 256) { int nn = e & 63, kk = e >> 6; int n = n0 + nn; Bs[kk][nn] = (n < p.N) ? B[(size_t)(k0 + kk) * p.ldbk + n] : 0.f; } }
    else { for (int e = threadIdx.x; e < 1024; e += 256) { int kk = e & 15, nn = e >> 4; int n = n0 + nn; Bs[kk][nn] = (n < p.N) ? B[(size_t)(k0 + kk) * p.ldbk + (size_t)n * p.ldbn] : 0.f; } }
    __syncthreads();
#pragma unroll
    for (int kk = 0; kk < 16; ++kk) {
      float a[4], b[4];
#pragma unroll
      for (int i = 0; i < 4; ++i) { a[i] = As[kk][ty * 4 + i]; b[i] = Bs[kk][tx * 4 + i]; }
#pragma unroll
      for (int i = 0; i < 4; ++i)
#pragma unroll
        for (int j = 0; j < 4; ++j) acc[i][j] += a[i] * b[j];
    }
    __syncthreads();
  }
#pragma unroll
  for (int i = 0; i < 4; ++i)
#pragma unroll
    for (int j = 0; j < 4; ++j) {
      int m = m0 + ty * 4 + i, n = n0 + tx * 4 + j;
      if (m < p.M && n < p.N) { float v = acc[i][j] * p.scale; if (p.act == 1) { v = fmaxf(v, 0.f); v = v * v; } C[(size_t)m * p.ldc + n] = v; }
    }
}

__global__ void k_fox_cum(const float* __restrict__ proj, const float* __restrict__ fbias, float* cum) {
  int bh = blockIdx.x, b = bh / GH, h = bh % GH;
  if (threadIdx.x != 0) return;
  float c = 0.f; float fb = fbias[h];
  for (int t = 0; t < SEQ; ++t) { c += log_sigmoidf_(proj[(size_t)(b * SEQ + t) * INW + FOX_OFF + 3 * G + h] + fb); cum[(size_t)bh * SEQ + t] = c; }
}
template <int MODE> __global__ void __launch_bounds__(64) k_attn_naive(const float* __restrict__ Q, const float* __restrict__ K, const float* __restrict__ V, int ld, int ldv, const float* __restrict__ cum, float* out, int ldo) {
  int idx = blockIdx.x * 64 + threadIdx.x; int q = idx % SEQ, bh = idx / SEQ, b = bh / GH, h = bh % GH;
  const float* qr = Q + (size_t)(b * SEQ + q) * ld + h * HD;
  float qv[HD], o[HD];
#pragma unroll
  for (int d = 0; d < HD; ++d) { qv[d] = qr[d]; o[d] = 0.f; }
  float m = -INFINITY, l = 0.f, cq = MODE == 0 ? cum[(size_t)bh * SEQ + q] : 0.f;
  float lg2 = MODE == 1 ? log2f(1.f - exp2f(-5.f - (float)h)) : 0.f;
  int qmax = __shfl(q, 63);
  for (int k = 0; k <= qmax; ++k) {
    const float* kr = K + (size_t)(b * SEQ + k) * ld + h * HD; const float* vr = V + (size_t)(b * SEQ + k) * ldv + h * HD;
    float s = 0.f;
#pragma unroll
    for (int d = 0; d < HD; ++d) s += qv[d] * kr[d];
    if (MODE == 0) {
      s = s * 0.125f + cq - cum[(size_t)bh * SEQ + k];
      if (k > q) s = -INFINITY;
      float mn = fmaxf(m, s); float f = (mn == -INFINITY) ? 1.f : __expf(m - mn); float pp = (s == -INFINITY) ? 0.f : __expf(s - mn);
      l = l * f + pp; m = mn;
#pragma unroll
      for (int d = 0; d < HD; ++d) o[d] = o[d] * f + pp * vr[d];
    } else {
      float w = (k <= q) ? s * exp2f(lg2 * (float)(q - k)) : 0.f;
#pragma unroll
      for (int d = 0; d < HD; ++d) o[d] += w * vr[d];
    }
  }
  float inv = MODE == 0 ? 1.f / l : 1.f;
  float* orow = out + (size_t)(b * SEQ + q) * ldo + h * HD;
#pragma unroll
  for (int d = 0; d < HD; ++d) orow[d] = o[d] * inv;
}

__global__ void __launch_bounds__(256) k_lru_prep(const float* __restrict__ proj, const float* cw, const float* cb, const float* raw, const float* rab, const float* riw, const float* rib, const float* lam, float* A, float* U) {
  __shared__ float xc[G];
  int t = blockIdx.x, c = threadIdx.x, s = t % SEQ;
  float v = cb[c];
#pragma unroll
  for (int j = 0; j < 4; ++j) { int ss = s - 3 + j; if (ss >= 0) v += proj[(size_t)(t - 3 + j) * INW + LRU_OFF + c] * cw[j * G + c]; }
  xc[c] = v; __syncthreads();
  int h = c >> 6, jj = c & 63; float r = rab[c], i = rib[c];
  for (int k = 0; k < 64; ++k) { float xv = xc[h * 64 + k]; r += xv * raw[(h * 64 + k) * 64 + jj]; i += xv * riw[(h * 64 + k) * 64 + jj]; }
  r = sigmoidf_(r); i = sigmoidf_(i);
  float log_a = 8.f * r * log_sigmoidf_(lam[c]);
  float a = __expf(log_a), mult = sqrtf(fmaxf(-expm1f(2.f * log_a), 0.f));
  A[(size_t)t * G + c] = a; U[(size_t)t * G + c] = mult * (i * v);
}
__global__ void __launch_bounds__(64) k_lru_scan(const float* __restrict__ proj, const float* __restrict__ A, const float* __restrict__ U, float* mix) {
  int idx = blockIdx.x * 64 + threadIdx.x, b = idx / G, c = idx % G; float h = 0.f;
  for (int s = 0; s < SEQ; ++s) { size_t t = (size_t)b * SEQ + s; h = A[t * G + c] * h + U[t * G + c]; mix[t * D + G + c] = h * gelu_tanh(proj[t * INW + LRU_OFF + G + c]); }
}

struct RwkvP { const float* proj; const float *mu, *w0, *w2, *a0, *a2, *g2, *k_k, *k_a, *r_k, *v0, *v1, *v2; float *R, *W, *Kk, *Vv, *Av, *Bv, *Gg, *vfirst; int layer; int pad; };
__global__ void __launch_bounds__(256) k_rwkv_prep(RwkvP p) {
  __shared__ float s[1024]; __shared__ float tmp[256]; __shared__ float red[4]; __shared__ float vv1[32];
  int t = blockIdx.x, c = threadIdx.x, sq = t % SEQ;
  for (int e = c; e < 1024; e += 256) { float cur = p.proj[(size_t)t * INW + RWKV_OFF + e]; float prev = sq > 0 ? p.proj[(size_t)(t - 1) * INW + RWKV_OFF + e] : 0.f; s[e] = cur + (prev - cur) * p.mu[e]; }
  __syncthreads();
  float r = s[c], k = s[G + c], v = s[2 * G + c];
  float wacc = p.w0[c], aacc = p.a0[c], gacc = 0.f;
  for (int j = 0; j < 64; ++j) { wacc += tanhf(s[768 + j]) * p.w2[j * G + c]; aacc += s[832 + j] * p.a2[j * G + c]; }
  for (int j = 0; j < 128; ++j) gacc += sigmoidf_(s[896 + j]) * p.g2[j * G + c];
  float w_log = -softplusf_(-wacc) - 0.5f; float decay = __expf(-__expf(w_log));
  float a = sigmoidf_(aacc);
  if (p.layer > 0) {
    if (c < 32) { float acc = 0.f; for (int j = 0; j < 256; ++j) acc += s[2 * G + j] * p.v1[j * 32 + c]; vv1[c] = acc; }
    __syncthreads();
    float acc = p.v0[c]; for (int j = 0; j < 32; ++j) acc += vv1[j] * p.v2[j * G + c];
    float vf = p.vfirst[(size_t)t * G + c];
    v = v + (vf - v) * sigmoidf_(acc);
  } else p.vfirst[(size_t)t * G + c] = v;
  float kk = k * p.k_k[c];
  float sq2 = wave_sum(kk * kk);
  kk = kk / fmaxf(sqrtf(sq2), 1e-12f);
  k = k * (1.f + (a - 1.f) * p.k_a[c]);
  size_t o = (size_t)t * G + c;
  p.R[o] = r; p.W[o] = decay; p.Kk[o] = k; p.Vv[o] = v; p.Av[o] = -kk; p.Bv[o] = kk * a; p.Gg[o] = gacc;
}
__global__ void __launch_bounds__(64) k_rwkv_scan(const float* __restrict__ R, const float* __restrict__ W, const float* __restrict__ Kk, const float* __restrict__ Vv, const float* __restrict__ Av, const float* __restrict__ Bv, float* Y) {
  int bh = blockIdx.x, b = bh / GH, h = bh % GH, i = threadIdx.x;
  float st[64];
#pragma unroll
  for (int j = 0; j < 64; ++j) st[j] = 0.f;
  for (int s = 0; s < SEQ; ++s) {
    size_t o = ((size_t)b * SEQ + s) * G + h * HD;
    float vi = Vv[o + i];
    float sa = 0.f;
#pragma unroll
    for (int j = 0; j < 64; ++j) sa += st[j] * Av[o + j];
    float y = 0.f;
#pragma unroll
    for (int j = 0; j < 64; ++j) { st[j] = st[j] * W[o + j] + sa * Bv[o + j] + vi * Kk[o + j]; y += st[j] * R[o + j]; }
    Y[o + i] = y;
  }
}
__global__ void __launch_bounds__(256) k_rwkv_post(const float* __restrict__ Y, const float* __restrict__ R, const float* __restrict__ Kk, const float* __restrict__ Vv, const float* __restrict__ Gg, const float* r_k, const float* gn_w, const float* gn_b, float* mix) {
  int t = blockIdx.x, c = threadIdx.x; size_t o = (size_t)t * G + c;
  float y = Y[o]; float mu = wave_sum(y) * (1.f / 64.f); float d = y - mu; float var = wave_sum(d * d) * (1.f / 64.f);
  float yn = d * rsqrtf(var + 64e-5f) * gn_w[c] + gn_b[c];
  float bon = wave_sum(R[o] * Kk[o] * r_k[c]) * Vv[o];
  mix[(size_t)t * D + 2 * G + c] = (yn + bon) * Gg[o];
}

__global__ void __launch_bounds__(256) k_ret_rot(const float* __restrict__ proj, float* RQ, float* RK) {
  int t = blockIdx.x, c = threadIdx.x, pos = t % SEQ, h = c >> 6, d = c & 63, i = d & 31;
  float inv = 1.f / powf(10000.f, (float)i / 31.f); float ang = (float)pos * inv; float cs = cosf(ang), sn = sinf(ang);
  const float* q = proj + (size_t)t * INW + RET_OFF + h * 64; const float* k = q + G;
  float q1 = q[i], q2 = q[i + 32], k1 = k[i], k2 = k[i + 32];
  float qo = d < 32 ? q1 * cs - q2 * sn : q1 * sn + q2 * cs; float ko = d < 32 ? k1 * cs - k2 * sn : k1 * sn + k2 * cs;
  RQ[(size_t)t * G + c] = qo; RK[(size_t)t * G + c] = ko * 0.125f;
}
__global__ void __launch_bounds__(256) k_ret_post(const float* __restrict__ O, const float* __restrict__ proj, const float* gn_w, float* mix) {
  int t = blockIdx.x, c = threadIdx.x; float o = O[(size_t)t * G + c];
  float ss = wave_sum(o * o) * (1.f / 64.f); float on = o * rsqrtf(ss + EPS) * gn_w[c];
  float g = proj[(size_t)t * INW + RET_OFF + 3 * G + c];
  mix[(size_t)t * D + 3 * G + c] = on * (g * sigmoidf_(g));
}
__global__ void __launch_bounds__(256) k_softmax256(float* S, int rows) {
  int row = blockIdx.x * 4 + (threadIdx.x >> 6), lane = threadIdx.x & 63; if (row >= rows) return;
  float4 v = ((float4*)(S + (size_t)row * 256))[lane];
  float m = fmaxf(fmaxf(v.x, v.y), fmaxf(v.z, v.w));
#pragma unroll
  for (int o = 1; o < 64; o <<= 1) m = fmaxf(m, __shfl_xor(m, o));
  v.x = __expf(v.x - m); v.y = __expf(v.y - m); v.z = __expf(v.z - m); v.w = __expf(v.w - m);
  float s = wave_sum(v.x + v.y + v.z + v.w); float inv = 1.f / s;
  v.x *= inv; v.y *= inv; v.z *= inv; v.w *= inv;
  ((float4*)(S + (size_t)row * 256))[lane] = v;
}

static void gemm(hipStream_t st, const float* A, const float* B, float* C, int M, int N, int K, int lda, int ldbk, int ldbn, int ldc, int act = 0, float scale = 1.f,
                 int nb1 = 1, int nb2 = 1, long sA1 = 0, long sA2 = 0, long sB1 = 0, long sB2 = 0, long sC1 = 0, long sC2 = 0) {
  GemmP p{}; p.A = A; p.B = B; p.C = C; p.M = M; p.N = N; p.K = K; p.lda = lda; p.ldbk = ldbk; p.ldbn = ldbn; p.ldc = ldc;
  p.sA1 = sA1; p.sA2 = sA2; p.sB1 = sB1; p.sB2 = sB2; p.sC1 = sC1; p.sC2 = sC2; p.nb2 = nb2; p.act = act; p.scale = scale; p.pad = 0;
  hipLaunchKernelGGL(k_gemm, dim3((N + 63) / 64, (M + 63) / 64, nb1 * nb2), dim3(256), 0, st, p);
}

extern "C" void kernel_launch(void* const* d_in, const int* in_sizes, int n_in, void* d_out, int out_size, void* d_ws, size_t ws_size, hipStream_t stream) {
  const float* const* in = (const float* const*)d_in;
  float* ws = (float*)d_ws; size_t off = 0;
  auto alloc = [&](size_t n) { float* p = ws + off; off += (n + 63) & ~(size_t)63; return p; };
  float* hbuf = alloc((size_t)SEQ * D); float* proj = alloc((size_t)SEQ * INW); float* mix = alloc((size_t)SEQ * D); float* tmp = alloc((size_t)SEQ * D);
  float* memn = alloc((size_t)MEM * D); float* km = alloc((size_t)MEM * D); float* vm = alloc((size_t)MEM * D);
  float* cum = alloc((size_t)GH * SEQ);
  float* bufs[12]; for (int i = 0; i < 12; ++i) bufs[i] = alloc((size_t)SEQ * G);
  float* vfirst_all = alloc((size_t)T * G);
  float* big = alloc((size_t)2048 * DFF);
  float* xout = (float*)d_out;
  for (int l = 0; l < DEPTH; ++l) for (int b = 0; b < BATCH; ++b) {
    const float* xcur = (l == 0 ? in[0] : (const float*)xout) + (size_t)b * SEQ * D;
    float* xo = xout + (size_t)b * SEQ * D;
    float* vfirst = vfirst_all + (size_t)b * SEQ * G;
    const float* w_in = in[9] + (size_t)l * D * INW;
    hipLaunchKernelGGL(k_norm, dim3(SEQ / 4), dim3(256), 0, stream, xcur, in[2] + l * D, (const float*)nullptr, hbuf, SEQ);
    gemm(stream, hbuf, w_in, proj, SEQ, INW, D, D, INW, 1, INW);
    hipLaunchKernelGGL(k_fox_cum, dim3(GH), dim3(64), 0, stream, proj, in[11] + l * GH, cum);
    hipLaunchKernelGGL(k_attn_naive<0>, dim3(GH * SEQ / 64), dim3(64), 0, stream, proj + FOX_OFF, proj + FOX_OFF + G, proj + FOX_OFF + 2 * G, INW, INW, cum, mix, D);
    hipLaunchKernelGGL(k_lru_prep, dim3(SEQ), dim3(256), 0, stream, proj, in[12] + l * 4 * G, in[13] + l * G, in[14] + l * GH * HD * HD, in[15] + l * G, in[16] + l * GH * HD * HD, in[17] + l * G, in[18] + l * G, bufs[0], bufs[1]);
    hipLaunchKernelGGL(k_lru_scan, dim3(G / 64), dim3(64), 0, stream, proj, bufs[0], bufs[1], mix);
    RwkvP rp{}; rp.proj = proj; rp.mu = in[19] + l * 1024; rp.w0 = in[20] + l * G; rp.w2 = in[21] + l * 64 * G; rp.a0 = in[22] + l * G; rp.a2 = in[23] + l * 64 * G; rp.g2 = in[24] + l * 128 * G;
    rp.k_k = in[25] + l * G; rp.k_a = in[26] + l * G; rp.r_k = in[27] + l * G; rp.v0 = in[30] + (l > 0 ? (l - 1) * G : 0); rp.v1 = in[31] + (l > 0 ? (l - 1) * G * 32 : 0); rp.v2 = in[32] + (l > 0 ? (l - 1) * 32 * G : 0);
    rp.R = bufs[2]; rp.W = bufs[3]; rp.Kk = bufs[4]; rp.Vv = bufs[5]; rp.Av = bufs[6]; rp.Bv = bufs[7]; rp.Gg = bufs[8]; rp.vfirst = vfirst; rp.layer = l; rp.pad = 0;
    hipLaunchKernelGGL(k_rwkv_prep, dim3(SEQ), dim3(256), 0, stream, rp);
    hipLaunchKernelGGL(k_rwkv_scan, dim3(GH), dim3(64), 0, stream, bufs[2], bufs[3], bufs[4], bufs[5], bufs[6], bufs[7], bufs[9]);
    hipLaunchKernelGGL(k_rwkv_post, dim3(SEQ), dim3(256), 0, stream, bufs[9], bufs[2], bufs[4], bufs[5], bufs[8], in[27] + l * G, in[28] + l * G, in[29] + l * G, mix);
    hipLaunchKernelGGL(k_ret_rot, dim3(SEQ), dim3(256), 0, stream, proj, bufs[10], bufs[11]);
    hipLaunchKernelGGL(k_attn_naive<1>, dim3(GH * SEQ / 64), dim3(64), 0, stream, bufs[10], bufs[11], proj + RET_OFF + 2 * G, G, INW, (const float*)nullptr, bufs[0], G);
    hipLaunchKernelGGL(k_ret_post, dim3(SEQ), dim3(256), 0, stream, bufs[0], proj, in[33] + l * G, mix);
    gemm(stream, mix, in[10] + (size_t)l * D * D, tmp, SEQ, D, D, D, D, 1, D);
    hipLaunchKernelGGL(k_norm, dim3(SEQ / 4), dim3(256), 0, stream, tmp, in[3] + l * D, xcur, xo, SEQ);
    hipLaunchKernelGGL(k_norm, dim3(SEQ / 4), dim3(256), 0, stream, xo, in[4] + l * D, (const float*)nullptr, hbuf, SEQ);
    hipLaunchKernelGGL(k_norm, dim3(MEM / 4), dim3(256), 0, stream, in[1] + (size_t)b * MEM * D, in[6] + l * D, (const float*)nullptr, memn, MEM);
    gemm(stream, hbuf, in[34] + (size_t)l * D * D, tmp, SEQ, D, D, D, D, 1, D);
    gemm(stream, memn, in[35] + (size_t)l * D * D, km, MEM, D, D, D, D, 1, D);
    gemm(stream, memn, in[36] + (size_t)l * D * D, vm, MEM, D, D, D, D, 1, D);
    gemm(stream, tmp, km, big, SEQ, MEM, 256, D, 1, D, MEM, 0, 1.f / 16.f, 1, 4, 0, 256, 0, 256, 0, (long)SEQ * MEM);
    hipLaunchKernelGGL(k_softmax256, dim3(4 * SEQ / 4), dim3(256), 0, stream, big, 4 * SEQ);
    gemm(stream, big, vm, mix, SEQ, 256, MEM, MEM, D, 1, D, 0, 1.f, 1, 4, 0, (long)SEQ * MEM, 0, 256, 0, 256);
    gemm(stream, mix, in[37] + (size_t)l * D * D, tmp, SEQ, D, D, D, D, 1, D);
    hipLaunchKernelGGL(k_norm, dim3(SEQ / 4), dim3(256), 0, stream, tmp, in[5] + l * D, (const float*)xo, xo, SEQ);
    hipLaunchKernelGGL(k_norm, dim3(SEQ / 4), dim3(256), 0, stream, xo, in[7] + l * D, (const float*)nullptr, hbuf, SEQ);
    for (int c = 0; c < 2; ++c) {
      gemm(stream, hbuf + (size_t)c * 2048 * D, in[38] + (size_t)l * D * DFF, big, 2048, DFF, D, D, DFF, 1, DFF, 1);
      gemm(stream, big, in[39] + (size_t)l * DFF * D, tmp + (size_t)c * 2048 * D, 2048, D, DFF, DFF, D, 1, D);
    }
    hipLaunchKernelGGL(k_norm, dim3(SEQ / 4), dim3(256), 0, stream, tmp, in[8] + l * D, (const float*)xo, xo, SEQ);
  }
}
```

```cpp
#define DEBUG_LAUNCHES 0
#include <hip/hip_runtime.h>
#include <hip/hip_cooperative_groups.h>
#include <cstdio>
#include <cstdint>
#include <cmath>
namespace cg = cooperative_groups;
namespace pg8 {
#define PG8_LAS __attribute__((address_space(3)))
typedef unsigned short bf16_t;
typedef short bf16x8 __attribute__((ext_vector_type(8)));
typedef float f32x4 __attribute__((ext_vector_type(4)));
typedef unsigned u32x4 __attribute__((ext_vector_type(4)));
constexpr int BM = 256, BK = 64, HALF = 128, HTB = HALF * BK * 2  , STAGE_BYTES = 8 * HTB, NXCD = 8, WGM = 8;

__host__ __device__ __forceinline__ int lds_byte(int r, int c) { const int st = (r >> 4) * 2 + (c >> 5), rr = r & 15, cc = c & 31, ob = rr * 64 + cc * 2; return st * 1024 + (ob ^ (((ob >> 9) & 1) << 5)); }
__host__ __device__ __forceinline__ void stage_rc(int b, int& R, int& C) { const int st = b / 1024, sb = b % 1024, swz = sb ^ (((sb >> 9) & 1) << 5); R = (st >> 1) * 16 + swz / 64; C = (st & 1) * 32 + (swz % 64) / 2; }
__host__ __device__ __forceinline__ int perm32(int rho) { const int n = rho >> 4, i = rho & 15; return 8 * (i >> 2) + 4 * n + (i & 3); }

struct Unit { int pm, pn; };
struct Gemm { const bf16_t* A; const bf16_t* Bt; int M, N, K, lda; };

struct StaticOrder {
    int nM, nN, nwg, G, c;
    __host__ __device__ void init(int M, int N, int G_, int c_) { nM = M / BM; nN = N / BM; nwg = nM * nN; G = G_; c = c_; }
    __host__ __device__ bool next(int i, Unit& u) const {
        const long L = (long)i * G + c; if (L >= nwg) return false;
        int wgid = (int)L; { const int q = nwg / NXCD, r = nwg % NXCD, xcd = wgid % NXCD, off = wgid / NXCD; wgid = (xcd < r ? xcd * (q + 1) : r * (q + 1) + (xcd - r) * q) + off; }
        const int nig = WGM * nN, gid = wgid / nig, fm = gid * WGM, gsz = (nM - fm) < WGM ? (nM - fm) : WGM;
        u.pm = fm + ((wgid % nig) % gsz); u.pn = (wgid % nig) / gsz; return true;
    }
    __device__ __forceinline__ void a_ready(const Unit&) const {}
    __device__ __forceinline__ void done(const Unit&) const {}
};

__device__ __forceinline__ unsigned cvt_pk_bf16(float lo, float hi) { unsigned r; asm volatile("v_cvt_pk_bf16_f32 %0, %1, %2" : "=v"(r) : "v"(lo), "v"(hi)); return r; }
typedef float f32x2 __attribute__((ext_vector_type(2)));
template <class Epi, class Sched, bool ALIGN_EPI = false, bool SP2 = false>
__device__ __forceinline__ void gemm_phase(PG8_LAS unsigned char* lds, const Gemm g, const Sched& S, const Epi& E) {
    int tid_l = threadIdx.x; asm volatile("" : "+v"(tid_l));
    const int tid = tid_l, wid = __builtin_amdgcn_readfirstlane(tid >> 6), lane = tid & 63, wr = wid >> 2, wc = wid & 3, fr = lane & 15, fq = lane >> 4;
    const int K = g.K, nt = K / BK;
    unsigned voffA[2], voffB[2];
#pragma unroll
    for (int i = 0; i < 2; ++i) { int R, C; stage_rc(tid * 16 + i * 8192, R, C); const int Rb = Epi::PERM ? ((R & ~31) + perm32(R & 31)) : R;
        voffA[i] = (unsigned)(R * g.lda + C) * 2u; voffB[i] = (unsigned)(Rb * K + C) * 2u; }
    const size_t kstep = (size_t)(BK * 2);
    const size_t hstep = (size_t)HALF * K * 2;
    const size_t tstep = 2 * hstep; const size_t hstepA = (size_t)HALF * g.lda * 2; const size_t tstepA = 2 * hstepA;
    const unsigned ldsw = (unsigned)wid * 1024u;
    const int aoff = lds_byte(wr * 64 + fr, fq * 8), boff = lds_byte(wc * 32 + fr, fq * 8);
#define PG8_SA(b, h) (((b) * 2 + (h)) * HTB)
#define PG8_SB(b, h) ((4 + (b) * 2 + (h)) * HTB)
#define PG8_STAGE(bufoff, gbase, voff) do { _Pragma("unroll") for (int _i = 0; _i < 2; ++_i) \
        __builtin_amdgcn_global_load_lds((const unsigned*)((const char*)(gbase) + (voff)[_i]), (PG8_LAS unsigned*)(lds + (bufoff) + ldsw + _i * 8192), 16, 0, 0); } while (0)
#define PG8_LDA(dst, b, h) do { _Pragma("unroll") for (int m = 0; m < 4; ++m) _Pragma("unroll") for (int k = 0; k < 2; ++k) dst[m][k] = *(const PG8_LAS bf16x8*)(lds + PG8_SA(b, h) + aoff + m * 2048 + k * 1024); } while (0)
#define PG8_LDB(dst, b, h) do { _Pragma("unroll") for (int n = 0; n < 2; ++n) _Pragma("unroll") for (int k = 0; k < 2; ++k) dst[n][k] = *(const PG8_LAS bf16x8*)(lds + PG8_SB(b, h) + boff + n * 2048 + k * 1024); } while (0)
#define PG8_MMA(ai, bj, At, Bt) do { __builtin_amdgcn_s_setprio(1); _Pragma("unroll") for (int m = 0; m < 4; ++m) _Pragma("unroll") for (int n = 0; n < 2; ++n) _Pragma("unroll") for (int k = 0; k < 2; ++k) \
        acc[ai][bj][m][n] = __builtin_amdgcn_mfma_f32_16x16x32_bf16(Bt[n][k], At[m][k], acc[ai][bj][m][n], 0, 0, 0); __builtin_amdgcn_s_setprio(0); } while (0)
#define PG8_WAIT_V(n) asm volatile("s_waitcnt vmcnt(" #n ")" ::: "memory")
#define PG8_WAIT_L(n) asm volatile("s_waitcnt lgkmcnt(" #n ")" ::: "memory")
#define PG8_BAR __builtin_amdgcn_s_barrier()
#define PG8_SCHED __builtin_amdgcn_sched_barrier(0)
    Unit cur, nxt; int ui = 0;
    if (!S.next(0, cur)) return;
    f32x4 acc[2][2][4][2];
#pragma unroll
    for (int a = 0; a < 2; ++a)
#pragma unroll
        for (int b = 0; b < 2; ++b)
#pragma unroll
            for (int m = 0; m < 4; ++m)
#pragma unroll
                for (int n = 0; n < 2; ++n) acc[a][b][m][n] = (f32x4){0.f, 0.f, 0.f, 0.f};
    bf16x8 At[4][2], B0[2][2], B1[2][2];
    const char* cA = (const char*)g.A + (size_t)cur.pm * tstepA; const char* cB = (const char*)g.Bt + (size_t)cur.pn * tstep;
    S.a_ready(cur);
    if constexpr (SP2) {
        PG8_STAGE(PG8_SB(0, 0), cB, voffB); PG8_STAGE(PG8_SB(0, 1), cB + hstep, voffB); PG8_STAGE(PG8_SA(0, 0), cA, voffA); PG8_STAGE(PG8_SA(0, 1), cA + hstepA, voffA);
        if (wr == 1) PG8_BAR;
        PG8_WAIT_V(2); PG8_BAR;
        PG8_STAGE(PG8_SB(1, 0), cB + kstep, voffB); PG8_STAGE(PG8_SA(1, 0), cA + kstep, voffA); PG8_STAGE(PG8_SB(1, 1), cB + hstep + kstep, voffB);
        PG8_WAIT_V(6); PG8_BAR;
    } else {
        PG8_STAGE(PG8_SB(0, 0), cB, voffB); PG8_STAGE(PG8_SA(0, 0), cA, voffA); PG8_STAGE(PG8_SB(0, 1), cB + hstep, voffB); PG8_STAGE(PG8_SA(0, 1), cA + hstepA, voffA);
        if (wr == 1) PG8_BAR;
        PG8_WAIT_V(4); PG8_BAR;
        PG8_STAGE(PG8_SB(1, 0), cB + kstep, voffB); PG8_STAGE(PG8_SA(1, 0), cA + kstep, voffA); PG8_STAGE(PG8_SB(1, 1), cB + hstep + kstep, voffB);
        PG8_WAIT_V(6); PG8_BAR;
    }
    for (;;) {
        const bool has_next = S.next(ui + 1, nxt);
        const char* nA = has_next ? (const char*)g.A + (size_t)nxt.pm * tstepA : cA; const char* nB = has_next ? (const char*)g.Bt + (size_t)nxt.pn * tstep : cB;
        for (int t = 0; t < nt; t += 2) {
            const bool last = (t == nt - 2);
            const char* a1 = cA + (size_t)(t + 1) * kstep;
            const char* a2 = last ? nA : cA + (size_t)(t + 2) * kstep; const char* b2 = last ? nB : cB + (size_t)(t + 2) * kstep;
            const char* a3 = a2 + kstep; const char* b3 = b2 + kstep;
            if (last && has_next) S.a_ready(nxt);
            if constexpr (SP2) {
            PG8_LDB(B0, 0, 0); PG8_LDB(B1, 0, 1); PG8_SCHED; PG8_LDA(At, 0, 0); PG8_STAGE(PG8_SA(1, 1), a1 + hstepA, voffA);
            PG8_WAIT_V(8); PG8_WAIT_L(0); PG8_BAR; PG8_MMA(0, 0, At, B0); PG8_MMA(0, 1, At, B1); PG8_BAR; PG8_SCHED;
            PG8_LDA(At, 0, 1); PG8_STAGE(PG8_SB(0, 0), b2, voffB); PG8_STAGE(PG8_SB(0, 1), b2 + hstep, voffB); PG8_STAGE(PG8_SA(0, 0), a2, voffA);
            PG8_WAIT_V(8); PG8_WAIT_L(0); PG8_BAR; PG8_MMA(1, 0, At, B0); PG8_MMA(1, 1, At, B1); PG8_BAR; PG8_SCHED;
            PG8_LDB(B0, 1, 0); PG8_LDB(B1, 1, 1); PG8_SCHED; PG8_LDA(At, 1, 0); PG8_STAGE(PG8_SA(0, 1), a2 + hstepA, voffA);
            PG8_WAIT_V(8); PG8_WAIT_L(0); PG8_BAR; PG8_MMA(0, 0, At, B0); PG8_MMA(0, 1, At, B1); PG8_BAR; PG8_SCHED;
            PG8_LDA(At, 1, 1); PG8_STAGE(PG8_SB(1, 0), b3, voffB); PG8_STAGE(PG8_SB(1, 1), b3 + hstep, voffB); PG8_STAGE(PG8_SA(1, 0), a3, voffA);
            PG8_WAIT_V(8); PG8_WAIT_L(0); PG8_BAR; PG8_MMA(1, 0, At, B0); PG8_MMA(1, 1, At, B1); PG8_BAR; PG8_SCHED;
            } else {
            PG8_LDB(B0, 0, 0); PG8_SCHED; PG8_LDA(At, 0, 0); PG8_STAGE(PG8_SA(1, 1), a1 + hstepA, voffA);
            PG8_WAIT_L(8); PG8_BAR; PG8_WAIT_L(0); PG8_MMA(0, 0, At, B0); PG8_BAR; PG8_SCHED;
            PG8_LDB(B1, 0, 1); PG8_STAGE(PG8_SB(0, 0), b2, voffB);
            PG8_BAR; PG8_WAIT_L(0); PG8_MMA(0, 1, At, B1); PG8_BAR;
            PG8_LDA(At, 0, 1); PG8_STAGE(PG8_SA(0, 0), a2, voffA);
            PG8_BAR; PG8_WAIT_L(0); PG8_MMA(1, 0, At, B0); PG8_BAR; PG8_SCHED;
            PG8_STAGE(PG8_SB(0, 1), b2 + hstep, voffB);
            PG8_WAIT_V(6); PG8_BAR; PG8_MMA(1, 1, At, B1); PG8_BAR;
            PG8_LDB(B0, 1, 0); PG8_SCHED; PG8_LDA(At, 1, 0); PG8_STAGE(PG8_SA(0, 1), a2 + hstepA, voffA);
            PG8_WAIT_L(8); PG8_BAR; PG8_WAIT_L(0); PG8_MMA(0, 0, At, B0); PG8_BAR; PG8_SCHED;
            PG8_LDB(B1, 1, 1); PG8_STAGE(PG8_SB(1, 0), b3, voffB);
            PG8_BAR; PG8_WAIT_L(0); PG8_MMA(0, 1, At, B1); PG8_BAR;
            PG8_LDA(At, 1, 1); PG8_STAGE(PG8_SA(1, 0), a3, voffA);
            PG8_BAR; PG8_WAIT_L(0); PG8_MMA(1, 0, At, B0); PG8_BAR; PG8_SCHED;
            PG8_STAGE(PG8_SB(1, 1), b3 + hstep, voffB);
            PG8_WAIT_V(6); PG8_BAR; PG8_MMA(1, 1, At, B1); PG8_BAR;
            }
        }
        if constexpr (ALIGN_EPI) { if (wr == 0) PG8_BAR; }
        if constexpr (!Epi::AFTER_DRAIN) { E(acc, cur, wr, wc, fr, fq); S.done(cur); }
        if (!has_next) break;
#pragma unroll
        for (int a = 0; a < 2; ++a)
#pragma unroll
            for (int b = 0; b < 2; ++b)
#pragma unroll
                for (int m = 0; m < 4; ++m)
#pragma unroll
                    for (int n = 0; n < 2; ++n) acc[a][b][m][n] = (f32x4){0.f, 0.f, 0.f, 0.f};
        cur = nxt; cA = nA; cB = nB; ++ui;
        if constexpr (ALIGN_EPI) { if (wr == 1) PG8_BAR; }
    }
    PG8_WAIT_V(0);
    if constexpr (!ALIGN_EPI) { if (wr == 0) PG8_BAR; }
    PG8_BAR;
    if constexpr (Epi::AFTER_DRAIN) { E.fused(acc, cur, wr, wc, fr, fq, lds, wid, lane); S.done(cur); }
#undef PG8_SA
#undef PG8_SB
#undef PG8_STAGE
#undef PG8_LDA
#undef PG8_LDB
#undef PG8_MMA
#undef PG8_WAIT_V
#undef PG8_WAIT_L
#undef PG8_BAR
#undef PG8_SCHED
}
}

typedef unsigned short bf16;
typedef short bf16x8 __attribute__((ext_vector_type(8)));
typedef short bf16x4 __attribute__((ext_vector_type(4)));
typedef float f32x4 __attribute__((ext_vector_type(4)));
typedef float f32x2 __attribute__((ext_vector_type(2)));
typedef unsigned u32x4 __attribute__((ext_vector_type(4)));
typedef unsigned u32x2 __attribute__((ext_vector_type(2)));

constexpr int D = 1024, BATCH = 4, SEQ = 4096, DEPTH = 2, T = BATCH * SEQ;
constexpr int MEM = 256;
constexpr int G = 256, HD = 64, GH = 4;
constexpr int INW = 3332, DFF = 4096;
constexpr float EPS = 1e-6f, LOG2E = 1.4426950408889634f;
constexpr int NTHREADS = 512, NWAVES = 8;
constexpr int PW = 2816;
constexpr int C_FOXQ = 0, C_LRUY = 256, C_RWR = 512, C_RETQ = 768, C_FOXK = 1024, C_LRUX = 1280, C_RWK = 1536, C_RWV = 1792, C_RWX = 2048, C_RETK = 2304, C_RETG = 2560;
constexpr int NIN = 3328;
__device__ __constant__ const int kSrcCol[13] = {0, 1028, 1284, 2308, 256, 772, 1540, 1796, 2052, 2564, 3076, 512, 2820};

constexpr size_t MiB = 1u << 20;
constexpr size_t WS_W = 0;
constexpr size_t W_IN = 0, W_OUT = 7 * MiB, W_Q = 9 * MiB, W_O = 11 * MiB, W_1 = 13 * MiB, W_2 = 21 * MiB, W_SMALL = 29 * MiB;
constexpr size_t WS_W2T = W_SMALL, WS_A2T = WS_W2T + 256 * 64 * 2, WS_G2T = WS_A2T + 256 * 64 * 2, WS_V1T = WS_G2T + 256 * 128 * 2, WS_V2T = WS_V1T + 32 * 256 * 2, WS_RAT = WS_V2T + 256 * 32 * 2, WS_RIT = WS_RAT + 4 * 64 * 64 * 2;
constexpr size_t WS_P = 30 * MiB;
constexpr size_t P_FOXVT = WS_P + 88 * MiB, P_RETKT = WS_P + 96 * MiB, P_RETVT = WS_P + 104 * MiB, P_RETKV = WS_P + 112 * MiB;
constexpr size_t WS_RW = 158 * MiB;
constexpr size_t RW_E = WS_RW, RW_WR = WS_RW + 8 * MiB, RW_A = WS_RW + 16 * MiB, RW_B = WS_RW + 24 * MiB, RW_K = WS_RW + 32 * MiB, RW_V = WS_RW + 40 * MiB, RW_G = WS_P + 120 * MiB  , RW_Y = WS_RW + 56 * MiB;
constexpr size_t WS_O = WS_RW, WS_H = WS_RW + 32 * MiB;
constexpr size_t WS_WKV = WS_RW;
constexpr size_t WS_MEMN = WS_RW + 64 * MiB;
constexpr size_t WS_VF = 230 * MiB;
constexpr size_t WS_KM = 238 * MiB, WS_VMT = 242 * MiB;
constexpr size_t WS_SM = 246 * MiB;
constexpr size_t SM_LOGF = WS_SM, SM_CUM = SM_LOGF + 256 * 1024, SM_BR = SM_CUM + 256 * 1024, SM_KR = SM_BR + 256 * 1024, SM_RK = SM_KR + 256 * 1024,
                 SM_SS = SM_RK + 256 * 1024  , SM_ROT = SM_SS + 256 * 1024  , SM_Q = SM_ROT + MiB  , WS_END = SM_Q + 4096;
static_assert(WS_END <= 256 * MiB, "workspace map");
constexpr int LDS_BYTES = 147456;

__device__ __forceinline__ unsigned f2bf(float f) { unsigned u = __builtin_bit_cast(unsigned, f); return (u + 0x7fffu + ((u >> 16) & 1u)) >> 16; }
typedef __bf16 bf16x2_t __attribute__((ext_vector_type(2)));
__device__ __forceinline__ unsigned pk2(float lo, float hi) { const f32x2 v = {lo, hi}; const bf16x2_t b = __builtin_convertvector(v, bf16x2_t); return __builtin_bit_cast(unsigned, b); }
__device__ __forceinline__ float bflo(unsigned u) { return __builtin_bit_cast(float, u << 16); }
__device__ __forceinline__ float bfhi(unsigned u) { return __builtin_bit_cast(float, u & 0xffff0000u); }
__device__ __forceinline__ void unpack8(u32x4 w, float* f) { f[0] = bflo(w.x); f[1] = bfhi(w.x); f[2] = bflo(w.y); f[3] = bfhi(w.y); f[4] = bflo(w.z); f[5] = bfhi(w.z); f[6] = bflo(w.w); f[7] = bfhi(w.w); }
__device__ __forceinline__ u32x4 pack8(const float* f) { u32x4 w; w.x = pk2(f[0], f[1]); w.y = pk2(f[2], f[3]); w.z = pk2(f[4], f[5]); w.w = pk2(f[6], f[7]); return w; }
__device__ __forceinline__ float wave_sum(float v) {
#pragma unroll
  for (int o = 1; o < 64; o <<= 1) v += __shfl_xor(v, o);
  return v;
}
__device__ __forceinline__ float ex2(float x) { return __builtin_amdgcn_exp2f(x); }
__device__ __forceinline__ float rcpf_(float x) { return __builtin_amdgcn_rcpf(x); }
__device__ __forceinline__ float sigmoidf_(float x) { return rcpf_(1.f + __expf(-x)); }
__device__ __forceinline__ float lse0_(float x) { return __logf(1.f + __expf(-fabsf(x))); }
__device__ __forceinline__ float log_sigmoidf_(float x) { return fminf(x, 0.f) - lse0_(x); }
__device__ __forceinline__ float log_sigmoid_acc(float x) { return fminf(x, 0.f) - log1pf(__expf(-fabsf(x))); }
__device__ __forceinline__ float softplusf_(float x) { return fmaxf(x, 0.f) + lse0_(x); }
__device__ __forceinline__ float tanhf_(float x) { return 1.f - 2.f * rcpf_(1.f + __expf(2.f * x)); }
__device__ __forceinline__ float gelu_tanh(float x) { return 0.5f * x * (1.f + tanhf_(0.7978845608028654f * (x + 0.044715f * x * x * x))); }
#define WAVE_LDS_FENCE() asm volatile("s_waitcnt lgkmcnt(0)" ::: "memory")
#define MFMA16(a, b, c) __builtin_amdgcn_mfma_f32_16x16x32_bf16((a), (b), (c), 0, 0, 0)

struct Params { const float* in[40]; float* out; unsigned char* ws; int ph_lo, ph_hi; };

struct EpiIn {
  static constexpr bool PERM = true, AFTER_DRAIN = false;
  bf16* proj; bf16* foxvT; bf16* retkT; bf16* retvT; const float* rot;
  __device__ __forceinline__ void operator()(const f32x4 (&acc)[2][2][4][2], const pg8::Unit& u, int wr, int wc, int fr, int fq) const {
    const int pn = u.pn;
    const bool rotary = (pn == 3) || (pn == 9);
    const float sc = (pn == 9) ? 0.125f : 1.f;
    bf16* tdst = pn == 9 ? retkT : pn == 11 ? foxvT : pn == 12 ? retvT : nullptr;
    const bool rowmajor = pn <= 10;
#pragma unroll
    for (int ai = 0; ai < 2; ++ai)
#pragma unroll
      for (int m = 0; m < 4; ++m) {
        const int row = u.pm * 256 + ai * 128 + wr * 64 + m * 16 + fr; const int pos = row & (SEQ - 1), b = row >> 12;
#pragma unroll
        for (int bj = 0; bj < 2; ++bj) {
          const int c0 = bj * 128 + wc * 32 + 8 * fq;
          float v[8];
#pragma unroll
          for (int e = 0; e < 4; ++e) { v[e] = acc[ai][bj][m][0][e]; v[4 + e] = acc[ai][bj][m][1][e]; }
          if (rotary) {
            const int i0 = (c0 & 63) >> 1;
            const f32x4 r0 = *(const f32x4*)(rot + ((size_t)pos * 32 + i0) * 2), r1 = *(const f32x4*)(rot + ((size_t)pos * 32 + i0 + 2) * 2);
            const float cs[4] = {r0[0], r0[2], r1[0], r1[2]}, sn[4] = {r0[1], r0[3], r1[1], r1[3]};
#pragma unroll
            for (int p = 0; p < 4; ++p) { const float x1 = v[2 * p], x2 = v[2 * p + 1]; v[2 * p] = x1 * cs[p] - x2 * sn[p]; v[2 * p + 1] = x1 * sn[p] + x2 * cs[p]; }
          }
#pragma unroll
          for (int e = 0; e < 8; ++e) v[e] *= sc;
          const u32x4 w = pack8(v);
          if (rowmajor) *(u32x4*)(proj + (size_t)row * PW + pn * 256 + c0) = w;
          if (tdst) {
            const int hh = c0 >> 6, d0 = c0 & 63; bf16* tp = tdst + ((size_t)((b * 4 + hh) * 64 + d0)) * SEQ + pos;
            const unsigned ww[4] = {w.x, w.y, w.z, w.w};
#pragma unroll
            for (int e = 0; e < 8; ++e) tp[(size_t)e * SEQ] = (bf16)((e & 1) ? (ww[e >> 1] >> 16) : (ww[e >> 1] & 0xffffu));
          }
        }
      }
  }
};
struct EpiPlain {
  static constexpr bool PERM = true, AFTER_DRAIN = false;
  bf16* O; int ldc; int act; float* ss;
  __device__ __forceinline__ void operator()(const f32x4 (&acc)[2][2][4][2], const pg8::Unit& u, int wr, int wc, int fr, int fq) const {
#pragma unroll
    for (int ai = 0; ai < 2; ++ai)
#pragma unroll
      for (int m = 0; m < 4; ++m) {
        const int row = u.pm * 256 + ai * 128 + wr * 64 + m * 16 + fr; float s = 0.f;
#pragma unroll
        for (int bj = 0; bj < 2; ++bj) {
          const int c0 = u.pn * 256 + bj * 128 + wc * 32 + 8 * fq;
          float v[8];
#pragma unroll
          for (int e = 0; e < 4; ++e) { v[e] = acc[ai][bj][m][0][e]; v[4 + e] = acc[ai][bj][m][1][e]; }
          if (act == 1) {
#pragma unroll
            for (int e = 0; e < 8; ++e) { const float r = fmaxf(v[e], 0.f); v[e] = r * r; }
          }
#pragma unroll
          for (int e = 0; e < 8; ++e) s += v[e] * v[e];
          *(u32x4*)(O + (size_t)row * ldc + c0) = pack8(v);
        }
        if (ss) { s += __shfl_xor(s, 16); s += __shfl_xor(s, 32); if (fq == 0) atomicAdd(ss + row, s); }
      }
  }
};
struct EpiMem {
  static constexpr bool PERM = true, AFTER_DRAIN = false;
  bf16* kmem; bf16* vmemT;
  __device__ __forceinline__ void operator()(const f32x4 (&acc)[2][2][4][2], const pg8::Unit& u, int wr, int wc, int fr, int fq) const {
    const int layer = u.pm >> 2, pt = u.pn & 7; const bool isv = pt >= 4; const int head = pt & 3;
#pragma unroll
    for (int ai = 0; ai < 2; ++ai)
#pragma unroll
      for (int m = 0; m < 4; ++m) {
        const int rowl = (u.pm & 3) * 256 + ai * 128 + wr * 64 + m * 16 + fr;
#pragma unroll
        for (int bj = 0; bj < 2; ++bj) {
          const int c0 = bj * 128 + wc * 32 + 8 * fq;
          float v[8];
#pragma unroll
          for (int e = 0; e < 4; ++e) { v[e] = acc[ai][bj][m][0][e]; v[4 + e] = acc[ai][bj][m][1][e]; }
          const u32x4 w = pack8(v);
          if (!isv) *(u32x4*)(kmem + ((size_t)layer * 1024 + rowl) * 1024 + head * 256 + c0) = w;
          else {
            const int b = rowl >> 8, key = rowl & 255; bf16* tp = vmemT + ((size_t)(((layer * 4 + b) * 4 + head) * 256 + c0)) * 256 + key;
            const unsigned ww[4] = {w.x, w.y, w.z, w.w};
#pragma unroll
            for (int e = 0; e < 8; ++e) tp[(size_t)e * 256] = (bf16)((e & 1) ? (ww[e >> 1] >> 16) : (ww[e >> 1] & 0xffffu));
          }
        }
      }
  }
};
struct MemSched {
  int G, c;
  __device__ bool next(int i, pg8::Unit& u) const { const int L = i * G + c; if (L >= 64) return false; const int layer = L >> 5, r = L & 31; u.pm = layer * 4 + (r & 3); u.pn = layer * 8 + (r >> 2); return true; }
  __device__ __forceinline__ void a_ready(const pg8::Unit&) const {}
  __device__ __forceinline__ void done(const pg8::Unit&) const {}
};

template <int MAP> __device__ __forceinline__ int src_col(int n) {
  if (MAP == 0) return n;
  const int tile = n >> 8, j = n & 255; int jj = j;
  if (tile == 3 || tile == 9) { const int hh = j >> 6, l = j & 63; jj = hh * 64 + (l >> 1) + 32 * (l & 1); }
  return kSrcCol[tile] + jj;
}
template <int MAP> __device__ __forceinline__ void conv_item(const float* __restrict__ W, int K, int Nsrc, int N, bf16* WT, float* scr, int item, int lane) {
  const int nblk = N / 32, kb = item / nblk, nb = item % nblk, k0 = 64 * kb, n0 = 32 * nb;
  const int sc = src_col<MAP>(n0 + (lane & 31));
#pragma unroll 8
  for (int i = 0; i < 32; ++i) { const int kk = 2 * i + (lane >> 5); scr[kk * 33 + (lane & 31)] = W[(size_t)(k0 + kk) * Nsrc + sc]; }
  WAVE_LDS_FENCE();
  const int c = lane & 7;
#pragma unroll
  for (int j = 0; j < 4; ++j) { const int n = (lane >> 3) + 8 * j; const float* s = scr + (8 * c) * 33 + n;
    u32x4 o; o.x = pk2(s[0 * 33], s[1 * 33]); o.y = pk2(s[2 * 33], s[3 * 33]); o.z = pk2(s[4 * 33], s[5 * 33]); o.w = pk2(s[6 * 33], s[7 * 33]);
    *(u32x4*)(WT + (size_t)(n0 + n) * K + k0 + 8 * c) = o; }
  WAVE_LDS_FENCE();
}
__device__ __forceinline__ void conv_layer_weights(const Params& p, int l, float* scr, int gw, int NGW, int lane) {
  asm volatile("" ::: "memory");
  asm volatile("" : "+v"(lane));
  unsigned char* ws = p.ws;
  constexpr int I_IN = (D / 64) * (NIN / 32), I_SQ = (D / 64) * (D / 32), I_1 = (D / 64) * (DFF / 32), I_2 = (DFF / 64) * (D / 32);
  constexpr int I_W2 = 1 * 8, I_A2 = 8, I_G2 = 2 * 8, I_V1 = 4 * 1, I_V2 = 8  , I_R = 2 * 4 * 2;
  constexpr int NIT = I_IN + 3 * I_SQ + I_1 + I_2 + I_W2 + I_A2 + I_G2 + I_V1 + I_R;
  for (int it = gw; it < NIT; it += NGW) {
    int r = it;
    if (r < I_IN) { conv_item<1>(p.in[9] + (size_t)l * D * INW, D, INW, NIN, (bf16*)(ws + W_IN), scr, r, lane); continue; } r -= I_IN;
    if (r < I_SQ) { conv_item<0>(p.in[10] + (size_t)l * D * D, D, D, D, (bf16*)(ws + W_OUT), scr, r, lane); continue; } r -= I_SQ;
    if (r < I_SQ) { conv_item<0>(p.in[34] + (size_t)l * D * D, D, D, D, (bf16*)(ws + W_Q), scr, r, lane); continue; } r -= I_SQ;
    if (r < I_SQ) { conv_item<0>(p.in[37] + (size_t)l * D * D, D, D, D, (bf16*)(ws + W_O), scr, r, lane); continue; } r -= I_SQ;
    if (r < I_1) { conv_item<0>(p.in[38] + (size_t)l * D * DFF, D, DFF, DFF, (bf16*)(ws + W_1), scr, r, lane); continue; } r -= I_1;
    if (r < I_2) { conv_item<0>(p.in[39] + (size_t)l * DFF * D, DFF, D, D, (bf16*)(ws + W_2), scr, r, lane); continue; } r -= I_2;
    if (r < I_W2) { conv_item<0>(p.in[21] + (size_t)l * 64 * G, 64, G, G, (bf16*)(ws + WS_W2T), scr, r, lane); continue; } r -= I_W2;
    if (r < I_A2) { conv_item<0>(p.in[23] + (size_t)l * 64 * G, 64, G, G, (bf16*)(ws + WS_A2T), scr, r, lane); continue; } r -= I_A2;
    if (r < I_G2) { conv_item<0>(p.in[24] + (size_t)l * 128 * G, 128, G, G, (bf16*)(ws + WS_G2T), scr, r, lane); continue; } r -= I_G2;
    if (r < I_V1) { if (l > 0) conv_item<0>(p.in[31] + (size_t)(l - 1) * G * 32, G, 32, 32, (bf16*)(ws + WS_V1T), scr, r, lane); continue; } r -= I_V1;
    { const int gate = r >> 3, hh = (r >> 1) & 3, nb = r & 1;
      conv_item<0>(p.in[gate ? 16 : 14] + ((size_t)l * GH + hh) * HD * HD, 64, 64, 64, (bf16*)(ws + (gate ? WS_RIT : WS_RAT)) + hh * 4096, scr, nb, lane); }
  }
  if (l > 0) { const float* v2 = p.in[32] + (size_t)(l - 1) * 32 * G; bf16* v2t = (bf16*)(ws + WS_V2T);
    for (int e = gw * 64 + lane; e < 32 * G; e += NGW * 64) { const int k = e / G, n = e % G; v2t[n * 32 + k] = (bf16)f2bf(v2[e]); } }
}

struct RowArgs { const float* xin; const bf16* O; float* ss; const float* g_post; float* xout; const float* g_pre; bf16* hout; const float* wf; const float* fbias; float* logf; int rows; };
__device__ __forceinline__ void row_phase(const RowArgs& a, int gw, int NGW, int lane) {
  asm volatile("" ::: "memory");
  asm volatile("" : "+v"(lane));
  f32x4 gp[4], gq[4], wfv[4][4];
#pragma unroll
  for (int j = 0; j < 4; ++j) {
    gp[j] = a.O ? ((const f32x4*)a.g_post)[lane + 64 * j] : (f32x4){0.f, 0.f, 0.f, 0.f};
    gq[j] = a.hout ? ((const f32x4*)a.g_pre)[lane + 64 * j] : (f32x4){0.f, 0.f, 0.f, 0.f};
#pragma unroll
    for (int hh = 0; hh < 4; ++hh)
#pragma unroll
      for (int e = 0; e < 4; ++e) wfv[j][hh][e] = a.wf ? a.wf[(size_t)(4 * (lane + 64 * j) + e) * INW + 768 + hh] : 0.f;
  }
  for (int row = gw; row < a.rows; row += NGW) {
    f32x4 x[4];
#pragma unroll
    for (int j = 0; j < 4; ++j) x[j] = ((const f32x4*)(a.xin + (size_t)row * D))[lane + 64 * j];
    if (a.O) {
      float ov[4][4]; float so = 0.f;
#pragma unroll
      for (int j = 0; j < 4; ++j) { const u32x2 o = ((const u32x2*)(a.O + (size_t)row * D))[lane + 64 * j];
        ov[j][0] = bflo(o.x); ov[j][1] = bfhi(o.x); ov[j][2] = bflo(o.y); ov[j][3] = bfhi(o.y);
        so += ov[j][0] * ov[j][0] + ov[j][1] * ov[j][1] + ov[j][2] * ov[j][2] + ov[j][3] * ov[j][3]; }
      so = wave_sum(so);
      const float rs = rsqrtf(so * (1.f / D) + EPS);
#pragma unroll
      for (int j = 0; j < 4; ++j)
#pragma unroll
        for (int e = 0; e < 4; ++e) x[j][e] += ov[j][e] * rs * gp[j][e];
    }
    if (a.xout) {
#pragma unroll
      for (int j = 0; j < 4; ++j) ((f32x4*)(a.xout + (size_t)row * D))[lane + 64 * j] = x[j];
    }
    if (a.hout) {
      float s = 0.f;
#pragma unroll
      for (int j = 0; j < 4; ++j) s += x[j][0] * x[j][0] + x[j][1] * x[j][1] + x[j][2] * x[j][2] + x[j][3] * x[j][3];
      s = wave_sum(s); const float rs2 = rsqrtf(s * (1.f / D) + EPS);
      float fd[4] = {0.f, 0.f, 0.f, 0.f};
#pragma unroll
      for (int j = 0; j < 4; ++j) {
        f32x4 hv;
#pragma unroll
        for (int e = 0; e < 4; ++e) hv[e] = x[j][e] * rs2 * gq[j][e];
        u32x2 o; o.x = pk2(hv[0], hv[1]); o.y = pk2(hv[2], hv[3]);
        ((u32x2*)(a.hout + (size_t)row * D))[lane + 64 * j] = o;
        if (a.wf) {
#pragma unroll
          for (int hh = 0; hh < 4; ++hh) fd[hh] += hv[0] * wfv[j][hh][0] + hv[1] * wfv[j][hh][1] + hv[2] * wfv[j][hh][2] + hv[3] * wfv[j][hh][3];
        }
      }
      if (a.wf) {
#pragma unroll
        for (int hh = 0; hh < 4; ++hh) fd[hh] = wave_sum(fd[hh]);
        if (lane < 4) { const float f = lane == 0 ? fd[0] : lane == 1 ? fd[1] : lane == 2 ? fd[2] : fd[3]; a.logf[(size_t)row * 4 + lane] = log_sigmoidf_(f + a.fbias[lane]); }
      }
    }
  }
}

__device__ __forceinline__ void lerp8(const bf16* __restrict__ proj, const float* __restrict__ mu, int tok, int col, int mucol, float* out) {
  const u32x4 c = *(const u32x4*)(proj + (size_t)tok * PW + col);
  u32x4 pv = {0u, 0u, 0u, 0u};
  if ((tok & (SEQ - 1)) != 0) pv = *(const u32x4*)(proj + (size_t)(tok - 1) * PW + col);
  float cf[8], pf[8]; unpack8(c, cf); unpack8(pv, pf);
  const f32x4 m0 = *(const f32x4*)(mu + mucol), m1 = *(const f32x4*)(mu + mucol + 4);
#pragma unroll
  for (int e = 0; e < 4; ++e) { out[e] = cf[e] + (pf[e] - cf[e]) * m0[e]; out[4 + e] = cf[4 + e] + (pf[4 + e] - cf[4 + e]) * m1[e]; }
}
__device__ __forceinline__ bf16x8 pack_frag(const float* f) { const u32x4 w = pack8(f); return __builtin_bit_cast(bf16x8, w); }
constexpr int WLP = 260;
__device__ __forceinline__ void acc_to_lds(float* wl, const f32x4* acc, int ntiles, int li, int g) {
#pragma unroll
  for (int nt = 0; nt < 16; ++nt) if (nt < ntiles) {
#pragma unroll
    for (int j = 0; j < 4; ++j) wl[(4 * g + j) * WLP + nt * 16 + li] = acc[nt][j];
  }
}
template <int KS> __device__ __forceinline__ void mm16_to_lds(const bf16x8* af, const bf16* __restrict__ wt, int ldw, float* wl, int li, int g) {
#pragma unroll 1
  for (int ng = 0; ng < 4; ++ng) {
    f32x4 a4[4];
#pragma unroll
    for (int n4 = 0; n4 < 4; ++n4) { a4[n4] = (f32x4){0.f, 0.f, 0.f, 0.f};
#pragma unroll
      for (int ks = 0; ks < KS; ++ks) { const bf16x8 bfr = *(const bf16x8*)(wt + (size_t)((ng * 4 + n4) * 16 + li) * ldw + ks * 32 + 8 * g); a4[n4] = MFMA16(af[ks], bfr, a4[n4]); } }
#pragma unroll
    for (int n4 = 0; n4 < 4; ++n4)
#pragma unroll
      for (int j = 0; j < 4; ++j) wl[(4 * g + j) * WLP + (ng * 4 + n4) * 16 + li] = a4[n4][j];
  }
}
__device__ __forceinline__ void rwkv_prep_unit(const Params& p, int l, int unit, float* wl, int lane) {
  asm volatile("" ::: "memory");
  asm volatile("" : "+v"(lane));
  unsigned char* ws = p.ws;
  const bf16* proj = (const bf16*)(ws + WS_P);
  const float* mu = p.in[19] + (size_t)l * 1024;
  const int li = lane & 15, g = lane >> 4, t0 = unit * 16, ta = t0 + li;
  const int tl = t0 + (lane >> 2), cgp = lane & 3;
  {
    bf16x8 af[2];
#pragma unroll
    for (int ks = 0; ks < 2; ++ks) { float f[8]; lerp8(proj, mu, ta, C_RWX + ks * 32 + 8 * g, 768 + ks * 32 + 8 * g, f);
#pragma unroll
      for (int e = 0; e < 8; ++e) f[e] = tanhf_(f[e]);
      af[ks] = pack_frag(f); }
    mm16_to_lds<2>(af, (const bf16*)(ws + WS_W2T), 64, wl, li, g); WAVE_LDS_FENCE();
    const float* w0 = p.in[20] + (size_t)l * G;
#pragma unroll 1
    for (int i = 0; i < 8; ++i) { int col = cgp * 8 + 32 * i; asm volatile("" : "+v"(col)); float r[8], ev[8], wr[8];
      lerp8(proj, mu, tl, C_RWR + col, col, r);
#pragma unroll
      for (int e = 0; e < 8; ++e) { const float wa = wl[(lane >> 2) * WLP + col + e] + w0[col + e]; const float wlog = -softplusf_(-wa) - 0.5f; const float ee = __expf(wlog); ev[e] = ee; wr[e] = __expf(-ee) * r[e]; }
      *(u32x4*)((bf16*)(ws + RW_E) + (size_t)tl * G + col) = pack8(ev); *(u32x4*)((bf16*)(ws + RW_WR) + (size_t)tl * G + col) = pack8(wr); }
    WAVE_LDS_FENCE();
  }
  {
    bf16x8 af[2];
#pragma unroll
    for (int ks = 0; ks < 2; ++ks) { float f[8]; lerp8(proj, mu, ta, C_RWX + 64 + ks * 32 + 8 * g, 832 + ks * 32 + 8 * g, f); af[ks] = pack_frag(f); }
    mm16_to_lds<2>(af, (const bf16*)(ws + WS_A2T), 64, wl, li, g); WAVE_LDS_FENCE();
    const float* a0 = p.in[22] + (size_t)l * G; const float* k_k = p.in[25] + (size_t)l * G; const float* k_a = p.in[26] + (size_t)l * G; const float* r_k = p.in[27] + (size_t)l * G;
#pragma unroll 1
    for (int hh = 0; hh < 4; ++hh) {
      float av[2][8], kv[2][8], kk[2][8]; float ssq = 0.f;
#pragma unroll
      for (int ii = 0; ii < 2; ++ii) { int col = cgp * 8 + 32 * (2 * hh + ii); asm volatile("" : "+v"(col));
        lerp8(proj, mu, tl, C_RWK + col, 256 + col, kv[ii]);
#pragma unroll
        for (int e = 0; e < 8; ++e) { av[ii][e] = sigmoidf_(a0[col + e] + wl[(lane >> 2) * WLP + col + e]); kk[ii][e] = kv[ii][e] * k_k[col + e]; ssq += kk[ii][e] * kk[ii][e]; } }
      ssq += __shfl_xor(ssq, 1); ssq += __shfl_xor(ssq, 2);
      const float inv = 1.f / fmaxf(sqrtf(ssq), 1e-12f);
      float sbr = 0.f, skr = 0.f, srk = 0.f;
#pragma unroll
      for (int ii = 0; ii < 2; ++ii) { int col = cgp * 8 + 32 * (2 * hh + ii); asm volatile("" : "+v"(col)); float r[8], Av[8], Bv[8], k2[8];
        lerp8(proj, mu, tl, C_RWR + col, col, r);
#pragma unroll
        for (int e = 0; e < 8; ++e) { const float kn = kk[ii][e] * inv; Av[e] = -kn; Bv[e] = kn * av[ii][e]; k2[e] = kv[ii][e] * (1.f + (av[ii][e] - 1.f) * k_a[col + e]);
          const float rb = r[e]; sbr += Bv[e] * rb; skr += k2[e] * rb; srk += rb * k2[e] * r_k[col + e]; }
        *(u32x4*)((bf16*)(ws + RW_A) + (size_t)tl * G + col) = pack8(Av); *(u32x4*)((bf16*)(ws + RW_B) + (size_t)tl * G + col) = pack8(Bv); *(u32x4*)((bf16*)(ws + RW_K) + (size_t)tl * G + col) = pack8(k2); }
      sbr += __shfl_xor(sbr, 1); sbr += __shfl_xor(sbr, 2); skr += __shfl_xor(skr, 1); skr += __shfl_xor(skr, 2); srk += __shfl_xor(srk, 1); srk += __shfl_xor(srk, 2);
      if (cgp == 0) { ((float*)(ws + SM_BR))[(size_t)tl * 4 + hh] = sbr; ((float*)(ws + SM_KR))[(size_t)tl * 4 + hh] = skr; ((float*)(ws + SM_RK))[(size_t)tl * 4 + hh] = srk; }
    }
    WAVE_LDS_FENCE();
  }
  {
    bf16x8 af[4];
#pragma unroll
    for (int ks = 0; ks < 4; ++ks) { float f[8]; lerp8(proj, mu, ta, C_RWX + 128 + ks * 32 + 8 * g, 896 + ks * 32 + 8 * g, f);
#pragma unroll
      for (int e = 0; e < 8; ++e) f[e] = sigmoidf_(f[e]);
      af[ks] = pack_frag(f); }
    mm16_to_lds<4>(af, (const bf16*)(ws + WS_G2T), 128, wl, li, g); WAVE_LDS_FENCE();
#pragma unroll 1
    for (int i = 0; i < 8; ++i) { int col = cgp * 8 + 32 * i; asm volatile("" : "+v"(col)); float gv[8];
#pragma unroll
      for (int e = 0; e < 8; ++e) gv[e] = wl[(lane >> 2) * WLP + col + e];
      *(u32x4*)((bf16*)(ws + RW_G) + (size_t)tl * G + col) = pack8(gv); }
    WAVE_LDS_FENCE();
  }
  if (l > 0) {
    f32x4 a1[2] = {(f32x4){0.f, 0.f, 0.f, 0.f}, (f32x4){0.f, 0.f, 0.f, 0.f}};
    const bf16* v1t = (const bf16*)(ws + WS_V1T);
#pragma unroll
    for (int ks = 0; ks < 8; ++ks) { float f[8]; lerp8(proj, mu, ta, C_RWV + ks * 32 + 8 * g, 512 + ks * 32 + 8 * g, f); const bf16x8 af = pack_frag(f);
#pragma unroll
      for (int nt = 0; nt < 2; ++nt) { const bf16x8 bfr = *(const bf16x8*)(v1t + (size_t)(nt * 16 + li) * 256 + ks * 32 + 8 * g); a1[nt] = MFMA16(af, bfr, a1[nt]); } }
#pragma unroll
    for (int nt = 0; nt < 2; ++nt)
#pragma unroll
      for (int j = 0; j < 4; ++j) wl[(4 * g + j) * WLP + nt * 16 + li] = a1[nt][j];
    WAVE_LDS_FENCE();
    float f2[8];
#pragma unroll
    for (int e = 0; e < 8; ++e) f2[e] = wl[li * WLP + 8 * g + e];
    const bf16x8 af2 = pack_frag(f2);
    WAVE_LDS_FENCE();
    mm16_to_lds<1>(&af2, (const bf16*)(ws + WS_V2T), 32, wl, li, g); WAVE_LDS_FENCE();
    const float* v0 = p.in[30] + (size_t)(l - 1) * G;
#pragma unroll 1
    for (int i = 0; i < 8; ++i) { int col = cgp * 8 + 32 * i; asm volatile("" : "+v"(col)); float v[8], vf[8];
      lerp8(proj, mu, tl, C_RWV + col, 512 + col, v);
      unpack8(*(const u32x4*)((const bf16*)(ws + WS_VF) + (size_t)tl * G + col), vf);
#pragma unroll
      for (int e = 0; e < 8; ++e) v[e] = v[e] + (vf[e] - v[e]) * sigmoidf_(v0[col + e] + wl[(lane >> 2) * WLP + col + e]);
      *(u32x4*)((bf16*)(ws + RW_V) + (size_t)tl * G + col) = pack8(v); }
    WAVE_LDS_FENCE();
  } else {
#pragma unroll 1
    for (int i = 0; i < 8; ++i) { int col = cgp * 8 + 32 * i; asm volatile("" : "+v"(col)); float v[8];
      lerp8(proj, mu, tl, C_RWV + col, 512 + col, v);
      const u32x4 w = pack8(v);
      *(u32x4*)((bf16*)(ws + RW_V) + (size_t)tl * G + col) = w; *(u32x4*)((bf16*)(ws + WS_VF) + (size_t)tl * G + col) = w; }
  }
}
__device__ __forceinline__ void ret_kv_unit(const Params& p, int unit, int lane) {
  asm volatile("" ::: "memory");
  asm volatile("" : "+v"(lane));
  unsigned char* ws = p.ws;
  const int bh = unit >> 5, c = unit & 31, h = bh & 3, li = lane & 15, g = lane >> 4;
  const float lg2 = log2f(1.f - exp2f(-5.f - (float)h));
  const bf16* kT = (const bf16*)(ws + P_RETKT) + (size_t)bh * 64 * SEQ + c * 128;
  const bf16* vT = (const bf16*)(ws + P_RETVT) + (size_t)bh * 64 * SEQ + c * 128;
  f32x4 acc[4][4];
#pragma unroll
  for (int a = 0; a < 4; ++a)
#pragma unroll
    for (int b = 0; b < 4; ++b) acc[a][b] = (f32x4){0.f, 0.f, 0.f, 0.f};
#pragma unroll
  for (int ks = 0; ks < 4; ++ks) {
    float z[8];
#pragma unroll
    for (int e = 0; e < 8; ++e) z[e] = ex2(lg2 * (float)(127 - (ks * 32 + 8 * g + e)));
    bf16x8 af[4], bfr[4];
#pragma unroll
    for (int dt = 0; dt < 4; ++dt) { float f[8]; unpack8(*(const u32x4*)(kT + (size_t)(dt * 16 + li) * SEQ + ks * 32 + 8 * g), f);
#pragma unroll
      for (int e = 0; e < 8; ++e) f[e] *= z[e];
      af[dt] = pack_frag(f); }
#pragma unroll
    for (int et = 0; et < 4; ++et) bfr[et] = *(const bf16x8*)(vT + (size_t)(et * 16 + li) * SEQ + ks * 32 + 8 * g);
#pragma unroll
    for (int dt = 0; dt < 4; ++dt)
#pragma unroll
      for (int et = 0; et < 4; ++et) acc[dt][et] = MFMA16(af[dt], bfr[et], acc[dt][et]);
  }
  float* KV = (float*)(ws + P_RETKV) + (size_t)unit * 4096;
#pragma unroll
  for (int dt = 0; dt < 4; ++dt)
#pragma unroll
    for (int et = 0; et < 4; ++et)
#pragma unroll
      for (int j = 0; j < 4; ++j) KV[(dt * 16 + 4 * g + j) * 64 + et * 16 + li] = acc[dt][et][j];
}
__device__ __forceinline__ void fox_cum_unit(const Params& p, int bh, int lane) {
  asm volatile("" ::: "memory");
  asm volatile("" : "+v"(lane));
  const float* logf = (const float*)(p.ws + SM_LOGF); float* cum = (float*)(p.ws + SM_CUM);
  const int b = bh >> 2, h = bh & 3; const size_t base = ((size_t)b * SEQ + lane * 64) * 4 + h;
  float s = 0.f;
  for (int i = 0; i < 64; ++i) s += logf[base + (size_t)i * 4];
  float incl = s;
#pragma unroll
  for (int o = 1; o < 64; o <<= 1) { const float t = __shfl_up(incl, o); if (lane >= o) incl += t; }
  float run = incl - s;
  for (int i = 0; i < 64; ++i) { run += logf[base + (size_t)i * 4]; cum[(size_t)bh * SEQ + lane * 64 + i] = run * LOG2E; }
}

template <int CTRL> __device__ __forceinline__ float dpp_add(float x) {
  const int y = __builtin_amdgcn_update_dpp(0, __builtin_bit_cast(int, x), CTRL, 0xf, 0xf, false);
  return x + __builtin_bit_cast(float, y);
}
__device__ __forceinline__ float row16_sum(float x) {
  x = dpp_add<0xB1>(x); x = dpp_add<0x4E>(x); x = dpp_add<0x141>(x); x = dpp_add<0x140>(x); return x;
}
constexpr int RS_TS = 352;
constexpr int RS_CH = 32;
constexpr int RS_BUF = RS_CH * RS_TS;
struct RsRegs { u32x4 e, a, b, k, wr, v; float br, kr; };
__device__ __forceinline__ void rs_issue(const Params& p, RsRegs& r, int b, int h, int rq, int c, int lt) {
  unsigned char* ws = p.ws;
  const int tok = lt >> 3, ch = lt & 7; const size_t row = (size_t)b * SEQ + c * RS_CH + tok; const size_t o = row * G + h * 64 + ch * 8;
  r.e = *(const u32x4*)((const bf16*)(ws + RW_E) + o); r.a = *(const u32x4*)((const bf16*)(ws + RW_A) + o); r.b = *(const u32x4*)((const bf16*)(ws + RW_B) + o);
  r.k = *(const u32x4*)((const bf16*)(ws + RW_K) + o); r.wr = *(const u32x4*)((const bf16*)(ws + RW_WR) + o);
  if (lt < 64) { const int t2 = lt >> 1, c2 = lt & 1; r.v = *(const u32x4*)((const bf16*)(ws + RW_V) + ((size_t)b * SEQ + c * RS_CH + t2) * G + h * 64 + rq * 16 + c2 * 8); }
  else if (lt < 96) { const int t2 = lt - 64; const size_t rr = (size_t)b * SEQ + c * RS_CH + t2; r.br = ((const float*)(ws + SM_BR))[rr * 4 + h]; r.kr = ((const float*)(ws + SM_KR))[rr * 4 + h]; }
}
__device__ __forceinline__ void rs_commit(const RsRegs& r, float* buf, int lt) {
  const int tok = lt >> 3, ch = lt & 7; float* tp = buf + tok * RS_TS + ch * 8; float f[8];
  unpack8(r.e, f);
#pragma unroll
  for (int e = 0; e < 8; ++e) f[e] = ex2(-f[e] * LOG2E);
  *(f32x4*)(tp) = (f32x4){f[0], f[1], f[2], f[3]}; *(f32x4*)(tp + 4) = (f32x4){f[4], f[5], f[6], f[7]};
  unpack8(r.a, f); *(f32x4*)(tp + 64) = (f32x4){f[0], f[1], f[2], f[3]}; *(f32x4*)(tp + 68) = (f32x4){f[4], f[5], f[6], f[7]};
  unpack8(r.b, f); *(f32x4*)(tp + 128) = (f32x4){f[0], f[1], f[2], f[3]}; *(f32x4*)(tp + 132) = (f32x4){f[4], f[5], f[6], f[7]};
  unpack8(r.k, f); *(f32x4*)(tp + 192) = (f32x4){f[0], f[1], f[2], f[3]}; *(f32x4*)(tp + 196) = (f32x4){f[4], f[5], f[6], f[7]};
  unpack8(r.wr, f); *(f32x4*)(tp + 256) = (f32x4){f[0], f[1], f[2], f[3]}; *(f32x4*)(tp + 260) = (f32x4){f[4], f[5], f[6], f[7]};
  if (lt < 64) { const int t2 = lt >> 1, c2 = lt & 1; float* vp = buf + t2 * RS_TS + 320 + c2 * 8; unpack8(r.v, f); *(f32x4*)(vp) = (f32x4){f[0], f[1], f[2], f[3]}; *(f32x4*)(vp + 4) = (f32x4){f[4], f[5], f[6], f[7]}; }
  else if (lt < 96) { const int t2 = lt - 64; buf[t2 * RS_TS + 336] = r.br; buf[t2 * RS_TS + 337] = r.kr; }
}
__device__ __forceinline__ void rwkv_scan_unit(const Params& p, float* lds, int unit) {
  asm volatile("" ::: "memory");
  int tid = threadIdx.x; asm volatile("" : "+v"(tid)); const int wave = __builtin_amdgcn_readfirstlane(tid >> 6), lane = tid & 63;
  const int b = unit >> 4, h = (unit >> 2) & 3, rq = unit & 3;
  float* bufs = lds; float* ybuf = lds + 2 * RS_BUF;
  float* Y = (float*)(p.ws + RW_Y);
  constexpr int NCH = SEQ / RS_CH;
  const int lt = tid - 256;
  RsRegs rg;
  if (wave >= 4) { rs_issue(p, rg, b, h, rq, 0, lt); rs_commit(rg, bufs, lt); rs_issue(p, rg, b, h, rq, 1, lt); }
  __syncthreads();
  f32x4 S = {0.f, 0.f, 0.f, 0.f};
  const int seg = lane & 15, rloc = wave * 4 + (lane >> 4);
  for (int c = 0; c < NCH; ++c) {
    if (wave >= 4) {
      if (c + 1 < NCH) rs_commit(rg, bufs + ((c + 1) & 1) * RS_BUF, lt);
      if (c + 2 < NCH) rs_issue(p, rg, b, h, rq, c + 2, lt);
      if (c > 0) { const float* yb = ybuf + ((c - 1) & 1) * 512;
#pragma unroll
        for (int i = 0; i < 2; ++i) { const int e = lt + 256 * i, tok = e >> 4, r = e & 15; Y[((size_t)b * SEQ + (c - 1) * RS_CH + tok) * G + h * 64 + rq * 16 + r] = yb[e]; } }
    } else {
      const float* bp = bufs + (c & 1) * RS_BUF; float* yb = ybuf + (c & 1) * 512;
#pragma unroll 4
      for (int s = 0; s < RS_CH; ++s) {
        const float* tp = bp + s * RS_TS;
        const f32x4 w = *(const f32x4*)(tp + 4 * seg), a = *(const f32x4*)(tp + 64 + 4 * seg), bb = *(const f32x4*)(tp + 128 + 4 * seg), kk = *(const f32x4*)(tp + 192 + 4 * seg), wr = *(const f32x4*)(tp + 256 + 4 * seg);
        const float v = tp[320 + rloc], br = tp[336], kr = tp[337];
        float da = S[0] * a[0] + S[1] * a[1] + S[2] * a[2] + S[3] * a[3];
        float dy = S[0] * wr[0] + S[1] * wr[1] + S[2] * wr[2] + S[3] * wr[3];
        da = row16_sum(da); dy = row16_sum(dy);
        const float y = dy + da * br + v * kr;
#pragma unroll
        for (int e = 0; e < 4; ++e) S[e] = S[e] * w[e] + (da * bb[e] + v * kk[e]);
        if (seg == 0) yb[s * 16 + rloc] = y;
      }
    }
    __syncthreads();
  }
  if (wave >= 4) { const float* yb = ybuf + ((NCH - 1) & 1) * 512;
#pragma unroll
    for (int i = 0; i < 2; ++i) { const int e = lt + 256 * i, tok = e >> 4, r = e & 15; Y[((size_t)b * SEQ + (NCH - 1) * RS_CH + tok) * G + h * 64 + rq * 16 + r] = yb[e]; } }
  __syncthreads();
}
__device__ __forceinline__ void rwkv_post_row(const Params& p, int l, int row, int lane) {
  asm volatile("" ::: "memory");
  asm volatile("" : "+v"(lane));
  unsigned char* ws = p.ws;
  const f32x4 y = ((const f32x4*)((const float*)(ws + RW_Y) + (size_t)row * G))[lane];
  float s = y[0] + y[1] + y[2] + y[3];
  s += __shfl_xor(s, 1); s += __shfl_xor(s, 2); s += __shfl_xor(s, 4); s += __shfl_xor(s, 8);
  const float mu = s * (1.f / 64.f); const f32x4 d = y - mu;
  float q = d[0] * d[0] + d[1] * d[1] + d[2] * d[2] + d[3] * d[3];
  q += __shfl_xor(q, 1); q += __shfl_xor(q, 2); q += __shfl_xor(q, 4); q += __shfl_xor(q, 8);
  const float rstd = rsqrtf(q * (1.f / 64.f) + 64e-5f);
  const f32x4 gw = ((const f32x4*)(p.in[28] + (size_t)l * G))[lane], gb = ((const f32x4*)(p.in[29] + (size_t)l * G))[lane];
  const u32x2 vv = ((const u32x2*)((const bf16*)(ws + RW_V) + (size_t)row * G))[lane], gg = ((const u32x2*)((const bf16*)(ws + RW_G) + (size_t)row * G))[lane];
  const float rk = ((const float*)(ws + SM_RK))[(size_t)row * 4 + (lane >> 4)];
  const float v[4] = {bflo(vv.x), bfhi(vv.x), bflo(vv.y), bfhi(vv.y)}, gt[4] = {bflo(gg.x), bfhi(gg.x), bflo(gg.y), bfhi(gg.y)};
  float o[4];
#pragma unroll
  for (int e = 0; e < 4; ++e) o[e] = (d[e] * rstd * gw[e] + gb[e] + rk * v[e]) * gt[e];
  u32x2 w; w.x = pk2(o[0], o[1]); w.y = pk2(o[2], o[3]);
  ((u32x2*)((bf16*)(ws + WS_P) + (size_t)row * PW + C_RWR))[lane] = w;
}

__device__ __forceinline__ void lru_unit(const Params& p, int l, float* lds, int unit) {
  asm volatile("" ::: "memory");
  unsigned char* ws = p.ws; bf16* proj = (bf16*)(ws + WS_P);
  int tid = threadIdx.x; asm volatile("" : "+v"(tid)); const int wave = __builtin_amdgcn_readfirstlane(tid >> 6), lane = tid & 63, li = lane & 15, g = lane >> 4;
  const int b = unit >> 2, h = unit & 3;
  float* XB = lds;
  float* XC = XB + 67 * 64;
  float* AA = XC + 64 * 65;
  float* UU = AA + 64 * 65;
  float* HH = UU + 64 * 65;
  bf16* XCb = (bf16*)(HH + 64 * 65);
  const float* cw = p.in[12] + (size_t)l * 4 * G + h * 64; const float* cb = p.in[13] + (size_t)l * G + h * 64;
  const float* rab = p.in[15] + (size_t)l * G + h * 64; const float* rib = p.in[17] + (size_t)l * G + h * 64; const float* lam = p.in[18] + (size_t)l * G + h * 64;
  const int mt = wave & 3, ntp = wave >> 2;
  bf16x8 br_[2][2], bi_[2][2]; float lsl[2], rb[2], ib[2];
  { const bf16* rat = (const bf16*)(ws + WS_RAT) + h * 4096; const bf16* rit = (const bf16*)(ws + WS_RIT) + h * 4096;
#pragma unroll
    for (int n = 0; n < 2; ++n) { const int col = (2 * ntp + n) * 16 + li; lsl[n] = log_sigmoid_acc(lam[col]); rb[n] = rab[col]; ib[n] = rib[col];
#pragma unroll
      for (int ks = 0; ks < 2; ++ks) { br_[n][ks] = *(const bf16x8*)(rat + col * 64 + ks * 32 + 8 * g); bi_[n][ks] = *(const bf16x8*)(rit + col * 64 + ks * 32 + 8 * g); } } }
  float hcur = 0.f;
  const int tok = tid >> 3, ch8 = (tid & 7) * 8;
  for (int c = 0; c < SEQ / 64; ++c) {
    const int t0 = c * 64;
    for (int id = tid; id < 67 * 8; id += NTHREADS) { const int r = id >> 3, cc = (id & 7) * 8; const int pos = t0 - 3 + r; float f[8] = {0.f, 0.f, 0.f, 0.f, 0.f, 0.f, 0.f, 0.f};
      if (pos >= 0) unpack8(*(const u32x4*)(proj + ((size_t)b * SEQ + pos) * PW + C_LRUX + h * 64 + cc), f);
#pragma unroll
      for (int e = 0; e < 8; ++e) XB[r * 64 + cc + e] = f[e]; }
    __syncthreads();
    { float xc[8];
#pragma unroll
      for (int e = 0; e < 8; ++e) { float v = cb[ch8 + e];
#pragma unroll
        for (int j = 0; j < 4; ++j) v += XB[(tok + j) * 64 + ch8 + e] * cw[j * G + ch8 + e];
        xc[e] = v; XC[tok * 65 + ch8 + e] = v; }
      *(u32x4*)(XCb + tok * 72 + ch8) = pack8(xc); }
    __syncthreads();
    { bf16x8 af[2];
#pragma unroll
      for (int ks = 0; ks < 2; ++ks) af[ks] = *(const bf16x8*)(XCb + (mt * 16 + li) * 72 + ks * 32 + 8 * g);
#pragma unroll
      for (int n = 0; n < 2; ++n) { f32x4 cr = {0.f, 0.f, 0.f, 0.f}, ci = {0.f, 0.f, 0.f, 0.f};
#pragma unroll
        for (int ks = 0; ks < 2; ++ks) { cr = MFMA16(af[ks], br_[n][ks], cr); ci = MFMA16(af[ks], bi_[n][ks], ci); }
        const int col = (2 * ntp + n) * 16 + li;
#pragma unroll
        for (int j = 0; j < 4; ++j) { const int tk = mt * 16 + 4 * g + j; const float r = sigmoidf_(cr[j] + rb[n]), ig = sigmoidf_(ci[j] + ib[n]);
          const float log_a = 8.f * r * lsl[n]; const float a = __expf(log_a); const float mult = sqrtf(fmaxf(1.f - a * a, 0.f));
          AA[tk * 65 + col] = a; UU[tk * 65 + col] = mult * (ig * XC[tk * 65 + col]); } } }
    __syncthreads();
    if (wave == 0) {
#pragma unroll 8
      for (int s = 0; s < 64; ++s) { hcur = AA[s * 65 + lane] * hcur + UU[s * 65 + lane]; HH[s * 65 + lane] = hcur; } }
    __syncthreads();
    { bf16* yp = proj + ((size_t)b * SEQ + t0 + tok) * PW + C_LRUY + h * 64 + ch8; float y[8]; unpack8(*(const u32x4*)yp, y);
#pragma unroll
      for (int e = 0; e < 8; ++e) y[e] = HH[tok * 65 + ch8 + e] * gelu_tanh(y[e]);
      *(u32x4*)yp = pack8(y); }
  }
  __syncthreads();
}

constexpr int KS_P = 72, VS_P = 136;
constexpr int AT_KS = 0, AT_VS = 128 * KS_P * 2, AT_CS = AT_VS + 64 * VS_P * 2, AT_BUF = AT_CS + 512;
struct AtRegs { u32x4 k0, k1, v0, v1; float c; };
__device__ __forceinline__ void at_issue(AtRegs& r, const bf16* Kg  , const bf16* VTg  , const float* cumg, int tid) {
  { const int id = tid, row = id >> 3, ch = id & 7; r.k0 = *(const u32x4*)(Kg + (size_t)row * PW + ch * 8); }
  { const int id = tid + 512, row = id >> 3, ch = id & 7; r.k1 = *(const u32x4*)(Kg + (size_t)row * PW + ch * 8); }
  { const int id = tid, row = id >> 4, ch = id & 15; r.v0 = *(const u32x4*)(VTg + (size_t)row * SEQ + ch * 8); }
  { const int id = tid + 512, row = id >> 4, ch = id & 15; r.v1 = *(const u32x4*)(VTg + (size_t)row * SEQ + ch * 8); }
  r.c = (cumg && tid < 128) ? cumg[tid] : 0.f;
}
__device__ __forceinline__ void at_commit(const AtRegs& r, unsigned char* buf, int tid) {
  bf16* Ks = (bf16*)(buf + AT_KS); bf16* Vs = (bf16*)(buf + AT_VS); float* Cs = (float*)(buf + AT_CS);
  { const int id = tid, row = id >> 3, ch = id & 7; *(u32x4*)(Ks + row * KS_P + ch * 8) = r.k0; }
  { const int id = tid + 512, row = id >> 3, ch = id & 7; *(u32x4*)(Ks + row * KS_P + ch * 8) = r.k1; }
  { const int id = tid, row = id >> 4, ch = id & 15; *(u32x4*)(Vs + row * VS_P + ch * 8) = r.v0; }
  { const int id = tid + 512, row = id >> 4, ch = id & 15; *(u32x4*)(Vs + row * VS_P + ch * 8) = r.v1; }
  if (tid < 128) Cs[tid] = r.c;
}
__device__ __forceinline__ bf16x8 vfrag(const bf16* Vs, int d, int key0, int g) {
  const u32x2 lo = *(const u32x2*)(Vs + d * VS_P + key0 + 4 * g), hi = *(const u32x2*)(Vs + d * VS_P + key0 + 16 + 4 * g);
  const u32x4 w = {lo.x, lo.y, hi.x, hi.y}; return __builtin_bit_cast(bf16x8, w);
}
__device__ __forceinline__ void fox_unit(const Params& p, unsigned char* lds, int b, int h, int qb) {
  asm volatile("" ::: "memory");
  unsigned char* ws = p.ws; bf16* proj = (bf16*)(ws + WS_P);
  int tid = threadIdx.x; asm volatile("" : "+v"(tid)); const int wave = __builtin_amdgcn_readfirstlane(tid >> 6), lane = tid & 63, li = lane & 15, g = lane >> 4;
  const int bh = b * 4 + h; const int qrel = wave * 16 + li; const size_t qrow = (size_t)b * SEQ + qb * 128 + qrel;
  const float* cum = (const float*)(ws + SM_CUM) + (size_t)bh * SEQ;
  const bf16* Kbase = proj + (size_t)b * SEQ * PW + C_FOXK + h * 64; const bf16* VTbase = (const bf16*)(ws + P_FOXVT) + (size_t)bh * 64 * SEQ;
  bf16x8 qf[2];
#pragma unroll
  for (int ks = 0; ks < 2; ++ks) qf[ks] = *(const bf16x8*)(proj + qrow * PW + C_FOXQ + h * 64 + ks * 32 + 8 * g);
  const float cq = cum[qb * 128 + qrel];
  const float SC = 0.125f * LOG2E;
  f32x4 o[4];
#pragma unroll
  for (int dt = 0; dt < 4; ++dt) o[dt] = (f32x4){0.f, 0.f, 0.f, 0.f};
  float m = -INFINITY, lsum = 0.f;
  AtRegs rg; at_issue(rg, Kbase, VTbase, cum, tid);
  __syncthreads();
  at_commit(rg, lds, tid);
  if (qb > 0) at_issue(rg, Kbase + (size_t)128 * PW, VTbase + 128, cum + 128, tid);
  __syncthreads();
  for (int kb = 0; kb <= qb; ++kb) {
    unsigned char* buf = lds + (kb & 1) * AT_BUF; const bf16* Ks = (const bf16*)(buf + AT_KS); const bf16* Vs = (const bf16*)(buf + AT_VS); const float* Cs = (const float*)(buf + AT_CS);
    const bool diag = kb == qb; const int nst = diag ? (wave >> 1) + 1 : 4;
    for (int st = 0; st < nst; ++st) {
      f32x4 s0 = {0.f, 0.f, 0.f, 0.f}, s1 = {0.f, 0.f, 0.f, 0.f};
#pragma unroll
      for (int ks = 0; ks < 2; ++ks) { const bf16x8 a0 = *(const bf16x8*)(Ks + (st * 32 + li) * KS_P + ks * 32 + 8 * g), a1 = *(const bf16x8*)(Ks + (st * 32 + 16 + li) * KS_P + ks * 32 + 8 * g);
        s0 = MFMA16(a0, qf[ks], s0); s1 = MFMA16(a1, qf[ks], s1); }
      const f32x4 c0 = *(const f32x4*)(Cs + st * 32 + 4 * g), c1 = *(const f32x4*)(Cs + st * 32 + 16 + 4 * g);
      float x[8];
#pragma unroll
      for (int j = 0; j < 4; ++j) { x[j] = s0[j] * SC + (cq - c0[j]); x[4 + j] = s1[j] * SC + (cq - c1[j]); }
      if (diag) {
#pragma unroll
        for (int j = 0; j < 4; ++j) { if (st * 32 + 4 * g + j > qrel) x[j] = -INFINITY; if (st * 32 + 16 + 4 * g + j > qrel) x[4 + j] = -INFINITY; }
      }
      float mx = fmaxf(fmaxf(fmaxf(x[0], x[1]), fmaxf(x[2], x[3])), fmaxf(fmaxf(x[4], x[5]), fmaxf(x[6], x[7])));
      mx = fmaxf(mx, __shfl_xor(mx, 16)); mx = fmaxf(mx, __shfl_xor(mx, 32));
      const float mn = fmaxf(m, mx); const float f = ex2(m - mn); m = mn;
      float ps = 0.f;
#pragma unroll
      for (int j = 0; j < 8; ++j) { x[j] = ex2(x[j] - mn); ps += x[j]; }
      lsum = lsum * f + ps;
      const bf16x8 pb = pack_frag(x);
#pragma unroll
      for (int dt = 0; dt < 4; ++dt) { o[dt] = o[dt] * f; o[dt] = MFMA16(vfrag(Vs, dt * 16 + li, st * 32, g), pb, o[dt]); }
    }
    if (kb < qb) {
      at_commit(rg, lds + ((kb + 1) & 1) * AT_BUF, tid);
      if (kb + 2 <= qb) at_issue(rg, Kbase + (size_t)(kb + 2) * 128 * PW, VTbase + (kb + 2) * 128, cum + (kb + 2) * 128, tid);
      __syncthreads();
    }
  }
  lsum += __shfl_xor(lsum, 16); lsum += __shfl_xor(lsum, 32);
  const float inv = 1.f / lsum;
#pragma unroll
  for (int dt = 0; dt < 4; ++dt) { u32x2 w; w.x = pk2(o[dt][0] * inv, o[dt][1] * inv); w.y = pk2(o[dt][2] * inv, o[dt][3] * inv);
    *(u32x2*)(proj + qrow * PW + C_FOXQ + h * 64 + dt * 16 + 4 * g) = w; }
}
__device__ __forceinline__ void ret_unit(const Params& p, int l, unsigned char* lds, int b, int h, int c) {
  asm volatile("" ::: "memory");
  unsigned char* ws = p.ws; bf16* proj = (bf16*)(ws + WS_P);
  int tid = threadIdx.x; asm volatile("" : "+v"(tid)); const int wave = __builtin_amdgcn_readfirstlane(tid >> 6), lane = tid & 63, li = lane & 15, g = lane >> 4;
  const int bh = b * 4 + h; const int nrel = wave * 16 + li; const size_t qrow = (size_t)b * SEQ + c * 128 + nrel;
  const float lg2 = log2f(1.f - exp2f(-5.f - (float)h));
  bf16* RT = (bf16*)(lds + 2 * AT_BUF);
  AtRegs rg; at_issue(rg, proj + ((size_t)b * SEQ + c * 128) * PW + C_RETK + h * 64, (const bf16*)(ws + P_RETVT) + (size_t)bh * 64 * SEQ + c * 128, nullptr, tid);
  { const float cd = ex2(lg2 * 128.f); const float* KV = (const float*)(ws + P_RETKV) + (size_t)bh * 32 * 4096 + (tid >> 3) * 64 + (tid & 7) * 8;
    f32x4 a0 = {0.f, 0.f, 0.f, 0.f}, a1 = {0.f, 0.f, 0.f, 0.f};
    for (int cc = 0; cc < c; ++cc) { const f32x4 k0 = *(const f32x4*)(KV + (size_t)cc * 4096), k1 = *(const f32x4*)(KV + (size_t)cc * 4096 + 4); a0 = a0 * cd + k0; a1 = a1 * cd + k1; }
    __syncthreads();
    const int d = tid >> 3, e0 = (tid & 7) * 8;
#pragma unroll
    for (int e = 0; e < 4; ++e) { RT[(e0 + e) * KS_P + d] = (bf16)f2bf(a0[e]); RT[(e0 + 4 + e) * KS_P + d] = (bf16)f2bf(a1[e]); } }
  at_commit(rg, lds, tid);
  bf16x8 qf[2];
#pragma unroll
  for (int ks = 0; ks < 2; ++ks) qf[ks] = *(const bf16x8*)(proj + qrow * PW + C_RETQ + h * 64 + ks * 32 + 8 * g);
  __syncthreads();
  const bf16* Ks = (const bf16*)(lds + AT_KS); const bf16* Vs = (const bf16*)(lds + AT_VS);
  f32x4 o[4], cr[4];
#pragma unroll
  for (int et = 0; et < 4; ++et) { o[et] = (f32x4){0.f, 0.f, 0.f, 0.f}; cr[et] = (f32x4){0.f, 0.f, 0.f, 0.f};
#pragma unroll
    for (int ks = 0; ks < 2; ++ks) cr[et] = MFMA16(*(const bf16x8*)(RT + (et * 16 + li) * KS_P + ks * 32 + 8 * g), qf[ks], cr[et]); }
  const int nst = (wave >> 1) + 1;
  for (int st = 0; st < nst; ++st) {
    f32x4 s0 = {0.f, 0.f, 0.f, 0.f}, s1 = {0.f, 0.f, 0.f, 0.f};
#pragma unroll
    for (int ks = 0; ks < 2; ++ks) { const bf16x8 a0 = *(const bf16x8*)(Ks + (st * 32 + li) * KS_P + ks * 32 + 8 * g), a1 = *(const bf16x8*)(Ks + (st * 32 + 16 + li) * KS_P + ks * 32 + 8 * g);
      s0 = MFMA16(a0, qf[ks], s0); s1 = MFMA16(a1, qf[ks], s1); }
    float x[8];
#pragma unroll
    for (int j = 0; j < 4; ++j) { const int m0 = st * 32 + 4 * g + j, m1 = m0 + 16;
      x[j] = (m0 <= nrel) ? s0[j] * ex2(lg2 * (float)(nrel - m0)) : 0.f; x[4 + j] = (m1 <= nrel) ? s1[j] * ex2(lg2 * (float)(nrel - m1)) : 0.f; }
    const bf16x8 pb = pack_frag(x);
#pragma unroll
    for (int et = 0; et < 4; ++et) o[et] = MFMA16(vfrag(Vs, et * 16 + li, st * 32, g), pb, o[et]);
  }
  const float xi = ex2(lg2 * (float)(nrel + 1));
  float ss = 0.f;
#pragma unroll
  for (int et = 0; et < 4; ++et)
#pragma unroll
    for (int j = 0; j < 4; ++j) { o[et][j] += xi * cr[et][j]; ss += o[et][j] * o[et][j]; }
  ss += __shfl_xor(ss, 16); ss += __shfl_xor(ss, 32);
  const float rs = rsqrtf(ss * (1.f / 64.f) + EPS);
  const float* gnw = p.in[33] + (size_t)l * G + h * 64;
#pragma unroll
  for (int et = 0; et < 4; ++et) { const int e0 = et * 16 + 4 * g;
    const u32x2 gg = *(const u32x2*)(proj + qrow * PW + C_RETG + h * 64 + e0); const float gt[4] = {bflo(gg.x), bfhi(gg.x), bflo(gg.y), bfhi(gg.y)};
    float r[4];
#pragma unroll
    for (int j = 0; j < 4; ++j) r[j] = o[et][j] * rs * gnw[e0 + j] * (gt[j] * sigmoidf_(gt[j]));
    u32x2 w; w.x = pk2(r[0], r[1]); w.y = pk2(r[2], r[3]);
    *(u32x2*)(proj + qrow * PW + C_RETQ + h * 64 + e0) = w; }
}

constexpr int XP = 264;
__device__ __forceinline__ void xattn_unit(const Params& p, int l, unsigned char* lds, int unit) {
  asm volatile("" ::: "memory");
  unsigned char* ws = p.ws; bf16* qb = (bf16*)(ws + WS_P);
  int tid = threadIdx.x; asm volatile("" : "+v"(tid)); const int wave = __builtin_amdgcn_readfirstlane(tid >> 6), lane = tid & 63, li = lane & 15, g = lane >> 4;
  const int b = unit >> 6, head = (unit >> 4) & 3, qt = unit & 15;
  bf16* L = (bf16*)lds;
  const bf16* kg = (const bf16*)(ws + WS_KM) + ((size_t)l * 1024 + b * 256) * 1024 + head * 256;
  const bf16* vg = (const bf16*)(ws + WS_VMT) + (size_t)(((l * 4 + b) * 4 + head) * 256) * 256;
  __syncthreads();
  for (int i = 0; i < 16; ++i) { const int id = tid + 512 * i, row = id >> 5, ch = id & 31; *(u32x4*)(L + row * XP + ch * 8) = *(const u32x4*)(kg + (size_t)row * 1024 + ch * 8); }
  __syncthreads();
  bf16x8 pb[2][8]; float linv[2];
  const float SC = LOG2E / 16.f;
#pragma unroll
  for (int grp = 0; grp < 2; ++grp) {
    const size_t row = (size_t)b * SEQ + qt * 256 + wave * 32 + grp * 16 + li;
    bf16x8 qf[8];
#pragma unroll
    for (int ks = 0; ks < 8; ++ks) qf[ks] = *(const bf16x8*)(qb + row * 1024 + head * 256 + ks * 32 + 8 * g);
    f32x4 s[16];
#pragma unroll
    for (int kt = 0; kt < 16; ++kt) { s[kt] = (f32x4){0.f, 0.f, 0.f, 0.f};
#pragma unroll
      for (int ks = 0; ks < 8; ++ks) s[kt] = MFMA16(*(const bf16x8*)(L + (kt * 16 + li) * XP + ks * 32 + 8 * g), qf[ks], s[kt]);
      if ((kt & 1) == 1) __builtin_amdgcn_sched_barrier(0); }
    float mx = -INFINITY;
#pragma unroll
    for (int kt = 0; kt < 16; ++kt) mx = fmaxf(mx, fmaxf(fmaxf(s[kt][0], s[kt][1]), fmaxf(s[kt][2], s[kt][3])));
    mx = fmaxf(mx, __shfl_xor(mx, 16)); mx = fmaxf(mx, __shfl_xor(mx, 32));
    float ps = 0.f;
#pragma unroll
    for (int kt = 0; kt < 16; ++kt)
#pragma unroll
      for (int j = 0; j < 4; ++j) { s[kt][j] = ex2((s[kt][j] - mx) * SC); ps += s[kt][j]; }
    ps += __shfl_xor(ps, 16); ps += __shfl_xor(ps, 32);
    linv[grp] = 1.f / ps;
#pragma unroll
    for (int kk = 0; kk < 8; ++kk) { float x[8];
#pragma unroll
      for (int j = 0; j < 4; ++j) { x[j] = s[2 * kk][j]; x[4 + j] = s[2 * kk + 1][j]; }
      pb[grp][kk] = pack_frag(x); }
    __builtin_amdgcn_sched_barrier(0);
  }
  __syncthreads();
  for (int i = 0; i < 16; ++i) { const int id = tid + 512 * i, row = id >> 5, ch = id & 31; *(u32x4*)(L + row * XP + ch * 8) = *(const u32x4*)(vg + (size_t)row * 256 + ch * 8); }
  __syncthreads();
#pragma unroll
  for (int grp = 0; grp < 2; ++grp) {
    const size_t row = (size_t)b * SEQ + qt * 256 + wave * 32 + grp * 16 + li;
#pragma unroll
    for (int dt = 0; dt < 16; ++dt) { f32x4 o = {0.f, 0.f, 0.f, 0.f};
#pragma unroll
      for (int kk = 0; kk < 8; ++kk) { const u32x2 lo = *(const u32x2*)(L + (dt * 16 + li) * XP + kk * 32 + 4 * g), hi = *(const u32x2*)(L + (dt * 16 + li) * XP + kk * 32 + 16 + 4 * g);
        const u32x4 w = {lo.x, lo.y, hi.x, hi.y}; o = MFMA16(__builtin_bit_cast(bf16x8, w), pb[grp][kk], o); }
      u32x2 w; w.x = pk2(o[0] * linv[grp], o[1] * linv[grp]); w.y = pk2(o[2] * linv[grp], o[3] * linv[grp]);
      *(u32x2*)(qb + row * 1024 + head * 256 + dt * 16 + 4 * g) = w;
      __builtin_amdgcn_sched_barrier(0); }
  }
}

#ifndef DEBUG_LAUNCHES
#define DEBUG_LAUNCHES 0
#endif
constexpr int PH_PER_LAYER = 13, N_PHASES = 1 + PH_PER_LAYER * DEPTH;

__global__ void __launch_bounds__(NTHREADS) mega_fwd(Params p) {
  extern __shared__ __attribute__((aligned(16))) unsigned char lds[];
  cg::grid_group grid = cg::this_grid();
  constexpr int NB = 256, NGW = NB * NWAVES;
  unsigned char* ws = p.ws;
  PG8_LAS unsigned char* glds = (PG8_LAS unsigned char*)lds;
  bf16* Hb = (bf16*)(ws + WS_H); bf16* Ob = (bf16*)(ws + WS_O); bf16* Pb = (bf16*)(ws + WS_P);
  int ph = 0;
#ifdef DBG_CLR
#define DBG_LDSCLEAR { for (int e_ = threadIdx.x; e_ < LDS_BYTES / 4; e_ += NTHREADS) ((unsigned*)lds)[e_] = 0u; __syncthreads(); }
#else
#define DBG_LDSCLEAR
#endif
#define PHASE_BEGIN if (ph >= p.ph_lo && ph < p.ph_hi) { int tid = threadIdx.x; asm volatile("" : "+v"(tid)); const int lane = tid & 63, wave = __builtin_amdgcn_readfirstlane(tid >> 6), gw = blockIdx.x * NWAVES + wave; (void)lane; (void)gw; DBG_LDSCLEAR
#define PHASE_END   if (ph + 1 < p.ph_hi) grid.sync(); } ++ph;

  PHASE_BEGIN
    float* scr = (float*)lds + wave * (64 * 33);
    conv_layer_weights(p, 0, scr, gw, NGW, lane);
    { constexpr int I_SQ = (D / 64) * (D / 32);
      for (int it = gw; it < 4 * I_SQ; it += NGW) { const int w = it / I_SQ, r = it % I_SQ, layer = w >> 1, isv = w & 1;
        conv_item<0>(p.in[isv ? 36 : 35] + (size_t)layer * D * D, D, D, D, (bf16*)(ws + WS_WKV) + (size_t)w * D * D, scr, r, lane); } }
    for (int l = 0; l < DEPTH; ++l) { RowArgs a{}; a.xin = p.in[1]; a.g_pre = p.in[6] + (size_t)l * D; a.hout = (bf16*)(ws + WS_MEMN) + (size_t)l * 1024 * 1024; a.rows = 1024; row_phase(a, gw, NGW, lane); }
    { RowArgs a{}; a.xin = p.in[0]; a.g_pre = p.in[2]; a.hout = Hb; a.wf = p.in[9]; a.fbias = p.in[11]; a.logf = (float*)(ws + SM_LOGF); a.rows = T; row_phase(a, gw, NGW, lane); }
#ifdef DBG_FILLG
    for (int e = blockIdx.x * NTHREADS + tid; e < T * G / 2; e += NB * NTHREADS) ((unsigned*)(ws + RW_G))[e] = 0x447A447Au;
#endif
    for (int e = blockIdx.x * NTHREADS + tid; e < SEQ * 32; e += NB * NTHREADS) { const int pos = e >> 5, i = e & 31; const float inv = 1.f / powf(10000.f, (float)i / 31.f); const float ang = (float)pos * inv;
      ((float*)(ws + SM_ROT))[2 * e] = cosf(ang); ((float*)(ws + SM_ROT))[2 * e + 1] = sinf(ang); }
  PHASE_END

  for (int l = 0; l < DEPTH; ++l) {
    PHASE_BEGIN
      { pg8::Gemm g{Hb, (const bf16*)(ws + W_IN), T, NIN, D, D}; pg8::StaticOrder S; S.init(T, NIN, NB, (int)blockIdx.x);
        EpiIn E{Pb, (bf16*)(ws + P_FOXVT), (bf16*)(ws + P_RETKT), (bf16*)(ws + P_RETVT), (const float*)(ws + SM_ROT)};
        pg8::gemm_phase<EpiIn, pg8::StaticOrder, true, true>(glds, g, S, E); }
      if (l == 0) { pg8::Gemm g{(const bf16*)(ws + WS_MEMN), (const bf16*)(ws + WS_WKV), 2048, 4096, D, D}; MemSched S{NB, (int)blockIdx.x};
        EpiMem E{(bf16*)(ws + WS_KM), (bf16*)(ws + WS_VMT)};
        pg8::gemm_phase<EpiMem, MemSched, true, true>(glds, g, S, E); }
    PHASE_END
    PHASE_BEGIN
      float* wl = (float*)lds + wave * (16 * WLP);
      for (int u = gw; u < 1024; u += NGW) rwkv_prep_unit(p, l, u, wl, lane);
      for (int u = gw; u < 512; u += NGW) ret_kv_unit(p, u, lane);
      for (int u = gw; u < 16; u += NGW) fox_cum_unit(p, u, lane);
      if (blockIdx.x == 0 && tid == 0) *(int*)(ws + SM_Q) = 0;
    PHASE_END
    PHASE_BEGIN
#ifndef DBG_P3
#define DBG_P3 15
#endif
      if (blockIdx.x < 64) { if (DBG_P3 & 1) rwkv_scan_unit(p, (float*)lds, blockIdx.x); }
      else if (blockIdx.x < 80) { if (DBG_P3 & 2) lru_unit(p, l, (float*)lds, blockIdx.x - 64); }
      int* qword = (int*)(lds + LDS_BYTES - 16);
      for (;;) {
        __syncthreads();
        if (tid == 0) *qword = atomicAdd((int*)(ws + SM_Q), 1);
        __syncthreads();
        const int id = *qword;
        if (id >= 1024) break;
        if (id < 512) { if (DBG_P3 & 4) fox_unit(p, lds, (id & 15) >> 2, id & 3, 31 - (id >> 4)); }
        else if (DBG_P3 & 8) { const int r = id - 512; ret_unit(p, l, lds, r >> 7, (r >> 5) & 3, r & 31); }
      }
    PHASE_END
    PHASE_BEGIN
      for (int row = gw; row < T; row += NGW) rwkv_post_row(p, l, row, lane);
    PHASE_END
    PHASE_BEGIN
      pg8::Gemm g{Pb, (const bf16*)(ws + W_OUT), T, D, D, PW}; pg8::StaticOrder S; S.init(T, D, NB, (int)blockIdx.x);
      EpiPlain E{Ob, D, 0, nullptr};
      pg8::gemm_phase<EpiPlain, pg8::StaticOrder, true, true>(glds, g, S, E);
    PHASE_END
    PHASE_BEGIN
      RowArgs a{}; a.xin = l == 0 ? p.in[0] : p.out; a.O = Ob; a.g_post = p.in[3] + (size_t)l * D; a.xout = p.out; a.g_pre = p.in[4] + (size_t)l * D; a.hout = Hb; a.rows = T;
      row_phase(a, gw, NGW, lane);
    PHASE_END
    PHASE_BEGIN
      pg8::Gemm g{Hb, (const bf16*)(ws + W_Q), T, D, D, D}; pg8::StaticOrder S; S.init(T, D, NB, (int)blockIdx.x);
      EpiPlain E{Pb, D, 0, nullptr};
      pg8::gemm_phase<EpiPlain, pg8::StaticOrder, true, true>(glds, g, S, E);
    PHASE_END
    PHASE_BEGIN
      for (int u = blockIdx.x; u < 256; u += NB) xattn_unit(p, l, lds, u);
    PHASE_END
    PHASE_BEGIN
      pg8::Gemm g{Pb, (const bf16*)(ws + W_O), T, D, D, D}; pg8::StaticOrder S; S.init(T, D, NB, (int)blockIdx.x);
      EpiPlain E{Ob, D, 0, nullptr};
      pg8::gemm_phase<EpiPlain, pg8::StaticOrder, true, true>(glds, g, S, E);
    PHASE_END
    PHASE_BEGIN
      RowArgs a{}; a.xin = p.out; a.O = Ob; a.g_post = p.in[5] + (size_t)l * D; a.xout = p.out; a.g_pre = p.in[7] + (size_t)l * D; a.hout = Hb; a.rows = T;
      row_phase(a, gw, NGW, lane);
    PHASE_END
    PHASE_BEGIN
      pg8::Gemm g{Hb, (const bf16*)(ws + W_1), T, DFF, D, D}; pg8::StaticOrder S; S.init(T, DFF, NB, (int)blockIdx.x);
      EpiPlain E{Pb, DFF, 1, nullptr};
      pg8::gemm_phase<EpiPlain, pg8::StaticOrder, true, true>(glds, g, S, E);
    PHASE_END
    PHASE_BEGIN
      pg8::Gemm g{Pb, (const bf16*)(ws + W_2), T, D, DFF, DFF}; pg8::StaticOrder S; S.init(T, D, NB, (int)blockIdx.x);
      EpiPlain E{Ob, D, 0, nullptr};
      pg8::gemm_phase<EpiPlain, pg8::StaticOrder, true, true>(glds, g, S, E);
    PHASE_END
    PHASE_BEGIN
      RowArgs a{}; a.xin = p.out; a.O = Ob; a.g_post = p.in[8] + (size_t)l * D; a.xout = p.out; a.rows = T;
      if (l + 1 < DEPTH) { a.g_pre = p.in[2] + (size_t)(l + 1) * D; a.hout = Hb; a.wf = p.in[9] + (size_t)(l + 1) * D * INW; a.fbias = p.in[11] + (size_t)(l + 1) * GH; a.logf = (float*)(ws + SM_LOGF); }
      row_phase(a, gw, NGW, lane);
      if (l + 1 < DEPTH) { __syncthreads(); conv_layer_weights(p, l + 1, (float*)lds + wave * (64 * 33), gw, NGW, lane); }
    PHASE_END
  }
}


#ifdef DBG_STOP
#ifndef DBG_MASK
#define DBG_MASK 15
#endif
__global__ void dbg_dump(const unsigned char* ws, float* out) {
  const size_t i = (size_t)blockIdx.x * 256 + threadIdx.x; const int row = (int)(i >> 10), c = (int)(i & 1023);
#ifndef DBG_SRC
#define DBG_SRC 0
#endif
#ifndef DBG_COFF
#define DBG_COFF 0
#endif
  const bf16* proj = (const bf16*)(ws + WS_P);
  if (DBG_SRC == 0) out[i] = ((DBG_MASK >> (c >> 8)) & 1) ? bflo((unsigned)proj[(size_t)row * PW + DBG_COFF + c]) : 0.f;
  else if (DBG_SRC == 1) { const bf16* a = (const bf16*)(ws + WS_RW) + (size_t)(c >> 8) * (8u << 19); out[i] = ((DBG_MASK >> (c >> 8)) & 1) ? bflo((unsigned)a[(size_t)row * G + (c & 255)]) : 0.f; }
  else if (DBG_SRC == 2) { const bf16* a = (const bf16*)(ws + RW_K) + (size_t)(c >> 8) * (8u << 19); float v = 0.f; if (c < 768) v = bflo((unsigned)a[(size_t)row * G + (c & 255)]); else if (c < 772) v = ((const float*)(ws + SM_BR))[row * 4 + (c & 3)]; else if (c < 776) v = ((const float*)(ws + SM_KR))[row * 4 + (c & 3)]; else if (c < 780) v = ((const float*)(ws + SM_RK))[row * 4 + (c & 3)];
    out[i] = ((DBG_MASK >> (c >> 8)) & 1) ? v : 0.f; }
  else if (DBG_SRC == 5) { out[i] = c < 256 ? bflo((unsigned)((const bf16*)(ws + RW_G))[(size_t)row * G + c]) : 0.f; }
  else if (DBG_SRC == 4) { out[i] = i < 512 * 1024 ? bflo((unsigned)((const bf16*)(ws + W_SMALL))[i]) : 0.f; }
  else { out[i] = c < 256 ? ((const float*)(ws + RW_Y))[(size_t)row * G + c] : 0.f; }
}
#endif

#ifdef DBG_GCHK
__global__ void dbg_snap(const unsigned char* ws, float* out) { const size_t i = (size_t)blockIdx.x * 256 + threadIdx.x; ((unsigned*)out)[i] = ((const unsigned*)(ws + RW_G))[i]; if (i == 0) *(unsigned*)(ws + SM_Q + 64) = 0u; }
__global__ void dbg_cmp(unsigned char* ws, const float* out) { const size_t i = (size_t)blockIdx.x * 256 + threadIdx.x; const unsigned a = ((const unsigned*)(ws + RW_G))[i], b = ((const unsigned*)out)[i];
  if (a != b) { unsigned f = 1u; if (a == 0x447A447Au) f |= 2u; else f |= 4u; atomicOr((unsigned*)(ws + SM_Q + 64), f); } }
__global__ void dbg_fin(const unsigned char* ws, float* out) { const size_t i = (size_t)blockIdx.x * 256 + threadIdx.x; out[i] = (i == 0) ? 1.0e6f * (float)(*(const unsigned*)(ws + SM_Q + 64)) : 0.f; }
#endif
extern "C" void kernel_launch(void* const* d_in, const int* in_sizes, int n_in, void* d_out, int out_size, void* d_ws, size_t ws_size, hipStream_t stream) {
  static int grid = 0;
  if (grid == 0) {
    if (ws_size < WS_END) { fprintf(stderr, "kernel_launch: workspace too small: %zu < %zu\n", ws_size, (size_t)WS_END); grid = -1; return; }
    int dev = 0, cus = 0, per_cu = 0;
    hipGetDevice(&dev); hipDeviceGetAttribute(&cus, hipDeviceAttributeMultiprocessorCount, dev);
    hipFuncSetAttribute((const void*)mega_fwd, hipFuncAttributeMaxDynamicSharedMemorySize, LDS_BYTES);
    hipOccupancyMaxActiveBlocksPerMultiprocessor(&per_cu, (const void*)mega_fwd, NTHREADS, LDS_BYTES);
    if (per_cu < 1) { fprintf(stderr, "kernel_launch: occupancy query says %d blocks/CU\n", per_cu); per_cu = 1; }
    grid = 256;
    if (cus < 256) { fprintf(stderr, "kernel_launch: needs 256 CUs, device has %d\n", cus); grid = -1; return; }
    (void)hipGetLastError();
  }
  if (grid < 0) return;
  Params p{};
  for (int i = 0; i < 40; ++i) p.in[i] = (const float*)d_in[i];
  p.out = (float*)d_out; p.ws = (unsigned char*)d_ws;
#if DEBUG_LAUNCHES
#ifdef DBG_GCHK
  for (int ph = 0; ph < 3; ++ph) { p.ph_lo = ph; p.ph_hi = ph + 1; hipLaunchKernelGGL(mega_fwd, dim3(grid), dim3(NTHREADS), LDS_BYTES, stream, p); }
  hipLaunchKernelGGL(dbg_snap, dim3(T * G / 2 / 256), dim3(256), 0, stream, (const unsigned char*)d_ws, (float*)d_out);
  p.ph_lo = 3; p.ph_hi = 4; hipLaunchKernelGGL(mega_fwd, dim3(grid), dim3(NTHREADS), LDS_BYTES, stream, p);
  hipLaunchKernelGGL(dbg_cmp, dim3(T * G / 2 / 256), dim3(256), 0, stream, (unsigned char*)d_ws, (const float*)d_out);
  hipLaunchKernelGGL(dbg_fin, dim3(T * 1024 / 256), dim3(256), 0, stream, (const unsigned char*)d_ws, (float*)d_out);
#elif defined(DBG_STOP)
  for (int ph = 0; ph < DBG_STOP; ++ph) { p.ph_lo = ph; p.ph_hi = ph + 1; hipLaunchKernelGGL(mega_fwd, dim3(grid), dim3(NTHREADS), LDS_BYTES, stream, p); }
  hipLaunchKernelGGL(dbg_dump, dim3(T * 1024 / 256), dim3(256), 0, stream, (const unsigned char*)d_ws, (float*)d_out);
#else
  for (int ph = 0; ph < N_PHASES; ++ph) { p.ph_lo = ph; p.ph_hi = ph + 1; hipLaunchKernelGGL(mega_fwd, dim3(grid), dim3(NTHREADS), LDS_BYTES, stream, p); }
#endif
#else
  p.ph_lo = 0; p.ph_hi = N_PHASES;
  void* args[] = {&p};
  hipError_t e = hipLaunchCooperativeKernel((const void*)mega_fwd, dim3(grid), dim3(NTHREADS), args, LDS_BYTES, stream);
  if (e != hipSuccess) fprintf(stderr, "cooperative launch failed: %s (grid %d)\n", hipGetErrorString(e), grid);
#endif
}
```

```cpp
#include <hip/hip_runtime.h>
#include <hip/hip_cooperative_groups.h>
#include <cstdio>
#include <cstdint>
#include <cmath>
namespace cg = cooperative_groups;
namespace pg8 {
#define PG8_LAS __attribute__((address_space(3)))
typedef unsigned short bf16_t;
typedef short bf16x8 __attribute__((ext_vector_type(8)));
typedef float f32x4 __attribute__((ext_vector_type(4)));
typedef unsigned u32x4 __attribute__((ext_vector_type(4)));
constexpr int BM = 256, BK = 64, HALF = 128, HTB = HALF * BK * 2  , STAGE_BYTES = 8 * HTB, NXCD = 8, WGM = 8;

__host__ __device__ __forceinline__ int lds_byte(int r, int c) { const int st = (r >> 4) * 2 + (c >> 5), rr = r & 15, cc = c & 31, ob = rr * 64 + cc * 2; return st * 1024 + (ob ^ (((ob >> 9) & 1) << 5)); }
__host__ __device__ __forceinline__ void stage_rc(int b, int& R, int& C) { const int st = b / 1024, sb = b % 1024, swz = sb ^ (((sb >> 9) & 1) << 5); R = (st >> 1) * 16 + swz / 64; C = (st & 1) * 32 + (swz % 64) / 2; }
__host__ __device__ __forceinline__ int perm32(int rho) { const int n = rho >> 4, i = rho & 15; return 8 * (i >> 2) + 4 * n + (i & 3); }

struct Unit { int pm, pn; };
struct Gemm { const bf16_t* A; const bf16_t* Bt; int M, N, K, lda; };

struct StaticOrder {
    int nM, nN, nwg, G, c;
    __host__ __device__ void init(int M, int N, int G_, int c_) { nM = M / BM; nN = N / BM; nwg = nM * nN; G = G_; c = c_; }
    __host__ __device__ bool next(int i, Unit& u) const {
        const long L = (long)i * G + c; if (L >= nwg) return false;
        int wgid = (int)L; { const int q = nwg / NXCD, r = nwg % NXCD, xcd = wgid % NXCD, off = wgid / NXCD; wgid = (xcd < r ? xcd * (q + 1) : r * (q + 1) + (xcd - r) * q) + off; }
        const int nig = WGM * nN, gid = wgid / nig, fm = gid * WGM, gsz = (nM - fm) < WGM ? (nM - fm) : WGM;
        u.pm = fm + ((wgid % nig) % gsz); u.pn = (wgid % nig) / gsz; return true;
    }
    __device__ __forceinline__ void a_ready(const Unit&) const {}
    __device__ __forceinline__ void done(const Unit&) const {}
};

__device__ __forceinline__ unsigned cvt_pk_bf16(float lo, float hi) { unsigned r; asm volatile("v_cvt_pk_bf16_f32 %0, %1, %2" : "=v"(r) : "v"(lo), "v"(hi)); return r; }
typedef float f32x2 __attribute__((ext_vector_type(2)));
template <class Epi, class Sched, bool ALIGN_EPI = false, bool SP2 = false>
__device__ __forceinline__ void gemm_phase(PG8_LAS unsigned char* lds, const Gemm g, const Sched& S, const Epi& E) {
    int tid_l = threadIdx.x; asm volatile("" : "+v"(tid_l));
    const int tid = tid_l, wid = __builtin_amdgcn_readfirstlane(tid >> 6), lane = tid & 63, wr = wid >> 2, wc = wid & 3, fr = lane & 15, fq = lane >> 4;
    const int K = g.K, nt = K / BK;
    unsigned voffA[2], voffB[2];
#pragma unroll
    for (int i = 0; i < 2; ++i) { int R, C; stage_rc(tid * 16 + i * 8192, R, C); const int Rb = Epi::PERM ? ((R & ~31) + perm32(R & 31)) : R;
        voffA[i] = (unsigned)(R * g.lda + C) * 2u; voffB[i] = (unsigned)(Rb * K + C) * 2u; }
    const size_t kstep = (size_t)(BK * 2);
    const size_t hstep = (size_t)HALF * K * 2;
    const size_t tstep = 2 * hstep; const size_t hstepA = (size_t)HALF * g.lda * 2; const size_t tstepA = 2 * hstepA;
    const unsigned ldsw = (unsigned)wid * 1024u;
    const int aoff = lds_byte(wr * 64 + fr, fq * 8), boff = lds_byte(wc * 32 + fr, fq * 8);
#define PG8_SA(b, h) (((b) * 2 + (h)) * HTB)
#define PG8_SB(b, h) ((4 + (b) * 2 + (h)) * HTB)
#define PG8_STAGE(bufoff, gbase, voff) do { _Pragma("unroll") for (int _i = 0; _i < 2; ++_i) \
        __builtin_amdgcn_global_load_lds((const unsigned*)((const char*)(gbase) + (voff)[_i]), (PG8_LAS unsigned*)(lds + (bufoff) + ldsw + _i * 8192), 16, 0, 0); } while (0)
#define PG8_LDA(dst, b, h) do { _Pragma("unroll") for (int m = 0; m < 4; ++m) _Pragma("unroll") for (int k = 0; k < 2; ++k) dst[m][k] = *(const PG8_LAS bf16x8*)(lds + PG8_SA(b, h) + aoff + m * 2048 + k * 1024); } while (0)
#define PG8_LDB(dst, b, h) do { _Pragma("unroll") for (int n = 0; n < 2; ++n) _Pragma("unroll") for (int k = 0; k < 2; ++k) dst[n][k] = *(const PG8_LAS bf16x8*)(lds + PG8_SB(b, h) + boff + n * 2048 + k * 1024); } while (0)
#define PG8_MMA(ai, bj, At, Bt) do { __builtin_amdgcn_s_setprio(1); _Pragma("unroll") for (int m = 0; m < 4; ++m) _Pragma("unroll") for (int n = 0; n < 2; ++n) _Pragma("unroll") for (int k = 0; k < 2; ++k) \
        acc[ai][bj][m][n] = __builtin_amdgcn_mfma_f32_16x16x32_bf16(Bt[n][k], At[m][k], acc[ai][bj][m][n], 0, 0, 0); __builtin_amdgcn_s_setprio(0); } while (0)
#define PG8_WAIT_V(n) asm volatile("s_waitcnt vmcnt(" #n ")" ::: "memory")
#define PG8_WAIT_L(n) asm volatile("s_waitcnt lgkmcnt(" #n ")" ::: "memory")
#define PG8_BAR __builtin_amdgcn_s_barrier()
#define PG8_SCHED __builtin_amdgcn_sched_barrier(0)
    Unit cur, nxt; int ui = 0;
    if (!S.next(0, cur)) return;
    f32x4 acc[2][2][4][2];
#pragma unroll
    for (int a = 0; a < 2; ++a)
#pragma unroll
        for (int b = 0; b < 2; ++b)
#pragma unroll
            for (int m = 0; m < 4; ++m)
#pragma unroll
                for (int n = 0; n < 2; ++n) acc[a][b][m][n] = (f32x4){0.f, 0.f, 0.f, 0.f};
    bf16x8 At[4][2], B0[2][2], B1[2][2];
    const char* cA = (const char*)g.A + (size_t)cur.pm * tstepA; const char* cB = (const char*)g.Bt + (size_t)cur.pn * tstep;
    S.a_ready(cur);
    if constexpr (SP2) {
        PG8_STAGE(PG8_SB(0, 0), cB, voffB); PG8_STAGE(PG8_SB(0, 1), cB + hstep, voffB); PG8_STAGE(PG8_SA(0, 0), cA, voffA); PG8_STAGE(PG8_SA(0, 1), cA + hstepA, voffA);
        if (wr == 1) PG8_BAR;
        PG8_WAIT_V(2); PG8_BAR;
        PG8_STAGE(PG8_SB(1, 0), cB + kstep, voffB); PG8_STAGE(PG8_SA(1, 0), cA + kstep, voffA); PG8_STAGE(PG8_SB(1, 1), cB + hstep + kstep, voffB);
        PG8_WAIT_V(6); PG8_BAR;
    } else {
        PG8_STAGE(PG8_SB(0, 0), cB, voffB); PG8_STAGE(PG8_SA(0, 0), cA, voffA); PG8_STAGE(PG8_SB(0, 1), cB + hstep, voffB); PG8_STAGE(PG8_SA(0, 1), cA + hstepA, voffA);
        if (wr == 1) PG8_BAR;
        PG8_WAIT_V(4); PG8_BAR;
        PG8_STAGE(PG8_SB(1, 0), cB + kstep, voffB); PG8_STAGE(PG8_SA(1, 0), cA + kstep, voffA); PG8_STAGE(PG8_SB(1, 1), cB + hstep + kstep, voffB);
        PG8_WAIT_V(6); PG8_BAR;
    }
    for (;;) {
        const bool has_next = S.next(ui + 1, nxt);
        const char* nA = has_next ? (const char*)g.A + (size_t)nxt.pm * tstepA : cA; const char* nB = has_next ? (const char*)g.Bt + (size_t)nxt.pn * tstep : cB;
        for (int t = 0; t < nt; t += 2) {
            const bool last = (t == nt - 2);
            const char* a1 = cA + (size_t)(t + 1) * kstep;
            const char* a2 = last ? nA : cA + (size_t)(t + 2) * kstep; const char* b2 = last ? nB : cB + (size_t)(t + 2) * kstep;
            const char* a3 = a2 + kstep; const char* b3 = b2 + kstep;
            if (last && has_next) S.a_ready(nxt);
            if constexpr (SP2) {
            PG8_LDB(B0, 0, 0); PG8_LDB(B1, 0, 1); PG8_SCHED; PG8_LDA(At, 0, 0); PG8_STAGE(PG8_SA(1, 1), a1 + hstepA, voffA);
            PG8_WAIT_V(8); PG8_WAIT_L(0); PG8_BAR; PG8_MMA(0, 0, At, B0); PG8_MMA(0, 1, At, B1); PG8_BAR; PG8_SCHED;
            PG8_LDA(At, 0, 1); PG8_STAGE(PG8_SB(0, 0), b2, voffB); PG8_STAGE(PG8_SB(0, 1), b2 + hstep, voffB); PG8_STAGE(PG8_SA(0, 0), a2, voffA);
            PG8_WAIT_V(8); PG8_WAIT_L(0); PG8_BAR; PG8_MMA(1, 0, At, B0); PG8_MMA(1, 1, At, B1); PG8_BAR; PG8_SCHED;
            PG8_LDB(B0, 1, 0); PG8_LDB(B1, 1, 1); PG8_SCHED; PG8_LDA(At, 1, 0); PG8_STAGE(PG8_SA(0, 1), a2 + hstepA, voffA);
            PG8_WAIT_V(8); PG8_WAIT_L(0); PG8_BAR; PG8_MMA(0, 0, At, B0); PG8_MMA(0, 1, At, B1); PG8_BAR; PG8_SCHED;
            PG8_LDA(At, 1, 1); PG8_STAGE(PG8_SB(1, 0), b3, voffB); PG8_STAGE(PG8_SB(1, 1), b3 + hstep, voffB); PG8_STAGE(PG8_SA(1, 0), a3, voffA);
            PG8_WAIT_V(8); PG8_WAIT_L(0); PG8_BAR; PG8_MMA(1, 0, At, B0); PG8_MMA(1, 1, At, B1); PG8_BAR; PG8_SCHED;
            } else {
            PG8_LDB(B0, 0, 0); PG8_SCHED; PG8_LDA(At, 0, 0); PG8_STAGE(PG8_SA(1, 1), a1 + hstepA, voffA);
            PG8_WAIT_L(8); PG8_BAR; PG8_WAIT_L(0); PG8_MMA(0, 0, At, B0); PG8_BAR; PG8_SCHED;
            PG8_LDB(B1, 0, 1); PG8_STAGE(PG8_SB(0, 0), b2, voffB);
            PG8_BAR; PG8_WAIT_L(0); PG8_MMA(0, 1, At, B1); PG8_BAR;
            PG8_LDA(At, 0, 1); PG8_STAGE(PG8_SA(0, 0), a2, voffA);
            PG8_BAR; PG8_WAIT_L(0); PG8_MMA(1, 0, At, B0); PG8_BAR; PG8_SCHED;
            PG8_STAGE(PG8_SB(0, 1), b2 + hstep, voffB);
            PG8_WAIT_V(6); PG8_BAR; PG8_MMA(1, 1, At, B1); PG8_BAR;
            PG8_LDB(B0, 1, 0); PG8_SCHED; PG8_LDA(At, 1, 0); PG8_STAGE(PG8_SA(0, 1), a2 + hstepA, voffA);
            PG8_WAIT_L(8); PG8_BAR; PG8_WAIT_L(0); PG8_MMA(0, 0, At, B0); PG8_BAR; PG8_SCHED;
            PG8_LDB(B1, 1, 1); PG8_STAGE(PG8_SB(1, 0), b3, voffB);
            PG8_BAR; PG8_WAIT_L(0); PG8_MMA(0, 1, At, B1); PG8_BAR;
            PG8_LDA(At, 1, 1); PG8_STAGE(PG8_SA(1, 0), a3, voffA);
            PG8_BAR; PG8_WAIT_L(0); PG8_MMA(1, 0, At, B0); PG8_BAR; PG8_SCHED;
            PG8_STAGE(PG8_SB(1, 1), b3 + hstep, voffB);
            PG8_WAIT_V(6); PG8_BAR; PG8_MMA(1, 1, At, B1); PG8_BAR;
            }
        }
        if constexpr (ALIGN_EPI) { if (wr == 0) PG8_BAR; }
        if constexpr (!Epi::AFTER_DRAIN) { E(acc, cur, wr, wc, fr, fq); S.done(cur); }
        if (!has_next) break;
#pragma unroll
        for (int a = 0; a < 2; ++a)
#pragma unroll
            for (int b = 0; b < 2; ++b)
#pragma unroll
                for (int m = 0; m < 4; ++m)
#pragma unroll
                    for (int n = 0; n < 2; ++n) acc[a][b][m][n] = (f32x4){0.f, 0.f, 0.f, 0.f};
        cur = nxt; cA = nA; cB = nB; ++ui;
        if constexpr (ALIGN_EPI) { if (wr == 1) PG8_BAR; }
    }
    PG8_WAIT_V(0);
    if constexpr (!ALIGN_EPI) { if (wr == 0) PG8_BAR; }
    PG8_BAR;
    if constexpr (Epi::AFTER_DRAIN) { E.fused(acc, cur, wr, wc, fr, fq, lds, wid, lane); S.done(cur); }
#undef PG8_SA
#undef PG8_SB
#undef PG8_STAGE
#undef PG8_LDA
#undef PG8_LDB
#undef PG8_MMA
#undef PG8_WAIT_V
#undef PG8_WAIT_L
#undef PG8_BAR
#undef PG8_SCHED
}
}

typedef unsigned short bf16;
typedef short bf16x8 __attribute__((ext_vector_type(8)));
typedef short bf16x4 __attribute__((ext_vector_type(4)));
typedef float f32x4 __attribute__((ext_vector_type(4)));
typedef float f32x2 __attribute__((ext_vector_type(2)));
typedef unsigned u32x4 __attribute__((ext_vector_type(4)));
typedef unsigned u32x2 __attribute__((ext_vector_type(2)));

constexpr int D = 1024, BATCH = 4, SEQ = 4096, DEPTH = 2, T = BATCH * SEQ;
constexpr int MEM = 256;
constexpr int G = 256, HD = 64, GH = 4;
constexpr int INW = 3332, DFF = 4096;
constexpr float EPS = 1e-6f, LOG2E = 1.4426950408889634f;
constexpr int NTHREADS = 512, NWAVES = 8;
constexpr int PW = 2816;
constexpr int C_FOXQ = 0, C_LRUY = 256, C_RWR = 512, C_RETQ = 768, C_FOXK = 1024, C_LRUX = 1280, C_RWK = 1536, C_RWV = 1792, C_RWX = 2048, C_RETK = 2304, C_RETG = 2560;
constexpr int NIN = 3328;
__device__ __constant__ const int kSrcCol[13] = {0, 1028, 1284, 2308, 256, 772, 1540, 1796, 2052, 2564, 3076, 512, 2820};

constexpr size_t MiB = 1u << 20;
constexpr size_t WS_W = 0;
constexpr size_t W_IN = 0, W_OUT = 7 * MiB, W_Q = 9 * MiB, W_O = 11 * MiB, W_1 = 13 * MiB, W_2 = 21 * MiB, W_SMALL = 29 * MiB;
constexpr size_t WS_W2T = W_SMALL, WS_A2T = WS_W2T + 256 * 64 * 2, WS_G2T = WS_A2T + 256 * 64 * 2, WS_V1T = WS_G2T + 256 * 128 * 2, WS_V2T = WS_V1T + 32 * 256 * 2, WS_RAT = WS_V2T + 256 * 32 * 2, WS_RIT = WS_RAT + 4 * 64 * 64 * 2;
constexpr size_t WS_P = 30 * MiB;
constexpr size_t P_FOXVT = WS_P + 88 * MiB, P_RETKT = WS_P + 96 * MiB, P_RETVT = WS_P + 104 * MiB, P_RETKV = WS_P + 112 * MiB;
constexpr size_t WS_RW = 158 * MiB;
constexpr size_t RW_E = WS_RW, RW_WR = WS_RW + 8 * MiB, RW_A = WS_RW + 16 * MiB, RW_B = WS_RW + 24 * MiB, RW_K = WS_RW + 32 * MiB, RW_V = WS_RW + 40 * MiB, RW_G = WS_P + 120 * MiB  , RW_Y = WS_RW + 56 * MiB;
constexpr size_t WS_O = WS_RW, WS_H = WS_RW + 32 * MiB;
constexpr size_t WS_WKV = WS_RW;
constexpr size_t WS_MEMN = WS_RW + 64 * MiB;
constexpr size_t WS_VF = 230 * MiB;
constexpr size_t WS_KM = 238 * MiB, WS_VMT = 242 * MiB;
constexpr size_t WS_SM = 246 * MiB;
constexpr size_t SM_LOGF = WS_SM, SM_CUM = SM_LOGF + 256 * 1024, SM_BR = SM_CUM + 256 * 1024, SM_KR = SM_BR + 256 * 1024, SM_RK = SM_KR + 256 * 1024,
                 SM_SS = SM_RK + 256 * 1024  , SM_ROT = SM_SS + 256 * 1024  , SM_Q = SM_ROT + MiB  , WS_END = SM_Q + 4096;
static_assert(WS_END <= 256 * MiB, "workspace map");
constexpr int LDS_BYTES = 147456;

__device__ __forceinline__ unsigned f2bf(float f) { unsigned u = __builtin_bit_cast(unsigned, f); return (u + 0x7fffu + ((u >> 16) & 1u)) >> 16; }
typedef __bf16 bf16x2_t __attribute__((ext_vector_type(2)));
__device__ __forceinline__ unsigned pk2(float lo, float hi) { const f32x2 v = {lo, hi}; const bf16x2_t b = __builtin_convertvector(v, bf16x2_t); return __builtin_bit_cast(unsigned, b); }
__device__ __forceinline__ float bflo(unsigned u) { return __builtin_bit_cast(float, u << 16); }
__device__ __forceinline__ float bfhi(unsigned u) { return __builtin_bit_cast(float, u & 0xffff0000u); }
__device__ __forceinline__ void unpack8(u32x4 w, float* f) { f[0] = bflo(w.x); f[1] = bfhi(w.x); f[2] = bflo(w.y); f[3] = bfhi(w.y); f[4] = bflo(w.z); f[5] = bfhi(w.z); f[6] = bflo(w.w); f[7] = bfhi(w.w); }
__device__ __forceinline__ u32x4 pack8(const float* f) { u32x4 w; w.x = pk2(f[0], f[1]); w.y = pk2(f[2], f[3]); w.z = pk2(f[4], f[5]); w.w = pk2(f[6], f[7]); return w; }
__device__ __forceinline__ float wave_sum(float v) {
#pragma unroll
  for (int o = 1; o < 64; o <<= 1) v += __shfl_xor(v, o);
  return v;
}
__device__ __forceinline__ float ex2(float x) { return __builtin_amdgcn_exp2f(x); }
__device__ __forceinline__ float rcpf_(float x) { return __builtin_amdgcn_rcpf(x); }
__device__ __forceinline__ float sigmoidf_(float x) { return rcpf_(1.f + __expf(-x)); }
__device__ __forceinline__ float lse0_(float x) { return __logf(1.f + __expf(-fabsf(x))); }
__device__ __forceinline__ float log_sigmoidf_(float x) { return fminf(x, 0.f) - lse0_(x); }
__device__ __forceinline__ float log_sigmoid_acc(float x) { return fminf(x, 0.f) - log1pf(__expf(-fabsf(x))); }
__device__ __forceinline__ float softplusf_(float x) { return fmaxf(x, 0.f) + lse0_(x); }
__device__ __forceinline__ float tanhf_(float x) { return 1.f - 2.f * rcpf_(1.f + __expf(2.f * x)); }
__device__ __forceinline__ float gelu_tanh(float x) { return 0.5f * x * (1.f + tanhf_(0.7978845608028654f * (x + 0.044715f * x * x * x))); }
#define WAVE_LDS_FENCE() asm volatile("s_waitcnt lgkmcnt(0)" ::: "memory")
#define LDS_BARRIER() asm volatile("s_waitcnt lgkmcnt(0)\n\ts_barrier" ::: "memory")
#define MFMA16(a, b, c) __builtin_amdgcn_mfma_f32_16x16x32_bf16((a), (b), (c), 0, 0, 0)

struct Params { const float* in[40]; float* out; unsigned char* ws; int ph_lo, ph_hi; };

struct EpiIn {
  static constexpr bool PERM = true, AFTER_DRAIN = false;
  bf16* proj; bf16* foxvT; bf16* retkT; bf16* retvT; const float* rot;
  __device__ __forceinline__ void operator()(const f32x4 (&acc)[2][2][4][2], const pg8::Unit& u, int wr, int wc, int fr, int fq) const {
    const int pn = u.pn;
    const bool rotary = (pn == 3) || (pn == 9);
    const float sc = (pn == 9) ? 0.125f : 1.f;
    bf16* tdst = pn == 9 ? retkT : pn == 11 ? foxvT : pn == 12 ? retvT : nullptr;
    const bool rowmajor = pn <= 10;
#pragma unroll
    for (int ai = 0; ai < 2; ++ai)
#pragma unroll
      for (int m = 0; m < 4; ++m) {
        const int row = u.pm * 256 + ai * 128 + wr * 64 + m * 16 + fr; const int pos = row & (SEQ - 1), b = row >> 12;
#pragma unroll
        for (int bj = 0; bj < 2; ++bj) {
          const int c0 = bj * 128 + wc * 32 + 8 * fq;
          float v[8];
#pragma unroll
          for (int e = 0; e < 4; ++e) { v[e] = acc[ai][bj][m][0][e]; v[4 + e] = acc[ai][bj][m][1][e]; }
          if (rotary) {
            const int i0 = (c0 & 63) >> 1;
            const f32x4 r0 = *(const f32x4*)(rot + ((size_t)pos * 32 + i0) * 2), r1 = *(const f32x4*)(rot + ((size_t)pos * 32 + i0 + 2) * 2);
            const float cs[4] = {r0[0], r0[2], r1[0], r1[2]}, sn[4] = {r0[1], r0[3], r1[1], r1[3]};
#pragma unroll
            for (int p = 0; p < 4; ++p) { const float x1 = v[2 * p], x2 = v[2 * p + 1]; v[2 * p] = x1 * cs[p] - x2 * sn[p]; v[2 * p + 1] = x1 * sn[p] + x2 * cs[p]; }
          }
#pragma unroll
          for (int e = 0; e < 8; ++e) v[e] *= sc;
          const u32x4 w = pack8(v);
          if (rowmajor) *(u32x4*)(proj + (size_t)row * PW + pn * 256 + c0) = w;
          if (tdst) {
            const int hh = c0 >> 6, d0 = c0 & 63; bf16* tp = tdst + ((size_t)((b * 4 + hh) * 64 + d0)) * SEQ + pos;
            const unsigned ww[4] = {w.x, w.y, w.z, w.w};
#pragma unroll
            for (int e = 0; e < 8; ++e) tp[(size_t)e * SEQ] = (bf16)((e & 1) ? (ww[e >> 1] >> 16) : (ww[e >> 1] & 0xffffu));
          }
        }
      }
  }
};
struct EpiPlain {
  static constexpr bool PERM = true, AFTER_DRAIN = false;
  bf16* O; int ldc; int act; float* ss;
  __device__ __forceinline__ void operator()(const f32x4 (&acc)[2][2][4][2], const pg8::Unit& u, int wr, int wc, int fr, int fq) const {
#pragma unroll
    for (int ai = 0; ai < 2; ++ai)
#pragma unroll
      for (int m = 0; m < 4; ++m) {
        const int row = u.pm * 256 + ai * 128 + wr * 64 + m * 16 + fr; float s = 0.f;
#pragma unroll
        for (int bj = 0; bj < 2; ++bj) {
          const int c0 = u.pn * 256 + bj * 128 + wc * 32 + 8 * fq;
          float v[8];
#pragma unroll
          for (int e = 0; e < 4; ++e) { v[e] = acc[ai][bj][m][0][e]; v[4 + e] = acc[ai][bj][m][1][e]; }
          if (act == 1) {
#pragma unroll
            for (int e = 0; e < 8; ++e) { const float r = fmaxf(v[e], 0.f); v[e] = r * r; }
          }
#pragma unroll
          for (int e = 0; e < 8; ++e) s += v[e] * v[e];
          *(u32x4*)(O + (size_t)row * ldc + c0) = pack8(v);
        }
        if (ss) { s += __shfl_xor(s, 16); s += __shfl_xor(s, 32); if (fq == 0) atomicAdd(ss + row, s); }
      }
  }
};
struct EpiMem {
  static constexpr bool PERM = true, AFTER_DRAIN = false;
  bf16* kmem; bf16* vmemT;
  __device__ __forceinline__ void operator()(const f32x4 (&acc)[2][2][4][2], const pg8::Unit& u, int wr, int wc, int fr, int fq) const {
    const int layer = u.pm >> 2, pt = u.pn & 7; const bool isv = pt >= 4; const int head = pt & 3;
#pragma unroll
    for (int ai = 0; ai < 2; ++ai)
#pragma unroll
      for (int m = 0; m < 4; ++m) {
        const int rowl = (u.pm & 3) * 256 + ai * 128 + wr * 64 + m * 16 + fr;
#pragma unroll
        for (int bj = 0; bj < 2; ++bj) {
          const int c0 = bj * 128 + wc * 32 + 8 * fq;
          float v[8];
#pragma unroll
          for (int e = 0; e < 4; ++e) { v[e] = acc[ai][bj][m][0][e]; v[4 + e] = acc[ai][bj][m][1][e]; }
          const u32x4 w = pack8(v);
          if (!isv) *(u32x4*)(kmem + ((size_t)layer * 1024 + rowl) * 1024 + head * 256 + c0) = w;
          else {
            const int b = rowl >> 8, key = rowl & 255; bf16* tp = vmemT + ((size_t)(((layer * 4 + b) * 4 + head) * 256 + c0)) * 256 + key;
            const unsigned ww[4] = {w.x, w.y, w.z, w.w};
#pragma unroll
            for (int e = 0; e < 8; ++e) tp[(size_t)e * 256] = (bf16)((e & 1) ? (ww[e >> 1] >> 16) : (ww[e >> 1] & 0xffffu));
          }
        }
      }
  }
};
struct MemSched {
  int G, c;
  __device__ bool next(int i, pg8::Unit& u) const { const int L = i * G + c; if (L >= 64) return false; const int layer = L >> 5, r = L & 31; u.pm = layer * 4 + (r & 3); u.pn = layer * 8 + (r >> 2); return true; }
  __device__ __forceinline__ void a_ready(const pg8::Unit&) const {}
  __device__ __forceinline__ void done(const pg8::Unit&) const {}
};

template <int MAP> __device__ __forceinline__ int src_col(int n) {
  if (MAP == 0) return n;
  const int tile = n >> 8, j = n & 255; int jj = j;
  if (tile == 3 || tile == 9) { const int hh = j >> 6, l = j & 63; jj = hh * 64 + (l >> 1) + 32 * (l & 1); }
  return kSrcCol[tile] + jj;
}
template <int MAP> __device__ __forceinline__ void conv_item(const float* __restrict__ W, int K, int Nsrc, int N, bf16* WT, float* scr, int item, int lane) {
  const int nblk = N / 32, kb = item / nblk, nb = item % nblk, k0 = 64 * kb, n0 = 32 * nb;
  const int sc = src_col<MAP>(n0 + (lane & 31));
#pragma unroll 8
  for (int i = 0; i < 32; ++i) { const int kk = 2 * i + (lane >> 5); scr[kk * 33 + (lane & 31)] = W[(size_t)(k0 + kk) * Nsrc + sc]; }
  WAVE_LDS_FENCE();
  const int c = lane & 7;
#pragma unroll
  for (int j = 0; j < 4; ++j) { const int n = (lane >> 3) + 8 * j; const float* s = scr + (8 * c) * 33 + n;
    u32x4 o; o.x = pk2(s[0 * 33], s[1 * 33]); o.y = pk2(s[2 * 33], s[3 * 33]); o.z = pk2(s[4 * 33], s[5 * 33]); o.w = pk2(s[6 * 33], s[7 * 33]);
    *(u32x4*)(WT + (size_t)(n0 + n) * K + k0 + 8 * c) = o; }
  WAVE_LDS_FENCE();
}
__device__ __forceinline__ void conv_layer_weights(const Params& p, int l, float* scr, int gw, int NGW, int lane) {
  asm volatile("" ::: "memory");
  asm volatile("" : "+v"(lane));
  unsigned char* ws = p.ws;
  constexpr int I_IN = (D / 64) * (NIN / 32), I_SQ = (D / 64) * (D / 32), I_1 = (D / 64) * (DFF / 32), I_2 = (DFF / 64) * (D / 32);
  constexpr int I_W2 = 1 * 8, I_A2 = 8, I_G2 = 2 * 8, I_V1 = 4 * 1, I_V2 = 8  , I_R = 2 * 4 * 2;
  constexpr int NIT = I_IN + 3 * I_SQ + I_1 + I_2 + I_W2 + I_A2 + I_G2 + I_V1 + I_R;
  for (int it = gw; it < NIT; it += NGW) {
    int r = it;
    if (r < I_IN) { conv_item<1>(p.in[9] + (size_t)l * D * INW, D, INW, NIN, (bf16*)(ws + W_IN), scr, r, lane); continue; } r -= I_IN;
    if (r < I_SQ) { conv_item<0>(p.in[10] + (size_t)l * D * D, D, D, D, (bf16*)(ws + W_OUT), scr, r, lane); continue; } r -= I_SQ;
    if (r < I_SQ) { conv_item<0>(p.in[34] + (size_t)l * D * D, D, D, D, (bf16*)(ws + W_Q), scr, r, lane); continue; } r -= I_SQ;
    if (r < I_SQ) { conv_item<0>(p.in[37] + (size_t)l * D * D, D, D, D, (bf16*)(ws + W_O), scr, r, lane); continue; } r -= I_SQ;
    if (r < I_1) { conv_item<0>(p.in[38] + (size_t)l * D * DFF, D, DFF, DFF, (bf16*)(ws + W_1), scr, r, lane); continue; } r -= I_1;
    if (r < I_2) { conv_item<0>(p.in[39] + (size_t)l * DFF * D, DFF, D, D, (bf16*)(ws + W_2), scr, r, lane); continue; } r -= I_2;
    if (r < I_W2) { conv_item<0>(p.in[21] + (size_t)l * 64 * G, 64, G, G, (bf16*)(ws + WS_W2T), scr, r, lane); continue; } r -= I_W2;
    if (r < I_A2) { conv_item<0>(p.in[23] + (size_t)l * 64 * G, 64, G, G, (bf16*)(ws + WS_A2T), scr, r, lane); continue; } r -= I_A2;
    if (r < I_G2) { conv_item<0>(p.in[24] + (size_t)l * 128 * G, 128, G, G, (bf16*)(ws + WS_G2T), scr, r, lane); continue; } r -= I_G2;
    if (r < I_V1) { if (l > 0) conv_item<0>(p.in[31] + (size_t)(l - 1) * G * 32, G, 32, 32, (bf16*)(ws + WS_V1T), scr, r, lane); continue; } r -= I_V1;
    { const int gate = r >> 3, hh = (r >> 1) & 3, nb = r & 1;
      conv_item<0>(p.in[gate ? 16 : 14] + ((size_t)l * GH + hh) * HD * HD, 64, 64, 64, (bf16*)(ws + (gate ? WS_RIT : WS_RAT)) + hh * 4096, scr, nb, lane); }
  }
  if (l > 0) { const float* v2 = p.in[32] + (size_t)(l - 1) * 32 * G; bf16* v2t = (bf16*)(ws + WS_V2T);
    for (int e = gw * 64 + lane; e < 32 * G; e += NGW * 64) { const int k = e / G, n = e % G; v2t[n * 32 + k] = (bf16)f2bf(v2[e]); } }
}

struct RowArgs { const float* xin; const bf16* O; float* ss; const float* g_post; float* xout; const float* g_pre; bf16* hout; const float* wf; const float* fbias; float* logf; int rows; };
__device__ __forceinline__ void row_phase(const RowArgs& a, int gw, int NGW, int lane) {
  asm volatile("" ::: "memory");
  asm volatile("" : "+v"(lane));
  f32x4 gp[4], gq[4], wfv[4][4];
#pragma unroll
  for (int j = 0; j < 4; ++j) {
    gp[j] = a.O ? ((const f32x4*)a.g_post)[lane + 64 * j] : (f32x4){0.f, 0.f, 0.f, 0.f};
    gq[j] = a.hout ? ((const f32x4*)a.g_pre)[lane + 64 * j] : (f32x4){0.f, 0.f, 0.f, 0.f};
#pragma unroll
    for (int hh = 0; hh < 4; ++hh)
#pragma unroll
      for (int e = 0; e < 4; ++e) wfv[j][hh][e] = a.wf ? a.wf[(size_t)(4 * (lane + 64 * j) + e) * INW + 768 + hh] : 0.f;
  }
  for (int row = gw; row < a.rows; row += NGW) {
    f32x4 x[4];
#pragma unroll
    for (int j = 0; j < 4; ++j) x[j] = ((const f32x4*)(a.xin + (size_t)row * D))[lane + 64 * j];
    if (a.O) {
      float ov[4][4]; float so = 0.f;
#pragma unroll
      for (int j = 0; j < 4; ++j) { const u32x2 o = ((const u32x2*)(a.O + (size_t)row * D))[lane + 64 * j];
        ov[j][0] = bflo(o.x); ov[j][1] = bfhi(o.x); ov[j][2] = bflo(o.y); ov[j][3] = bfhi(o.y);
        so += ov[j][0] * ov[j][0] + ov[j][1] * ov[j][1] + ov[j][2] * ov[j][2] + ov[j][3] * ov[j][3]; }
      so = wave_sum(so);
      const float rs = rsqrtf(so * (1.f / D) + EPS);
#pragma unroll
      for (int j = 0; j < 4; ++j)
#pragma unroll
        for (int e = 0; e < 4; ++e) x[j][e] += ov[j][e] * rs * gp[j][e];
    }
    if (a.xout) {
#pragma unroll
      for (int j = 0; j < 4; ++j) ((f32x4*)(a.xout + (size_t)row * D))[lane + 64 * j] = x[j];
    }
    if (a.hout) {
      float s = 0.f;
#pragma unroll
      for (int j = 0; j < 4; ++j) s += x[j][0] * x[j][0] + x[j][1] * x[j][1] + x[j][2] * x[j][2] + x[j][3] * x[j][3];
      s = wave_sum(s); const float rs2 = rsqrtf(s * (1.f / D) + EPS);
      float fd[4] = {0.f, 0.f, 0.f, 0.f};
#pragma unroll
      for (int j = 0; j < 4; ++j) {
        f32x4 hv;
#pragma unroll
        for (int e = 0; e < 4; ++e) hv[e] = x[j][e] * rs2 * gq[j][e];
        u32x2 o; o.x = pk2(hv[0], hv[1]); o.y = pk2(hv[2], hv[3]);
        ((u32x2*)(a.hout + (size_t)row * D))[lane + 64 * j] = o;
        if (a.wf) {
#pragma unroll
          for (int hh = 0; hh < 4; ++hh) fd[hh] += hv[0] * wfv[j][hh][0] + hv[1] * wfv[j][hh][1] + hv[2] * wfv[j][hh][2] + hv[3] * wfv[j][hh][3];
        }
      }
      if (a.wf) {
#pragma unroll
        for (int hh = 0; hh < 4; ++hh) fd[hh] = wave_sum(fd[hh]);
        if (lane < 4) { const float f = lane == 0 ? fd[0] : lane == 1 ? fd[1] : lane == 2 ? fd[2] : fd[3]; a.logf[(size_t)row * 4 + lane] = log_sigmoidf_(f + a.fbias[lane]); }
      }
    }
  }
}

__device__ __forceinline__ void lerp8(const bf16* __restrict__ proj, const float* __restrict__ mu, int tok, int col, int mucol, float* out) {
  const u32x4 c = *(const u32x4*)(proj + (size_t)tok * PW + col);
  u32x4 pv = {0u, 0u, 0u, 0u};
  if ((tok & (SEQ - 1)) != 0) pv = *(const u32x4*)(proj + (size_t)(tok - 1) * PW + col);
  float cf[8], pf[8]; unpack8(c, cf); unpack8(pv, pf);
  const f32x4 m0 = *(const f32x4*)(mu + mucol), m1 = *(const f32x4*)(mu + mucol + 4);
#pragma unroll
  for (int e = 0; e < 4; ++e) { out[e] = cf[e] + (pf[e] - cf[e]) * m0[e]; out[4 + e] = cf[4 + e] + (pf[4 + e] - cf[4 + e]) * m1[e]; }
}
__device__ __forceinline__ bf16x8 pack_frag(const float* f) { const u32x4 w = pack8(f); return __builtin_bit_cast(bf16x8, w); }
constexpr int WLP = 260;
__device__ __forceinline__ void acc_to_lds(float* wl, const f32x4* acc, int ntiles, int li, int g) {
#pragma unroll
  for (int nt = 0; nt < 16; ++nt) if (nt < ntiles) {
#pragma unroll
    for (int j = 0; j < 4; ++j) wl[(4 * g + j) * WLP + nt * 16 + li] = acc[nt][j];
  }
}
template <int KS> __device__ __forceinline__ void mm16_to_lds(const bf16x8* af, const bf16* __restrict__ wt, int ldw, float* wl, int li, int g) {
#pragma unroll 1
  for (int ng = 0; ng < 4; ++ng) {
    f32x4 a4[4];
#pragma unroll
    for (int n4 = 0; n4 < 4; ++n4) { a4[n4] = (f32x4){0.f, 0.f, 0.f, 0.f};
#pragma unroll
      for (int ks = 0; ks < KS; ++ks) { const bf16x8 bfr = *(const bf16x8*)(wt + (size_t)((ng * 4 + n4) * 16 + li) * ldw + ks * 32 + 8 * g); a4[n4] = MFMA16(af[ks], bfr, a4[n4]); } }
#pragma unroll
    for (int n4 = 0; n4 < 4; ++n4)
#pragma unroll
      for (int j = 0; j < 4; ++j) wl[(4 * g + j) * WLP + (ng * 4 + n4) * 16 + li] = a4[n4][j];
  }
}
__device__ __forceinline__ void rwkv_prep_unit(const Params& p, int l, int unit, float* wl, int lane) {
  asm volatile("" ::: "memory");
  asm volatile("" : "+v"(lane));
  unsigned char* ws = p.ws;
  const bf16* proj = (const bf16*)(ws + WS_P);
  const float* mu = p.in[19] + (size_t)l * 1024;
  const int li = lane & 15, g = lane >> 4, t0 = unit * 16, ta = t0 + li;
  const int tl = t0 + (lane >> 2), cgp = lane & 3;
  {
    bf16x8 af[2];
#pragma unroll
    for (int ks = 0; ks < 2; ++ks) { float f[8]; lerp8(proj, mu, ta, C_RWX + ks * 32 + 8 * g, 768 + ks * 32 + 8 * g, f);
#pragma unroll
      for (int e = 0; e < 8; ++e) f[e] = tanhf_(f[e]);
      af[ks] = pack_frag(f); }
    mm16_to_lds<2>(af, (const bf16*)(ws + WS_W2T), 64, wl, li, g); WAVE_LDS_FENCE();
    const float* w0 = p.in[20] + (size_t)l * G;
#pragma unroll 1
    for (int i = 0; i < 8; ++i) { int col = cgp * 8 + 32 * i; asm volatile("" : "+v"(col)); float r[8], ev[8], wr[8];
      lerp8(proj, mu, tl, C_RWR + col, col, r);
#pragma unroll
      for (int e = 0; e < 8; ++e) { const float wa = wl[(lane >> 2) * WLP + col + e] + w0[col + e]; const float wlog = -softplusf_(-wa) - 0.5f; const float ee = __expf(wlog); ev[e] = ee; wr[e] = __expf(-ee) * r[e]; }
      *(u32x4*)((bf16*)(ws + RW_E) + (size_t)tl * G + col) = pack8(ev); *(u32x4*)((bf16*)(ws + RW_WR) + (size_t)tl * G + col) = pack8(wr); }
    WAVE_LDS_FENCE();
  }
  {
    bf16x8 af[2];
#pragma unroll
    for (int ks = 0; ks < 2; ++ks) { float f[8]; lerp8(proj, mu, ta, C_RWX + 64 + ks * 32 + 8 * g, 832 + ks * 32 + 8 * g, f); af[ks] = pack_frag(f); }
    mm16_to_lds<2>(af, (const bf16*)(ws + WS_A2T), 64, wl, li, g); WAVE_LDS_FENCE();
    const float* a0 = p.in[22] + (size_t)l * G; const float* k_k = p.in[25] + (size_t)l * G; const float* k_a = p.in[26] + (size_t)l * G; const float* r_k = p.in[27] + (size_t)l * G;
#pragma unroll 1
    for (int hh = 0; hh < 4; ++hh) {
      float av[2][8], kv[2][8], kk[2][8]; float ssq = 0.f;
#pragma unroll
      for (int ii = 0; ii < 2; ++ii) { int col = cgp * 8 + 32 * (2 * hh + ii); asm volatile("" : "+v"(col));
        lerp8(proj, mu, tl, C_RWK + col, 256 + col, kv[ii]);
#pragma unroll
        for (int e = 0; e < 8; ++e) { av[ii][e] = sigmoidf_(a0[col + e] + wl[(lane >> 2) * WLP + col + e]); kk[ii][e] = kv[ii][e] * k_k[col + e]; ssq += kk[ii][e] * kk[ii][e]; } }
      ssq += __shfl_xor(ssq, 1); ssq += __shfl_xor(ssq, 2);
      const float inv = 1.f / fmaxf(sqrtf(ssq), 1e-12f);
      float sbr = 0.f, skr = 0.f, srk = 0.f;
#pragma unroll
      for (int ii = 0; ii < 2; ++ii) { int col = cgp * 8 + 32 * (2 * hh + ii); asm volatile("" : "+v"(col)); float r[8], Av[8], Bv[8], k2[8];
        lerp8(proj, mu, tl, C_RWR + col, col, r);
#pragma unroll
        for (int e = 0; e < 8; ++e) { const float kn = kk[ii][e] * inv; Av[e] = -kn; Bv[e] = kn * av[ii][e]; k2[e] = kv[ii][e] * (1.f + (av[ii][e] - 1.f) * k_a[col + e]);
          const float rb = r[e]; sbr += Bv[e] * rb; skr += k2[e] * rb; srk += rb * k2[e] * r_k[col + e]; }
        *(u32x4*)((bf16*)(ws + RW_A) + (size_t)tl * G + col) = pack8(Av); *(u32x4*)((bf16*)(ws + RW_B) + (size_t)tl * G + col) = pack8(Bv); *(u32x4*)((bf16*)(ws + RW_K) + (size_t)tl * G + col) = pack8(k2); }
      sbr += __shfl_xor(sbr, 1); sbr += __shfl_xor(sbr, 2); skr += __shfl_xor(skr, 1); skr += __shfl_xor(skr, 2); srk += __shfl_xor(srk, 1); srk += __shfl_xor(srk, 2);
      if (cgp == 0) { ((float*)(ws + SM_BR))[(size_t)tl * 4 + hh] = sbr; ((float*)(ws + SM_KR))[(size_t)tl * 4 + hh] = skr; ((float*)(ws + SM_RK))[(size_t)tl * 4 + hh] = srk; }
    }
    WAVE_LDS_FENCE();
  }
  {
    bf16x8 af[4];
#pragma unroll
    for (int ks = 0; ks < 4; ++ks) { float f[8]; lerp8(proj, mu, ta, C_RWX + 128 + ks * 32 + 8 * g, 896 + ks * 32 + 8 * g, f);
#pragma unroll
      for (int e = 0; e < 8; ++e) f[e] = sigmoidf_(f[e]);
      af[ks] = pack_frag(f); }
    mm16_to_lds<4>(af, (const bf16*)(ws + WS_G2T), 128, wl, li, g); WAVE_LDS_FENCE();
#pragma unroll 1
    for (int i = 0; i < 8; ++i) { int col = cgp * 8 + 32 * i; asm volatile("" : "+v"(col)); float gv[8];
#pragma unroll
      for (int e = 0; e < 8; ++e) gv[e] = wl[(lane >> 2) * WLP + col + e];
      *(u32x4*)((bf16*)(ws + RW_G) + (size_t)tl * G + col) = pack8(gv); }
    WAVE_LDS_FENCE();
  }
  if (l > 0) {
    f32x4 a1[2] = {(f32x4){0.f, 0.f, 0.f, 0.f}, (f32x4){0.f, 0.f, 0.f, 0.f}};
    const bf16* v1t = (const bf16*)(ws + WS_V1T);
#pragma unroll
    for (int ks = 0; ks < 8; ++ks) { float f[8]; lerp8(proj, mu, ta, C_RWV + ks * 32 + 8 * g, 512 + ks * 32 + 8 * g, f); const bf16x8 af = pack_frag(f);
#pragma unroll
      for (int nt = 0; nt < 2; ++nt) { const bf16x8 bfr = *(const bf16x8*)(v1t + (size_t)(nt * 16 + li) * 256 + ks * 32 + 8 * g); a1[nt] = MFMA16(af, bfr, a1[nt]); } }
#pragma unroll
    for (int nt = 0; nt < 2; ++nt)
#pragma unroll
      for (int j = 0; j < 4; ++j) wl[(4 * g + j) * WLP + nt * 16 + li] = a1[nt][j];
    WAVE_LDS_FENCE();
    float f2[8];
#pragma unroll
    for (int e = 0; e < 8; ++e) f2[e] = wl[li * WLP + 8 * g + e];
    const bf16x8 af2 = pack_frag(f2);
    WAVE_LDS_FENCE();
    mm16_to_lds<1>(&af2, (const bf16*)(ws + WS_V2T), 32, wl, li, g); WAVE_LDS_FENCE();
    const float* v0 = p.in[30] + (size_t)(l - 1) * G;
#pragma unroll 1
    for (int i = 0; i < 8; ++i) { int col = cgp * 8 + 32 * i; asm volatile("" : "+v"(col)); float v[8], vf[8];
      lerp8(proj, mu, tl, C_RWV + col, 512 + col, v);
      unpack8(*(const u32x4*)((const bf16*)(ws + WS_VF) + (size_t)tl * G + col), vf);
#pragma unroll
      for (int e = 0; e < 8; ++e) v[e] = v[e] + (vf[e] - v[e]) * sigmoidf_(v0[col + e] + wl[(lane >> 2) * WLP + col + e]);
      *(u32x4*)((bf16*)(ws + RW_V) + (size_t)tl * G + col) = pack8(v); }
    WAVE_LDS_FENCE();
  } else {
#pragma unroll 1
    for (int i = 0; i < 8; ++i) { int col = cgp * 8 + 32 * i; asm volatile("" : "+v"(col)); float v[8];
      lerp8(proj, mu, tl, C_RWV + col, 512 + col, v);
      const u32x4 w = pack8(v);
      *(u32x4*)((bf16*)(ws + RW_V) + (size_t)tl * G + col) = w; *(u32x4*)((bf16*)(ws + WS_VF) + (size_t)tl * G + col) = w; }
  }
}
__device__ __forceinline__ void ret_kv_unit(const Params& p, int unit, int lane) {
  asm volatile("" ::: "memory");
  asm volatile("" : "+v"(lane));
  unsigned char* ws = p.ws;
  const int bh = unit >> 5, c = unit & 31, h = bh & 3, li = lane & 15, g = lane >> 4;
  const float lg2 = log2f(1.f - exp2f(-5.f - (float)h));
  const bf16* kT = (const bf16*)(ws + P_RETKT) + (size_t)bh * 64 * SEQ + c * 128;
  const bf16* vT = (const bf16*)(ws + P_RETVT) + (size_t)bh * 64 * SEQ + c * 128;
  f32x4 acc[4][4];
#pragma unroll
  for (int a = 0; a < 4; ++a)
#pragma unroll
    for (int b = 0; b < 4; ++b) acc[a][b] = (f32x4){0.f, 0.f, 0.f, 0.f};
#pragma unroll
  for (int ks = 0; ks < 4; ++ks) {
    float z[8];
#pragma unroll
    for (int e = 0; e < 8; ++e) z[e] = ex2(lg2 * (float)(127 - (ks * 32 + 8 * g + e)));
    bf16x8 af[4], bfr[4];
#pragma unroll
    for (int dt = 0; dt < 4; ++dt) { float f[8]; unpack8(*(const u32x4*)(kT + (size_t)(dt * 16 + li) * SEQ + ks * 32 + 8 * g), f);
#pragma unroll
      for (int e = 0; e < 8; ++e) f[e] *= z[e];
      af[dt] = pack_frag(f); }
#pragma unroll
    for (int et = 0; et < 4; ++et) bfr[et] = *(const bf16x8*)(vT + (size_t)(et * 16 + li) * SEQ + ks * 32 + 8 * g);
#pragma unroll
    for (int dt = 0; dt < 4; ++dt)
#pragma unroll
      for (int et = 0; et < 4; ++et) acc[dt][et] = MFMA16(af[dt], bfr[et], acc[dt][et]);
  }
  float* KV = (float*)(ws + P_RETKV) + (size_t)unit * 4096;
#pragma unroll
  for (int dt = 0; dt < 4; ++dt)
#pragma unroll
    for (int et = 0; et < 4; ++et)
#pragma unroll
      for (int j = 0; j < 4; ++j) KV[(dt * 16 + 4 * g + j) * 64 + et * 16 + li] = acc[dt][et][j];
}
__device__ __forceinline__ void fox_cum_unit(const Params& p, int bh, int lane) {
  asm volatile("" ::: "memory");
  asm volatile("" : "+v"(lane));
  const float* logf = (const float*)(p.ws + SM_LOGF); float* cum = (float*)(p.ws + SM_CUM);
  const int b = bh >> 2, h = bh & 3; const size_t base = ((size_t)b * SEQ + lane * 64) * 4 + h;
  float s = 0.f;
  for (int i = 0; i < 64; ++i) s += logf[base + (size_t)i * 4];
  float incl = s;
#pragma unroll
  for (int o = 1; o < 64; o <<= 1) { const float t = __shfl_up(incl, o); if (lane >= o) incl += t; }
  float run = incl - s;
  for (int i = 0; i < 64; ++i) { run += logf[base + (size_t)i * 4]; cum[(size_t)bh * SEQ + lane * 64 + i] = run * LOG2E; }
}

template <int CTRL> __device__ __forceinline__ float dpp_add(float x) {
  const int y = __builtin_amdgcn_update_dpp(0, __builtin_bit_cast(int, x), CTRL, 0xf, 0xf, true);
  return x + __builtin_bit_cast(float, y);
}
__device__ __forceinline__ float row16_sum(float x) {
  x = dpp_add<0xB1>(x); x = dpp_add<0x4E>(x); x = dpp_add<0x141>(x); x = dpp_add<0x140>(x); return x;
}
constexpr int RS_TSB = 832;
constexpr int RS_CH = 32;
constexpr int RS_BUFB = RS_CH * RS_TSB;
constexpr int RS_ROWS = 8;
constexpr int RS_YP = 36;
constexpr int RS_YBUF = RS_CH * RS_ROWS * RS_YP;
struct RsRegs { u32x4 e, a, b, k, wr, v; float br, kr; };
__device__ __forceinline__ void rs_issue(const Params& p, RsRegs& r, int b, int h, int rq, int c, int lt) {
  unsigned char* ws = p.ws;
  { const int tok = lt >> 3, ch = lt & 7; const size_t o = ((size_t)b * SEQ + c * RS_CH + tok) * G + h * 64 + ch * 8;
    r.e = *(const u32x4*)((const bf16*)(ws + RW_E) + o); r.a = *(const u32x4*)((const bf16*)(ws + RW_A) + o); r.b = *(const u32x4*)((const bf16*)(ws + RW_B) + o);
    r.k = *(const u32x4*)((const bf16*)(ws + RW_K) + o); r.wr = *(const u32x4*)((const bf16*)(ws + RW_WR) + o); }
  { const int t2 = lt & 31; const size_t rr = (size_t)b * SEQ + c * RS_CH + t2;
    r.v = *(const u32x4*)((const bf16*)(ws + RW_V) + rr * G + h * 64 + rq * RS_ROWS);
    r.br = ((const float*)(ws + SM_BR))[rr * 4 + h]; r.kr = ((const float*)(ws + SM_KR))[rr * 4 + h]; }
}
__device__ __forceinline__ void rs_commit(const RsRegs& r, unsigned char* buf, int lt) {
  { const int tok = lt >> 3, ch = lt & 7; unsigned char* rec = buf + tok * RS_TSB; float f[8];
    unpack8(r.e, f);
#pragma unroll
    for (int e = 0; e < 8; ++e) f[e] = ex2(-f[e] * LOG2E);
    *(f32x4*)(rec + ch * 32) = (f32x4){f[0], f[1], f[2], f[3]}; *(f32x4*)(rec + ch * 32 + 16) = (f32x4){f[4], f[5], f[6], f[7]};
    *(u32x4*)(rec + 256 + ch * 16) = r.a; *(u32x4*)(rec + 384 + ch * 16) = r.b; *(u32x4*)(rec + 512 + ch * 16) = r.k; *(u32x4*)(rec + 640 + ch * 16) = r.wr; }
  if (lt < 32) { float f[8]; unpack8(r.v, f); unsigned char* rec = buf + lt * RS_TSB + 768; *(f32x4*)(rec) = (f32x4){f[0], f[1], f[2], f[3]}; *(f32x4*)(rec + 16) = (f32x4){f[4], f[5], f[6], f[7]}; }
  else if (lt >= 64 && lt < 96) { unsigned char* rec = buf + (lt - 64) * RS_TSB + 800; *(f32x2*)rec = (f32x2){r.br * (1.f / 32.f), r.kr * (1.f / 32.f)}; }
}
__device__ __forceinline__ float row32_sum(float x) {
  x = row16_sum(x);
  const auto rr = __builtin_amdgcn_permlane16_swap(__builtin_bit_cast(unsigned, x), __builtin_bit_cast(unsigned, x), false, false);
  return __builtin_bit_cast(float, (unsigned)rr[0]) + __builtin_bit_cast(float, (unsigned)rr[1]);
}
__device__ __forceinline__ f32x2 bf2x(unsigned u) { return (f32x2){bflo(u), bfhi(u)}; }
__device__ __forceinline__ void rwkv_scan_unit(const Params& p, unsigned char* lds, int unit) {
  asm volatile("" ::: "memory");
  int tid = threadIdx.x; asm volatile("" : "+v"(tid)); const int wave = __builtin_amdgcn_readfirstlane(tid >> 6), lane = tid & 63;
  const int b = unit >> 5, h = (unit >> 3) & 3, rq = unit & 7;
  unsigned char* bufs = lds; float* ybuf = (float*)(lds + 2 * RS_BUFB);
  float* Y = (float*)(p.ws + RW_Y);
  constexpr int NCH = SEQ / RS_CH;
  const int lt = tid - 256;
  RsRegs rg;
  if (wave >= 4) { rs_issue(p, rg, b, h, rq, 0, lt); rs_commit(rg, bufs, lt); rs_issue(p, rg, b, h, rq, 1, lt); }
  __syncthreads();
  f32x2 S = {0.f, 0.f};
  const int seg = lane & 31, rloc = wave * 2 + (lane >> 5);
#define RS_YOUT(cc) do { const float* yp_ = ybuf + ((cc) & 1) * RS_YBUF + lt * RS_YP; f32x4 t_ = *(const f32x4*)(yp_); \
    _Pragma("unroll") for (int j_ = 1; j_ < 8; ++j_) t_ += *(const f32x4*)(yp_ + 4 * j_); \
    Y[((size_t)b * SEQ + (cc) * RS_CH + (lt >> 3)) * G + h * 64 + rq * RS_ROWS + (lt & 7)] = (t_[0] + t_[1]) + (t_[2] + t_[3]); } while (0)
  for (int c = 0; c < NCH; ++c) {
    if (wave >= 4) {
      if (c + 1 < NCH) rs_commit(rg, bufs + ((c + 1) & 1) * RS_BUFB, lt);
      if (c + 2 < NCH) rs_issue(p, rg, b, h, rq, c + 2, lt);
      if (c > 0) RS_YOUT(c - 1);
    } else {
      const unsigned char* bp = bufs + (c & 1) * RS_BUFB; float* yb = ybuf + (c & 1) * RS_YBUF + rloc * RS_YP + seg;
      const unsigned char* pw = bp + seg * 8; const unsigned char* pa = bp + 256 + seg * 4; const unsigned char* pv = bp + 768 + rloc * 4; const unsigned char* ps = bp + 800;
      f32x2 nw = *(const f32x2*)(pw); unsigned na = *(const unsigned*)(pa), nb = *(const unsigned*)(pa + 128), nk = *(const unsigned*)(pa + 256), nr = *(const unsigned*)(pa + 384);
      float nv = *(const float*)(pv); f32x2 ns = *(const f32x2*)(ps);
#pragma unroll 4
      for (int s = 0; s < RS_CH; ++s) {
        const f32x2 w = nw, a = bf2x(na), bb = bf2x(nb), kk = bf2x(nk), wr = bf2x(nr); const float v = nv, br = ns[0], kr = ns[1];
        if (s + 1 < RS_CH) { const int o = (s + 1) * RS_TSB;
          nw = *(const f32x2*)(pw + o); na = *(const unsigned*)(pa + o); nb = *(const unsigned*)(pa + o + 128); nk = *(const unsigned*)(pa + o + 256); nr = *(const unsigned*)(pa + o + 384);
          nv = *(const float*)(pv + o); ns = *(const f32x2*)(ps + o); }
        const f32x2 pda = S * a, pdy = S * wr;
        const f32x2 vv = {v, v};
        const f32x2 u = S * w + vv * kk;
        const float t0 = v * kr + (pdy[0] + pdy[1]);
        const float da = row32_sum(pda[0] + pda[1]);
        const f32x2 dd = {da, da};
        S = dd * bb + u;
        yb[s * (RS_ROWS * RS_YP)] = da * br + t0;
      }
    }
    LDS_BARRIER();
  }
  if (wave >= 4) RS_YOUT(NCH - 1);
  __syncthreads();
#undef RS_YOUT
}
__device__ __forceinline__ void rwkv_post_row(const Params& p, int l, int row, int lane) {
  asm volatile("" ::: "memory");
  asm volatile("" : "+v"(lane));
  unsigned char* ws = p.ws;
  const f32x4 y = ((const f32x4*)((const float*)(ws + RW_Y) + (size_t)row * G))[lane];
  float s = y[0] + y[1] + y[2] + y[3];
  s += __shfl_xor(s, 1); s += __shfl_xor(s, 2); s += __shfl_xor(s, 4); s += __shfl_xor(s, 8);
  const float mu = s * (1.f / 64.f); const f32x4 d = y - mu;
  float q = d[0] * d[0] + d[1] * d[1] + d[2] * d[2] + d[3] * d[3];
  q += __shfl_xor(q, 1); q += __shfl_xor(q, 2); q += __shfl_xor(q, 4); q += __shfl_xor(q, 8);
  const float rstd = rsqrtf(q * (1.f / 64.f) + 64e-5f);
  const f32x4 gw = ((const f32x4*)(p.in[28] + (size_t)l * G))[lane], gb = ((const f32x4*)(p.in[29] + (size_t)l * G))[lane];
  const u32x2 vv = ((const u32x2*)((const bf16*)(ws + RW_V) + (size_t)row * G))[lane], gg = ((const u32x2*)((const bf16*)(ws + RW_G) + (size_t)row * G))[lane];
  const float rk = ((const float*)(ws + SM_RK))[(size_t)row * 4 + (lane >> 4)];
  const float v[4] = {bflo(vv.x), bfhi(vv.x), bflo(vv.y), bfhi(vv.y)}, gt[4] = {bflo(gg.x), bfhi(gg.x), bflo(gg.y), bfhi(gg.y)};
  float o[4];
#pragma unroll
  for (int e = 0; e < 4; ++e) o[e] = (d[e] * rstd * gw[e] + gb[e] + rk * v[e]) * gt[e];
  u32x2 w; w.x = pk2(o[0], o[1]); w.y = pk2(o[2], o[3]);
  ((u32x2*)((bf16*)(ws + WS_P) + (size_t)row * PW + C_RWR))[lane] = w;
}

__device__ __forceinline__ void lru_unit(const Params& p, int l, float* lds, int unit) {
  asm volatile("" ::: "memory");
  unsigned char* ws = p.ws; bf16* proj = (bf16*)(ws + WS_P);
  int tid = threadIdx.x; asm volatile("" : "+v"(tid)); const int wave = __builtin_amdgcn_readfirstlane(tid >> 6), lane = tid & 63, li = lane & 15, g = lane >> 4;
  const int b = unit >> 2, h = unit & 3;
  float* XB = lds;
  float* XC = XB + 67 * 64;
  float* AA = XC + 64 * 65;
  float* UU = AA + 64 * 65;
  float* HH = UU + 64 * 65;
  bf16* XCb = (bf16*)(HH + 64 * 65);
  const float* cw = p.in[12] + (size_t)l * 4 * G + h * 64; const float* cb = p.in[13] + (size_t)l * G + h * 64;
  const float* rab = p.in[15] + (size_t)l * G + h * 64; const float* rib = p.in[17] + (size_t)l * G + h * 64; const float* lam = p.in[18] + (size_t)l * G + h * 64;
  const int mt = wave & 3, ntp = wave >> 2;
  bf16x8 br_[2][2], bi_[2][2]; float lsl[2], rb[2], ib[2];
  { const bf16* rat = (const bf16*)(ws + WS_RAT) + h * 4096; const bf16* rit = (const bf16*)(ws + WS_RIT) + h * 4096;
#pragma unroll
    for (int n = 0; n < 2; ++n) { const int col = (2 * ntp + n) * 16 + li; lsl[n] = log_sigmoid_acc(lam[col]); rb[n] = rab[col]; ib[n] = rib[col];
#pragma unroll
      for (int ks = 0; ks < 2; ++ks) { br_[n][ks] = *(const bf16x8*)(rat + col * 64 + ks * 32 + 8 * g); bi_[n][ks] = *(const bf16x8*)(rit + col * 64 + ks * 32 + 8 * g); } } }
  float hcur = 0.f;
  const int tok = tid >> 3, ch8 = (tid & 7) * 8;
  for (int c = 0; c < SEQ / 64; ++c) {
    const int t0 = c * 64;
    for (int id = tid; id < 67 * 8; id += NTHREADS) { const int r = id >> 3, cc = (id & 7) * 8; const int pos = t0 - 3 + r; float f[8] = {0.f, 0.f, 0.f, 0.f, 0.f, 0.f, 0.f, 0.f};
      if (pos >= 0) unpack8(*(const u32x4*)(proj + ((size_t)b * SEQ + pos) * PW + C_LRUX + h * 64 + cc), f);
#pragma unroll
      for (int e = 0; e < 8; ++e) XB[r * 64 + cc + e] = f[e]; }
    __syncthreads();
    { float xc[8];
#pragma unroll
      for (int e = 0; e < 8; ++e) { float v = cb[ch8 + e];
#pragma unroll
        for (int j = 0; j < 4; ++j) v += XB[(tok + j) * 64 + ch8 + e] * cw[j * G + ch8 + e];
        xc[e] = v; XC[tok * 65 + ch8 + e] = v; }
      *(u32x4*)(XCb + tok * 72 + ch8) = pack8(xc); }
    __syncthreads();
    { bf16x8 af[2];
#pragma unroll
      for (int ks = 0; ks < 2; ++ks) af[ks] = *(const bf16x8*)(XCb + (mt * 16 + li) * 72 + ks * 32 + 8 * g);
#pragma unroll
      for (int n = 0; n < 2; ++n) { f32x4 cr = {0.f, 0.f, 0.f, 0.f}, ci = {0.f, 0.f, 0.f, 0.f};
#pragma unroll
        for (int ks = 0; ks < 2; ++ks) { cr = MFMA16(af[ks], br_[n][ks], cr); ci = MFMA16(af[ks], bi_[n][ks], ci); }
        const int col = (2 * ntp + n) * 16 + li;
#pragma unroll
        for (int j = 0; j < 4; ++j) { const int tk = mt * 16 + 4 * g + j; const float r = sigmoidf_(cr[j] + rb[n]), ig = sigmoidf_(ci[j] + ib[n]);
          const float log_a = 8.f * r * lsl[n]; const float a = __expf(log_a); const float mult = sqrtf(fmaxf(1.f - a * a, 0.f));
          AA[tk * 65 + col] = a; UU[tk * 65 + col] = mult * (ig * XC[tk * 65 + col]); } } }
    __syncthreads();
    if (wave == 0) {
#pragma unroll 8
      for (int s = 0; s < 64; ++s) { hcur = AA[s * 65 + lane] * hcur + UU[s * 65 + lane]; HH[s * 65 + lane] = hcur; } }
    __syncthreads();
    { bf16* yp = proj + ((size_t)b * SEQ + t0 + tok) * PW + C_LRUY + h * 64 + ch8; float y[8]; unpack8(*(const u32x4*)yp, y);
#pragma unroll
      for (int e = 0; e < 8; ++e) y[e] = HH[tok * 65 + ch8 + e] * gelu_tanh(y[e]);
      *(u32x4*)yp = pack8(y); }
  }
  __syncthreads();
}

constexpr int KS_P = 72, VS_P = 136;
constexpr int AT_KS = 0, AT_VS = 128 * KS_P * 2, AT_CS = AT_VS + 64 * VS_P * 2, AT_BUF = AT_CS + 512;
struct AtRegs { u32x4 k0, k1, v0, v1; float c; };
__device__ __forceinline__ void at_issue(AtRegs& r, const bf16* Kg  , const bf16* VTg  , const float* cumg, int tid) {
  { const int id = tid, row = id >> 3, ch = id & 7; r.k0 = *(const u32x4*)(Kg + (size_t)row * PW + ch * 8); }
  { const int id = tid + 512, row = id >> 3, ch = id & 7; r.k1 = *(const u32x4*)(Kg + (size_t)row * PW + ch * 8); }
  { const int id = tid, row = id >> 4, ch = id & 15; r.v0 = *(const u32x4*)(VTg + (size_t)row * SEQ + ch * 8); }
  { const int id = tid + 512, row = id >> 4, ch = id & 15; r.v1 = *(const u32x4*)(VTg + (size_t)row * SEQ + ch * 8); }
  r.c = (cumg && tid < 128) ? cumg[tid] : 0.f;
}
__device__ __forceinline__ void at_commit(const AtRegs& r, unsigned char* buf, int tid) {
  bf16* Ks = (bf16*)(buf + AT_KS); bf16* Vs = (bf16*)(buf + AT_VS); float* Cs = (float*)(buf + AT_CS);
  { const int id = tid, row = id >> 3, ch = id & 7; *(u32x4*)(Ks + row * KS_P + ch * 8) = r.k0; }
  { const int id = tid + 512, row = id >> 3, ch = id & 7; *(u32x4*)(Ks + row * KS_P + ch * 8) = r.k1; }
  { const int id = tid, row = id >> 4, ch = id & 15; *(u32x4*)(Vs + row * VS_P + ch * 8) = r.v0; }
  { const int id = tid + 512, row = id >> 4, ch = id & 15; *(u32x4*)(Vs + row * VS_P + ch * 8) = r.v1; }
  if (tid < 128) Cs[tid] = r.c;
}
__device__ __forceinline__ bf16x8 vfrag(const bf16* Vs, int d, int key0, int g) {
  const u32x2 lo = *(const u32x2*)(Vs + d * VS_P + key0 + 4 * g), hi = *(const u32x2*)(Vs + d * VS_P + key0 + 16 + 4 * g);
  const u32x4 w = {lo.x, lo.y, hi.x, hi.y}; return __builtin_bit_cast(bf16x8, w);
}
__device__ __forceinline__ void fox_unit(const Params& p, unsigned char* lds, int b, int h, int qb) {
  asm volatile("" ::: "memory");
  unsigned char* ws = p.ws; bf16* proj = (bf16*)(ws + WS_P);
  int tid = threadIdx.x; asm volatile("" : "+v"(tid)); const int wave = __builtin_amdgcn_readfirstlane(tid >> 6), lane = tid & 63, li = lane & 15, g = lane >> 4;
  const int bh = b * 4 + h; const int qrel = wave * 16 + li; const size_t qrow = (size_t)b * SEQ + qb * 128 + qrel;
  const float* cum = (const float*)(ws + SM_CUM) + (size_t)bh * SEQ;
  const bf16* Kbase = proj + (size_t)b * SEQ * PW + C_FOXK + h * 64; const bf16* VTbase = (const bf16*)(ws + P_FOXVT) + (size_t)bh * 64 * SEQ;
  bf16x8 qf[2];
#pragma unroll
  for (int ks = 0; ks < 2; ++ks) qf[ks] = *(const bf16x8*)(proj + qrow * PW + C_FOXQ + h * 64 + ks * 32 + 8 * g);
  const float cq = cum[qb * 128 + qrel];
  const float SC = 0.125f * LOG2E;
  f32x4 o[4];
#pragma unroll
  for (int dt = 0; dt < 4; ++dt) o[dt] = (f32x4){0.f, 0.f, 0.f, 0.f};
  float m = -INFINITY, lsum = 0.f;
  AtRegs rg; at_issue(rg, Kbase, VTbase, cum, tid);
  __syncthreads();
  at_commit(rg, lds, tid);
  if (qb > 0) at_issue(rg, Kbase + (size_t)128 * PW, VTbase + 128, cum + 128, tid);
  LDS_BARRIER();
  for (int kb = 0; kb <= qb; ++kb) {
    unsigned char* buf = lds + (kb & 1) * AT_BUF; const bf16* Ks = (const bf16*)(buf + AT_KS); const bf16* Vs = (const bf16*)(buf + AT_VS); const float* Cs = (const float*)(buf + AT_CS);
    const bool diag = kb == qb; const int nst = diag ? (wave >> 1) + 1 : 4;
    for (int st = 0; st < nst; ++st) {
      f32x4 s0 = {0.f, 0.f, 0.f, 0.f}, s1 = {0.f, 0.f, 0.f, 0.f};
#pragma unroll
      for (int ks = 0; ks < 2; ++ks) { const bf16x8 a0 = *(const bf16x8*)(Ks + (st * 32 + li) * KS_P + ks * 32 + 8 * g), a1 = *(const bf16x8*)(Ks + (st * 32 + 16 + li) * KS_P + ks * 32 + 8 * g);
        s0 = MFMA16(a0, qf[ks], s0); s1 = MFMA16(a1, qf[ks], s1); }
      const f32x4 c0 = *(const f32x4*)(Cs + st * 32 + 4 * g), c1 = *(const f32x4*)(Cs + st * 32 + 16 + 4 * g);
      float x[8];
#pragma unroll
      for (int j = 0; j < 4; ++j) { x[j] = s0[j] * SC + (cq - c0[j]); x[4 + j] = s1[j] * SC + (cq - c1[j]); }
      if (diag) {
#pragma unroll
        for (int j = 0; j < 4; ++j) { if (st * 32 + 4 * g + j > qrel) x[j] = -INFINITY; if (st * 32 + 16 + 4 * g + j > qrel) x[4 + j] = -INFINITY; }
      }
      float mx = fmaxf(fmaxf(fmaxf(x[0], x[1]), fmaxf(x[2], x[3])), fmaxf(fmaxf(x[4], x[5]), fmaxf(x[6], x[7])));
      mx = fmaxf(mx, __shfl_xor(mx, 16)); mx = fmaxf(mx, __shfl_xor(mx, 32));
      const float mn = fmaxf(m, mx); const float f = ex2(m - mn); m = mn;
      float ps = 0.f;
#pragma unroll
      for (int j = 0; j < 8; ++j) { x[j] = ex2(x[j] - mn); ps += x[j]; }
      lsum = lsum * f + ps;
      const bf16x8 pb = pack_frag(x);
#pragma unroll
      for (int dt = 0; dt < 4; ++dt) { o[dt] = o[dt] * f; o[dt] = MFMA16(vfrag(Vs, dt * 16 + li, st * 32, g), pb, o[dt]); }
    }
    if (kb < qb) {
      at_commit(rg, lds + ((kb + 1) & 1) * AT_BUF, tid);
      if (kb + 2 <= qb) at_issue(rg, Kbase + (size_t)(kb + 2) * 128 * PW, VTbase + (kb + 2) * 128, cum + (kb + 2) * 128, tid);
      LDS_BARRIER();
    }
  }
  lsum += __shfl_xor(lsum, 16); lsum += __shfl_xor(lsum, 32);
  const float inv = 1.f / lsum;
#pragma unroll
  for (int dt = 0; dt < 4; ++dt) { u32x2 w; w.x = pk2(o[dt][0] * inv, o[dt][1] * inv); w.y = pk2(o[dt][2] * inv, o[dt][3] * inv);
    *(u32x2*)(proj + qrow * PW + C_FOXQ + h * 64 + dt * 16 + 4 * g) = w; }
}
__device__ __forceinline__ void ret_unit(const Params& p, int l, unsigned char* lds, int b, int h, int c) {
  asm volatile("" ::: "memory");
  unsigned char* ws = p.ws; bf16* proj = (bf16*)(ws + WS_P);
  int tid = threadIdx.x; asm volatile("" : "+v"(tid)); const int wave = __builtin_amdgcn_readfirstlane(tid >> 6), lane = tid & 63, li = lane & 15, g = lane >> 4;
  const int bh = b * 4 + h; const int nrel = wave * 16 + li; const size_t qrow = (size_t)b * SEQ + c * 128 + nrel;
  const float lg2 = log2f(1.f - exp2f(-5.f - (float)h));
  bf16* RT = (bf16*)(lds + 2 * AT_BUF);
  AtRegs rg; at_issue(rg, proj + ((size_t)b * SEQ + c * 128) * PW + C_RETK + h * 64, (const bf16*)(ws + P_RETVT) + (size_t)bh * 64 * SEQ + c * 128, nullptr, tid);
  { const float cd = ex2(lg2 * 128.f); const float* KV = (const float*)(ws + P_RETKV) + (size_t)bh * 32 * 4096 + (tid >> 3) * 64 + (tid & 7) * 8;
    f32x4 a0 = {0.f, 0.f, 0.f, 0.f}, a1 = {0.f, 0.f, 0.f, 0.f};
    for (int cc = 0; cc < c; ++cc) { const f32x4 k0 = *(const f32x4*)(KV + (size_t)cc * 4096), k1 = *(const f32x4*)(KV + (size_t)cc * 4096 + 4); a0 = a0 * cd + k0; a1 = a1 * cd + k1; }
    __syncthreads();
    const int d = tid >> 3, e0 = (tid & 7) * 8;
#pragma unroll
    for (int e = 0; e < 4; ++e) { RT[(e0 + e) * KS_P + d] = (bf16)f2bf(a0[e]); RT[(e0 + 4 + e) * KS_P + d] = (bf16)f2bf(a1[e]); } }
  at_commit(rg, lds, tid);
  bf16x8 qf[2];
#pragma unroll
  for (int ks = 0; ks < 2; ++ks) qf[ks] = *(const bf16x8*)(proj + qrow * PW + C_RETQ + h * 64 + ks * 32 + 8 * g);
  __syncthreads();
  const bf16* Ks = (const bf16*)(lds + AT_KS); const bf16* Vs = (const bf16*)(lds + AT_VS);
  f32x4 o[4], cr[4];
#pragma unroll
  for (int et = 0; et < 4; ++et) { o[et] = (f32x4){0.f, 0.f, 0.f, 0.f}; cr[et] = (f32x4){0.f, 0.f, 0.f, 0.f};
#pragma unroll
    for (int ks = 0; ks < 2; ++ks) cr[et] = MFMA16(*(const bf16x8*)(RT + (et * 16 + li) * KS_P + ks * 32 + 8 * g), qf[ks], cr[et]); }
  const int nst = (wave >> 1) + 1;
  for (int st = 0; st < nst; ++st) {
    f32x4 s0 = {0.f, 0.f, 0.f, 0.f}, s1 = {0.f, 0.f, 0.f, 0.f};
#pragma unroll
    for (int ks = 0; ks < 2; ++ks) { const bf16x8 a0 = *(const bf16x8*)(Ks + (st * 32 + li) * KS_P + ks * 32 + 8 * g), a1 = *(const bf16x8*)(Ks + (st * 32 + 16 + li) * KS_P + ks * 32 + 8 * g);
      s0 = MFMA16(a0, qf[ks], s0); s1 = MFMA16(a1, qf[ks], s1); }
    float x[8];
#pragma unroll
    for (int j = 0; j < 4; ++j) { const int m0 = st * 32 + 4 * g + j, m1 = m0 + 16;
      x[j] = (m0 <= nrel) ? s0[j] * ex2(lg2 * (float)(nrel - m0)) : 0.f; x[4 + j] = (m1 <= nrel) ? s1[j] * ex2(lg2 * (float)(nrel - m1)) : 0.f; }
    const bf16x8 pb = pack_frag(x);
#pragma unroll
    for (int et = 0; et < 4; ++et) o[et] = MFMA16(vfrag(Vs, et * 16 + li, st * 32, g), pb, o[et]);
  }
  const float xi = ex2(lg2 * (float)(nrel + 1));
  float ss = 0.f;
#pragma unroll
  for (int et = 0; et < 4; ++et)
#pragma unroll
    for (int j = 0; j < 4; ++j) { o[et][j] += xi * cr[et][j]; ss += o[et][j] * o[et][j]; }
  ss += __shfl_xor(ss, 16); ss += __shfl_xor(ss, 32);
  const float rs = rsqrtf(ss * (1.f / 64.f) + EPS);
  const float* gnw = p.in[33] + (size_t)l * G + h * 64;
#pragma unroll
  for (int et = 0; et < 4; ++et) { const int e0 = et * 16 + 4 * g;
    const u32x2 gg = *(const u32x2*)(proj + qrow * PW + C_RETG + h * 64 + e0); const float gt[4] = {bflo(gg.x), bfhi(gg.x), bflo(gg.y), bfhi(gg.y)};
    float r[4];
#pragma unroll
    for (int j = 0; j < 4; ++j) r[j] = o[et][j] * rs * gnw[e0 + j] * (gt[j] * sigmoidf_(gt[j]));
    u32x2 w; w.x = pk2(r[0], r[1]); w.y = pk2(r[2], r[3]);
    *(u32x2*)(proj + qrow * PW + C_RETQ + h * 64 + e0) = w; }
}

constexpr int XP = 264;
__device__ __forceinline__ void xattn_unit(const Params& p, int l, unsigned char* lds, int unit) {
  asm volatile("" ::: "memory");
  unsigned char* ws = p.ws; bf16* qb = (bf16*)(ws + WS_P);
  int tid = threadIdx.x; asm volatile("" : "+v"(tid)); const int wave = __builtin_amdgcn_readfirstlane(tid >> 6), lane = tid & 63, li = lane & 15, g = lane >> 4;
  const int b = unit >> 6, head = (unit >> 4) & 3, qt = unit & 15;
  bf16* L = (bf16*)lds;
  const bf16* kg = (const bf16*)(ws + WS_KM) + ((size_t)l * 1024 + b * 256) * 1024 + head * 256;
  const bf16* vg = (const bf16*)(ws + WS_VMT) + (size_t)(((l * 4 + b) * 4 + head) * 256) * 256;
  __syncthreads();
  for (int i = 0; i < 16; ++i) { const int id = tid + 512 * i, row = id >> 5, ch = id & 31; *(u32x4*)(L + row * XP + ch * 8) = *(const u32x4*)(kg + (size_t)row * 1024 + ch * 8); }
  __syncthreads();
  bf16x8 pb[2][8]; float linv[2];
  const float SC = LOG2E / 16.f;
#pragma unroll
  for (int grp = 0; grp < 2; ++grp) {
    const size_t row = (size_t)b * SEQ + qt * 256 + wave * 32 + grp * 16 + li;
    bf16x8 qf[8];
#pragma unroll
    for (int ks = 0; ks < 8; ++ks) qf[ks] = *(const bf16x8*)(qb + row * 1024 + head * 256 + ks * 32 + 8 * g);
    f32x4 s[16];
#pragma unroll
    for (int kt = 0; kt < 16; ++kt) { s[kt] = (f32x4){0.f, 0.f, 0.f, 0.f};
#pragma unroll
      for (int ks = 0; ks < 8; ++ks) s[kt] = MFMA16(*(const bf16x8*)(L + (kt * 16 + li) * XP + ks * 32 + 8 * g), qf[ks], s[kt]);
      if ((kt & 1) == 1) __builtin_amdgcn_sched_barrier(0); }
    float mx = -INFINITY;
#pragma unroll
    for (int kt = 0; kt < 16; ++kt) mx = fmaxf(mx, fmaxf(fmaxf(s[kt][0], s[kt][1]), fmaxf(s[kt][2], s[kt][3])));
    mx = fmaxf(mx, __shfl_xor(mx, 16)); mx = fmaxf(mx, __shfl_xor(mx, 32));
    float ps = 0.f;
#pragma unroll
    for (int kt = 0; kt < 16; ++kt)
#pragma unroll
      for (int j = 0; j < 4; ++j) { s[kt][j] = ex2((s[kt][j] - mx) * SC); ps += s[kt][j]; }
    ps += __shfl_xor(ps, 16); ps += __shfl_xor(ps, 32);
    linv[grp] = 1.f / ps;
#pragma unroll
    for (int kk = 0; kk < 8; ++kk) { float x[8];
#pragma unroll
      for (int j = 0; j < 4; ++j) { x[j] = s[2 * kk][j]; x[4 + j] = s[2 * kk + 1][j]; }
      pb[grp][kk] = pack_frag(x); }
    __builtin_amdgcn_sched_barrier(0);
  }
  __syncthreads();
  for (int i = 0; i < 16; ++i) { const int id = tid + 512 * i, row = id >> 5, ch = id & 31; *(u32x4*)(L + row * XP + ch * 8) = *(const u32x4*)(vg + (size_t)row * 256 + ch * 8); }
  __syncthreads();
#pragma unroll
  for (int grp = 0; grp < 2; ++grp) {
    const size_t row = (size_t)b * SEQ + qt * 256 + wave * 32 + grp * 16 + li;
#pragma unroll
    for (int dt = 0; dt < 16; ++dt) { f32x4 o = {0.f, 0.f, 0.f, 0.f};
#pragma unroll
      for (int kk = 0; kk < 8; ++kk) { const u32x2 lo = *(const u32x2*)(L + (dt * 16 + li) * XP + kk * 32 + 4 * g), hi = *(const u32x2*)(L + (dt * 16 + li) * XP + kk * 32 + 16 + 4 * g);
        const u32x4 w = {lo.x, lo.y, hi.x, hi.y}; o = MFMA16(__builtin_bit_cast(bf16x8, w), pb[grp][kk], o); }
      u32x2 w; w.x = pk2(o[0] * linv[grp], o[1] * linv[grp]); w.y = pk2(o[2] * linv[grp], o[3] * linv[grp]);
      *(u32x2*)(qb + row * 1024 + head * 256 + dt * 16 + 4 * g) = w;
      __builtin_amdgcn_sched_barrier(0); }
  }
}

#ifndef DEBUG_LAUNCHES
#define DEBUG_LAUNCHES 0
#endif
constexpr int PH_PER_LAYER = 13, N_PHASES = 1 + PH_PER_LAYER * DEPTH;

__global__ void __launch_bounds__(NTHREADS) mega_fwd(Params p) {
  extern __shared__ __attribute__((aligned(16))) unsigned char lds[];
  cg::grid_group grid = cg::this_grid();
  constexpr int NB = 256, NGW = NB * NWAVES;
  unsigned char* ws = p.ws;
  PG8_LAS unsigned char* glds = (PG8_LAS unsigned char*)lds;
  bf16* Hb = (bf16*)(ws + WS_H); bf16* Ob = (bf16*)(ws + WS_O); bf16* Pb = (bf16*)(ws + WS_P);
  int ph = 0;
#ifdef DBG_CLR
#define DBG_LDSCLEAR { for (int e_ = threadIdx.x; e_ < LDS_BYTES / 4; e_ += NTHREADS) ((unsigned*)lds)[e_] = 0u; __syncthreads(); }
#else
#define DBG_LDSCLEAR
#endif
#define PHASE_BEGIN if (ph >= p.ph_lo && ph < p.ph_hi) { int tid = threadIdx.x; asm volatile("" : "+v"(tid)); const int lane = tid & 63, wave = __builtin_amdgcn_readfirstlane(tid >> 6), gw = blockIdx.x * NWAVES + wave; (void)lane; (void)gw; DBG_LDSCLEAR
#define PHASE_END   if (ph + 1 < p.ph_hi) grid.sync(); } ++ph;

  PHASE_BEGIN
    float* scr = (float*)lds + wave * (64 * 33);
    conv_layer_weights(p, 0, scr, gw, NGW, lane);
    { constexpr int I_SQ = (D / 64) * (D / 32);
      for (int it = gw; it < 4 * I_SQ; it += NGW) { const int w = it / I_SQ, r = it % I_SQ, layer = w >> 1, isv = w & 1;
        conv_item<0>(p.in[isv ? 36 : 35] + (size_t)layer * D * D, D, D, D, (bf16*)(ws + WS_WKV) + (size_t)w * D * D, scr, r, lane); } }
    for (int l = 0; l < DEPTH; ++l) { RowArgs a{}; a.xin = p.in[1]; a.g_pre = p.in[6] + (size_t)l * D; a.hout = (bf16*)(ws + WS_MEMN) + (size_t)l * 1024 * 1024; a.rows = 1024; row_phase(a, gw, NGW, lane); }
    { RowArgs a{}; a.xin = p.in[0]; a.g_pre = p.in[2]; a.hout = Hb; a.wf = p.in[9]; a.fbias = p.in[11]; a.logf = (float*)(ws + SM_LOGF); a.rows = T; row_phase(a, gw, NGW, lane); }
#ifdef DBG_FILLG
    for (int e = blockIdx.x * NTHREADS + tid; e < T * G / 2; e += NB * NTHREADS) ((unsigned*)(ws + RW_G))[e] = 0x447A447Au;
#endif
    for (int e = blockIdx.x * NTHREADS + tid; e < SEQ * 32; e += NB * NTHREADS) { const int pos = e >> 5, i = e & 31; const float inv = 1.f / powf(10000.f, (float)i / 31.f); const float ang = (float)pos * inv;
      ((float*)(ws + SM_ROT))[2 * e] = cosf(ang); ((float*)(ws + SM_ROT))[2 * e + 1] = sinf(ang); }
  PHASE_END

  for (int l = 0; l < DEPTH; ++l) {
    PHASE_BEGIN
      { pg8::Gemm g{Hb, (const bf16*)(ws + W_IN), T, NIN, D, D}; pg8::StaticOrder S; S.init(T, NIN, NB, (int)blockIdx.x);
        EpiIn E{Pb, (bf16*)(ws + P_FOXVT), (bf16*)(ws + P_RETKT), (bf16*)(ws + P_RETVT), (const float*)(ws + SM_ROT)};
        pg8::gemm_phase<EpiIn, pg8::StaticOrder, true, true>(glds, g, S, E); }
      if (l == 0) { pg8::Gemm g{(const bf16*)(ws + WS_MEMN), (const bf16*)(ws + WS_WKV), 2048, 4096, D, D}; MemSched S{NB, (int)blockIdx.x};
        EpiMem E{(bf16*)(ws + WS_KM), (bf16*)(ws + WS_VMT)};
        pg8::gemm_phase<EpiMem, MemSched, true, true>(glds, g, S, E); }
    PHASE_END
    PHASE_BEGIN
      float* wl = (float*)lds + wave * (16 * WLP);
      for (int u = gw; u < 1024; u += NGW) rwkv_prep_unit(p, l, u, wl, lane);
      for (int u = gw; u < 512; u += NGW) ret_kv_unit(p, u, lane);
      for (int u = gw; u < 16; u += NGW) fox_cum_unit(p, u, lane);
      if (blockIdx.x == 0 && tid == 0) *(int*)(ws + SM_Q) = 0;
    PHASE_END
    PHASE_BEGIN
#ifndef DBG_P3
#define DBG_P3 15
#endif
      if (blockIdx.x < 128) { if (DBG_P3 & 1) rwkv_scan_unit(p, lds, blockIdx.x);
#ifdef REP_SCAN
        rwkv_scan_unit(p, lds, blockIdx.x);
#endif
      }
      else if (blockIdx.x < 144) { if (DBG_P3 & 2) lru_unit(p, l, (float*)lds, blockIdx.x - 128); }
      int* qword = (int*)(lds + LDS_BYTES - 16);
      for (;;) {
        __syncthreads();
        if (tid == 0) *qword = atomicAdd((int*)(ws + SM_Q), 1);
        __syncthreads();
        const int id = *qword;
        if (id >= 1024) break;
        if (id < 512) { if (DBG_P3 & 4) fox_unit(p, lds, (id & 15) >> 2, id & 3, 31 - (id >> 4)); }
        else if (DBG_P3 & 8) { const int r = id - 512; ret_unit(p, l, lds, r >> 7, (r >> 5) & 3, r & 31); }
      }
    PHASE_END
    PHASE_BEGIN
      for (int row = gw; row < T; row += NGW) rwkv_post_row(p, l, row, lane);
    PHASE_END
    PHASE_BEGIN
      pg8::Gemm g{Pb, (const bf16*)(ws + W_OUT), T, D, D, PW}; pg8::StaticOrder S; S.init(T, D, NB, (int)blockIdx.x);
      EpiPlain E{Ob, D, 0, nullptr};
      pg8::gemm_phase<EpiPlain, pg8::StaticOrder, true, true>(glds, g, S, E);
    PHASE_END
    PHASE_BEGIN
      RowArgs a{}; a.xin = l == 0 ? p.in[0] : p.out; a.O = Ob; a.g_post = p.in[3] + (size_t)l * D; a.xout = p.out; a.g_pre = p.in[4] + (size_t)l * D; a.hout = Hb; a.rows = T;
      row_phase(a, gw, NGW, lane);
    PHASE_END
    PHASE_BEGIN
      pg8::Gemm g{Hb, (const bf16*)(ws + W_Q), T, D, D, D}; pg8::StaticOrder S; S.init(T, D, NB, (int)blockIdx.x);
      EpiPlain E{Pb, D, 0, nullptr};
      pg8::gemm_phase<EpiPlain, pg8::StaticOrder, true, true>(glds, g, S, E);
    PHASE_END
    PHASE_BEGIN
      for (int u = blockIdx.x; u < 256; u += NB) xattn_unit(p, l, lds, u);
    PHASE_END
    PHASE_BEGIN
      pg8::Gemm g{Pb, (const bf16*)(ws + W_O), T, D, D, D}; pg8::StaticOrder S; S.init(T, D, NB, (int)blockIdx.x);
      EpiPlain E{Ob, D, 0, nullptr};
      pg8::gemm_phase<EpiPlain, pg8::StaticOrder, true, true>(glds, g, S, E);
    PHASE_END
    PHASE_BEGIN
      RowArgs a{}; a.xin = p.out; a.O = Ob; a.g_post = p.in[5] + (size_t)l * D; a.xout = p.out; a.g_pre = p.in[7] + (size_t)l * D; a.hout = Hb; a.rows = T;
      row_phase(a, gw, NGW, lane);
    PHASE_END
    PHASE_BEGIN
      pg8::Gemm g{Hb, (const bf16*)(ws + W_1), T, DFF, D, D}; pg8::StaticOrder S; S.init(T, DFF, NB, (int)blockIdx.x);
      EpiPlain E{Pb, DFF, 1, nullptr};
      pg8::gemm_phase<EpiPlain, pg8::StaticOrder, true, true>(glds, g, S, E);
    PHASE_END
    PHASE_BEGIN
      pg8::Gemm g{Pb, (const bf16*)(ws + W_2), T, D, DFF, DFF}; pg8::StaticOrder S; S.init(T, D, NB, (int)blockIdx.x);
      EpiPlain E{Ob, D, 0, nullptr};
      pg8::gemm_phase<EpiPlain, pg8::StaticOrder, true, true>(glds, g, S, E);
    PHASE_END
    PHASE_BEGIN
      RowArgs a{}; a.xin = p.out; a.O = Ob; a.g_post = p.in[8] + (size_t)l * D; a.xout = p.out; a.rows = T;
      if (l + 1 < DEPTH) { a.g_pre = p.in[2] + (size_t)(l + 1) * D; a.hout = Hb; a.wf = p.in[9] + (size_t)(l + 1) * D * INW; a.fbias = p.in[11] + (size_t)(l + 1) * GH; a.logf = (float*)(ws + SM_LOGF); }
      row_phase(a, gw, NGW, lane);
      if (l + 1 < DEPTH) { __syncthreads(); conv_layer_weights(p, l + 1, (float*)lds + wave * (64 * 33), gw, NGW, lane); }
    PHASE_END
  }
}


#ifdef DBG_STOP
#ifndef DBG_MASK
#define DBG_MASK 15
#endif
__global__ void dbg_dump(const unsigned char* ws, float* out) {
  const size_t i = (size_t)blockIdx.x * 256 + threadIdx.x; const int row = (int)(i >> 10), c = (int)(i & 1023);
#ifndef DBG_SRC
#define DBG_SRC 0
#endif
#ifndef DBG_COFF
#define DBG_COFF 0
#endif
  const bf16* proj = (const bf16*)(ws + WS_P);
  if (DBG_SRC == 0) out[i] = ((DBG_MASK >> (c >> 8)) & 1) ? bflo((unsigned)proj[(size_t)row * PW + DBG_COFF + c]) : 0.f;
  else if (DBG_SRC == 1) { const bf16* a = (const bf16*)(ws + WS_RW) + (size_t)(c >> 8) * (8u << 19); out[i] = ((DBG_MASK >> (c >> 8)) & 1) ? bflo((unsigned)a[(size_t)row * G + (c & 255)]) : 0.f; }
  else if (DBG_SRC == 2) { const bf16* a = (const bf16*)(ws + RW_K) + (size_t)(c >> 8) * (8u << 19); float v = 0.f; if (c < 768) v = bflo((unsigned)a[(size_t)row * G + (c & 255)]); else if (c < 772) v = ((const float*)(ws + SM_BR))[row * 4 + (c & 3)]; else if (c < 776) v = ((const float*)(ws + SM_KR))[row * 4 + (c & 3)]; else if (c < 780) v = ((const float*)(ws + SM_RK))[row * 4 + (c & 3)];
    out[i] = ((DBG_MASK >> (c >> 8)) & 1) ? v : 0.f; }
  else if (DBG_SRC == 5) { out[i] = c < 256 ? bflo((unsigned)((const bf16*)(ws + RW_G))[(size_t)row * G + c]) : 0.f; }
  else if (DBG_SRC == 4) { out[i] = i < 512 * 1024 ? bflo((unsigned)((const bf16*)(ws + W_SMALL))[i]) : 0.f; }
  else { out[i] = c < 256 ? ((const float*)(ws + RW_Y))[(size_t)row * G + c] : 0.f; }
}
#endif

#ifdef DBG_GCHK
__global__ void dbg_snap(const unsigned char* ws, float* out) { const size_t i = (size_t)blockIdx.x * 256 + threadIdx.x; ((unsigned*)out)[i] = ((const unsigned*)(ws + RW_G))[i]; if (i == 0) *(unsigned*)(ws + SM_Q + 64) = 0u; }
__global__ void dbg_cmp(unsigned char* ws, const float* out) { const size_t i = (size_t)blockIdx.x * 256 + threadIdx.x; const unsigned a = ((const unsigned*)(ws + RW_G))[i], b = ((const unsigned*)out)[i];
  if (a != b) { unsigned f = 1u; if (a == 0x447A447Au) f |= 2u; else f |= 4u; atomicOr((unsigned*)(ws + SM_Q + 64), f); } }
__global__ void dbg_fin(const unsigned char* ws, float* out) { const size_t i = (size_t)blockIdx.x * 256 + threadIdx.x; out[i] = (i == 0) ? 1.0e6f * (float)(*(const unsigned*)(ws + SM_Q + 64)) : 0.f; }
#endif
extern "C" void kernel_launch(void* const* d_in, const int* in_sizes, int n_in, void* d_out, int out_size, void* d_ws, size_t ws_size, hipStream_t stream) {
  static int grid = 0;
  if (grid == 0) {
    if (ws_size < WS_END) { fprintf(stderr, "kernel_launch: workspace too small: %zu < %zu\n", ws_size, (size_t)WS_END); grid = -1; return; }
    int dev = 0, cus = 0, per_cu = 0;
    hipGetDevice(&dev); hipDeviceGetAttribute(&cus, hipDeviceAttributeMultiprocessorCount, dev);
    hipFuncSetAttribute((const void*)mega_fwd, hipFuncAttributeMaxDynamicSharedMemorySize, LDS_BYTES);
    hipOccupancyMaxActiveBlocksPerMultiprocessor(&per_cu, (const void*)mega_fwd, NTHREADS, LDS_BYTES);
    if (per_cu < 1) { fprintf(stderr, "kernel_launch: occupancy query says %d blocks/CU\n", per_cu); per_cu = 1; }
    grid = 256;
    if (cus < 256) { fprintf(stderr, "kernel_launch: needs 256 CUs, device has %d\n", cus); grid = -1; return; }
    (void)hipGetLastError();
  }
  if (grid < 0) return;
  Params p{};
  for (int i = 0; i < 40; ++i) p.in[i] = (const float*)d_in[i];
  p.out = (float*)d_out; p.ws = (unsigned char*)d_ws;
#if DEBUG_LAUNCHES
#ifdef DBG_GCHK
  for (int ph = 0; ph < 3; ++ph) { p.ph_lo = ph; p.ph_hi = ph + 1; hipLaunchKernelGGL(mega_fwd, dim3(grid), dim3(NTHREADS), LDS_BYTES, stream, p); }
  hipLaunchKernelGGL(dbg_snap, dim3(T * G / 2 / 256), dim3(256), 0, stream, (const unsigned char*)d_ws, (float*)d_out);
  p.ph_lo = 3; p.ph_hi = 4; hipLaunchKernelGGL(mega_fwd, dim3(grid), dim3(NTHREADS), LDS_BYTES, stream, p);
  hipLaunchKernelGGL(dbg_cmp, dim3(T * G / 2 / 256), dim3(256), 0, stream, (unsigned char*)d_ws, (const float*)d_out);
  hipLaunchKernelGGL(dbg_fin, dim3(T * 1024 / 256), dim3(256), 0, stream, (const unsigned char*)d_ws, (float*)d_out);
#elif defined(DBG_STOP)
  for (int ph = 0; ph < DBG_STOP; ++ph) { p.ph_lo = ph; p.ph_hi = ph + 1; hipLaunchKernelGGL(mega_fwd, dim3(grid), dim3(NTHREADS), LDS_BYTES, stream, p); }
  hipLaunchKernelGGL(dbg_dump, dim3(T * 1024 / 256), dim3(256), 0, stream, (const unsigned char*)d_ws, (float*)d_out);
#else
#ifndef REP_MASK
#define REP_MASK 0
#endif
  for (int ph = 0; ph < N_PHASES; ++ph) { p.ph_lo = ph; p.ph_hi = ph + 1; const int rel = ph == 0 ? 0 : 1 + (ph - 1) % PH_PER_LAYER;
    const int reps = ((REP_MASK >> rel) & 1) ? 2 : 1;
    for (int r = 0; r < reps; ++r) hipLaunchKernelGGL(mega_fwd, dim3(grid), dim3(NTHREADS), LDS_BYTES, stream, p); }
#endif
#else
  p.ph_lo = 0; p.ph_hi = N_PHASES;
  void* args[] = {&p};
  hipError_t e = hipLaunchCooperativeKernel((const void*)mega_fwd, dim3(grid), dim3(NTHREADS), args, LDS_BYTES, stream);
  if (e != hipSuccess) fprintf(stderr, "cooperative launch failed: %s (grid %d)\n", hipGetErrorString(e), grid);
#endif
}
```

```cpp
#include <hip/hip_runtime.h>
#include <hip/hip_cooperative_groups.h>
#include <cstdio>
#include <cstdint>
#include <cmath>
namespace cg = cooperative_groups;
namespace pg8 {
#define PG8_LAS __attribute__((address_space(3)))
typedef unsigned short bf16_t;
typedef short bf16x8 __attribute__((ext_vector_type(8)));
typedef float f32x4 __attribute__((ext_vector_type(4)));
typedef unsigned u32x4 __attribute__((ext_vector_type(4)));
constexpr int BM = 256, BK = 64, HALF = 128, HTB = HALF * BK * 2  , STAGE_BYTES = 8 * HTB, NXCD = 8, WGM = 8;

__host__ __device__ __forceinline__ int lds_byte(int r, int c) { const int st = (r >> 4) * 2 + (c >> 5), rr = r & 15, cc = c & 31, ob = rr * 64 + cc * 2; return st * 1024 + (ob ^ (((ob >> 9) & 1) << 5)); }
__host__ __device__ __forceinline__ void stage_rc(int b, int& R, int& C) { const int st = b / 1024, sb = b % 1024, swz = sb ^ (((sb >> 9) & 1) << 5); R = (st >> 1) * 16 + swz / 64; C = (st & 1) * 32 + (swz % 64) / 2; }
__host__ __device__ __forceinline__ int perm32(int rho) { const int n = rho >> 4, i = rho & 15; return 8 * (i >> 2) + 4 * n + (i & 3); }

struct Unit { int pm, pn; };
struct Gemm { const bf16_t* A; const bf16_t* Bt; int M, N, K, lda; };

struct StaticOrder {
    int nM, nN, nwg, G, c;
    __host__ __device__ void init(int M, int N, int G_, int c_) { nM = M / BM; nN = N / BM; nwg = nM * nN; G = G_; c = c_; }
    __host__ __device__ bool next(int i, Unit& u) const {
        const long L = (long)i * G + c; if (L >= nwg) return false;
        int wgid = (int)L; { const int q = nwg / NXCD, r = nwg % NXCD, xcd = wgid % NXCD, off = wgid / NXCD; wgid = (xcd < r ? xcd * (q + 1) : r * (q + 1) + (xcd - r) * q) + off; }
        const int nig = WGM * nN, gid = wgid / nig, fm = gid * WGM, gsz = (nM - fm) < WGM ? (nM - fm) : WGM;
        u.pm = fm + ((wgid % nig) % gsz); u.pn = (wgid % nig) / gsz; return true;
    }
    __device__ __forceinline__ void a_ready(const Unit&) const {}
    __device__ __forceinline__ void done(const Unit&) const {}
};

__device__ __forceinline__ unsigned cvt_pk_bf16(float lo, float hi) { unsigned r; asm volatile("v_cvt_pk_bf16_f32 %0, %1, %2" : "=v"(r) : "v"(lo), "v"(hi)); return r; }
typedef float f32x2 __attribute__((ext_vector_type(2)));
template <class Epi, class Sched, bool ALIGN_EPI = false, bool SP2 = false>
__device__ __forceinline__ void gemm_phase(PG8_LAS unsigned char* lds, const Gemm g, const Sched& S, const Epi& E) {
    int tid_l = threadIdx.x; asm volatile("" : "+v"(tid_l));
    const int tid = tid_l, wid = __builtin_amdgcn_readfirstlane(tid >> 6), lane = tid & 63, wr = wid >> 2, wc = wid & 3, fr = lane & 15, fq = lane >> 4;
    const int K = g.K, nt = K / BK;
    unsigned voffA[2], voffB[2];
#pragma unroll
    for (int i = 0; i < 2; ++i) { int R, C; stage_rc(tid * 16 + i * 8192, R, C); const int Rb = Epi::PERM ? ((R & ~31) + perm32(R & 31)) : R;
        voffA[i] = (unsigned)(R * g.lda + C) * 2u; voffB[i] = (unsigned)(Rb * K + C) * 2u; }
    const size_t kstep = (size_t)(BK * 2);
    const size_t hstep = (size_t)HALF * K * 2;
    const size_t tstep = 2 * hstep; const size_t hstepA = (size_t)HALF * g.lda * 2; const size_t tstepA = 2 * hstepA;
    const unsigned ldsw = (unsigned)wid * 1024u;
    const int aoff = lds_byte(wr * 64 + fr, fq * 8), boff = lds_byte(wc * 32 + fr, fq * 8);
#define PG8_SA(b, h) (((b) * 2 + (h)) * HTB)
#define PG8_SB(b, h) ((4 + (b) * 2 + (h)) * HTB)
#define PG8_STAGE(bufoff, gbase, voff) do { _Pragma("unroll") for (int _i = 0; _i < 2; ++_i) \
        __builtin_amdgcn_global_load_lds((const unsigned*)((const char*)(gbase) + (voff)[_i]), (PG8_LAS unsigned*)(lds + (bufoff) + ldsw + _i * 8192), 16, 0, 0); } while (0)
#define PG8_LDA(dst, b, h) do { _Pragma("unroll") for (int m = 0; m < 4; ++m) _Pragma("unroll") for (int k = 0; k < 2; ++k) dst[m][k] = *(const PG8_LAS bf16x8*)(lds + PG8_SA(b, h) + aoff + m * 2048 + k * 1024); } while (0)
#define PG8_LDB(dst, b, h) do { _Pragma("unroll") for (int n = 0; n < 2; ++n) _Pragma("unroll") for (int k = 0; k < 2; ++k) dst[n][k] = *(const PG8_LAS bf16x8*)(lds + PG8_SB(b, h) + boff + n * 2048 + k * 1024); } while (0)
#define PG8_MMA(ai, bj, At, Bt) do { __builtin_amdgcn_s_setprio(1); _Pragma("unroll") for (int m = 0; m < 4; ++m) _Pragma("unroll") for (int n = 0; n < 2; ++n) _Pragma("unroll") for (int k = 0; k < 2; ++k) \
        acc[ai][bj][m][n] = __builtin_amdgcn_mfma_f32_16x16x32_bf16(Bt[n][k], At[m][k], acc[ai][bj][m][n], 0, 0, 0); __builtin_amdgcn_s_setprio(0); } while (0)
#define PG8_WAIT_V(n) asm volatile("s_waitcnt vmcnt(" #n ")" ::: "memory")
#define PG8_WAIT_L(n) asm volatile("s_waitcnt lgkmcnt(" #n ")" ::: "memory")
#define PG8_BAR __builtin_amdgcn_s_barrier()
#define PG8_SCHED __builtin_amdgcn_sched_barrier(0)
    Unit cur, nxt; int ui = 0;
    if (!S.next(0, cur)) return;
    f32x4 acc[2][2][4][2];
#pragma unroll
    for (int a = 0; a < 2; ++a)
#pragma unroll
        for (int b = 0; b < 2; ++b)
#pragma unroll
            for (int m = 0; m < 4; ++m)
#pragma unroll
                for (int n = 0; n < 2; ++n) acc[a][b][m][n] = (f32x4){0.f, 0.f, 0.f, 0.f};
    bf16x8 At[4][2], B0[2][2], B1[2][2];
    const char* cA = (const char*)g.A + (size_t)cur.pm * tstepA; const char* cB = (const char*)g.Bt + (size_t)cur.pn * tstep;
    S.a_ready(cur);
    if constexpr (SP2) {
        PG8_STAGE(PG8_SB(0, 0), cB, voffB); PG8_STAGE(PG8_SB(0, 1), cB + hstep, voffB); PG8_STAGE(PG8_SA(0, 0), cA, voffA); PG8_STAGE(PG8_SA(0, 1), cA + hstepA, voffA);
        if (wr == 1) PG8_BAR;
        PG8_WAIT_V(2); PG8_BAR;
        PG8_STAGE(PG8_SB(1, 0), cB + kstep, voffB); PG8_STAGE(PG8_SA(1, 0), cA + kstep, voffA); PG8_STAGE(PG8_SB(1, 1), cB + hstep + kstep, voffB);
        PG8_WAIT_V(6); PG8_BAR;
    } else {
        PG8_STAGE(PG8_SB(0, 0), cB, voffB); PG8_STAGE(PG8_SA(0, 0), cA, voffA); PG8_STAGE(PG8_SB(0, 1), cB + hstep, voffB); PG8_STAGE(PG8_SA(0, 1), cA + hstepA, voffA);
        if (wr == 1) PG8_BAR;
        PG8_WAIT_V(4); PG8_BAR;
        PG8_STAGE(PG8_SB(1, 0), cB + kstep, voffB); PG8_STAGE(PG8_SA(1, 0), cA + kstep, voffA); PG8_STAGE(PG8_SB(1, 1), cB + hstep + kstep, voffB);
        PG8_WAIT_V(6); PG8_BAR;
    }
    for (;;) {
        const bool has_next = S.next(ui + 1, nxt);
        const char* nA = has_next ? (const char*)g.A + (size_t)nxt.pm * tstepA : cA; const char* nB = has_next ? (const char*)g.Bt + (size_t)nxt.pn * tstep : cB;
        for (int t = 0; t < nt; t += 2) {
            const bool last = (t == nt - 2);
            const char* a1 = cA + (size_t)(t + 1) * kstep;
            const char* a2 = last ? nA : cA + (size_t)(t + 2) * kstep; const char* b2 = last ? nB : cB + (size_t)(t + 2) * kstep;
            const char* a3 = a2 + kstep; const char* b3 = b2 + kstep;
            if (last && has_next) S.a_ready(nxt);
            if constexpr (SP2) {
            PG8_LDB(B0, 0, 0); PG8_LDB(B1, 0, 1); PG8_SCHED; PG8_LDA(At, 0, 0); PG8_STAGE(PG8_SA(1, 1), a1 + hstepA, voffA);
            PG8_WAIT_V(8); PG8_WAIT_L(0); PG8_BAR; PG8_MMA(0, 0, At, B0); PG8_MMA(0, 1, At, B1); PG8_BAR; PG8_SCHED;
            PG8_LDA(At, 0, 1); PG8_STAGE(PG8_SB(0, 0), b2, voffB); PG8_STAGE(PG8_SB(0, 1), b2 + hstep, voffB); PG8_STAGE(PG8_SA(0, 0), a2, voffA);
            PG8_WAIT_V(8); PG8_WAIT_L(0); PG8_BAR; PG8_MMA(1, 0, At, B0); PG8_MMA(1, 1, At, B1); PG8_BAR; PG8_SCHED;
            PG8_LDB(B0, 1, 0); PG8_LDB(B1, 1, 1); PG8_SCHED; PG8_LDA(At, 1, 0); PG8_STAGE(PG8_SA(0, 1), a2 + hstepA, voffA);
            PG8_WAIT_V(8); PG8_WAIT_L(0); PG8_BAR; PG8_MMA(0, 0, At, B0); PG8_MMA(0, 1, At, B1); PG8_BAR; PG8_SCHED;
            PG8_LDA(At, 1, 1); PG8_STAGE(PG8_SB(1, 0), b3, voffB); PG8_STAGE(PG8_SB(1, 1), b3 + hstep, voffB); PG8_STAGE(PG8_SA(1, 0), a3, voffA);
            PG8_WAIT_V(8); PG8_WAIT_L(0); PG8_BAR; PG8_MMA(1, 0, At, B0); PG8_MMA(1, 1, At, B1); PG8_BAR; PG8_SCHED;
            } else {
            PG8_LDB(B0, 0, 0); PG8_SCHED; PG8_LDA(At, 0, 0); PG8_STAGE(PG8_SA(1, 1), a1 + hstepA, voffA);
            PG8_WAIT_L(8); PG8_BAR; PG8_WAIT_L(0); PG8_MMA(0, 0, At, B0); PG8_BAR; PG8_SCHED;
            PG8_LDB(B1, 0, 1); PG8_STAGE(PG8_SB(0, 0), b2, voffB);
            PG8_BAR; PG8_WAIT_L(0); PG8_MMA(0, 1, At, B1); PG8_BAR;
            PG8_LDA(At, 0, 1); PG8_STAGE(PG8_SA(0, 0), a2, voffA);
            PG8_BAR; PG8_WAIT_L(0); PG8_MMA(1, 0, At, B0); PG8_BAR; PG8_SCHED;
            PG8_STAGE(PG8_SB(0, 1), b2 + hstep, voffB);
            PG8_WAIT_V(6); PG8_BAR; PG8_MMA(1, 1, At, B1); PG8_BAR;
            PG8_LDB(B0, 1, 0); PG8_SCHED; PG8_LDA(At, 1, 0); PG8_STAGE(PG8_SA(0, 1), a2 + hstepA, voffA);
            PG8_WAIT_L(8); PG8_BAR; PG8_WAIT_L(0); PG8_MMA(0, 0, At, B0); PG8_BAR; PG8_SCHED;
            PG8_LDB(B1, 1, 1); PG8_STAGE(PG8_SB(1, 0), b3, voffB);
            PG8_BAR; PG8_WAIT_L(0); PG8_MMA(0, 1, At, B1); PG8_BAR;
            PG8_LDA(At, 1, 1); PG8_STAGE(PG8_SA(1, 0), a3, voffA);
            PG8_BAR; PG8_WAIT_L(0); PG8_MMA(1, 0, At, B0); PG8_BAR; PG8_SCHED;
            PG8_STAGE(PG8_SB(1, 1), b3 + hstep, voffB);
            PG8_WAIT_V(6); PG8_BAR; PG8_MMA(1, 1, At, B1); PG8_BAR;
            }
        }
        if constexpr (ALIGN_EPI) { if (wr == 0) PG8_BAR; }
        if constexpr (!Epi::AFTER_DRAIN) { E(acc, cur, wr, wc, fr, fq); S.done(cur); }
        if (!has_next) break;
#pragma unroll
        for (int a = 0; a < 2; ++a)
#pragma unroll
            for (int b = 0; b < 2; ++b)
#pragma unroll
                for (int m = 0; m < 4; ++m)
#pragma unroll
                    for (int n = 0; n < 2; ++n) acc[a][b][m][n] = (f32x4){0.f, 0.f, 0.f, 0.f};
        cur = nxt; cA = nA; cB = nB; ++ui;
        if constexpr (ALIGN_EPI) { if (wr == 1) PG8_BAR; }
    }
    PG8_WAIT_V(0);
    if constexpr (!ALIGN_EPI) { if (wr == 0) PG8_BAR; }
    PG8_BAR;
    if constexpr (Epi::AFTER_DRAIN) { E.fused(acc, cur, wr, wc, fr, fq, lds, wid, lane); S.done(cur); }
#undef PG8_SA
#undef PG8_SB
#undef PG8_STAGE
#undef PG8_LDA
#undef PG8_LDB
#undef PG8_MMA
#undef PG8_WAIT_V
#undef PG8_WAIT_L
#undef PG8_BAR
#undef PG8_SCHED
}
}

typedef unsigned short bf16;
typedef short bf16x8 __attribute__((ext_vector_type(8)));
typedef short bf16x4 __attribute__((ext_vector_type(4)));
typedef float f32x4 __attribute__((ext_vector_type(4)));
typedef float f32x2 __attribute__((ext_vector_type(2)));
typedef unsigned u32x4 __attribute__((ext_vector_type(4)));
typedef unsigned u32x2 __attribute__((ext_vector_type(2)));

constexpr int D = 1024, BATCH = 4, SEQ = 4096, DEPTH = 2, T = BATCH * SEQ;
constexpr int MEM = 256;
constexpr int G = 256, HD = 64, GH = 4;
constexpr int INW = 3332, DFF = 4096;
constexpr float EPS = 1e-6f, LOG2E = 1.4426950408889634f;
constexpr int NTHREADS = 512, NWAVES = 8;
constexpr int PW = 2816;
constexpr int C_FOXQ = 0, C_LRUY = 256, C_RWR = 512, C_RETQ = 768, C_FOXK = 1024, C_LRUX = 1280, C_RWK = 1536, C_RWV = 1792, C_RWX = 2048, C_RETK = 2304, C_RETG = 2560;
constexpr int NIN = 3328;
__device__ __constant__ const int kSrcCol[13] = {0, 1028, 1284, 2308, 256, 772, 1540, 1796, 2052, 2564, 3076, 512, 2820};

constexpr size_t MiB = 1u << 20;
constexpr size_t WS_W = 0;
constexpr size_t W_IN = 0, W_OUT = 7 * MiB, W_Q = 9 * MiB, W_O = 11 * MiB, W_1 = 13 * MiB, W_2 = 21 * MiB, W_SMALL = 29 * MiB;
constexpr size_t WS_W2T = W_SMALL, WS_A2T = WS_W2T + 256 * 64 * 2, WS_G2T = WS_A2T + 256 * 64 * 2, WS_V1T = WS_G2T + 256 * 128 * 2, WS_V2T = WS_V1T + 32 * 256 * 2, WS_RAT = WS_V2T + 256 * 32 * 2, WS_RIT = WS_RAT + 4 * 64 * 64 * 2;
constexpr size_t WS_P = 30 * MiB;
constexpr size_t P_FOXVT = WS_P + 88 * MiB, P_RETKT = WS_P + 96 * MiB, P_RETVT = WS_P + 104 * MiB, P_RETKV = WS_P + 112 * MiB;
constexpr size_t WS_RW = 158 * MiB;
constexpr size_t RW_E = WS_RW, RW_WR = WS_RW + 8 * MiB, RW_A = WS_RW + 16 * MiB, RW_B = WS_RW + 24 * MiB, RW_K = WS_RW + 32 * MiB, RW_V = WS_RW + 40 * MiB, RW_G = WS_P + 120 * MiB  , RW_Y = WS_RW + 56 * MiB;
constexpr int RW_REC = 320;
__device__ __forceinline__ size_t rw_off(int tok  , int arr, int col  ) { const int b = tok >> 12, pos = tok & (SEQ - 1), hh = col >> 6; return ((size_t)((b * 4 + hh) * SEQ + pos)) * RW_REC + arr * 64 + (col & 63); }
constexpr size_t WS_O = WS_RW, WS_H = WS_RW + 32 * MiB;
constexpr size_t WS_WKV = WS_RW;
constexpr size_t WS_MEMN = WS_RW + 64 * MiB;
constexpr size_t WS_VF = 230 * MiB;
constexpr size_t WS_KM = 238 * MiB, WS_VMT = 242 * MiB;
constexpr size_t WS_SM = 246 * MiB;
constexpr size_t SM_LOGF = WS_SM, SM_CUM = SM_LOGF + 256 * 1024, SM_BR = SM_CUM + 256 * 1024, SM_KR = SM_BR + 256 * 1024, SM_RK = SM_KR + 256 * 1024,
                 SM_SS = SM_RK + 256 * 1024  , SM_ROT = SM_SS + 256 * 1024  , SM_Q = SM_ROT + MiB  , SM_BAR = SM_Q + 4096  , WS_END = SM_BAR + 16384;
static_assert(WS_END <= 256 * MiB, "workspace map");
constexpr int LDS_BYTES = 147456;

__device__ __forceinline__ unsigned f2bf(float f) { unsigned u = __builtin_bit_cast(unsigned, f); return (u + 0x7fffu + ((u >> 16) & 1u)) >> 16; }
typedef __bf16 bf16x2_t __attribute__((ext_vector_type(2)));
__device__ __forceinline__ unsigned pk2(float lo, float hi) { const f32x2 v = {lo, hi}; const bf16x2_t b = __builtin_convertvector(v, bf16x2_t); return __builtin_bit_cast(unsigned, b); }
__device__ __forceinline__ float bflo(unsigned u) { return __builtin_bit_cast(float, u << 16); }
__device__ __forceinline__ float bfhi(unsigned u) { return __builtin_bit_cast(float, u & 0xffff0000u); }
__device__ __forceinline__ void unpack8(u32x4 w, float* f) { f[0] = bflo(w.x); f[1] = bfhi(w.x); f[2] = bflo(w.y); f[3] = bfhi(w.y); f[4] = bflo(w.z); f[5] = bfhi(w.z); f[6] = bflo(w.w); f[7] = bfhi(w.w); }
__device__ __forceinline__ u32x4 pack8(const float* f) { u32x4 w; w.x = pk2(f[0], f[1]); w.y = pk2(f[2], f[3]); w.z = pk2(f[4], f[5]); w.w = pk2(f[6], f[7]); return w; }
__device__ __forceinline__ float wave_sum(float v) {
#pragma unroll
  for (int o = 1; o < 64; o <<= 1) v += __shfl_xor(v, o);
  return v;
}
__device__ __forceinline__ float ex2(float x) { return __builtin_amdgcn_exp2f(x); }
__device__ __forceinline__ float rcpf_(float x) { return __builtin_amdgcn_rcpf(x); }
__device__ __forceinline__ float sigmoidf_(float x) { return rcpf_(1.f + __expf(-x)); }
__device__ __forceinline__ float lse0_(float x) { return __logf(1.f + __expf(-fabsf(x))); }
__device__ __forceinline__ float log_sigmoidf_(float x) { return fminf(x, 0.f) - lse0_(x); }
__device__ __forceinline__ float log_sigmoid_acc(float x) { return fminf(x, 0.f) - log1pf(__expf(-fabsf(x))); }
__device__ __forceinline__ float softplusf_(float x) { return fmaxf(x, 0.f) + lse0_(x); }
__device__ __forceinline__ float tanhf_(float x) { return 1.f - 2.f * rcpf_(1.f + __expf(2.f * x)); }
__device__ __forceinline__ float gelu_tanh(float x) { return 0.5f * x * (1.f + tanhf_(0.7978845608028654f * (x + 0.044715f * x * x * x))); }
#define WAVE_LDS_FENCE() asm volatile("s_waitcnt lgkmcnt(0)" ::: "memory")
#define LDS_BARRIER() asm volatile("s_waitcnt lgkmcnt(0)\n\ts_barrier" ::: "memory")
#define MFMA16(a, b, c) __builtin_amdgcn_mfma_f32_16x16x32_bf16((a), (b), (c), 0, 0, 0)

struct Params { const float* in[40]; float* out; unsigned char* ws; int ph_lo, ph_hi; };

struct EpiIn {
  static constexpr bool PERM = true, AFTER_DRAIN = false;
  bf16* proj; bf16* foxvT; bf16* retkT; bf16* retvT; const float* rot;
  __device__ __forceinline__ void operator()(const f32x4 (&acc)[2][2][4][2], const pg8::Unit& u, int wr, int wc, int fr, int fq) const {
    const int pn = u.pn;
    const bool rotary = (pn == 3) || (pn == 9);
    const float sc = (pn == 9) ? 0.125f : 1.f;
    bf16* tdst = pn == 9 ? retkT : pn == 11 ? foxvT : pn == 12 ? retvT : nullptr;
    const bool rowmajor = pn <= 10;
#pragma unroll
    for (int ai = 0; ai < 2; ++ai)
#pragma unroll
      for (int m = 0; m < 4; ++m) {
        const int row = u.pm * 256 + ai * 128 + wr * 64 + m * 16 + fr; const int pos = row & (SEQ - 1), b = row >> 12;
#pragma unroll
        for (int bj = 0; bj < 2; ++bj) {
          const int c0 = bj * 128 + wc * 32 + 8 * fq;
          float v[8];
#pragma unroll
          for (int e = 0; e < 4; ++e) { v[e] = acc[ai][bj][m][0][e]; v[4 + e] = acc[ai][bj][m][1][e]; }
          if (rotary) {
            const int i0 = (c0 & 63) >> 1;
            const f32x4 r0 = *(const f32x4*)(rot + ((size_t)pos * 32 + i0) * 2), r1 = *(const f32x4*)(rot + ((size_t)pos * 32 + i0 + 2) * 2);
            const float cs[4] = {r0[0], r0[2], r1[0], r1[2]}, sn[4] = {r0[1], r0[3], r1[1], r1[3]};
#pragma unroll
            for (int p = 0; p < 4; ++p) { const float x1 = v[2 * p], x2 = v[2 * p + 1]; v[2 * p] = x1 * cs[p] - x2 * sn[p]; v[2 * p + 1] = x1 * sn[p] + x2 * cs[p]; }
          }
#pragma unroll
          for (int e = 0; e < 8; ++e) v[e] *= sc;
          const u32x4 w = pack8(v);
          if (rowmajor) *(u32x4*)(proj + (size_t)row * PW + pn * 256 + c0) = w;
          if (tdst) {
            const int hh = c0 >> 6, d0 = c0 & 63; bf16* tp = tdst + ((size_t)((b * 4 + hh) * 64 + d0)) * SEQ + pos;
            const unsigned ww[4] = {w.x, w.y, w.z, w.w};
#pragma unroll
            for (int e = 0; e < 8; ++e) tp[(size_t)e * SEQ] = (bf16)((e & 1) ? (ww[e >> 1] >> 16) : (ww[e >> 1] & 0xffffu));
          }
        }
      }
  }
};
struct EpiPlain {
  static constexpr bool PERM = true, AFTER_DRAIN = false;
  bf16* O; int ldc; int act; float* ss;
  __device__ __forceinline__ void operator()(const f32x4 (&acc)[2][2][4][2], const pg8::Unit& u, int wr, int wc, int fr, int fq) const {
#pragma unroll
    for (int ai = 0; ai < 2; ++ai)
#pragma unroll
      for (int m = 0; m < 4; ++m) {
        const int row = u.pm * 256 + ai * 128 + wr * 64 + m * 16 + fr; float s = 0.f;
#pragma unroll
        for (int bj = 0; bj < 2; ++bj) {
          const int c0 = u.pn * 256 + bj * 128 + wc * 32 + 8 * fq;
          float v[8];
#pragma unroll
          for (int e = 0; e < 4; ++e) { v[e] = acc[ai][bj][m][0][e]; v[4 + e] = acc[ai][bj][m][1][e]; }
          if (act == 1) {
#pragma unroll
            for (int e = 0; e < 8; ++e) { const float r = fmaxf(v[e], 0.f); v[e] = r * r; }
          }
#pragma unroll
          for (int e = 0; e < 8; ++e) s += v[e] * v[e];
          *(u32x4*)(O + (size_t)row * ldc + c0) = pack8(v);
        }
        if (ss) { s += __shfl_xor(s, 16); s += __shfl_xor(s, 32); if (fq == 0) atomicAdd(ss + row, s); }
      }
  }
};
struct EpiMem {
  static constexpr bool PERM = true, AFTER_DRAIN = false;
  bf16* kmem; bf16* vmemT;
  __device__ __forceinline__ void operator()(const f32x4 (&acc)[2][2][4][2], const pg8::Unit& u, int wr, int wc, int fr, int fq) const {
    const int layer = u.pm >> 2, pt = u.pn & 7; const bool isv = pt >= 4; const int head = pt & 3;
#pragma unroll
    for (int ai = 0; ai < 2; ++ai)
#pragma unroll
      for (int m = 0; m < 4; ++m) {
        const int rowl = (u.pm & 3) * 256 + ai * 128 + wr * 64 + m * 16 + fr;
#pragma unroll
        for (int bj = 0; bj < 2; ++bj) {
          const int c0 = bj * 128 + wc * 32 + 8 * fq;
          float v[8];
#pragma unroll
          for (int e = 0; e < 4; ++e) { v[e] = acc[ai][bj][m][0][e]; v[4 + e] = acc[ai][bj][m][1][e]; }
          const u32x4 w = pack8(v);
          if (!isv) *(u32x4*)(kmem + ((size_t)layer * 1024 + rowl) * 1024 + head * 256 + c0) = w;
          else {
            const int b = rowl >> 8, key = rowl & 255; bf16* tp = vmemT + ((size_t)(((layer * 4 + b) * 4 + head) * 256 + c0)) * 256 + key;
            const unsigned ww[4] = {w.x, w.y, w.z, w.w};
#pragma unroll
            for (int e = 0; e < 8; ++e) tp[(size_t)e * 256] = (bf16)((e & 1) ? (ww[e >> 1] >> 16) : (ww[e >> 1] & 0xffffu));
          }
        }
      }
  }
};
struct MemSched {
  int G, c;
  __device__ bool next(int i, pg8::Unit& u) const { const int L = i * G + c; if (c < 0 || L >= 64) return false; const int layer = L >> 5, r = L & 31; u.pm = layer * 4 + (r & 3); u.pn = layer * 8 + (r >> 2); return true; }
  __device__ __forceinline__ void a_ready(const pg8::Unit&) const {}
  __device__ __forceinline__ void done(const pg8::Unit&) const {}
};

template <int MAP> __device__ __forceinline__ int src_col(int n) {
  if (MAP == 0) return n;
  const int tile = n >> 8, j = n & 255; int jj = j;
  if (tile == 3 || tile == 9) { const int hh = j >> 6, l = j & 63; jj = hh * 64 + (l >> 1) + 32 * (l & 1); }
  return kSrcCol[tile] + jj;
}
template <int MAP> __device__ __forceinline__ void conv_item(const float* __restrict__ W, int K, int Nsrc, int N, bf16* WT, float* scr, int item, int lane) {
  const int nblk = N / 32, kb = item / nblk, nb = item % nblk, k0 = 64 * kb, n0 = 32 * nb;
  const int sc = src_col<MAP>(n0 + (lane & 31));
#pragma unroll 8
  for (int i = 0; i < 32; ++i) { const int kk = 2 * i + (lane >> 5); scr[kk * 33 + (lane & 31)] = W[(size_t)(k0 + kk) * Nsrc + sc]; }
  WAVE_LDS_FENCE();
  const int c = lane & 7;
#pragma unroll
  for (int j = 0; j < 4; ++j) { const int n = (lane >> 3) + 8 * j; const float* s = scr + (8 * c) * 33 + n;
    u32x4 o; o.x = pk2(s[0 * 33], s[1 * 33]); o.y = pk2(s[2 * 33], s[3 * 33]); o.z = pk2(s[4 * 33], s[5 * 33]); o.w = pk2(s[6 * 33], s[7 * 33]);
    *(u32x4*)(WT + (size_t)(n0 + n) * K + k0 + 8 * c) = o; }
  WAVE_LDS_FENCE();
}
__device__ __forceinline__ void conv_layer_weights(const Params& p, int l, float* scr, int gw, int NGW, int lane) {
  asm volatile("" ::: "memory");
  asm volatile("" : "+v"(lane));
  unsigned char* ws = p.ws;
  constexpr int I_IN = (D / 64) * (NIN / 32), I_SQ = (D / 64) * (D / 32), I_1 = (D / 64) * (DFF / 32), I_2 = (DFF / 64) * (D / 32);
  constexpr int I_W2 = 1 * 8, I_A2 = 8, I_G2 = 2 * 8, I_V1 = 4 * 1, I_V2 = 8  , I_R = 2 * 4 * 2;
  constexpr int NIT = I_IN + 3 * I_SQ + I_1 + I_2 + I_W2 + I_A2 + I_G2 + I_V1 + I_R;
  for (int it = gw; it < NIT; it += NGW) {
    int r = it;
    if (r < I_IN) { conv_item<1>(p.in[9] + (size_t)l * D * INW, D, INW, NIN, (bf16*)(ws + W_IN), scr, r, lane); continue; } r -= I_IN;
    if (r < I_SQ) { conv_item<0>(p.in[10] + (size_t)l * D * D, D, D, D, (bf16*)(ws + W_OUT), scr, r, lane); continue; } r -= I_SQ;
    if (r < I_SQ) { conv_item<0>(p.in[34] + (size_t)l * D * D, D, D, D, (bf16*)(ws + W_Q), scr, r, lane); continue; } r -= I_SQ;
    if (r < I_SQ) { conv_item<0>(p.in[37] + (size_t)l * D * D, D, D, D, (bf16*)(ws + W_O), scr, r, lane); continue; } r -= I_SQ;
    if (r < I_1) { conv_item<0>(p.in[38] + (size_t)l * D * DFF, D, DFF, DFF, (bf16*)(ws + W_1), scr, r, lane); continue; } r -= I_1;
    if (r < I_2) { conv_item<0>(p.in[39] + (size_t)l * DFF * D, DFF, D, D, (bf16*)(ws + W_2), scr, r, lane); continue; } r -= I_2;
    if (r < I_W2) { conv_item<0>(p.in[21] + (size_t)l * 64 * G, 64, G, G, (bf16*)(ws + WS_W2T), scr, r, lane); continue; } r -= I_W2;
    if (r < I_A2) { conv_item<0>(p.in[23] + (size_t)l * 64 * G, 64, G, G, (bf16*)(ws + WS_A2T), scr, r, lane); continue; } r -= I_A2;
    if (r < I_G2) { conv_item<0>(p.in[24] + (size_t)l * 128 * G, 128, G, G, (bf16*)(ws + WS_G2T), scr, r, lane); continue; } r -= I_G2;
    if (r < I_V1) { if (l > 0) conv_item<0>(p.in[31] + (size_t)(l - 1) * G * 32, G, 32, 32, (bf16*)(ws + WS_V1T), scr, r, lane); continue; } r -= I_V1;
    { const int gate = r >> 3, hh = (r >> 1) & 3, nb = r & 1;
      conv_item<0>(p.in[gate ? 16 : 14] + ((size_t)l * GH + hh) * HD * HD, 64, 64, 64, (bf16*)(ws + (gate ? WS_RIT : WS_RAT)) + hh * 4096, scr, nb, lane); }
  }
  if (l > 0) { const float* v2 = p.in[32] + (size_t)(l - 1) * 32 * G; bf16* v2t = (bf16*)(ws + WS_V2T);
    for (int e = gw * 64 + lane; e < 32 * G; e += NGW * 64) { const int k = e / G, n = e % G; v2t[n * 32 + k] = (bf16)f2bf(v2[e]); } }
}

struct RowArgs { const float* xin; const bf16* O; float* ss; const float* g_post; float* xout; const float* g_pre; bf16* hout; const float* wf; const float* fbias; float* logf; int rows; };
__device__ __forceinline__ void row_phase(const RowArgs& a, int gw, int NGW, int lane) {
  asm volatile("" ::: "memory");
  asm volatile("" : "+v"(lane));
  f32x4 gp[4], gq[4], wfv[4][4];
#pragma unroll
  for (int j = 0; j < 4; ++j) {
    gp[j] = a.O ? ((const f32x4*)a.g_post)[lane + 64 * j] : (f32x4){0.f, 0.f, 0.f, 0.f};
    gq[j] = a.hout ? ((const f32x4*)a.g_pre)[lane + 64 * j] : (f32x4){0.f, 0.f, 0.f, 0.f};
#pragma unroll
    for (int hh = 0; hh < 4; ++hh)
#pragma unroll
      for (int e = 0; e < 4; ++e) wfv[j][hh][e] = a.wf ? a.wf[(size_t)(4 * (lane + 64 * j) + e) * INW + 768 + hh] : 0.f;
  }
  for (int row0 = gw; row0 < a.rows; row0 += 2 * NGW) {
    const int rowv[2] = {row0, row0 + NGW}; const bool val[2] = {true, row0 + NGW < a.rows};
    f32x4 x[2][4]; float ov[2][4][4];
#pragma unroll
    for (int r = 0; r < 2; ++r) if (val[r]) {
#pragma unroll
      for (int j = 0; j < 4; ++j) x[r][j] = ((const f32x4*)(a.xin + (size_t)rowv[r] * D))[lane + 64 * j];
      if (a.O) {
#pragma unroll
        for (int j = 0; j < 4; ++j) { const u32x2 o = ((const u32x2*)(a.O + (size_t)rowv[r] * D))[lane + 64 * j];
          ov[r][j][0] = bflo(o.x); ov[r][j][1] = bfhi(o.x); ov[r][j][2] = bflo(o.y); ov[r][j][3] = bfhi(o.y); }
      }
    }
#pragma unroll
    for (int r = 0; r < 2; ++r) if (val[r]) {
      const int row = rowv[r];
      if (a.O) {
        float so = 0.f;
#pragma unroll
        for (int j = 0; j < 4; ++j) so += ov[r][j][0] * ov[r][j][0] + ov[r][j][1] * ov[r][j][1] + ov[r][j][2] * ov[r][j][2] + ov[r][j][3] * ov[r][j][3];
        so = wave_sum(so);
        const float rs = rsqrtf(so * (1.f / D) + EPS);
#pragma unroll
        for (int j = 0; j < 4; ++j)
#pragma unroll
          for (int e = 0; e < 4; ++e) x[r][j][e] += ov[r][j][e] * rs * gp[j][e];
      }
      if (a.xout) {
#pragma unroll
        for (int j = 0; j < 4; ++j) ((f32x4*)(a.xout + (size_t)row * D))[lane + 64 * j] = x[r][j];
      }
      if (a.hout) {
        float s = 0.f;
#pragma unroll
        for (int j = 0; j < 4; ++j) s += x[r][j][0] * x[r][j][0] + x[r][j][1] * x[r][j][1] + x[r][j][2] * x[r][j][2] + x[r][j][3] * x[r][j][3];
        s = wave_sum(s); const float rs2 = rsqrtf(s * (1.f / D) + EPS);
        float fd[4] = {0.f, 0.f, 0.f, 0.f};
#pragma unroll
        for (int j = 0; j < 4; ++j) {
          f32x4 hv;
#pragma unroll
          for (int e = 0; e < 4; ++e) hv[e] = x[r][j][e] * rs2 * gq[j][e];
          u32x2 o; o.x = pk2(hv[0], hv[1]); o.y = pk2(hv[2], hv[3]);
          ((u32x2*)(a.hout + (size_t)row * D))[lane + 64 * j] = o;
          if (a.wf) {
#pragma unroll
            for (int hh = 0; hh < 4; ++hh) fd[hh] += hv[0] * wfv[j][hh][0] + hv[1] * wfv[j][hh][1] + hv[2] * wfv[j][hh][2] + hv[3] * wfv[j][hh][3];
          }
        }
        if (a.wf) {
#pragma unroll
          for (int hh = 0; hh < 4; ++hh) fd[hh] = wave_sum(fd[hh]);
          if (lane < 4) { const float f = lane == 0 ? fd[0] : lane == 1 ? fd[1] : lane == 2 ? fd[2] : fd[3]; a.logf[(size_t)row * 4 + lane] = log_sigmoidf_(f + a.fbias[lane]); }
        }
      }
    }
  }
}

__device__ __forceinline__ void lerp8(const bf16* __restrict__ proj, const float* __restrict__ mu, int tok, int col, int mucol, float* out) {
  const u32x4 c = *(const u32x4*)(proj + (size_t)tok * PW + col);
  u32x4 pv = {0u, 0u, 0u, 0u};
  if ((tok & (SEQ - 1)) != 0) pv = *(const u32x4*)(proj + (size_t)(tok - 1) * PW + col);
  float cf[8], pf[8]; unpack8(c, cf); unpack8(pv, pf);
  const f32x4 m0 = *(const f32x4*)(mu + mucol), m1 = *(const f32x4*)(mu + mucol + 4);
#pragma unroll
  for (int e = 0; e < 4; ++e) { out[e] = cf[e] + (pf[e] - cf[e]) * m0[e]; out[4 + e] = cf[4 + e] + (pf[4 + e] - cf[4 + e]) * m1[e]; }
}
__device__ __forceinline__ bf16x8 pack_frag(const float* f) { const u32x4 w = pack8(f); return __builtin_bit_cast(bf16x8, w); }
constexpr int WLP = 260;
__device__ __forceinline__ void acc_to_lds(float* wl, const f32x4* acc, int ntiles, int li, int g) {
#pragma unroll
  for (int nt = 0; nt < 16; ++nt) if (nt < ntiles) {
#pragma unroll
    for (int j = 0; j < 4; ++j) wl[(4 * g + j) * WLP + nt * 16 + li] = acc[nt][j];
  }
}
template <int KS> __device__ __forceinline__ void mm16_to_lds(const bf16x8* af, const bf16* __restrict__ wt, int ldw, float* wl, int li, int g) {
#pragma unroll 1
  for (int ng = 0; ng < 4; ++ng) {
    f32x4 a4[4];
#pragma unroll
    for (int n4 = 0; n4 < 4; ++n4) { a4[n4] = (f32x4){0.f, 0.f, 0.f, 0.f};
#pragma unroll
      for (int ks = 0; ks < KS; ++ks) { const bf16x8 bfr = *(const bf16x8*)(wt + (size_t)((ng * 4 + n4) * 16 + li) * ldw + ks * 32 + 8 * g); a4[n4] = MFMA16(af[ks], bfr, a4[n4]); } }
#pragma unroll
    for (int n4 = 0; n4 < 4; ++n4)
#pragma unroll
      for (int j = 0; j < 4; ++j) wl[(4 * g + j) * WLP + (ng * 4 + n4) * 16 + li] = a4[n4][j];
  }
}
__device__ __forceinline__ void rwkv_prep_unit(const Params& p, int l, int unit, int pass, float* wl, int lane) {
  asm volatile("" ::: "memory");
  asm volatile("" : "+v"(lane));
  unsigned char* ws = p.ws;
  const bf16* proj = (const bf16*)(ws + WS_P);
  const float* mu = p.in[19] + (size_t)l * 1024;
  const int li = lane & 15, g = lane >> 4, t0 = unit * 16, ta = t0 + li;
  const int tl = t0 + (lane >> 2), cgp = lane & 3;
  if (pass == 0) {
    bf16x8 af[2];
#pragma unroll
    for (int ks = 0; ks < 2; ++ks) { float f[8]; lerp8(proj, mu, ta, C_RWX + ks * 32 + 8 * g, 768 + ks * 32 + 8 * g, f);
#pragma unroll
      for (int e = 0; e < 8; ++e) f[e] = tanhf_(f[e]);
      af[ks] = pack_frag(f); }
    mm16_to_lds<2>(af, (const bf16*)(ws + WS_W2T), 64, wl, li, g); WAVE_LDS_FENCE();
    const float* w0 = p.in[20] + (size_t)l * G;
#pragma unroll 2
    for (int i = 0; i < 8; ++i) { int col = cgp * 8 + 32 * i; asm volatile("" : "+v"(col)); float r[8], ev[8], wr[8];
      lerp8(proj, mu, tl, C_RWR + col, col, r);
#pragma unroll
      for (int e = 0; e < 8; ++e) { const float wa = wl[(lane >> 2) * WLP + col + e] + w0[col + e]; const float wlog = -softplusf_(-wa) - 0.5f; const float ee = __expf(wlog); ev[e] = ee; wr[e] = __expf(-ee) * r[e]; }
      *(u32x4*)((bf16*)(ws + WS_RW) + rw_off(tl, 0, col)) = pack8(ev); *(u32x4*)((bf16*)(ws + WS_RW) + rw_off(tl, 1, col)) = pack8(wr); }
    WAVE_LDS_FENCE();
  }
  if (pass == 1) {
    bf16x8 af[2];
#pragma unroll
    for (int ks = 0; ks < 2; ++ks) { float f[8]; lerp8(proj, mu, ta, C_RWX + 64 + ks * 32 + 8 * g, 832 + ks * 32 + 8 * g, f); af[ks] = pack_frag(f); }
    mm16_to_lds<2>(af, (const bf16*)(ws + WS_A2T), 64, wl, li, g); WAVE_LDS_FENCE();
    const float* a0 = p.in[22] + (size_t)l * G; const float* k_k = p.in[25] + (size_t)l * G; const float* k_a = p.in[26] + (size_t)l * G; const float* r_k = p.in[27] + (size_t)l * G;
#pragma unroll 1
    for (int hh = 0; hh < 4; ++hh) {
      float av[2][8], kv[2][8], kk[2][8]; float ssq = 0.f;
#pragma unroll
      for (int ii = 0; ii < 2; ++ii) { int col = cgp * 8 + 32 * (2 * hh + ii); asm volatile("" : "+v"(col));
        lerp8(proj, mu, tl, C_RWK + col, 256 + col, kv[ii]);
#pragma unroll
        for (int e = 0; e < 8; ++e) { av[ii][e] = sigmoidf_(a0[col + e] + wl[(lane >> 2) * WLP + col + e]); kk[ii][e] = kv[ii][e] * k_k[col + e]; ssq += kk[ii][e] * kk[ii][e]; } }
      ssq += __shfl_xor(ssq, 1); ssq += __shfl_xor(ssq, 2);
      const float inv = 1.f / fmaxf(sqrtf(ssq), 1e-12f);
      float sbr = 0.f, skr = 0.f, srk = 0.f;
#pragma unroll
      for (int ii = 0; ii < 2; ++ii) { int col = cgp * 8 + 32 * (2 * hh + ii); asm volatile("" : "+v"(col)); float r[8], Av[8], Bv[8], k2[8];
        lerp8(proj, mu, tl, C_RWR + col, col, r);
#pragma unroll
        for (int e = 0; e < 8; ++e) { const float kn = kk[ii][e] * inv; Av[e] = -kn; Bv[e] = kn * av[ii][e]; k2[e] = kv[ii][e] * (1.f + (av[ii][e] - 1.f) * k_a[col + e]);
          const float rb = r[e]; sbr += Bv[e] * rb; skr += k2[e] * rb; srk += rb * k2[e] * r_k[col + e]; }
        *(u32x4*)((bf16*)(ws + WS_RW) + rw_off(tl, 2, col)) = pack8(Av); *(u32x4*)((bf16*)(ws + WS_RW) + rw_off(tl, 3, col)) = pack8(Bv); *(u32x4*)((bf16*)(ws + WS_RW) + rw_off(tl, 4, col)) = pack8(k2); }
      sbr += __shfl_xor(sbr, 1); sbr += __shfl_xor(sbr, 2); skr += __shfl_xor(skr, 1); skr += __shfl_xor(skr, 2); srk += __shfl_xor(srk, 1); srk += __shfl_xor(srk, 2);
      if (cgp == 0) { ((float*)(ws + SM_BR))[(size_t)tl * 4 + hh] = sbr; ((float*)(ws + SM_KR))[(size_t)tl * 4 + hh] = skr; ((float*)(ws + SM_RK))[(size_t)tl * 4 + hh] = srk; }
    }
    WAVE_LDS_FENCE();
  }
  if (pass == 2) {
    bf16x8 af[4];
#pragma unroll
    for (int ks = 0; ks < 4; ++ks) { float f[8]; lerp8(proj, mu, ta, C_RWX + 128 + ks * 32 + 8 * g, 896 + ks * 32 + 8 * g, f);
#pragma unroll
      for (int e = 0; e < 8; ++e) f[e] = sigmoidf_(f[e]);
      af[ks] = pack_frag(f); }
    mm16_to_lds<4>(af, (const bf16*)(ws + WS_G2T), 128, wl, li, g); WAVE_LDS_FENCE();
#pragma unroll 2
    for (int i = 0; i < 8; ++i) { int col = cgp * 8 + 32 * i; asm volatile("" : "+v"(col)); float gv[8];
#pragma unroll
      for (int e = 0; e < 8; ++e) gv[e] = wl[(lane >> 2) * WLP + col + e];
      *(u32x4*)((bf16*)(ws + RW_G) + (size_t)tl * G + col) = pack8(gv); }
    WAVE_LDS_FENCE();
  }
  if (pass != 3) return;
  if (l > 0) {
    f32x4 a1[2] = {(f32x4){0.f, 0.f, 0.f, 0.f}, (f32x4){0.f, 0.f, 0.f, 0.f}};
    const bf16* v1t = (const bf16*)(ws + WS_V1T);
#pragma unroll
    for (int ks = 0; ks < 8; ++ks) { float f[8]; lerp8(proj, mu, ta, C_RWV + ks * 32 + 8 * g, 512 + ks * 32 + 8 * g, f); const bf16x8 af = pack_frag(f);
#pragma unroll
      for (int nt = 0; nt < 2; ++nt) { const bf16x8 bfr = *(const bf16x8*)(v1t + (size_t)(nt * 16 + li) * 256 + ks * 32 + 8 * g); a1[nt] = MFMA16(af, bfr, a1[nt]); } }
#pragma unroll
    for (int nt = 0; nt < 2; ++nt)
#pragma unroll
      for (int j = 0; j < 4; ++j) wl[(4 * g + j) * WLP + nt * 16 + li] = a1[nt][j];
    WAVE_LDS_FENCE();
    float f2[8];
#pragma unroll
    for (int e = 0; e < 8; ++e) f2[e] = wl[li * WLP + 8 * g + e];
    const bf16x8 af2 = pack_frag(f2);
    WAVE_LDS_FENCE();
    mm16_to_lds<1>(&af2, (const bf16*)(ws + WS_V2T), 32, wl, li, g); WAVE_LDS_FENCE();
    const float* v0 = p.in[30] + (size_t)(l - 1) * G;
#pragma unroll 2
    for (int i = 0; i < 8; ++i) { int col = cgp * 8 + 32 * i; asm volatile("" : "+v"(col)); float v[8], vf[8];
      lerp8(proj, mu, tl, C_RWV + col, 512 + col, v);
      unpack8(*(const u32x4*)((const bf16*)(ws + WS_VF) + (size_t)tl * G + col), vf);
#pragma unroll
      for (int e = 0; e < 8; ++e) v[e] = v[e] + (vf[e] - v[e]) * sigmoidf_(v0[col + e] + wl[(lane >> 2) * WLP + col + e]);
      *(u32x4*)((bf16*)(ws + RW_V) + (size_t)tl * G + col) = pack8(v); }
    WAVE_LDS_FENCE();
  } else {
#pragma unroll 2
    for (int i = 0; i < 8; ++i) { int col = cgp * 8 + 32 * i; asm volatile("" : "+v"(col)); float v[8];
      lerp8(proj, mu, tl, C_RWV + col, 512 + col, v);
      const u32x4 w = pack8(v);
      *(u32x4*)((bf16*)(ws + RW_V) + (size_t)tl * G + col) = w; *(u32x4*)((bf16*)(ws + WS_VF) + (size_t)tl * G + col) = w; }
  }
}
__device__ __forceinline__ void ret_kv_unit(const Params& p, int unit, int lane) {
  asm volatile("" ::: "memory");
  asm volatile("" : "+v"(lane));
  unsigned char* ws = p.ws;
  const int bh = unit >> 5, c = unit & 31, h = bh & 3, li = lane & 15, g = lane >> 4;
  const float lg2 = log2f(1.f - exp2f(-5.f - (float)h));
  const bf16* kT = (const bf16*)(ws + P_RETKT) + (size_t)bh * 64 * SEQ + c * 128;
  const bf16* vT = (const bf16*)(ws + P_RETVT) + (size_t)bh * 64 * SEQ + c * 128;
  f32x4 acc[4][4];
#pragma unroll
  for (int a = 0; a < 4; ++a)
#pragma unroll
    for (int b = 0; b < 4; ++b) acc[a][b] = (f32x4){0.f, 0.f, 0.f, 0.f};
#pragma unroll
  for (int ks = 0; ks < 4; ++ks) {
    float z[8];
#pragma unroll
    for (int e = 0; e < 8; ++e) z[e] = ex2(lg2 * (float)(127 - (ks * 32 + 8 * g + e)));
    bf16x8 af[4], bfr[4];
#pragma unroll
    for (int dt = 0; dt < 4; ++dt) { float f[8]; unpack8(*(const u32x4*)(kT + (size_t)(dt * 16 + li) * SEQ + ks * 32 + 8 * g), f);
#pragma unroll
      for (int e = 0; e < 8; ++e) f[e] *= z[e];
      af[dt] = pack_frag(f); }
#pragma unroll
    for (int et = 0; et < 4; ++et) bfr[et] = *(const bf16x8*)(vT + (size_t)(et * 16 + li) * SEQ + ks * 32 + 8 * g);
#pragma unroll
    for (int dt = 0; dt < 4; ++dt)
#pragma unroll
      for (int et = 0; et < 4; ++et) acc[dt][et] = MFMA16(af[dt], bfr[et], acc[dt][et]);
  }
  float* KV = (float*)(ws + P_RETKV) + (size_t)unit * 4096;
#pragma unroll
  for (int dt = 0; dt < 4; ++dt)
#pragma unroll
    for (int et = 0; et < 4; ++et)
#pragma unroll
      for (int j = 0; j < 4; ++j) KV[(dt * 16 + 4 * g + j) * 64 + et * 16 + li] = acc[dt][et][j];
}
__device__ __forceinline__ void fox_cum_unit(const Params& p, int bh, int lane) {
  asm volatile("" ::: "memory");
  asm volatile("" : "+v"(lane));
  const float* logf = (const float*)(p.ws + SM_LOGF); float* cum = (float*)(p.ws + SM_CUM);
  const int b = bh >> 2, h = bh & 3; const size_t base = ((size_t)b * SEQ + lane * 64) * 4 + h;
  float s = 0.f;
  for (int i = 0; i < 64; ++i) s += logf[base + (size_t)i * 4];
  float incl = s;
#pragma unroll
  for (int o = 1; o < 64; o <<= 1) { const float t = __shfl_up(incl, o); if (lane >= o) incl += t; }
  float run = incl - s;
  for (int i = 0; i < 64; ++i) { run += logf[base + (size_t)i * 4]; cum[(size_t)bh * SEQ + lane * 64 + i] = run * LOG2E; }
}

template <int CTRL> __device__ __forceinline__ float dpp_add(float x) {
  const int y = __builtin_amdgcn_update_dpp(0, __builtin_bit_cast(int, x), CTRL, 0xf, 0xf, true);
  return x + __builtin_bit_cast(float, y);
}
__device__ __forceinline__ float row16_sum(float x) {
  x = dpp_add<0xB1>(x); x = dpp_add<0x4E>(x); x = dpp_add<0x141>(x); x = dpp_add<0x140>(x); return x;
}
constexpr int RS_TSB = 896;
constexpr int RS_CH = 32;
constexpr int RS_BUFB = RS_CH * RS_TSB;
constexpr int RS_ROWS = 8;
constexpr int RS_YP = 40;
constexpr int RS_YBUF = RS_CH * RS_ROWS * RS_YP;
struct RsRegs { u32x4 e, a, b, k, wr, v; float br, kr; };
__device__ __forceinline__ void rs_issue(const Params& p, RsRegs& r, int b, int h, int rq, int c, int lt) {
  unsigned char* ws = p.ws;
  { const int tok = lt >> 3, ch = lt & 7; const bf16* rec = (const bf16*)(ws + WS_RW) + ((size_t)((b * 4 + h) * SEQ + c * RS_CH + tok)) * RW_REC + ch * 8;
    r.e = *(const u32x4*)(rec); r.wr = *(const u32x4*)(rec + 64); r.a = *(const u32x4*)(rec + 128); r.b = *(const u32x4*)(rec + 192); r.k = *(const u32x4*)(rec + 256); }
  { const int t2 = lt & 31; const size_t rr = (size_t)b * SEQ + c * RS_CH + t2;
    r.v = *(const u32x4*)((const bf16*)(ws + RW_V) + rr * G + h * 64 + rq * RS_ROWS);
    r.br = ((const float*)(ws + SM_BR))[rr * 4 + h]; r.kr = ((const float*)(ws + SM_KR))[rr * 4 + h]; }
}
__device__ __forceinline__ void rs_commit(const RsRegs& r, unsigned char* buf, int lt) {
  { const int tok = lt >> 3, ch = lt & 7; unsigned char* rec = buf + tok * RS_TSB; float f[8];
    unpack8(r.e, f);
#pragma unroll
    for (int e = 0; e < 8; ++e) f[e] = ex2(-f[e] * LOG2E);
    *(f32x4*)(rec + ch * 32) = (f32x4){f[0], f[1], f[2], f[3]}; *(f32x4*)(rec + ch * 32 + 16) = (f32x4){f[4], f[5], f[6], f[7]};
    { const unsigned aw[4] = {r.a.x, r.a.y, r.a.z, r.a.w}, bw[4] = {r.b.x, r.b.y, r.b.z, r.b.w}, kw[4] = {r.k.x, r.k.y, r.k.z, r.k.w}, ww[4] = {r.wr.x, r.wr.y, r.wr.z, r.wr.w};
#pragma unroll
      for (int j = 0; j < 4; ++j) *(u32x4*)(rec + 256 + (ch * 4 + j) * 16) = (u32x4){aw[j], bw[j], kw[j], ww[j]}; } }
  if (lt < 32) { float f[8]; unpack8(r.v, f); unsigned char* rec = buf + lt * RS_TSB + 768; const float b32 = r.br * (1.f / 32.f), k32 = r.kr * (1.f / 32.f);
#pragma unroll
    for (int j = 0; j < 8; ++j) *(f32x4*)(rec + 16 * j) = (f32x4){f[j], b32, k32, 0.f}; }
}
__device__ __forceinline__ float row32_sum(float x) {
  x = row16_sum(x);
  const auto rr = __builtin_amdgcn_permlane16_swap(__builtin_bit_cast(unsigned, x), __builtin_bit_cast(unsigned, x), false, false);
  return __builtin_bit_cast(float, (unsigned)rr[0]) + __builtin_bit_cast(float, (unsigned)rr[1]);
}
__device__ __forceinline__ f32x2 bf2x(unsigned u) { return (f32x2){bflo(u), bfhi(u)}; }
__device__ __forceinline__ void rwkv_scan_unit(const Params& p, unsigned char* lds, int unit) {
  asm volatile("" ::: "memory");
  int tid = threadIdx.x; asm volatile("" : "+v"(tid)); const int wave = __builtin_amdgcn_readfirstlane(tid >> 6), lane = tid & 63;
  const int b = unit >> 5, h = (unit >> 3) & 3, rq = unit & 7;
  unsigned char* bufs = lds; bf16* ybuf = (bf16*)(lds + 2 * RS_BUFB);
  float* Y = (float*)(p.ws + RW_Y);
  constexpr int NCH = SEQ / RS_CH;
  const int lt = tid - 256;
  RsRegs rg;
  if (wave >= 4) { rs_issue(p, rg, b, h, rq, 0, lt); rs_commit(rg, bufs, lt); rs_issue(p, rg, b, h, rq, 1, lt); }
  __syncthreads();
  f32x2 S = {0.f, 0.f};
  const int seg = lane & 31, rloc = wave * 2 + (lane >> 5);
#define RS_YOUT(cc) do { const bf16* yp_ = ybuf + ((cc) & 1) * RS_YBUF + lt * RS_YP; float t_ = 0.f; \
    _Pragma("unroll") for (int j_ = 0; j_ < 4; ++j_) { float f_[8]; unpack8(*(const u32x4*)(yp_ + 8 * j_), f_); t_ += ((f_[0] + f_[1]) + (f_[2] + f_[3])) + ((f_[4] + f_[5]) + (f_[6] + f_[7])); } \
    Y[((size_t)b * SEQ + (cc) * RS_CH + (lt >> 3)) * G + h * 64 + rq * RS_ROWS + (lt & 7)] = t_; } while (0)
  for (int c = 0; c < NCH; ++c) {
    if (wave >= 4) {
      if (c + 1 < NCH) rs_commit(rg, bufs + ((c + 1) & 1) * RS_BUFB, lt);
      if (c + 2 < NCH) rs_issue(p, rg, b, h, rq, c + 2, lt);
      if (c > 0) RS_YOUT(c - 1);
    } else {
      const unsigned char* bp = bufs + (c & 1) * RS_BUFB; bf16* yb = ybuf + (c & 1) * RS_YBUF + rloc * RS_YP + seg;
      const unsigned char* pw = bp + seg * 8; const unsigned char* pa = bp + 256 + seg * 16; const unsigned char* pv = bp + 768 + rloc * 16;
      f32x2 nw = *(const f32x2*)(pw); u32x4 nq = *(const u32x4*)(pa); f32x4 nvs = *(const f32x4*)(pv);
#pragma unroll 8
      for (int s = 0; s < RS_CH; ++s) {
        const f32x2 w = nw, a = bf2x(nq.x), bb = bf2x(nq.y), kk = bf2x(nq.z), wr = bf2x(nq.w); const float v = nvs[0], br = nvs[1], kr = nvs[2];
        if (s + 1 < RS_CH) { const int o = (s + 1) * RS_TSB; nw = *(const f32x2*)(pw + o); nq = *(const u32x4*)(pa + o); nvs = *(const f32x4*)(pv + o); }
        const f32x2 pda = S * a, pdy = S * wr;
        const f32x2 vv = {v, v};
        const f32x2 u = S * w + vv * kk;
        const float t0 = v * kr + (pdy[0] + pdy[1]);
        const float da = row32_sum(pda[0] + pda[1]);
        const f32x2 dd = {da, da};
        S = dd * bb + u;
        yb[s * (RS_ROWS * RS_YP)] = (bf16)(__builtin_bit_cast(unsigned, da * br + t0) >> 16);
      }
    }
    LDS_BARRIER();
  }
  if (wave >= 4) RS_YOUT(NCH - 1);
  __syncthreads();
#undef RS_YOUT
}
__device__ __forceinline__ void rwkv_post_row(const Params& p, int l, int row, int lane) {
  asm volatile("" ::: "memory");
  asm volatile("" : "+v"(lane));
  unsigned char* ws = p.ws;
  const f32x4 y = ((const f32x4*)((const float*)(ws + RW_Y) + (size_t)row * G))[lane];
  float s = y[0] + y[1] + y[2] + y[3];
  s += __shfl_xor(s, 1); s += __shfl_xor(s, 2); s += __shfl_xor(s, 4); s += __shfl_xor(s, 8);
  const float mu = s * (1.f / 64.f); const f32x4 d = y - mu;
  float q = d[0] * d[0] + d[1] * d[1] + d[2] * d[2] + d[3] * d[3];
  q += __shfl_xor(q, 1); q += __shfl_xor(q, 2); q += __shfl_xor(q, 4); q += __shfl_xor(q, 8);
  const float rstd = rsqrtf(q * (1.f / 64.f) + 64e-5f);
  const f32x4 gw = ((const f32x4*)(p.in[28] + (size_t)l * G))[lane], gb = ((const f32x4*)(p.in[29] + (size_t)l * G))[lane];
  const u32x2 vv = ((const u32x2*)((const bf16*)(ws + RW_V) + (size_t)row * G))[lane], gg = ((const u32x2*)((const bf16*)(ws + RW_G) + (size_t)row * G))[lane];
  const float rk = ((const float*)(ws + SM_RK))[(size_t)row * 4 + (lane >> 4)];
  const float v[4] = {bflo(vv.x), bfhi(vv.x), bflo(vv.y), bfhi(vv.y)}, gt[4] = {bflo(gg.x), bfhi(gg.x), bflo(gg.y), bfhi(gg.y)};
  float o[4];
#pragma unroll
  for (int e = 0; e < 4; ++e) o[e] = (d[e] * rstd * gw[e] + gb[e] + rk * v[e]) * gt[e];
  u32x2 w; w.x = pk2(o[0], o[1]); w.y = pk2(o[2], o[3]);
  ((u32x2*)((bf16*)(ws + WS_P) + (size_t)row * PW + C_RWR))[lane] = w;
}

__device__ __forceinline__ void lru_unit(const Params& p, int l, float* lds, int unit) {
  asm volatile("" ::: "memory");
  unsigned char* ws = p.ws; bf16* proj = (bf16*)(ws + WS_P);
  int tid = threadIdx.x; asm volatile("" : "+v"(tid)); const int wave = __builtin_amdgcn_readfirstlane(tid >> 6), lane = tid & 63, li = lane & 15, g = lane >> 4;
  const int b = unit >> 2, h = unit & 3;
  float* XB = lds;
  float* XC = XB + 67 * 64;
  float* AA = XC + 64 * 65;
  float* UU = AA + 64 * 65;
  float* HH = UU + 64 * 65;
  bf16* XCb = (bf16*)(HH + 64 * 65);
  const float* cw = p.in[12] + (size_t)l * 4 * G + h * 64; const float* cb = p.in[13] + (size_t)l * G + h * 64;
  const float* rab = p.in[15] + (size_t)l * G + h * 64; const float* rib = p.in[17] + (size_t)l * G + h * 64; const float* lam = p.in[18] + (size_t)l * G + h * 64;
  const int mt = wave & 3, ntp = wave >> 2;
  bf16x8 br_[2][2], bi_[2][2]; float lsl[2], rb[2], ib[2];
  { const bf16* rat = (const bf16*)(ws + WS_RAT) + h * 4096; const bf16* rit = (const bf16*)(ws + WS_RIT) + h * 4096;
#pragma unroll
    for (int n = 0; n < 2; ++n) { const int col = (2 * ntp + n) * 16 + li; lsl[n] = log_sigmoid_acc(lam[col]); rb[n] = rab[col]; ib[n] = rib[col];
#pragma unroll
      for (int ks = 0; ks < 2; ++ks) { br_[n][ks] = *(const bf16x8*)(rat + col * 64 + ks * 32 + 8 * g); bi_[n][ks] = *(const bf16x8*)(rit + col * 64 + ks * 32 + 8 * g); } } }
  float hcur = 0.f;
  const int tok = tid >> 3, ch8 = (tid & 7) * 8;
  u32x4 nx0 = {0u, 0u, 0u, 0u}, nx1 = {0u, 0u, 0u, 0u}, ny;
  const int r1 = (tid + NTHREADS) >> 3;
  { const int pos0 = -3 + tok; if (pos0 >= 0) nx0 = *(const u32x4*)(proj + ((size_t)b * SEQ + pos0) * PW + C_LRUX + h * 64 + ch8);
    if (tid < 24) nx1 = *(const u32x4*)(proj + ((size_t)b * SEQ + (-3 + r1)) * PW + C_LRUX + h * 64 + ch8);
    ny = *(const u32x4*)(proj + ((size_t)b * SEQ + tok) * PW + C_LRUY + h * 64 + ch8); }
  for (int c = 0; c < SEQ / 64; ++c) {
    const int t0 = c * 64;
    { float f8[8]; unpack8(nx0, f8);
#pragma unroll
      for (int e = 0; e < 8; ++e) XB[tok * 64 + ch8 + e] = f8[e];
      if (tid < 24) { unpack8(nx1, f8);
#pragma unroll
        for (int e = 0; e < 8; ++e) XB[r1 * 64 + ch8 + e] = f8[e]; } }
    const u32x4 ycur = ny;
    if (c + 1 < SEQ / 64) { const int tn = t0 + 64;
      nx0 = *(const u32x4*)(proj + ((size_t)b * SEQ + tn - 3 + tok) * PW + C_LRUX + h * 64 + ch8);
      if (tid < 24) nx1 = *(const u32x4*)(proj + ((size_t)b * SEQ + tn - 3 + r1) * PW + C_LRUX + h * 64 + ch8);
      ny = *(const u32x4*)(proj + ((size_t)b * SEQ + tn + tok) * PW + C_LRUY + h * 64 + ch8); }
    LDS_BARRIER();
    { float xc[8];
#pragma unroll
      for (int e = 0; e < 8; ++e) { float v = cb[ch8 + e];
#pragma unroll
        for (int j = 0; j < 4; ++j) v += XB[(tok + j) * 64 + ch8 + e] * cw[j * G + ch8 + e];
        xc[e] = v; XC[tok * 65 + ch8 + e] = v; }
      *(u32x4*)(XCb + tok * 72 + ch8) = pack8(xc); }
    LDS_BARRIER();
    { bf16x8 af[2];
#pragma unroll
      for (int ks = 0; ks < 2; ++ks) af[ks] = *(const bf16x8*)(XCb + (mt * 16 + li) * 72 + ks * 32 + 8 * g);
#pragma unroll
      for (int n = 0; n < 2; ++n) { f32x4 cr = {0.f, 0.f, 0.f, 0.f}, ci = {0.f, 0.f, 0.f, 0.f};
#pragma unroll
        for (int ks = 0; ks < 2; ++ks) { cr = MFMA16(af[ks], br_[n][ks], cr); ci = MFMA16(af[ks], bi_[n][ks], ci); }
        const int col = (2 * ntp + n) * 16 + li;
#pragma unroll
        for (int j = 0; j < 4; ++j) { const int tk = mt * 16 + 4 * g + j; const float r = sigmoidf_(cr[j] + rb[n]), ig = sigmoidf_(ci[j] + ib[n]);
          const float log_a = 8.f * r * lsl[n]; const float a = __expf(log_a); const float mult = sqrtf(fmaxf(1.f - a * a, 0.f));
          AA[tk * 65 + col] = a; UU[tk * 65 + col] = mult * (ig * XC[tk * 65 + col]); } } }
    LDS_BARRIER();
    if (wave == 0) {
#pragma unroll 8
      for (int s = 0; s < 64; ++s) { hcur = AA[s * 65 + lane] * hcur + UU[s * 65 + lane]; HH[s * 65 + lane] = hcur; } }
    LDS_BARRIER();
    { bf16* yp = proj + ((size_t)b * SEQ + t0 + tok) * PW + C_LRUY + h * 64 + ch8; float y[8]; unpack8(ycur, y);
#pragma unroll
      for (int e = 0; e < 8; ++e) y[e] = HH[tok * 65 + ch8 + e] * gelu_tanh(y[e]);
      *(u32x4*)yp = pack8(y); }
  }
  __syncthreads();
}

constexpr int KS_P = 72, VS_P = 136;
constexpr int AT_KS = 0, AT_VS = 128 * KS_P * 2, AT_CS = AT_VS + 64 * VS_P * 2, AT_BUF = AT_CS + 512;
struct AtRegs { u32x4 k0, k1, v0, v1; float c; };
__device__ __forceinline__ void at_issue(AtRegs& r, const bf16* Kg  , const bf16* VTg  , const float* cumg, int tid) {
  { const int id = tid, row = id >> 3, ch = id & 7; r.k0 = *(const u32x4*)(Kg + (size_t)row * PW + ch * 8); }
  { const int id = tid + 512, row = id >> 3, ch = id & 7; r.k1 = *(const u32x4*)(Kg + (size_t)row * PW + ch * 8); }
  { const int id = tid, row = id >> 4, ch = id & 15; r.v0 = *(const u32x4*)(VTg + (size_t)row * SEQ + ch * 8); }
  { const int id = tid + 512, row = id >> 4, ch = id & 15; r.v1 = *(const u32x4*)(VTg + (size_t)row * SEQ + ch * 8); }
  r.c = (cumg && tid < 128) ? -cumg[tid] : 0.f;
}
__device__ __forceinline__ void at_commit(const AtRegs& r, unsigned char* buf, int tid) {
  bf16* Ks = (bf16*)(buf + AT_KS); bf16* Vs = (bf16*)(buf + AT_VS); float* Cs = (float*)(buf + AT_CS);
  { const int id = tid, row = id >> 3, ch = id & 7; *(u32x4*)(Ks + row * KS_P + ch * 8) = r.k0; }
  { const int id = tid + 512, row = id >> 3, ch = id & 7; *(u32x4*)(Ks + row * KS_P + ch * 8) = r.k1; }
  { const int id = tid, row = id >> 4, ch = id & 15; *(u32x4*)(Vs + row * VS_P + ch * 8) = r.v0; }
  { const int id = tid + 512, row = id >> 4, ch = id & 15; *(u32x4*)(Vs + row * VS_P + ch * 8) = r.v1; }
  if (tid < 128) Cs[tid] = r.c;
}
__device__ __forceinline__ bf16x8 vfrag(const bf16* Vs, int d, int key0, int g) {
  const u32x2 lo = *(const u32x2*)(Vs + d * VS_P + key0 + 4 * g), hi = *(const u32x2*)(Vs + d * VS_P + key0 + 16 + 4 * g);
  const u32x4 w = {lo.x, lo.y, hi.x, hi.y}; return __builtin_bit_cast(bf16x8, w);
}
__device__ __forceinline__ float grp4_max(float x) {
  const auto a = __builtin_amdgcn_permlane16_swap(__builtin_bit_cast(unsigned, x), __builtin_bit_cast(unsigned, x), false, false);
  x = fmaxf(__builtin_bit_cast(float, (unsigned)a[0]), __builtin_bit_cast(float, (unsigned)a[1]));
  const auto b = __builtin_amdgcn_permlane32_swap(__builtin_bit_cast(unsigned, x), __builtin_bit_cast(unsigned, x), false, false);
  return fmaxf(__builtin_bit_cast(float, (unsigned)b[0]), __builtin_bit_cast(float, (unsigned)b[1]));
}
__device__ __forceinline__ float grp4_sum(float x) {
  const auto a = __builtin_amdgcn_permlane16_swap(__builtin_bit_cast(unsigned, x), __builtin_bit_cast(unsigned, x), false, false);
  x = __builtin_bit_cast(float, (unsigned)a[0]) + __builtin_bit_cast(float, (unsigned)a[1]);
  const auto b = __builtin_amdgcn_permlane32_swap(__builtin_bit_cast(unsigned, x), __builtin_bit_cast(unsigned, x), false, false);
  return __builtin_bit_cast(float, (unsigned)b[0]) + __builtin_bit_cast(float, (unsigned)b[1]);
}
__device__ __forceinline__ void fox_unit(const Params& p, unsigned char* lds, int b, int h, int qb) {
  asm volatile("" ::: "memory");
  unsigned char* ws = p.ws; bf16* proj = (bf16*)(ws + WS_P);
  int tid = threadIdx.x; asm volatile("" : "+v"(tid)); const int wave = __builtin_amdgcn_readfirstlane(tid >> 6), lane = tid & 63, li = lane & 15, g = lane >> 4;
  const int bh = b * 4 + h; const int qrel = wave * 16 + li; const size_t qrow = (size_t)b * SEQ + qb * 128 + qrel;
  const float* cum = (const float*)(ws + SM_CUM) + (size_t)bh * SEQ;
  const bf16* Kbase = proj + (size_t)b * SEQ * PW + C_FOXK + h * 64; const bf16* VTbase = (const bf16*)(ws + P_FOXVT) + (size_t)bh * 64 * SEQ;
  bf16x8 qf[2];
#pragma unroll
  for (int ks = 0; ks < 2; ++ks) qf[ks] = *(const bf16x8*)(proj + qrow * PW + C_FOXQ + h * 64 + ks * 32 + 8 * g);
  const float SC = 0.125f * LOG2E;
  f32x4 o[4];
#pragma unroll
  for (int dt = 0; dt < 4; ++dt) o[dt] = (f32x4){0.f, 0.f, 0.f, 0.f};
  float m = -INFINITY, lsum = 0.f;
  AtRegs rg; at_issue(rg, Kbase, VTbase, cum, tid);
  __syncthreads();
  at_commit(rg, lds, tid);
  if (qb > 0) at_issue(rg, Kbase + (size_t)128 * PW, VTbase + 128, cum + 128, tid);
  LDS_BARRIER();
  for (int kb = 0; kb <= qb; ++kb) {
    unsigned char* buf = lds + (kb & 1) * AT_BUF; const bf16* Ks = (const bf16*)(buf + AT_KS); const bf16* Vs = (const bf16*)(buf + AT_VS); const float* Cs = (const float*)(buf + AT_CS);
    const bool diag = kb == qb; const int nst = diag ? (wave >> 1) + 1 : 4;
    for (int st = 0; st < nst; ++st) {
      f32x4 s0 = {0.f, 0.f, 0.f, 0.f}, s1 = {0.f, 0.f, 0.f, 0.f};
#pragma unroll
      for (int ks = 0; ks < 2; ++ks) { const bf16x8 a0 = *(const bf16x8*)(Ks + (st * 32 + li) * KS_P + ks * 32 + 8 * g), a1 = *(const bf16x8*)(Ks + (st * 32 + 16 + li) * KS_P + ks * 32 + 8 * g);
        s0 = MFMA16(a0, qf[ks], s0); s1 = MFMA16(a1, qf[ks], s1); }
      const f32x4 c0 = *(const f32x4*)(Cs + st * 32 + 4 * g), c1 = *(const f32x4*)(Cs + st * 32 + 16 + 4 * g);
      float x[8];
#pragma unroll
      for (int j = 0; j < 4; ++j) { x[j] = s0[j] * SC + c0[j]; x[4 + j] = s1[j] * SC + c1[j]; }
      if (diag) {
#pragma unroll
        for (int j = 0; j < 4; ++j) { if (st * 32 + 4 * g + j > qrel) x[j] = -INFINITY; if (st * 32 + 16 + 4 * g + j > qrel) x[4 + j] = -INFINITY; }
      }
      float mx = fmaxf(fmaxf(fmaxf(x[0], x[1]), fmaxf(x[2], x[3])), fmaxf(fmaxf(x[4], x[5]), fmaxf(x[6], x[7])));
      mx = grp4_max(mx);
      const float mn = fmaxf(m, mx);
      const bool grew = __any(mn > m);
      float ps = 0.f;
#pragma unroll
      for (int j = 0; j < 8; ++j) { x[j] = ex2(x[j] - mn); ps += x[j]; }
      if (grew) { const float f = ex2(m - mn); lsum *= f;
#pragma unroll
        for (int dt = 0; dt < 4; ++dt) o[dt] = o[dt] * f;
        m = mn; }
      lsum += ps;
      const bf16x8 pb = pack_frag(x);
#pragma unroll
      for (int dt = 0; dt < 4; ++dt) o[dt] = MFMA16(vfrag(Vs, dt * 16 + li, st * 32, g), pb, o[dt]);
    }
    if (kb < qb) {
      at_commit(rg, lds + ((kb + 1) & 1) * AT_BUF, tid);
      if (kb + 2 <= qb) at_issue(rg, Kbase + (size_t)(kb + 2) * 128 * PW, VTbase + (kb + 2) * 128, cum + (kb + 2) * 128, tid);
      LDS_BARRIER();
    }
  }
  lsum = grp4_sum(lsum);
  const float inv = 1.f / lsum;
#pragma unroll
  for (int dt = 0; dt < 4; ++dt) { u32x2 w; w.x = pk2(o[dt][0] * inv, o[dt][1] * inv); w.y = pk2(o[dt][2] * inv, o[dt][3] * inv);
    *(u32x2*)(proj + qrow * PW + C_FOXQ + h * 64 + dt * 16 + 4 * g) = w; }
}
__device__ __forceinline__ void ret_unit(const Params& p, int l, unsigned char* lds, int b, int h, int c) {
  asm volatile("" ::: "memory");
  unsigned char* ws = p.ws; bf16* proj = (bf16*)(ws + WS_P);
  int tid = threadIdx.x; asm volatile("" : "+v"(tid)); const int wave = __builtin_amdgcn_readfirstlane(tid >> 6), lane = tid & 63, li = lane & 15, g = lane >> 4;
  const int bh = b * 4 + h; const int nrel = wave * 16 + li; const size_t qrow = (size_t)b * SEQ + c * 128 + nrel;
  const float lg2 = log2f(1.f - exp2f(-5.f - (float)h));
  bf16* RT = (bf16*)(lds + 2 * AT_BUF);
  AtRegs rg; at_issue(rg, proj + ((size_t)b * SEQ + c * 128) * PW + C_RETK + h * 64, (const bf16*)(ws + P_RETVT) + (size_t)bh * 64 * SEQ + c * 128, nullptr, tid);
  { const float cd = ex2(lg2 * 128.f); const float* KV = (const float*)(ws + P_RETKV) + (size_t)bh * 32 * 4096 + (tid >> 3) * 64 + (tid & 7) * 8;
    f32x4 a0 = {0.f, 0.f, 0.f, 0.f}, a1 = {0.f, 0.f, 0.f, 0.f};
    int cc = 0;
    for (; cc + 4 <= c; cc += 4) { f32x4 k0[4], k1[4];
#pragma unroll
      for (int u = 0; u < 4; ++u) { k0[u] = *(const f32x4*)(KV + (size_t)(cc + u) * 4096); k1[u] = *(const f32x4*)(KV + (size_t)(cc + u) * 4096 + 4); }
#pragma unroll
      for (int u = 0; u < 4; ++u) { a0 = a0 * cd + k0[u]; a1 = a1 * cd + k1[u]; } }
    for (; cc < c; ++cc) { const f32x4 k0 = *(const f32x4*)(KV + (size_t)cc * 4096), k1 = *(const f32x4*)(KV + (size_t)cc * 4096 + 4); a0 = a0 * cd + k0; a1 = a1 * cd + k1; }
    __syncthreads();
    const int d = tid >> 3, e0 = (tid & 7) * 8;
#pragma unroll
    for (int e = 0; e < 4; ++e) { RT[(e0 + e) * KS_P + d] = (bf16)f2bf(a0[e]); RT[(e0 + 4 + e) * KS_P + d] = (bf16)f2bf(a1[e]); } }
  at_commit(rg, lds, tid);
  bf16x8 qf[2];
#pragma unroll
  for (int ks = 0; ks < 2; ++ks) qf[ks] = *(const bf16x8*)(proj + qrow * PW + C_RETQ + h * 64 + ks * 32 + 8 * g);
  __syncthreads();
  const bf16* Ks = (const bf16*)(lds + AT_KS); const bf16* Vs = (const bf16*)(lds + AT_VS);
  f32x4 o[4], cr[4];
#pragma unroll
  for (int et = 0; et < 4; ++et) { o[et] = (f32x4){0.f, 0.f, 0.f, 0.f}; cr[et] = (f32x4){0.f, 0.f, 0.f, 0.f};
#pragma unroll
    for (int ks = 0; ks < 2; ++ks) cr[et] = MFMA16(*(const bf16x8*)(RT + (et * 16 + li) * KS_P + ks * 32 + 8 * g), qf[ks], cr[et]); }
  const int nst = (wave >> 1) + 1;
  for (int st = 0; st < nst; ++st) {
    f32x4 s0 = {0.f, 0.f, 0.f, 0.f}, s1 = {0.f, 0.f, 0.f, 0.f};
#pragma unroll
    for (int ks = 0; ks < 2; ++ks) { const bf16x8 a0 = *(const bf16x8*)(Ks + (st * 32 + li) * KS_P + ks * 32 + 8 * g), a1 = *(const bf16x8*)(Ks + (st * 32 + 16 + li) * KS_P + ks * 32 + 8 * g);
      s0 = MFMA16(a0, qf[ks], s0); s1 = MFMA16(a1, qf[ks], s1); }
    float x[8];
#pragma unroll
    for (int j = 0; j < 4; ++j) { const int m0 = st * 32 + 4 * g + j, m1 = m0 + 16;
      x[j] = (m0 <= nrel) ? s0[j] * ex2(lg2 * (float)(nrel - m0)) : 0.f; x[4 + j] = (m1 <= nrel) ? s1[j] * ex2(lg2 * (float)(nrel - m1)) : 0.f; }
    const bf16x8 pb = pack_frag(x);
#pragma unroll
    for (int et = 0; et < 4; ++et) o[et] = MFMA16(vfrag(Vs, et * 16 + li, st * 32, g), pb, o[et]);
  }
  const float xi = ex2(lg2 * (float)(nrel + 1));
  float ss = 0.f;
#pragma unroll
  for (int et = 0; et < 4; ++et)
#pragma unroll
    for (int j = 0; j < 4; ++j) { o[et][j] += xi * cr[et][j]; ss += o[et][j] * o[et][j]; }
  ss += __shfl_xor(ss, 16); ss += __shfl_xor(ss, 32);
  const float rs = rsqrtf(ss * (1.f / 64.f) + EPS);
  const float* gnw = p.in[33] + (size_t)l * G + h * 64;
#pragma unroll
  for (int et = 0; et < 4; ++et) { const int e0 = et * 16 + 4 * g;
    const u32x2 gg = *(const u32x2*)(proj + qrow * PW + C_RETG + h * 64 + e0); const float gt[4] = {bflo(gg.x), bfhi(gg.x), bflo(gg.y), bfhi(gg.y)};
    float r[4];
#pragma unroll
    for (int j = 0; j < 4; ++j) r[j] = o[et][j] * rs * gnw[e0 + j] * (gt[j] * sigmoidf_(gt[j]));
    u32x2 w; w.x = pk2(r[0], r[1]); w.y = pk2(r[2], r[3]);
    *(u32x2*)(proj + qrow * PW + C_RETQ + h * 64 + e0) = w; }
}

constexpr int XP = 264;
__device__ __forceinline__ void xattn_unit(const Params& p, int l, unsigned char* lds, int unit) {
  asm volatile("" ::: "memory");
  unsigned char* ws = p.ws; bf16* qb = (bf16*)(ws + WS_P);
  int tid = threadIdx.x; asm volatile("" : "+v"(tid)); const int wave = __builtin_amdgcn_readfirstlane(tid >> 6), lane = tid & 63, li = lane & 15, g = lane >> 4;
  const int b = unit >> 6, head = (unit >> 4) & 3, qt = unit & 15;
  bf16* L = (bf16*)lds;
  const bf16* kg = (const bf16*)(ws + WS_KM) + ((size_t)l * 1024 + b * 256) * 1024 + head * 256;
  const bf16* vg = (const bf16*)(ws + WS_VMT) + (size_t)(((l * 4 + b) * 4 + head) * 256) * 256;
  __syncthreads();
#pragma unroll
  for (int i0 = 0; i0 < 16; i0 += 8) { u32x4 t[8];
#pragma unroll
    for (int i = 0; i < 8; ++i) { const int id = tid + 512 * (i0 + i), row = id >> 5, ch = id & 31; t[i] = *(const u32x4*)(kg + (size_t)row * 1024 + ch * 8); }
#pragma unroll
    for (int i = 0; i < 8; ++i) { const int id = tid + 512 * (i0 + i), row = id >> 5, ch = id & 31; *(u32x4*)(L + row * XP + ch * 8) = t[i]; } }
  __syncthreads();
  bf16x8 pb[2][8]; float linv[2];
  const float SC = LOG2E / 16.f;
#pragma unroll
  for (int grp = 0; grp < 2; ++grp) {
    const size_t row = (size_t)b * SEQ + qt * 256 + wave * 32 + grp * 16 + li;
    bf16x8 qf[8];
#pragma unroll
    for (int ks = 0; ks < 8; ++ks) qf[ks] = *(const bf16x8*)(qb + row * 1024 + head * 256 + ks * 32 + 8 * g);
    f32x4 s[16];
#pragma unroll
    for (int kt = 0; kt < 16; ++kt) { s[kt] = (f32x4){0.f, 0.f, 0.f, 0.f};
#pragma unroll
      for (int ks = 0; ks < 8; ++ks) s[kt] = MFMA16(*(const bf16x8*)(L + (kt * 16 + li) * XP + ks * 32 + 8 * g), qf[ks], s[kt]);
      if ((kt & 3) == 3) __builtin_amdgcn_sched_barrier(0); }
    float mx = -INFINITY;
#pragma unroll
    for (int kt = 0; kt < 16; ++kt) mx = fmaxf(mx, fmaxf(fmaxf(s[kt][0], s[kt][1]), fmaxf(s[kt][2], s[kt][3])));
    mx = fmaxf(mx, __shfl_xor(mx, 16)); mx = fmaxf(mx, __shfl_xor(mx, 32));
    float ps = 0.f;
#pragma unroll
    for (int kt = 0; kt < 16; ++kt)
#pragma unroll
      for (int j = 0; j < 4; ++j) { s[kt][j] = ex2((s[kt][j] - mx) * SC); ps += s[kt][j]; }
    ps += __shfl_xor(ps, 16); ps += __shfl_xor(ps, 32);
    linv[grp] = 1.f / ps;
#pragma unroll
    for (int kk = 0; kk < 8; ++kk) { float x[8];
#pragma unroll
      for (int j = 0; j < 4; ++j) { x[j] = s[2 * kk][j]; x[4 + j] = s[2 * kk + 1][j]; }
      pb[grp][kk] = pack_frag(x); }
    __builtin_amdgcn_sched_barrier(0);
  }
  __syncthreads();
#pragma unroll
  for (int i0 = 0; i0 < 16; i0 += 8) { u32x4 t[8];
#pragma unroll
    for (int i = 0; i < 8; ++i) { const int id = tid + 512 * (i0 + i), row = id >> 5, ch = id & 31; t[i] = *(const u32x4*)(vg + (size_t)row * 256 + ch * 8); }
#pragma unroll
    for (int i = 0; i < 8; ++i) { const int id = tid + 512 * (i0 + i), row = id >> 5, ch = id & 31; *(u32x4*)(L + row * XP + ch * 8) = t[i]; } }
  __syncthreads();
#pragma unroll
  for (int grp = 0; grp < 2; ++grp) {
    const size_t row = (size_t)b * SEQ + qt * 256 + wave * 32 + grp * 16 + li;
#pragma unroll
    for (int dt = 0; dt < 16; ++dt) { f32x4 o = {0.f, 0.f, 0.f, 0.f};
#pragma unroll
      for (int kk = 0; kk < 8; ++kk) { const u32x2 lo = *(const u32x2*)(L + (dt * 16 + li) * XP + kk * 32 + 4 * g), hi = *(const u32x2*)(L + (dt * 16 + li) * XP + kk * 32 + 16 + 4 * g);
        const u32x4 w = {lo.x, lo.y, hi.x, hi.y}; o = MFMA16(__builtin_bit_cast(bf16x8, w), pb[grp][kk], o); }
      u32x2 w; w.x = pk2(o[0] * linv[grp], o[1] * linv[grp]); w.y = pk2(o[2] * linv[grp], o[3] * linv[grp]);
      *(u32x2*)(qb + row * 1024 + head * 256 + dt * 16 + 4 * g) = w;
      __builtin_amdgcn_sched_barrier(0); }
  }
}

#define LAS __attribute__((address_space(3)))
#define XB_TMO      128
#define XB_XCNT(j)  (256  + 64 * (j))
#define XB_XSUB(j)  (1280 + 64 * (j))
#define XB_XGEN(j)  (2304 + 64 * (j))
#define XB_TOP      3328
#define XB_TOPGEN   3392
#define XCD_BAR_WORDS 3456
#define XB_SPIN_CAP (1u << 18)

__device__ __forceinline__ unsigned xb_ld(unsigned* p)              { return __hip_atomic_load(p, __ATOMIC_RELAXED, __HIP_MEMORY_SCOPE_AGENT); }
__device__ __forceinline__ unsigned xb_add(unsigned* p, unsigned v) { return __hip_atomic_fetch_add(p, v, __ATOMIC_RELAXED, __HIP_MEMORY_SCOPE_AGENT); }
__device__ __forceinline__ unsigned xb_xcc_id() { return (unsigned)__builtin_amdgcn_s_getreg((3 << 11) | 20) & 0xFu; }
#define XB_SPIN(cond, bar) do { unsigned _sp = 0; while (cond) { __builtin_amdgcn_s_sleep(1); \
    if ((++_sp & 255u) == 0u) { if (xb_ld(&(bar)[XB_TMO])) break; if (_sp > XB_SPIN_CAP) { atomicAdd(&(bar)[XB_TMO], 1u); break; } } } } while (0)

struct XcdBarrier {
    unsigned* bar; unsigned x;
    volatile LAS unsigned* st;
};

__device__ __forceinline__ XcdBarrier xcd_barrier_post(unsigned* bar, volatile LAS unsigned* st) {
    XcdBarrier b; b.bar = bar; b.x = xb_xcc_id(); b.st = st;
    if (threadIdx.x == 0) (void)xb_add(&bar[XB_XCNT(b.x)], 1u);
    return b;
}
__device__ __forceinline__ void xcd_barrier_complete(unsigned* bar, unsigned x, unsigned& nloc, unsigned& nx) {
    const unsigned G = gridDim.x * gridDim.y * gridDim.z;
    unsigned sum, cnt, mine, sp = 0u;
    for (;;) {
        sum = 0u; cnt = 0u; mine = 0u;
#pragma unroll
        for (unsigned j = 0; j < 16; ++j) { const unsigned c = xb_ld(&bar[XB_XCNT(j)]); sum += c; cnt += (c > 0u) ? 1u : 0u; mine = (j == x) ? c : mine; }
        if (sum == G) break;
        __builtin_amdgcn_s_sleep(1);
        if ((++sp & 255u) == 0u) { if (xb_ld(&bar[XB_TMO])) break; if (sp > XB_SPIN_CAP) { atomicAdd(&bar[XB_TMO], 1u); break; } }
    }
    nloc = mine > 0u ? mine : 1u; nx = cnt > 0u ? cnt : 1u;
}

__device__ __forceinline__ void xcd_barrier(const XcdBarrier& b) {
    asm volatile("s_waitcnt vmcnt(0)" ::: "memory");
    __syncthreads();
    if (threadIdx.x == 0) {
        unsigned* bar = b.bar;
        __builtin_amdgcn_s_waitcnt(0);
        unsigned nloc = b.st[0], nx = b.st[1];
        if (nloc == 0u) { xcd_barrier_complete(bar, b.x, nloc, nx); b.st[0] = nloc; b.st[1] = nx; }
        const unsigned old = xb_add(&bar[XB_XSUB(b.x)], 1u);
        const unsigned gen = old / nloc;
        if (old + 1u == (gen + 1u) * nloc) {
            __builtin_amdgcn_fence(__ATOMIC_RELEASE, "agent");
            asm volatile("s_waitcnt vmcnt(0)" ::: "memory");
            const unsigned og = xb_add(&bar[XB_TOP], 1u);
            const unsigned tg = og / nx;
            if (og + 1u == (tg + 1u) * nx) xb_add(&bar[XB_TOPGEN], 1u);
            else XB_SPIN(xb_ld(&bar[XB_TOPGEN]) == tg, bar);
            __builtin_amdgcn_fence(__ATOMIC_ACQUIRE, "agent");
            xb_add(&bar[XB_XGEN(b.x)], 1u);
            asm volatile("s_waitcnt vmcnt(0)" ::: "memory");
        } else {
            XB_SPIN(xb_ld(&bar[XB_XGEN(b.x)]) == gen, bar);
            __builtin_amdgcn_fence(__ATOMIC_ACQUIRE, "agent");
            asm volatile("s_waitcnt vmcnt(0)" ::: "memory");
        }
    }
    __syncthreads();
}


#ifndef DEBUG_LAUNCHES
#define DEBUG_LAUNCHES 0
#endif
constexpr int PH_PER_LAYER = 13, N_PHASES = 1 + PH_PER_LAYER * DEPTH;

__global__ void __launch_bounds__(NTHREADS) mega_fwd(Params p) {
  extern __shared__ __attribute__((aligned(16))) unsigned char lds[];
  cg::grid_group grid = cg::this_grid();
  constexpr int NB = 256, NGW = NB * NWAVES;
  unsigned char* ws = p.ws;
  PG8_LAS unsigned char* glds = (PG8_LAS unsigned char*)lds;
  bf16* Hb = (bf16*)(ws + WS_H); bf16* Ob = (bf16*)(ws + WS_O); bf16* Pb = (bf16*)(ws + WS_P);
  volatile LAS unsigned* xb_st = (volatile LAS unsigned*)((LAS unsigned char*)lds + (LDS_BYTES - 32));
  if (threadIdx.x == 0) { xb_st[0] = 0u; xb_st[1] = 0u; }
  __syncthreads();
  const XcdBarrier xbar = xcd_barrier_post((unsigned*)(ws + SM_BAR), xb_st);
  int ph = 0;
#ifdef DBG_CLR
#define DBG_LDSCLEAR { for (int e_ = threadIdx.x; e_ < LDS_BYTES / 4; e_ += NTHREADS) ((unsigned*)lds)[e_] = 0u; __syncthreads(); }
#else
#define DBG_LDSCLEAR
#endif
#define PHASE_BEGIN if (ph >= p.ph_lo && ph < p.ph_hi) { int tid = threadIdx.x; asm volatile("" : "+v"(tid)); const int lane = tid & 63, wave = __builtin_amdgcn_readfirstlane(tid >> 6), gw = blockIdx.x * NWAVES + wave; (void)lane; (void)gw; DBG_LDSCLEAR
#ifdef TS_PH
#define TS_REC if (blockIdx.x == 0 && threadIdx.x == 0) ((unsigned long long*)(ws + SM_Q + 256))[ph + 1] = __builtin_amdgcn_s_memrealtime();
#else
#define TS_REC
#endif
#define PHASE_END   if (ph + 1 < p.ph_hi) { if (p.ph_lo < 0) grid.sync();   else xcd_barrier(xbar); } TS_REC } ++ph;

  PHASE_BEGIN
    float* scr = (float*)lds + wave * (64 * 33);
    conv_layer_weights(p, 0, scr, gw, NGW, lane);
    { constexpr int I_SQ = (D / 64) * (D / 32);
      for (int it = gw; it < 4 * I_SQ; it += NGW) { const int w = it / I_SQ, r = it % I_SQ, layer = w >> 1, isv = w & 1;
        conv_item<0>(p.in[isv ? 36 : 35] + (size_t)layer * D * D, D, D, D, (bf16*)(ws + WS_WKV) + (size_t)w * D * D, scr, r, lane); } }
    for (int l = 0; l < DEPTH; ++l) { RowArgs a{}; a.xin = p.in[1]; a.g_pre = p.in[6] + (size_t)l * D; a.hout = (bf16*)(ws + WS_MEMN) + (size_t)l * 1024 * 1024; a.rows = 1024; row_phase(a, gw, NGW, lane); }
    { RowArgs a{}; a.xin = p.in[0]; a.g_pre = p.in[2]; a.hout = Hb; a.wf = p.in[9]; a.fbias = p.in[11]; a.logf = (float*)(ws + SM_LOGF); a.rows = T; row_phase(a, gw, NGW, lane); }
#ifdef DBG_FILLG
    for (int e = blockIdx.x * NTHREADS + tid; e < T * G / 2; e += NB * NTHREADS) ((unsigned*)(ws + RW_G))[e] = 0x447A447Au;
#endif
    for (int e = blockIdx.x * NTHREADS + tid; e < SEQ * 32; e += NB * NTHREADS) { const int pos = e >> 5, i = e & 31; const float inv = 1.f / powf(10000.f, (float)i / 31.f); const float ang = (float)pos * inv;
      ((float*)(ws + SM_ROT))[2 * e] = cosf(ang); ((float*)(ws + SM_ROT))[2 * e + 1] = sinf(ang); }
  PHASE_END

  for (int l = 0; l < DEPTH; ++l) {
    PHASE_BEGIN
      { pg8::Gemm g{Hb, (const bf16*)(ws + W_IN), T, NIN, D, D}; pg8::StaticOrder S; S.init(T, NIN, NB, (int)blockIdx.x);
        EpiIn E{Pb, (bf16*)(ws + P_FOXVT), (bf16*)(ws + P_RETKT), (bf16*)(ws + P_RETVT), (const float*)(ws + SM_ROT)};
        pg8::gemm_phase<EpiIn, pg8::StaticOrder, true, true>(glds, g, S, E); }
      if (l == 0) { pg8::Gemm g{(const bf16*)(ws + WS_MEMN), (const bf16*)(ws + WS_WKV), 2048, 4096, D, D}; MemSched S{NB, (int)blockIdx.x - 64};
        EpiMem E{(bf16*)(ws + WS_KM), (bf16*)(ws + WS_VMT)};
        pg8::gemm_phase<EpiMem, MemSched, true, true>(glds, g, S, E); }
    PHASE_END
    PHASE_BEGIN
      float* wl = (float*)lds + wave * (16 * WLP);
      for (int u = gw; u < 4096; u += NGW) rwkv_prep_unit(p, l, u >> 2, u & 3, wl, lane);
      for (int u = gw; u < 512; u += NGW) ret_kv_unit(p, u, lane);
      for (int u = gw; u < 16; u += NGW) fox_cum_unit(p, u, lane);
      if (blockIdx.x == 0 && tid == 0) *(int*)(ws + SM_Q) = 0;
    PHASE_END
    PHASE_BEGIN
#ifndef DBG_P3
#define DBG_P3 15
#endif
      if (blockIdx.x < 128) { if (DBG_P3 & 1) rwkv_scan_unit(p, lds, blockIdx.x);
#ifdef REP_SCAN
        rwkv_scan_unit(p, lds, blockIdx.x);
#endif
      }
      else if (blockIdx.x < 144) { if (DBG_P3 & 2) lru_unit(p, l, (float*)lds, blockIdx.x - 128); }
      int* qword = (int*)(lds + LDS_BYTES - 16);
      for (;;) {
        __syncthreads();
        if (tid == 0) *qword = atomicAdd((int*)(ws + SM_Q), 1);
        __syncthreads();
        const int id = *qword;
        if (id >= 1024) break;
        if (id < 512) { if (DBG_P3 & 4) fox_unit(p, lds, (id & 15) >> 2, id & 3, 31 - (id >> 4)); }
        else if (DBG_P3 & 8) { const int r = id - 512; ret_unit(p, l, lds, r >> 7, (r >> 5) & 3, r & 31); }
      }
    PHASE_END
    PHASE_BEGIN
      for (int row = gw; row < T; row += NGW) rwkv_post_row(p, l, row, lane);
    PHASE_END
    PHASE_BEGIN
      pg8::Gemm g{Pb, (const bf16*)(ws + W_OUT), T, D, D, PW}; pg8::StaticOrder S; S.init(T, D, NB, (int)blockIdx.x);
      EpiPlain E{Ob, D, 0, nullptr};
      pg8::gemm_phase<EpiPlain, pg8::StaticOrder, true, true>(glds, g, S, E);
    PHASE_END
    PHASE_BEGIN
      RowArgs a{}; a.xin = l == 0 ? p.in[0] : p.out; a.O = Ob; a.g_post = p.in[3] + (size_t)l * D; a.xout = p.out; a.g_pre = p.in[4] + (size_t)l * D; a.hout = Hb; a.rows = T;
      row_phase(a, gw, NGW, lane);
    PHASE_END
    PHASE_BEGIN
      pg8::Gemm g{Hb, (const bf16*)(ws + W_Q), T, D, D, D}; pg8::StaticOrder S; S.init(T, D, NB, (int)blockIdx.x);
      EpiPlain E{Pb, D, 0, nullptr};
      pg8::gemm_phase<EpiPlain, pg8::StaticOrder, true, true>(glds, g, S, E);
    PHASE_END
    PHASE_BEGIN
      for (int u = blockIdx.x; u < 256; u += NB) xattn_unit(p, l, lds, u);
    PHASE_END
    PHASE_BEGIN
      pg8::Gemm g{Pb, (const bf16*)(ws + W_O), T, D, D, D}; pg8::StaticOrder S; S.init(T, D, NB, (int)blockIdx.x);
      EpiPlain E{Ob, D, 0, nullptr};
      pg8::gemm_phase<EpiPlain, pg8::StaticOrder, true, true>(glds, g, S, E);
    PHASE_END
    PHASE_BEGIN
      RowArgs a{}; a.xin = p.out; a.O = Ob; a.g_post = p.in[5] + (size_t)l * D; a.xout = p.out; a.g_pre = p.in[7] + (size_t)l * D; a.hout = Hb; a.rows = T;
      row_phase(a, gw, NGW, lane);
    PHASE_END
    PHASE_BEGIN
      pg8::Gemm g{Hb, (const bf16*)(ws + W_1), T, DFF, D, D}; pg8::StaticOrder S; S.init(T, DFF, NB, (int)blockIdx.x);
      EpiPlain E{Pb, DFF, 1, nullptr};
      pg8::gemm_phase<EpiPlain, pg8::StaticOrder, true, true>(glds, g, S, E);
    PHASE_END
    PHASE_BEGIN
      pg8::Gemm g{Pb, (const bf16*)(ws + W_2), T, D, DFF, DFF}; pg8::StaticOrder S; S.init(T, D, NB, (int)blockIdx.x);
      EpiPlain E{Ob, D, 0, nullptr};
      pg8::gemm_phase<EpiPlain, pg8::StaticOrder, true, true>(glds, g, S, E);
    PHASE_END
    PHASE_BEGIN
      RowArgs a{}; a.xin = p.out; a.O = Ob; a.g_post = p.in[8] + (size_t)l * D; a.xout = p.out; a.rows = T;
      if (l + 1 < DEPTH) { a.g_pre = p.in[2] + (size_t)(l + 1) * D; a.hout = Hb; a.wf = p.in[9] + (size_t)(l + 1) * D * INW; a.fbias = p.in[11] + (size_t)(l + 1) * GH; a.logf = (float*)(ws + SM_LOGF); }
      row_phase(a, gw, NGW, lane);
      if (l + 1 < DEPTH) { __syncthreads(); conv_layer_weights(p, l + 1, (float*)lds + wave * (64 * 33), gw, NGW, lane); }
    PHASE_END
  }
#ifdef TS_PH
  grid.sync();
  if (blockIdx.x == 0) { const unsigned long long* ts = (const unsigned long long*)(ws + SM_Q + 256);
#ifdef TS_CONST
    const float dt_us = TS_CONST;
#else
    const float dt_us = (float)(ts[TS_PH + 1] - ts[TS_PH]) * 0.01f;
#endif
    const float delta = 0.01f * sqrtf(dt_us);
    for (int r = threadIdx.x; r < T; r += NTHREADS) p.out[(size_t)r * D] += delta; }
#endif
}


#ifdef DBG_STOP
#ifndef DBG_MASK
#define DBG_MASK 15
#endif
__global__ void dbg_dump(const unsigned char* ws, float* out) {
  const size_t i = (size_t)blockIdx.x * 256 + threadIdx.x; const int row = (int)(i >> 10), c = (int)(i & 1023);
#ifndef DBG_SRC
#define DBG_SRC 0
#endif
#ifndef DBG_COFF
#define DBG_COFF 0
#endif
  const bf16* proj = (const bf16*)(ws + WS_P);
  if (DBG_SRC == 0) out[i] = ((DBG_MASK >> (c >> 8)) & 1) ? bflo((unsigned)proj[(size_t)row * PW + DBG_COFF + c]) : 0.f;
  else if (DBG_SRC == 1) { const bf16* a = (const bf16*)(ws + WS_RW) + (size_t)(c >> 8) * (8u << 19); out[i] = ((DBG_MASK >> (c >> 8)) & 1) ? bflo((unsigned)a[(size_t)row * G + (c & 255)]) : 0.f; }
  else if (DBG_SRC == 2) { const bf16* a = (const bf16*)(ws + RW_K) + (size_t)(c >> 8) * (8u << 19); float v = 0.f; if (c < 768) v = bflo((unsigned)a[(size_t)row * G + (c & 255)]); else if (c < 772) v = ((const float*)(ws + SM_BR))[row * 4 + (c & 3)]; else if (c < 776) v = ((const float*)(ws + SM_KR))[row * 4 + (c & 3)]; else if (c < 780) v = ((const float*)(ws + SM_RK))[row * 4 + (c & 3)];
    out[i] = ((DBG_MASK >> (c >> 8)) & 1) ? v : 0.f; }
  else if (DBG_SRC == 5) { out[i] = c < 256 ? bflo((unsigned)((const bf16*)(ws + RW_G))[(size_t)row * G + c]) : 0.f; }
  else if (DBG_SRC == 4) { out[i] = i < 512 * 1024 ? bflo((unsigned)((const bf16*)(ws + W_SMALL))[i]) : 0.f; }
  else { out[i] = c < 256 ? ((const float*)(ws + RW_Y))[(size_t)row * G + c] : 0.f; }
}
#endif

#ifdef DBG_GCHK
__global__ void dbg_snap(const unsigned char* ws, float* out) { const size_t i = (size_t)blockIdx.x * 256 + threadIdx.x; ((unsigned*)out)[i] = ((const unsigned*)(ws + RW_G))[i]; if (i == 0) *(unsigned*)(ws + SM_Q + 64) = 0u; }
__global__ void dbg_cmp(unsigned char* ws, const float* out) { const size_t i = (size_t)blockIdx.x * 256 + threadIdx.x; const unsigned a = ((const unsigned*)(ws + RW_G))[i], b = ((const unsigned*)out)[i];
  if (a != b) { unsigned f = 1u; if (a == 0x447A447Au) f |= 2u; else f |= 4u; atomicOr((unsigned*)(ws + SM_Q + 64), f); } }
__global__ void dbg_fin(const unsigned char* ws, float* out) { const size_t i = (size_t)blockIdx.x * 256 + threadIdx.x; out[i] = (i == 0) ? 1.0e6f * (float)(*(const unsigned*)(ws + SM_Q + 64)) : 0.f; }
#endif
extern "C" void kernel_launch(void* const* d_in, const int* in_sizes, int n_in, void* d_out, int out_size, void* d_ws, size_t ws_size, hipStream_t stream) {
  static int grid = 0;
  if (grid == 0) {
    if (ws_size < WS_END) { fprintf(stderr, "kernel_launch: workspace too small: %zu < %zu\n", ws_size, (size_t)WS_END); grid = -1; return; }
    int dev = 0, cus = 0, per_cu = 0;
    hipGetDevice(&dev); hipDeviceGetAttribute(&cus, hipDeviceAttributeMultiprocessorCount, dev);
    hipFuncSetAttribute((const void*)mega_fwd, hipFuncAttributeMaxDynamicSharedMemorySize, LDS_BYTES);
    hipOccupancyMaxActiveBlocksPerMultiprocessor(&per_cu, (const void*)mega_fwd, NTHREADS, LDS_BYTES);
    if (per_cu < 1) { fprintf(stderr, "kernel_launch: occupancy query says %d blocks/CU\n", per_cu); per_cu = 1; }
    grid = 256;
    if (cus < 256) { fprintf(stderr, "kernel_launch: needs 256 CUs, device has %d\n", cus); grid = -1; return; }
    (void)hipGetLastError();
  }
  if (grid < 0) return;
  Params p{};
  for (int i = 0; i < 40; ++i) p.in[i] = (const float*)d_in[i];
  p.out = (float*)d_out; p.ws = (unsigned char*)d_ws;
#if DEBUG_LAUNCHES
#ifdef DBG_GCHK
  for (int ph = 0; ph < 3; ++ph) { p.ph_lo = ph; p.ph_hi = ph + 1; hipLaunchKernelGGL(mega_fwd, dim3(grid), dim3(NTHREADS), LDS_BYTES, stream, p); }
  hipLaunchKernelGGL(dbg_snap, dim3(T * G / 2 / 256), dim3(256), 0, stream, (const unsigned char*)d_ws, (float*)d_out);
  p.ph_lo = 3; p.ph_hi = 4; hipLaunchKernelGGL(mega_fwd, dim3(grid), dim3(NTHREADS), LDS_BYTES, stream, p);
  hipLaunchKernelGGL(dbg_cmp, dim3(T * G / 2 / 256), dim3(256), 0, stream, (unsigned char*)d_ws, (const float*)d_out);
  hipLaunchKernelGGL(dbg_fin, dim3(T * 1024 / 256), dim3(256), 0, stream, (const unsigned char*)d_ws, (float*)d_out);
#elif defined(DBG_STOP)
  for (int ph = 0; ph < DBG_STOP; ++ph) { p.ph_lo = ph; p.ph_hi = ph + 1; hipLaunchKernelGGL(mega_fwd, dim3(grid), dim3(NTHREADS), LDS_BYTES, stream, p); }
  hipLaunchKernelGGL(dbg_dump, dim3(T * 1024 / 256), dim3(256), 0, stream, (const unsigned char*)d_ws, (float*)d_out);
#else
#ifndef REP_MASK
#define REP_MASK 0
#endif
  int rewound = 0;
  for (int ph = 0; ph < N_PHASES; ++ph) { p.ph_lo = ph; p.ph_hi = ph + 1; const int rel = ph == 0 ? 0 : 1 + (ph - 1) % PH_PER_LAYER;
    const int reps = ((REP_MASK >> rel) & 1) ? 2 : 1;
    for (int r = 0; r < reps; ++r) hipLaunchKernelGGL(mega_fwd, dim3(grid), dim3(NTHREADS), LDS_BYTES, stream, p);
#ifdef REP_GROUP
    if (rel == 4) { if (!rewound) { rewound = 1; ph -= 4; } else rewound = 0; }
#endif
  }
#endif
#else
  p.ph_lo = 0; p.ph_hi = N_PHASES;
  hipMemsetAsync((unsigned char*)d_ws + SM_BAR, 0, 16384, stream);
  void* args[] = {&p};
  hipError_t e = hipLaunchCooperativeKernel((const void*)mega_fwd, dim3(grid), dim3(NTHREADS), args, LDS_BYTES, stream);
  if (e != hipSuccess) fprintf(stderr, "cooperative launch failed: %s (grid %d)\n", hipGetErrorString(e), grid);
#endif
}
```

```cpp
#include <hip/hip_runtime.h>
#include <hip/hip_cooperative_groups.h>
#include <cstdio>
#include <cstdint>
#include <cmath>
namespace cg = cooperative_groups;
namespace pg8 {
#define PG8_LAS __attribute__((address_space(3)))
typedef unsigned short bf16_t;
typedef short bf16x8 __attribute__((ext_vector_type(8)));
typedef float f32x4 __attribute__((ext_vector_type(4)));
typedef unsigned u32x4 __attribute__((ext_vector_type(4)));
constexpr int BM = 256, BK = 64, HALF = 128, HTB = HALF * BK * 2  , STAGE_BYTES = 8 * HTB, NXCD = 8, WGM = 8;

__host__ __device__ __forceinline__ int lds_byte(int r, int c) { const int st = (r >> 4) * 2 + (c >> 5), rr = r & 15, cc = c & 31, ob = rr * 64 + cc * 2; return st * 1024 + (ob ^ (((ob >> 9) & 1) << 5)); }
__host__ __device__ __forceinline__ void stage_rc(int b, int& R, int& C) { const int st = b / 1024, sb = b % 1024, swz = sb ^ (((sb >> 9) & 1) << 5); R = (st >> 1) * 16 + swz / 64; C = (st & 1) * 32 + (swz % 64) / 2; }
__host__ __device__ __forceinline__ int perm32(int rho) { const int n = rho >> 4, i = rho & 15; return 8 * (i >> 2) + 4 * n + (i & 3); }

struct Unit { int pm, pn; };
struct Gemm { const bf16_t* A; const bf16_t* Bt; int M, N, K, lda; };

struct StaticOrder {
    int nM, nN, nwg, G, c;
    __host__ __device__ void init(int M, int N, int G_, int c_) { nM = M / BM; nN = N / BM; nwg = nM * nN; G = G_; c = c_; }
    __host__ __device__ bool next(int i, Unit& u) const {
        const long L = (long)i * G + c; if (L >= nwg) return false;
        int wgid = (int)L; { const int q = nwg / NXCD, r = nwg % NXCD, xcd = wgid % NXCD, off = wgid / NXCD; wgid = (xcd < r ? xcd * (q + 1) : r * (q + 1) + (xcd - r) * q) + off; }
        const int nig = WGM * nN, gid = wgid / nig, fm = gid * WGM, gsz = (nM - fm) < WGM ? (nM - fm) : WGM;
        u.pm = fm + ((wgid % nig) % gsz); u.pn = (wgid % nig) / gsz; return true;
    }
    __device__ __forceinline__ void a_ready(const Unit&) const {}
    __device__ __forceinline__ void done(const Unit&) const {}
};

__device__ __forceinline__ unsigned cvt_pk_bf16(float lo, float hi) { unsigned r; asm volatile("v_cvt_pk_bf16_f32 %0, %1, %2" : "=v"(r) : "v"(lo), "v"(hi)); return r; }
typedef float f32x2 __attribute__((ext_vector_type(2)));
template <class Epi, class Sched, bool ALIGN_EPI = false, bool SP2 = false>
__device__ __forceinline__ void gemm_phase(PG8_LAS unsigned char* lds, const Gemm g, const Sched& S, const Epi& E) {
    int tid_l = threadIdx.x; asm volatile("" : "+v"(tid_l));
    const int tid = tid_l, wid = __builtin_amdgcn_readfirstlane(tid >> 6), lane = tid & 63, wr = wid >> 2, wc = wid & 3, fr = lane & 15, fq = lane >> 4;
    const int K = g.K, nt = K / BK;
    unsigned voffA[2], voffB[2];
#pragma unroll
    for (int i = 0; i < 2; ++i) { int R, C; stage_rc(tid * 16 + i * 8192, R, C); const int Rb = Epi::PERM ? ((R & ~31) + perm32(R & 31)) : R;
        voffA[i] = (unsigned)(R * g.lda + C) * 2u; voffB[i] = (unsigned)(Rb * K + C) * 2u; }
    const size_t kstep = (size_t)(BK * 2);
    const size_t hstep = (size_t)HALF * K * 2;
    const size_t tstep = 2 * hstep; const size_t hstepA = (size_t)HALF * g.lda * 2; const size_t tstepA = 2 * hstepA;
    const unsigned ldsw = (unsigned)wid * 1024u;
    const int aoff = lds_byte(wr * 64 + fr, fq * 8), boff = lds_byte(wc * 32 + fr, fq * 8);
#define PG8_SA(b, h) (((b) * 2 + (h)) * HTB)
#define PG8_SB(b, h) ((4 + (b) * 2 + (h)) * HTB)
#define PG8_STAGE(bufoff, gbase, voff) do { _Pragma("unroll") for (int _i = 0; _i < 2; ++_i) \
        __builtin_amdgcn_global_load_lds((const unsigned*)((const char*)(gbase) + (voff)[_i]), (PG8_LAS unsigned*)(lds + (bufoff) + ldsw + _i * 8192), 16, 0, 0); } while (0)
#define PG8_LDA(dst, b, h) do { _Pragma("unroll") for (int m = 0; m < 4; ++m) _Pragma("unroll") for (int k = 0; k < 2; ++k) dst[m][k] = *(const PG8_LAS bf16x8*)(lds + PG8_SA(b, h) + aoff + m * 2048 + k * 1024); } while (0)
#define PG8_LDB(dst, b, h) do { _Pragma("unroll") for (int n = 0; n < 2; ++n) _Pragma("unroll") for (int k = 0; k < 2; ++k) dst[n][k] = *(const PG8_LAS bf16x8*)(lds + PG8_SB(b, h) + boff + n * 2048 + k * 1024); } while (0)
#define PG8_MMA(ai, bj, At, Bt) do { __builtin_amdgcn_s_setprio(1); _Pragma("unroll") for (int m = 0; m < 4; ++m) _Pragma("unroll") for (int n = 0; n < 2; ++n) _Pragma("unroll") for (int k = 0; k < 2; ++k) \
        acc[ai][bj][m][n] = __builtin_amdgcn_mfma_f32_16x16x32_bf16(Bt[n][k], At[m][k], acc[ai][bj][m][n], 0, 0, 0); __builtin_amdgcn_s_setprio(0); } while (0)
#define PG8_WAIT_V(n) asm volatile("s_waitcnt vmcnt(" #n ")" ::: "memory")
#define PG8_WAIT_L(n) asm volatile("s_waitcnt lgkmcnt(" #n ")" ::: "memory")
#define PG8_BAR __builtin_amdgcn_s_barrier()
#define PG8_SCHED __builtin_amdgcn_sched_barrier(0)
    Unit cur, nxt; int ui = 0;
    if (!S.next(0, cur)) return;
    f32x4 acc[2][2][4][2];
#pragma unroll
    for (int a = 0; a < 2; ++a)
#pragma unroll
        for (int b = 0; b < 2; ++b)
#pragma unroll
            for (int m = 0; m < 4; ++m)
#pragma unroll
                for (int n = 0; n < 2; ++n) acc[a][b][m][n] = (f32x4){0.f, 0.f, 0.f, 0.f};
    bf16x8 At[4][2], B0[2][2], B1[2][2];
    const char* cA = (const char*)g.A + (size_t)cur.pm * tstepA; const char* cB = (const char*)g.Bt + (size_t)cur.pn * tstep;
    S.a_ready(cur);
    if constexpr (SP2) {
        PG8_STAGE(PG8_SB(0, 0), cB, voffB); PG8_STAGE(PG8_SB(0, 1), cB + hstep, voffB); PG8_STAGE(PG8_SA(0, 0), cA, voffA); PG8_STAGE(PG8_SA(0, 1), cA + hstepA, voffA);
        if (wr == 1) PG8_BAR;
        PG8_WAIT_V(2); PG8_BAR;
        PG8_STAGE(PG8_SB(1, 0), cB + kstep, voffB); PG8_STAGE(PG8_SA(1, 0), cA + kstep, voffA); PG8_STAGE(PG8_SB(1, 1), cB + hstep + kstep, voffB);
        PG8_WAIT_V(6); PG8_BAR;
    } else {
        PG8_STAGE(PG8_SB(0, 0), cB, voffB); PG8_STAGE(PG8_SA(0, 0), cA, voffA); PG8_STAGE(PG8_SB(0, 1), cB + hstep, voffB); PG8_STAGE(PG8_SA(0, 1), cA + hstepA, voffA);
        if (wr == 1) PG8_BAR;
        PG8_WAIT_V(4); PG8_BAR;
        PG8_STAGE(PG8_SB(1, 0), cB + kstep, voffB); PG8_STAGE(PG8_SA(1, 0), cA + kstep, voffA); PG8_STAGE(PG8_SB(1, 1), cB + hstep + kstep, voffB);
        PG8_WAIT_V(6); PG8_BAR;
    }
    for (;;) {
        const bool has_next = S.next(ui + 1, nxt);
        const char* nA = has_next ? (const char*)g.A + (size_t)nxt.pm * tstepA : cA; const char* nB = has_next ? (const char*)g.Bt + (size_t)nxt.pn * tstep : cB;
        for (int t = 0; t < nt; t += 2) {
            const bool last = (t == nt - 2);
            const char* a1 = cA + (size_t)(t + 1) * kstep;
            const char* a2 = last ? nA : cA + (size_t)(t + 2) * kstep; const char* b2 = last ? nB : cB + (size_t)(t + 2) * kstep;
            const char* a3 = a2 + kstep; const char* b3 = b2 + kstep;
            if (last && has_next) S.a_ready(nxt);
            if constexpr (SP2) {
            PG8_LDB(B0, 0, 0); PG8_LDB(B1, 0, 1); PG8_SCHED; PG8_LDA(At, 0, 0); PG8_STAGE(PG8_SA(1, 1), a1 + hstepA, voffA);
            PG8_WAIT_V(8); PG8_WAIT_L(0); PG8_BAR; PG8_MMA(0, 0, At, B0); PG8_MMA(0, 1, At, B1); PG8_BAR; PG8_SCHED;
            PG8_LDA(At, 0, 1); PG8_STAGE(PG8_SB(0, 0), b2, voffB); PG8_STAGE(PG8_SB(0, 1), b2 + hstep, voffB); PG8_STAGE(PG8_SA(0, 0), a2, voffA);
            PG8_WAIT_V(8); PG8_WAIT_L(0); PG8_BAR; PG8_MMA(1, 0, At, B0); PG8_MMA(1, 1, At, B1); PG8_BAR; PG8_SCHED;
            PG8_LDB(B0, 1, 0); PG8_LDB(B1, 1, 1); PG8_SCHED; PG8_LDA(At, 1, 0); PG8_STAGE(PG8_SA(0, 1), a2 + hstepA, voffA);
            PG8_WAIT_V(8); PG8_WAIT_L(0); PG8_BAR; PG8_MMA(0, 0, At, B0); PG8_MMA(0, 1, At, B1); PG8_BAR; PG8_SCHED;
            PG8_LDA(At, 1, 1); PG8_STAGE(PG8_SB(1, 0), b3, voffB); PG8_STAGE(PG8_SB(1, 1), b3 + hstep, voffB); PG8_STAGE(PG8_SA(1, 0), a3, voffA);
            PG8_WAIT_V(8); PG8_WAIT_L(0); PG8_BAR; PG8_MMA(1, 0, At, B0); PG8_MMA(1, 1, At, B1); PG8_BAR; PG8_SCHED;
            } else {
            PG8_LDB(B0, 0, 0); PG8_SCHED; PG8_LDA(At, 0, 0); PG8_STAGE(PG8_SA(1, 1), a1 + hstepA, voffA);
            PG8_WAIT_L(8); PG8_BAR; PG8_WAIT_L(0); PG8_MMA(0, 0, At, B0); PG8_BAR; PG8_SCHED;
            PG8_LDB(B1, 0, 1); PG8_STAGE(PG8_SB(0, 0), b2, voffB);
            PG8_BAR; PG8_WAIT_L(0); PG8_MMA(0, 1, At, B1); PG8_BAR;
            PG8_LDA(At, 0, 1); PG8_STAGE(PG8_SA(0, 0), a2, voffA);
            PG8_BAR; PG8_WAIT_L(0); PG8_MMA(1, 0, At, B0); PG8_BAR; PG8_SCHED;
            PG8_STAGE(PG8_SB(0, 1), b2 + hstep, voffB);
            PG8_WAIT_V(6); PG8_BAR; PG8_MMA(1, 1, At, B1); PG8_BAR;
            PG8_LDB(B0, 1, 0); PG8_SCHED; PG8_LDA(At, 1, 0); PG8_STAGE(PG8_SA(0, 1), a2 + hstepA, voffA);
            PG8_WAIT_L(8); PG8_BAR; PG8_WAIT_L(0); PG8_MMA(0, 0, At, B0); PG8_BAR; PG8_SCHED;
            PG8_LDB(B1, 1, 1); PG8_STAGE(PG8_SB(1, 0), b3, voffB);
            PG8_BAR; PG8_WAIT_L(0); PG8_MMA(0, 1, At, B1); PG8_BAR;
            PG8_LDA(At, 1, 1); PG8_STAGE(PG8_SA(1, 0), a3, voffA);
            PG8_BAR; PG8_WAIT_L(0); PG8_MMA(1, 0, At, B0); PG8_BAR; PG8_SCHED;
            PG8_STAGE(PG8_SB(1, 1), b3 + hstep, voffB);
            PG8_WAIT_V(6); PG8_BAR; PG8_MMA(1, 1, At, B1); PG8_BAR;
            }
        }
        if constexpr (ALIGN_EPI) { if (wr == 0) PG8_BAR; }
        if constexpr (!Epi::AFTER_DRAIN) { E(acc, cur, wr, wc, fr, fq); S.done(cur); }
        if (!has_next) break;
#pragma unroll
        for (int a = 0; a < 2; ++a)
#pragma unroll
            for (int b = 0; b < 2; ++b)
#pragma unroll
                for (int m = 0; m < 4; ++m)
#pragma unroll
                    for (int n = 0; n < 2; ++n) acc[a][b][m][n] = (f32x4){0.f, 0.f, 0.f, 0.f};
        cur = nxt; cA = nA; cB = nB; ++ui;
        if constexpr (ALIGN_EPI) { if (wr == 1) PG8_BAR; }
    }
    PG8_WAIT_V(0);
    if constexpr (!ALIGN_EPI) { if (wr == 0) PG8_BAR; }
    PG8_BAR;
    if constexpr (Epi::AFTER_DRAIN) { E.fused(acc, cur, wr, wc, fr, fq, lds, wid, lane); S.done(cur); }
#undef PG8_SA
#undef PG8_SB
#undef PG8_STAGE
#undef PG8_LDA
#undef PG8_LDB
#undef PG8_MMA
#undef PG8_WAIT_V
#undef PG8_WAIT_L
#undef PG8_BAR
#undef PG8_SCHED
}
}

typedef unsigned short bf16;
typedef short bf16x8 __attribute__((ext_vector_type(8)));
typedef short bf16x4 __attribute__((ext_vector_type(4)));
typedef float f32x4 __attribute__((ext_vector_type(4)));
typedef float f32x2 __attribute__((ext_vector_type(2)));
typedef unsigned u32x4 __attribute__((ext_vector_type(4)));
typedef unsigned u32x2 __attribute__((ext_vector_type(2)));

constexpr int D = 1024, BATCH = 4, SEQ = 4096, DEPTH = 2, T = BATCH * SEQ;
constexpr int MEM = 256;
constexpr int G = 256, HD = 64, GH = 4;
constexpr int INW = 3332, DFF = 4096;
constexpr float EPS = 1e-6f, LOG2E = 1.4426950408889634f;
constexpr int NTHREADS = 512, NWAVES = 8;
constexpr int PW = 2816;
constexpr int C_FOXQ = 0, C_LRUY = 256, C_RWR = 512, C_RETQ = 768, C_FOXK = 1024, C_LRUX = 1280, C_RWK = 1536, C_RWV = 1792, C_RWX = 2048, C_RETK = 2304, C_RETG = 2560;
constexpr int NIN = 3328;
__device__ __constant__ const int kSrcCol[13] = {0, 1028, 1284, 2308, 256, 772, 1540, 1796, 2052, 2564, 3076, 512, 2820};

constexpr size_t MiB = 1u << 20;
constexpr size_t WS_W = 0;
constexpr size_t W_IN = 0, W_OUT = 7 * MiB, W_Q = 9 * MiB, W_O = 11 * MiB, W_1 = 13 * MiB, W_2 = 21 * MiB, W_SMALL = 29 * MiB;
constexpr size_t WS_W2T = W_SMALL, WS_A2T = WS_W2T + 256 * 64 * 2, WS_G2T = WS_A2T + 256 * 64 * 2, WS_V1T = WS_G2T + 256 * 128 * 2, WS_V2T = WS_V1T + 32 * 256 * 2, WS_RAT = WS_V2T + 256 * 32 * 2, WS_RIT = WS_RAT + 4 * 64 * 64 * 2;
constexpr size_t WS_P = 30 * MiB;
constexpr size_t P_FOXVT = WS_P + 88 * MiB, P_RETKT = WS_P + 96 * MiB, P_RETVT = WS_P + 104 * MiB, P_RETKV = WS_P + 112 * MiB;
constexpr size_t WS_RW = 158 * MiB;
constexpr size_t RW_E = WS_RW, RW_WR = WS_RW + 8 * MiB, RW_A = WS_RW + 16 * MiB, RW_B = WS_RW + 24 * MiB, RW_K = WS_RW + 32 * MiB, RW_V = WS_RW + 40 * MiB, RW_G = WS_P + 120 * MiB  , RW_Y = WS_RW + 56 * MiB;
constexpr int RW_REC = 320;
__device__ __forceinline__ size_t rw_off(int tok  , int arr, int col  ) { const int b = tok >> 12, pos = tok & (SEQ - 1), hh = col >> 6; return ((size_t)((b * 4 + hh) * SEQ + pos)) * RW_REC + arr * 64 + (col & 63); }
constexpr size_t WS_O = WS_RW, WS_H = WS_RW + 32 * MiB;
constexpr size_t WS_WKV = WS_RW;
constexpr size_t WS_MEMN = WS_RW + 64 * MiB;
constexpr size_t WS_VF = 230 * MiB;
constexpr size_t WS_KM = 238 * MiB, WS_VMT = 242 * MiB;
constexpr size_t WS_SM = 246 * MiB;
constexpr size_t SM_LOGF = WS_SM, SM_CUM = SM_LOGF + 256 * 1024, SM_BR = SM_CUM + 256 * 1024, SM_KR = SM_BR + 256 * 1024, SM_RK = SM_KR + 256 * 1024,
                 SM_SS = SM_RK + 256 * 1024  , SM_ROT = SM_SS + 256 * 1024  , SM_Q = SM_ROT + MiB  , SM_BAR = SM_Q + 4096  , WS_END = SM_BAR + 16384;
static_assert(WS_END <= 256 * MiB, "workspace map");
constexpr int LDS_BYTES = 147456;

__device__ __forceinline__ unsigned f2bf(float f) { unsigned u = __builtin_bit_cast(unsigned, f); return (u + 0x7fffu + ((u >> 16) & 1u)) >> 16; }
typedef __bf16 bf16x2_t __attribute__((ext_vector_type(2)));
__device__ __forceinline__ unsigned pk2(float lo, float hi) { const f32x2 v = {lo, hi}; const bf16x2_t b = __builtin_convertvector(v, bf16x2_t); return __builtin_bit_cast(unsigned, b); }
__device__ __forceinline__ float bflo(unsigned u) { return __builtin_bit_cast(float, u << 16); }
__device__ __forceinline__ float bfhi(unsigned u) { return __builtin_bit_cast(float, u & 0xffff0000u); }
__device__ __forceinline__ void unpack8(u32x4 w, float* f) { f[0] = bflo(w.x); f[1] = bfhi(w.x); f[2] = bflo(w.y); f[3] = bfhi(w.y); f[4] = bflo(w.z); f[5] = bfhi(w.z); f[6] = bflo(w.w); f[7] = bfhi(w.w); }
__device__ __forceinline__ u32x4 pack8(const float* f) { u32x4 w; w.x = pk2(f[0], f[1]); w.y = pk2(f[2], f[3]); w.z = pk2(f[4], f[5]); w.w = pk2(f[6], f[7]); return w; }
__device__ __forceinline__ float wave_sum(float v) {
#pragma unroll
  for (int o = 1; o < 64; o <<= 1) v += __shfl_xor(v, o);
  return v;
}
__device__ __forceinline__ float ex2(float x) { return __builtin_amdgcn_exp2f(x); }
__device__ __forceinline__ float rcpf_(float x) { return __builtin_amdgcn_rcpf(x); }
__device__ __forceinline__ float sigmoidf_(float x) { return rcpf_(1.f + __expf(-x)); }
__device__ __forceinline__ float lse0_(float x) { return __logf(1.f + __expf(-fabsf(x))); }
__device__ __forceinline__ float log_sigmoidf_(float x) { return fminf(x, 0.f) - lse0_(x); }
__device__ __forceinline__ float log_sigmoid_acc(float x) { return fminf(x, 0.f) - log1pf(__expf(-fabsf(x))); }
__device__ __forceinline__ float softplusf_(float x) { return fmaxf(x, 0.f) + lse0_(x); }
__device__ __forceinline__ float tanhf_(float x) { return 1.f - 2.f * rcpf_(1.f + __expf(2.f * x)); }
__device__ __forceinline__ float gelu_tanh(float x) { return 0.5f * x * (1.f + tanhf_(0.7978845608028654f * (x + 0.044715f * x * x * x))); }
#define WAVE_LDS_FENCE() asm volatile("s_waitcnt lgkmcnt(0)" ::: "memory")
#define LDS_BARRIER() asm volatile("s_waitcnt lgkmcnt(0)\n\ts_barrier" ::: "memory")
#define MFMA16(a, b, c) __builtin_amdgcn_mfma_f32_16x16x32_bf16((a), (b), (c), 0, 0, 0)

struct Params { const float* in[40]; float* out; unsigned char* ws; int ph_lo, ph_hi; };

struct EpiIn {
  static constexpr bool PERM = true, AFTER_DRAIN = false;
  bf16* proj; bf16* foxvT; bf16* retkT; bf16* retvT; const float* rot;
  __device__ __forceinline__ void operator()(const f32x4 (&acc)[2][2][4][2], const pg8::Unit& u, int wr, int wc, int fr, int fq) const {
    const int pn = u.pn;
    const bool rotary = (pn == 3) || (pn == 9);
    const float sc = (pn == 9) ? 0.125f : 1.f;
    bf16* tdst = pn == 9 ? retkT : pn == 11 ? foxvT : pn == 12 ? retvT : nullptr;
    const bool rowmajor = pn <= 10;
#pragma unroll
    for (int ai = 0; ai < 2; ++ai)
#pragma unroll
      for (int m = 0; m < 4; ++m) {
        const int row = u.pm * 256 + ai * 128 + wr * 64 + m * 16 + fr; const int pos = row & (SEQ - 1), b = row >> 12;
#pragma unroll
        for (int bj = 0; bj < 2; ++bj) {
          const int c0 = bj * 128 + wc * 32 + 8 * fq;
          float v[8];
#pragma unroll
          for (int e = 0; e < 4; ++e) { v[e] = acc[ai][bj][m][0][e]; v[4 + e] = acc[ai][bj][m][1][e]; }
          if (rotary) {
            const int i0 = (c0 & 63) >> 1;
            const f32x4 r0 = *(const f32x4*)(rot + ((size_t)pos * 32 + i0) * 2), r1 = *(const f32x4*)(rot + ((size_t)pos * 32 + i0 + 2) * 2);
            const float cs[4] = {r0[0], r0[2], r1[0], r1[2]}, sn[4] = {r0[1], r0[3], r1[1], r1[3]};
#pragma unroll
            for (int p = 0; p < 4; ++p) { const float x1 = v[2 * p], x2 = v[2 * p + 1]; v[2 * p] = x1 * cs[p] - x2 * sn[p]; v[2 * p + 1] = x1 * sn[p] + x2 * cs[p]; }
          }
#pragma unroll
          for (int e = 0; e < 8; ++e) v[e] *= sc;
          const u32x4 w = pack8(v);
          if (rowmajor) *(u32x4*)(proj + (size_t)row * PW + pn * 256 + c0) = w;
          if (tdst) {
            const int hh = c0 >> 6, d0 = c0 & 63; bf16* tp = tdst + ((size_t)((b * 4 + hh) * 64 + d0)) * SEQ + pos;
            const unsigned ww[4] = {w.x, w.y, w.z, w.w};
#pragma unroll
            for (int e = 0; e < 8; ++e) tp[(size_t)e * SEQ] = (bf16)((e & 1) ? (ww[e >> 1] >> 16) : (ww[e >> 1] & 0xffffu));
          }
        }
      }
  }
};
struct EpiPlain {
  static constexpr bool PERM = true, AFTER_DRAIN = false;
  bf16* O; int ldc; int act; float* ss;
  __device__ __forceinline__ void operator()(const f32x4 (&acc)[2][2][4][2], const pg8::Unit& u, int wr, int wc, int fr, int fq) const {
#pragma unroll
    for (int ai = 0; ai < 2; ++ai)
#pragma unroll
      for (int m = 0; m < 4; ++m) {
        const int row = u.pm * 256 + ai * 128 + wr * 64 + m * 16 + fr; float s = 0.f;
#pragma unroll
        for (int bj = 0; bj < 2; ++bj) {
          const int c0 = u.pn * 256 + bj * 128 + wc * 32 + 8 * fq;
          float v[8];
#pragma unroll
          for (int e = 0; e < 4; ++e) { v[e] = acc[ai][bj][m][0][e]; v[4 + e] = acc[ai][bj][m][1][e]; }
          if (act == 1) {
#pragma unroll
            for (int e = 0; e < 8; ++e) { const float r = fmaxf(v[e], 0.f); v[e] = r * r; }
          }
#pragma unroll
          for (int e = 0; e < 8; ++e) s += v[e] * v[e];
          *(u32x4*)(O + (size_t)row * ldc + c0) = pack8(v);
        }
        if (ss) { s += __shfl_xor(s, 16); s += __shfl_xor(s, 32); if (fq == 0) atomicAdd(ss + row, s); }
      }
  }
};
struct EpiMem {
  static constexpr bool PERM = true, AFTER_DRAIN = false;
  bf16* kmem; bf16* vmemT;
  __device__ __forceinline__ void operator()(const f32x4 (&acc)[2][2][4][2], const pg8::Unit& u, int wr, int wc, int fr, int fq) const {
    const int layer = u.pm >> 2, pt = u.pn & 7; const bool isv = pt >= 4; const int head = pt & 3;
#pragma unroll
    for (int ai = 0; ai < 2; ++ai)
#pragma unroll
      for (int m = 0; m < 4; ++m) {
        const int rowl = (u.pm & 3) * 256 + ai * 128 + wr * 64 + m * 16 + fr;
#pragma unroll
        for (int bj = 0; bj < 2; ++bj) {
          const int c0 = bj * 128 + wc * 32 + 8 * fq;
          float v[8];
#pragma unroll
          for (int e = 0; e < 4; ++e) { v[e] = acc[ai][bj][m][0][e]; v[4 + e] = acc[ai][bj][m][1][e]; }
          const u32x4 w = pack8(v);
          if (!isv) *(u32x4*)(kmem + ((size_t)layer * 1024 + rowl) * 1024 + head * 256 + c0) = w;
          else {
            const int b = rowl >> 8, key = rowl & 255; bf16* tp = vmemT + ((size_t)(((layer * 4 + b) * 4 + head) * 256 + c0)) * 256 + key;
            const unsigned ww[4] = {w.x, w.y, w.z, w.w};
#pragma unroll
            for (int e = 0; e < 8; ++e) tp[(size_t)e * 256] = (bf16)((e & 1) ? (ww[e >> 1] >> 16) : (ww[e >> 1] & 0xffffu));
          }
        }
      }
  }
};
struct MemSched {
  int G, c;
  __device__ bool next(int i, pg8::Unit& u) const { const int L = i * G + c; if (c < 0 || L >= 64) return false; const int layer = L >> 5, r = L & 31; u.pm = layer * 4 + (r & 3); u.pn = layer * 8 + (r >> 2); return true; }
  __device__ __forceinline__ void a_ready(const pg8::Unit&) const {}
  __device__ __forceinline__ void done(const pg8::Unit&) const {}
};

template <int MAP> __device__ __forceinline__ int src_col(int n) {
  if (MAP == 0) return n;
  const int tile = n >> 8, j = n & 255; int jj = j;
  if (tile == 3 || tile == 9) { const int hh = j >> 6, l = j & 63; jj = hh * 64 + (l >> 1) + 32 * (l & 1); }
  return kSrcCol[tile] + jj;
}
template <int MAP> __device__ __forceinline__ void conv_item(const float* __restrict__ W, int K, int Nsrc, int N, bf16* WT, float* scr, int item, int lane) {
  const int nblk = N / 32, kb = item / nblk, nb = item % nblk, k0 = 64 * kb, n0 = 32 * nb;
  const int sc = src_col<MAP>(n0 + (lane & 31));
#pragma unroll 8
  for (int i = 0; i < 32; ++i) { const int kk = 2 * i + (lane >> 5); scr[kk * 33 + (lane & 31)] = W[(size_t)(k0 + kk) * Nsrc + sc]; }
  WAVE_LDS_FENCE();
  const int c = lane & 7;
#pragma unroll
  for (int j = 0; j < 4; ++j) { const int n = (lane >> 3) + 8 * j; const float* s = scr + (8 * c) * 33 + n;
    u32x4 o; o.x = pk2(s[0 * 33], s[1 * 33]); o.y = pk2(s[2 * 33], s[3 * 33]); o.z = pk2(s[4 * 33], s[5 * 33]); o.w = pk2(s[6 * 33], s[7 * 33]);
    *(u32x4*)(WT + (size_t)(n0 + n) * K + k0 + 8 * c) = o; }
  WAVE_LDS_FENCE();
}
__device__ __forceinline__ void conv_layer_weights(const Params& p, int l, float* scr, int gw, int NGW, int lane) {
  asm volatile("" ::: "memory");
  asm volatile("" : "+v"(lane));
  unsigned char* ws = p.ws;
  constexpr int I_IN = (D / 64) * (NIN / 32), I_SQ = (D / 64) * (D / 32), I_1 = (D / 64) * (DFF / 32), I_2 = (DFF / 64) * (D / 32);
  constexpr int I_W2 = 1 * 8, I_A2 = 8, I_G2 = 2 * 8, I_V1 = 4 * 1, I_V2 = 8  , I_R = 2 * 4 * 2;
  constexpr int NIT = I_IN + 3 * I_SQ + I_1 + I_2 + I_W2 + I_A2 + I_G2 + I_V1 + I_R;
  for (int it = gw; it < NIT; it += NGW) {
    int r = it;
    if (r < I_IN) { conv_item<1>(p.in[9] + (size_t)l * D * INW, D, INW, NIN, (bf16*)(ws + W_IN), scr, r, lane); continue; } r -= I_IN;
    if (r < I_SQ) { conv_item<0>(p.in[10] + (size_t)l * D * D, D, D, D, (bf16*)(ws + W_OUT), scr, r, lane); continue; } r -= I_SQ;
    if (r < I_SQ) { conv_item<0>(p.in[34] + (size_t)l * D * D, D, D, D, (bf16*)(ws + W_Q), scr, r, lane); continue; } r -= I_SQ;
    if (r < I_SQ) { conv_item<0>(p.in[37] + (size_t)l * D * D, D, D, D, (bf16*)(ws + W_O), scr, r, lane); continue; } r -= I_SQ;
    if (r < I_1) { conv_item<0>(p.in[38] + (size_t)l * D * DFF, D, DFF, DFF, (bf16*)(ws + W_1), scr, r, lane); continue; } r -= I_1;
    if (r < I_2) { conv_item<0>(p.in[39] + (size_t)l * DFF * D, DFF, D, D, (bf16*)(ws + W_2), scr, r, lane); continue; } r -= I_2;
    if (r < I_W2) { conv_item<0>(p.in[21] + (size_t)l * 64 * G, 64, G, G, (bf16*)(ws + WS_W2T), scr, r, lane); continue; } r -= I_W2;
    if (r < I_A2) { conv_item<0>(p.in[23] + (size_t)l * 64 * G, 64, G, G, (bf16*)(ws + WS_A2T), scr, r, lane); continue; } r -= I_A2;
    if (r < I_G2) { conv_item<0>(p.in[24] + (size_t)l * 128 * G, 128, G, G, (bf16*)(ws + WS_G2T), scr, r, lane); continue; } r -= I_G2;
    if (r < I_V1) { if (l > 0) conv_item<0>(p.in[31] + (size_t)(l - 1) * G * 32, G, 32, 32, (bf16*)(ws + WS_V1T), scr, r, lane); continue; } r -= I_V1;
    { const int gate = r >> 3, hh = (r >> 1) & 3, nb = r & 1;
      conv_item<0>(p.in[gate ? 16 : 14] + ((size_t)l * GH + hh) * HD * HD, 64, 64, 64, (bf16*)(ws + (gate ? WS_RIT : WS_RAT)) + hh * 4096, scr, nb, lane); }
  }
  if (l > 0) { const float* v2 = p.in[32] + (size_t)(l - 1) * 32 * G; bf16* v2t = (bf16*)(ws + WS_V2T);
    for (int e = gw * 64 + lane; e < 32 * G; e += NGW * 64) { const int k = e / G, n = e % G; v2t[n * 32 + k] = (bf16)f2bf(v2[e]); } }
}

struct RowArgs { const float* xin; const bf16* O; float* ss; const float* g_post; float* xout; const float* g_pre; bf16* hout; const float* wf; const float* fbias; float* logf; int rows; };
__device__ __forceinline__ void row_phase(const RowArgs& a, int gw, int NGW, int lane) {
  asm volatile("" ::: "memory");
  asm volatile("" : "+v"(lane));
  f32x4 gp[4], gq[4], wfv[4][4];
#pragma unroll
  for (int j = 0; j < 4; ++j) {
    gp[j] = a.O ? ((const f32x4*)a.g_post)[lane + 64 * j] : (f32x4){0.f, 0.f, 0.f, 0.f};
    gq[j] = a.hout ? ((const f32x4*)a.g_pre)[lane + 64 * j] : (f32x4){0.f, 0.f, 0.f, 0.f};
#pragma unroll
    for (int hh = 0; hh < 4; ++hh)
#pragma unroll
      for (int e = 0; e < 4; ++e) wfv[j][hh][e] = a.wf ? a.wf[(size_t)(4 * (lane + 64 * j) + e) * INW + 768 + hh] : 0.f;
  }
  for (int row0 = gw; row0 < a.rows; row0 += 2 * NGW) {
    const int rowv[2] = {row0, row0 + NGW}; const bool val[2] = {true, row0 + NGW < a.rows};
    f32x4 x[2][4]; float ov[2][4][4];
#pragma unroll
    for (int r = 0; r < 2; ++r) if (val[r]) {
#pragma unroll
      for (int j = 0; j < 4; ++j) x[r][j] = ((const f32x4*)(a.xin + (size_t)rowv[r] * D))[lane + 64 * j];
      if (a.O) {
#pragma unroll
        for (int j = 0; j < 4; ++j) { const u32x2 o = ((const u32x2*)(a.O + (size_t)rowv[r] * D))[lane + 64 * j];
          ov[r][j][0] = bflo(o.x); ov[r][j][1] = bfhi(o.x); ov[r][j][2] = bflo(o.y); ov[r][j][3] = bfhi(o.y); }
      }
    }
#pragma unroll
    for (int r = 0; r < 2; ++r) if (val[r]) {
      const int row = rowv[r];
      if (a.O) {
        float so = 0.f;
#pragma unroll
        for (int j = 0; j < 4; ++j) so += ov[r][j][0] * ov[r][j][0] + ov[r][j][1] * ov[r][j][1] + ov[r][j][2] * ov[r][j][2] + ov[r][j][3] * ov[r][j][3];
        so = wave_sum(so);
        const float rs = rsqrtf(so * (1.f / D) + EPS);
#pragma unroll
        for (int j = 0; j < 4; ++j)
#pragma unroll
          for (int e = 0; e < 4; ++e) x[r][j][e] += ov[r][j][e] * rs * gp[j][e];
      }
      if (a.xout) {
#pragma unroll
        for (int j = 0; j < 4; ++j) ((f32x4*)(a.xout + (size_t)row * D))[lane + 64 * j] = x[r][j];
      }
      if (a.hout) {
        float s = 0.f;
#pragma unroll
        for (int j = 0; j < 4; ++j) s += x[r][j][0] * x[r][j][0] + x[r][j][1] * x[r][j][1] + x[r][j][2] * x[r][j][2] + x[r][j][3] * x[r][j][3];
        s = wave_sum(s); const float rs2 = rsqrtf(s * (1.f / D) + EPS);
        float fd[4] = {0.f, 0.f, 0.f, 0.f};
#pragma unroll
        for (int j = 0; j < 4; ++j) {
          f32x4 hv;
#pragma unroll
          for (int e = 0; e < 4; ++e) hv[e] = x[r][j][e] * rs2 * gq[j][e];
          u32x2 o; o.x = pk2(hv[0], hv[1]); o.y = pk2(hv[2], hv[3]);
          ((u32x2*)(a.hout + (size_t)row * D))[lane + 64 * j] = o;
          if (a.wf) {
#pragma unroll
            for (int hh = 0; hh < 4; ++hh) fd[hh] += hv[0] * wfv[j][hh][0] + hv[1] * wfv[j][hh][1] + hv[2] * wfv[j][hh][2] + hv[3] * wfv[j][hh][3];
          }
        }
        if (a.wf) {
#pragma unroll
          for (int hh = 0; hh < 4; ++hh) fd[hh] = wave_sum(fd[hh]);
          if (lane < 4) { const float f = lane == 0 ? fd[0] : lane == 1 ? fd[1] : lane == 2 ? fd[2] : fd[3]; a.logf[(size_t)row * 4 + lane] = log_sigmoidf_(f + a.fbias[lane]); }
        }
      }
    }
  }
}

__device__ __forceinline__ void lerp8(const bf16* __restrict__ proj, const float* __restrict__ mu, int tok, int col, int mucol, float* out) {
  const u32x4 c = *(const u32x4*)(proj + (size_t)tok * PW + col);
  u32x4 pv = {0u, 0u, 0u, 0u};
  if ((tok & (SEQ - 1)) != 0) pv = *(const u32x4*)(proj + (size_t)(tok - 1) * PW + col);
  float cf[8], pf[8]; unpack8(c, cf); unpack8(pv, pf);
  const f32x4 m0 = *(const f32x4*)(mu + mucol), m1 = *(const f32x4*)(mu + mucol + 4);
#pragma unroll
  for (int e = 0; e < 4; ++e) { out[e] = cf[e] + (pf[e] - cf[e]) * m0[e]; out[4 + e] = cf[4 + e] + (pf[4 + e] - cf[4 + e]) * m1[e]; }
}
__device__ __forceinline__ bf16x8 pack_frag(const float* f) { const u32x4 w = pack8(f); return __builtin_bit_cast(bf16x8, w); }
constexpr int WLP = 260;
__device__ __forceinline__ void acc_to_lds(float* wl, const f32x4* acc, int ntiles, int li, int g) {
#pragma unroll
  for (int nt = 0; nt < 16; ++nt) if (nt < ntiles) {
#pragma unroll
    for (int j = 0; j < 4; ++j) wl[(4 * g + j) * WLP + nt * 16 + li] = acc[nt][j];
  }
}
template <int KS> __device__ __forceinline__ void mm16_to_lds(const bf16x8* af, const bf16* __restrict__ wt, int ldw, float* wl, int li, int g) {
#pragma unroll 1
  for (int ng = 0; ng < 4; ++ng) {
    f32x4 a4[4];
#pragma unroll
    for (int n4 = 0; n4 < 4; ++n4) { a4[n4] = (f32x4){0.f, 0.f, 0.f, 0.f};
#pragma unroll
      for (int ks = 0; ks < KS; ++ks) { const bf16x8 bfr = *(const bf16x8*)(wt + (size_t)((ng * 4 + n4) * 16 + li) * ldw + ks * 32 + 8 * g); a4[n4] = MFMA16(af[ks], bfr, a4[n4]); } }
#pragma unroll
    for (int n4 = 0; n4 < 4; ++n4)
#pragma unroll
      for (int j = 0; j < 4; ++j) wl[(4 * g + j) * WLP + (ng * 4 + n4) * 16 + li] = a4[n4][j];
  }
}
__device__ __forceinline__ void rwkv_prep_unit(const Params& p, int l, int unit, int pass, float* wl, int lane) {
  asm volatile("" ::: "memory");
  asm volatile("" : "+v"(lane));
  unsigned char* ws = p.ws;
  const bf16* proj = (const bf16*)(ws + WS_P);
  const float* mu = p.in[19] + (size_t)l * 1024;
  const int li = lane & 15, g = lane >> 4, t0 = unit * 16, ta = t0 + li;
  const int tl = t0 + (lane >> 2), cgp = lane & 3;
  if (pass == 0) {
    bf16x8 af[2];
#pragma unroll
    for (int ks = 0; ks < 2; ++ks) { float f[8]; lerp8(proj, mu, ta, C_RWX + ks * 32 + 8 * g, 768 + ks * 32 + 8 * g, f);
#pragma unroll
      for (int e = 0; e < 8; ++e) f[e] = tanhf_(f[e]);
      af[ks] = pack_frag(f); }
    mm16_to_lds<2>(af, (const bf16*)(ws + WS_W2T), 64, wl, li, g); WAVE_LDS_FENCE();
    const float* w0 = p.in[20] + (size_t)l * G;
#pragma unroll 2
    for (int i = 0; i < 8; ++i) { int col = cgp * 8 + 32 * i; asm volatile("" : "+v"(col)); float r[8], ev[8], wr[8];
      lerp8(proj, mu, tl, C_RWR + col, col, r);
#pragma unroll
      for (int e = 0; e < 8; ++e) { const float wa = wl[(lane >> 2) * WLP + col + e] + w0[col + e]; const float wlog = -softplusf_(-wa) - 0.5f; const float ee = __expf(wlog); ev[e] = ee; wr[e] = __expf(-ee) * r[e]; }
      *(u32x4*)((bf16*)(ws + WS_RW) + rw_off(tl, 0, col)) = pack8(ev); *(u32x4*)((bf16*)(ws + WS_RW) + rw_off(tl, 1, col)) = pack8(wr); }
    WAVE_LDS_FENCE();
  }
  if (pass == 1) {
    bf16x8 af[2];
#pragma unroll
    for (int ks = 0; ks < 2; ++ks) { float f[8]; lerp8(proj, mu, ta, C_RWX + 64 + ks * 32 + 8 * g, 832 + ks * 32 + 8 * g, f); af[ks] = pack_frag(f); }
    mm16_to_lds<2>(af, (const bf16*)(ws + WS_A2T), 64, wl, li, g); WAVE_LDS_FENCE();
    const float* a0 = p.in[22] + (size_t)l * G; const float* k_k = p.in[25] + (size_t)l * G; const float* k_a = p.in[26] + (size_t)l * G; const float* r_k = p.in[27] + (size_t)l * G;
#pragma unroll 1
    for (int hh = 0; hh < 4; ++hh) {
      float av[2][8], kv[2][8], kk[2][8]; float ssq = 0.f;
#pragma unroll
      for (int ii = 0; ii < 2; ++ii) { int col = cgp * 8 + 32 * (2 * hh + ii); asm volatile("" : "+v"(col));
        lerp8(proj, mu, tl, C_RWK + col, 256 + col, kv[ii]);
#pragma unroll
        for (int e = 0; e < 8; ++e) { av[ii][e] = sigmoidf_(a0[col + e] + wl[(lane >> 2) * WLP + col + e]); kk[ii][e] = kv[ii][e] * k_k[col + e]; ssq += kk[ii][e] * kk[ii][e]; } }
      ssq += __shfl_xor(ssq, 1); ssq += __shfl_xor(ssq, 2);
      const float inv = 1.f / fmaxf(sqrtf(ssq), 1e-12f);
      float sbr = 0.f, skr = 0.f, srk = 0.f;
#pragma unroll
      for (int ii = 0; ii < 2; ++ii) { int col = cgp * 8 + 32 * (2 * hh + ii); asm volatile("" : "+v"(col)); float r[8], Av[8], Bv[8], k2[8];
        lerp8(proj, mu, tl, C_RWR + col, col, r);
#pragma unroll
        for (int e = 0; e < 8; ++e) { const float kn = kk[ii][e] * inv; Av[e] = -kn; Bv[e] = kn * av[ii][e]; k2[e] = kv[ii][e] * (1.f + (av[ii][e] - 1.f) * k_a[col + e]);
          const float rb = r[e]; sbr += Bv[e] * rb; skr += k2[e] * rb; srk += rb * k2[e] * r_k[col + e]; }
        *(u32x4*)((bf16*)(ws + WS_RW) + rw_off(tl, 2, col)) = pack8(Av); *(u32x4*)((bf16*)(ws + WS_RW) + rw_off(tl, 3, col)) = pack8(Bv); *(u32x4*)((bf16*)(ws + WS_RW) + rw_off(tl, 4, col)) = pack8(k2); }
      sbr += __shfl_xor(sbr, 1); sbr += __shfl_xor(sbr, 2); skr += __shfl_xor(skr, 1); skr += __shfl_xor(skr, 2); srk += __shfl_xor(srk, 1); srk += __shfl_xor(srk, 2);
      if (cgp == 0) { ((float*)(ws + SM_BR))[(size_t)tl * 4 + hh] = sbr; ((float*)(ws + SM_KR))[(size_t)tl * 4 + hh] = skr; ((float*)(ws + SM_RK))[(size_t)tl * 4 + hh] = srk; }
    }
    WAVE_LDS_FENCE();
  }
  if (pass == 2) {
    bf16x8 af[4];
#pragma unroll
    for (int ks = 0; ks < 4; ++ks) { float f[8]; lerp8(proj, mu, ta, C_RWX + 128 + ks * 32 + 8 * g, 896 + ks * 32 + 8 * g, f);
#pragma unroll
      for (int e = 0; e < 8; ++e) f[e] = sigmoidf_(f[e]);
      af[ks] = pack_frag(f); }
    mm16_to_lds<4>(af, (const bf16*)(ws + WS_G2T), 128, wl, li, g); WAVE_LDS_FENCE();
#pragma unroll 2
    for (int i = 0; i < 8; ++i) { int col = cgp * 8 + 32 * i; asm volatile("" : "+v"(col)); float gv[8];
#pragma unroll
      for (int e = 0; e < 8; ++e) gv[e] = wl[(lane >> 2) * WLP + col + e];
      *(u32x4*)((bf16*)(ws + RW_G) + (size_t)tl * G + col) = pack8(gv); }
    WAVE_LDS_FENCE();
  }
  if (pass != 3) return;
  if (l > 0) {
    f32x4 a1[2] = {(f32x4){0.f, 0.f, 0.f, 0.f}, (f32x4){0.f, 0.f, 0.f, 0.f}};
    const bf16* v1t = (const bf16*)(ws + WS_V1T);
#pragma unroll
    for (int ks = 0; ks < 8; ++ks) { float f[8]; lerp8(proj, mu, ta, C_RWV + ks * 32 + 8 * g, 512 + ks * 32 + 8 * g, f); const bf16x8 af = pack_frag(f);
#pragma unroll
      for (int nt = 0; nt < 2; ++nt) { const bf16x8 bfr = *(const bf16x8*)(v1t + (size_t)(nt * 16 + li) * 256 + ks * 32 + 8 * g); a1[nt] = MFMA16(af, bfr, a1[nt]); } }
#pragma unroll
    for (int nt = 0; nt < 2; ++nt)
#pragma unroll
      for (int j = 0; j < 4; ++j) wl[(4 * g + j) * WLP + nt * 16 + li] = a1[nt][j];
    WAVE_LDS_FENCE();
    float f2[8];
#pragma unroll
    for (int e = 0; e < 8; ++e) f2[e] = wl[li * WLP + 8 * g + e];
    const bf16x8 af2 = pack_frag(f2);
    WAVE_LDS_FENCE();
    mm16_to_lds<1>(&af2, (const bf16*)(ws + WS_V2T), 32, wl, li, g); WAVE_LDS_FENCE();
    const float* v0 = p.in[30] + (size_t)(l - 1) * G;
#pragma unroll 2
    for (int i = 0; i < 8; ++i) { int col = cgp * 8 + 32 * i; asm volatile("" : "+v"(col)); float v[8], vf[8];
      lerp8(proj, mu, tl, C_RWV + col, 512 + col, v);
      unpack8(*(const u32x4*)((const bf16*)(ws + WS_VF) + (size_t)tl * G + col), vf);
#pragma unroll
      for (int e = 0; e < 8; ++e) v[e] = v[e] + (vf[e] - v[e]) * sigmoidf_(v0[col + e] + wl[(lane >> 2) * WLP + col + e]);
      *(u32x4*)((bf16*)(ws + RW_V) + (size_t)tl * G + col) = pack8(v); }
    WAVE_LDS_FENCE();
  } else {
#pragma unroll 2
    for (int i = 0; i < 8; ++i) { int col = cgp * 8 + 32 * i; asm volatile("" : "+v"(col)); float v[8];
      lerp8(proj, mu, tl, C_RWV + col, 512 + col, v);
      const u32x4 w = pack8(v);
      *(u32x4*)((bf16*)(ws + RW_V) + (size_t)tl * G + col) = w; *(u32x4*)((bf16*)(ws + WS_VF) + (size_t)tl * G + col) = w; }
  }
}
__device__ __forceinline__ void ret_kv_unit(const Params& p, int unit, int lane) {
  asm volatile("" ::: "memory");
  asm volatile("" : "+v"(lane));
  unsigned char* ws = p.ws;
  const int bh = unit >> 5, c = unit & 31, h = bh & 3, li = lane & 15, g = lane >> 4;
  const float lg2 = log2f(1.f - exp2f(-5.f - (float)h));
  const bf16* kT = (const bf16*)(ws + P_RETKT) + (size_t)bh * 64 * SEQ + c * 128;
  const bf16* vT = (const bf16*)(ws + P_RETVT) + (size_t)bh * 64 * SEQ + c * 128;
  f32x4 acc[4][4];
#pragma unroll
  for (int a = 0; a < 4; ++a)
#pragma unroll
    for (int b = 0; b < 4; ++b) acc[a][b] = (f32x4){0.f, 0.f, 0.f, 0.f};
#pragma unroll
  for (int ks = 0; ks < 4; ++ks) {
    float z[8];
#pragma unroll
    for (int e = 0; e < 8; ++e) z[e] = ex2(lg2 * (float)(127 - (ks * 32 + 8 * g + e)));
    bf16x8 af[4], bfr[4];
#pragma unroll
    for (int dt = 0; dt < 4; ++dt) { float f[8]; unpack8(*(const u32x4*)(kT + (size_t)(dt * 16 + li) * SEQ + ks * 32 + 8 * g), f);
#pragma unroll
      for (int e = 0; e < 8; ++e) f[e] *= z[e];
      af[dt] = pack_frag(f); }
#pragma unroll
    for (int et = 0; et < 4; ++et) bfr[et] = *(const bf16x8*)(vT + (size_t)(et * 16 + li) * SEQ + ks * 32 + 8 * g);
#pragma unroll
    for (int dt = 0; dt < 4; ++dt)
#pragma unroll
      for (int et = 0; et < 4; ++et) acc[dt][et] = MFMA16(af[dt], bfr[et], acc[dt][et]);
  }
  float* KV = (float*)(ws + P_RETKV) + (size_t)unit * 4096;
#pragma unroll
  for (int dt = 0; dt < 4; ++dt)
#pragma unroll
    for (int et = 0; et < 4; ++et)
#pragma unroll
      for (int j = 0; j < 4; ++j) KV[(dt * 16 + 4 * g + j) * 64 + et * 16 + li] = acc[dt][et][j];
}
__device__ __forceinline__ void fox_cum_unit(const Params& p, int bh, int lane) {
  asm volatile("" ::: "memory");
  asm volatile("" : "+v"(lane));
  const float* logf = (const float*)(p.ws + SM_LOGF); float* cum = (float*)(p.ws + SM_CUM);
  const int b = bh >> 2, h = bh & 3; const size_t base = ((size_t)b * SEQ + lane * 64) * 4 + h;
  float s = 0.f;
  for (int i = 0; i < 64; ++i) s += logf[base + (size_t)i * 4];
  float incl = s;
#pragma unroll
  for (int o = 1; o < 64; o <<= 1) { const float t = __shfl_up(incl, o); if (lane >= o) incl += t; }
  float run = incl - s;
  for (int i = 0; i < 64; ++i) { run += logf[base + (size_t)i * 4]; cum[(size_t)bh * SEQ + lane * 64 + i] = run * LOG2E; }
}

template <int CTRL> __device__ __forceinline__ float dpp_add(float x) {
  const int y = __builtin_amdgcn_update_dpp(0, __builtin_bit_cast(int, x), CTRL, 0xf, 0xf, true);
  return x + __builtin_bit_cast(float, y);
}
__device__ __forceinline__ float row16_sum(float x) {
  x = dpp_add<0xB1>(x); x = dpp_add<0x4E>(x); x = dpp_add<0x141>(x); x = dpp_add<0x140>(x); return x;
}
constexpr int RS_TSB = 896;
constexpr int RS_CH = 32;
constexpr int RS_BUFB = RS_CH * RS_TSB;
constexpr int RS_ROWS = 8;
constexpr int RS_YP = 40;
constexpr int RS_YBUF = RS_CH * RS_ROWS * RS_YP;
struct RsRegs { u32x4 e, a, b, k, wr, v; float br, kr; };
__device__ __forceinline__ void rs_issue(const Params& p, RsRegs& r, int b, int h, int rq, int c, int lt) {
  unsigned char* ws = p.ws;
  { const int tok = lt >> 3, ch = lt & 7; const bf16* rec = (const bf16*)(ws + WS_RW) + ((size_t)((b * 4 + h) * SEQ + c * RS_CH + tok)) * RW_REC + ch * 8;
    r.e = *(const u32x4*)(rec); r.wr = *(const u32x4*)(rec + 64); r.a = *(const u32x4*)(rec + 128); r.b = *(const u32x4*)(rec + 192); r.k = *(const u32x4*)(rec + 256); }
  { const int t2 = lt & 31; const size_t rr = (size_t)b * SEQ + c * RS_CH + t2;
    r.v = *(const u32x4*)((const bf16*)(ws + RW_V) + rr * G + h * 64 + rq * RS_ROWS);
    r.br = ((const float*)(ws + SM_BR))[rr * 4 + h]; r.kr = ((const float*)(ws + SM_KR))[rr * 4 + h]; }
}
__device__ __forceinline__ void rs_commit(const RsRegs& r, unsigned char* buf, int lt) {
  { const int tok = lt >> 3, ch = lt & 7; unsigned char* rec = buf + tok * RS_TSB; float f[8];
    unpack8(r.e, f);
#pragma unroll
    for (int e = 0; e < 8; ++e) f[e] = ex2(-f[e] * LOG2E);
    *(f32x4*)(rec + ch * 32) = (f32x4){f[0], f[1], f[2], f[3]}; *(f32x4*)(rec + ch * 32 + 16) = (f32x4){f[4], f[5], f[6], f[7]};
    { const unsigned aw[4] = {r.a.x, r.a.y, r.a.z, r.a.w}, bw[4] = {r.b.x, r.b.y, r.b.z, r.b.w}, kw[4] = {r.k.x, r.k.y, r.k.z, r.k.w}, ww[4] = {r.wr.x, r.wr.y, r.wr.z, r.wr.w};
#pragma unroll
      for (int j = 0; j < 4; ++j) *(u32x4*)(rec + 256 + (ch * 4 + j) * 16) = (u32x4){aw[j], bw[j], kw[j], ww[j]}; } }
  if (lt < 32) { float f[8]; unpack8(r.v, f); unsigned char* rec = buf + lt * RS_TSB + 768; const float b32 = r.br * (1.f / 32.f), k32 = r.kr * (1.f / 32.f);
#pragma unroll
    for (int j = 0; j < 8; ++j) *(f32x4*)(rec + 16 * j) = (f32x4){f[j], b32, k32, 0.f}; }
}
__device__ __forceinline__ float row32_sum(float x) {
  x = row16_sum(x);
  const auto rr = __builtin_amdgcn_permlane16_swap(__builtin_bit_cast(unsigned, x), __builtin_bit_cast(unsigned, x), false, false);
  return __builtin_bit_cast(float, (unsigned)rr[0]) + __builtin_bit_cast(float, (unsigned)rr[1]);
}
__device__ __forceinline__ f32x2 bf2x(unsigned u) { return (f32x2){bflo(u), bfhi(u)}; }
__device__ __forceinline__ void rwkv_scan_unit(const Params& p, unsigned char* lds, int unit) {
  asm volatile("" ::: "memory");
  int tid = threadIdx.x; asm volatile("" : "+v"(tid)); const int wave = __builtin_amdgcn_readfirstlane(tid >> 6), lane = tid & 63;
  const int b = unit >> 5, h = (unit >> 3) & 3, rq = unit & 7;
  unsigned char* bufs = lds; bf16* ybuf = (bf16*)(lds + 2 * RS_BUFB);
  float* Y = (float*)(p.ws + RW_Y);
  constexpr int NCH = SEQ / RS_CH;
  const int lt = tid - 256;
  RsRegs rg;
  if (wave >= 4) { rs_issue(p, rg, b, h, rq, 0, lt); rs_commit(rg, bufs, lt); rs_issue(p, rg, b, h, rq, 1, lt); }
  __syncthreads();
  f32x2 S = {0.f, 0.f};
  const int seg = lane & 31, rloc = wave * 2 + (lane >> 5);
#define RS_YOUT(cc) do { const bf16* yp_ = ybuf + ((cc) & 1) * RS_YBUF + lt * RS_YP; float t_ = 0.f; \
    _Pragma("unroll") for (int j_ = 0; j_ < 4; ++j_) { float f_[8]; unpack8(*(const u32x4*)(yp_ + 8 * j_), f_); t_ += ((f_[0] + f_[1]) + (f_[2] + f_[3])) + ((f_[4] + f_[5]) + (f_[6] + f_[7])); } \
    Y[((size_t)b * SEQ + (cc) * RS_CH + (lt >> 3)) * G + h * 64 + rq * RS_ROWS + (lt & 7)] = t_; } while (0)
  for (int c = 0; c < NCH; ++c) {
    if (wave >= 4) {
      if (c + 1 < NCH) rs_commit(rg, bufs + ((c + 1) & 1) * RS_BUFB, lt);
      if (c + 2 < NCH) rs_issue(p, rg, b, h, rq, c + 2, lt);
      if (c > 0) RS_YOUT(c - 1);
    } else {
      const unsigned char* bp = bufs + (c & 1) * RS_BUFB; bf16* yb = ybuf + (c & 1) * RS_YBUF + rloc * RS_YP + seg;
      const unsigned char* pw = bp + seg * 8; const unsigned char* pa = bp + 256 + seg * 16; const unsigned char* pv = bp + 768 + rloc * 16;
      f32x2 nw = *(const f32x2*)(pw); u32x4 nq = *(const u32x4*)(pa); f32x4 nvs = *(const f32x4*)(pv);
#pragma unroll 8
      for (int s = 0; s < RS_CH; ++s) {
        const f32x2 w = nw, a = bf2x(nq.x), bb = bf2x(nq.y), kk = bf2x(nq.z), wr = bf2x(nq.w); const float v = nvs[0], br = nvs[1], kr = nvs[2];
        if (s + 1 < RS_CH) { const int o = (s + 1) * RS_TSB; nw = *(const f32x2*)(pw + o); nq = *(const u32x4*)(pa + o); nvs = *(const f32x4*)(pv + o); }
        const f32x2 pda = S * a, pdy = S * wr;
        const f32x2 vv = {v, v};
        const f32x2 u = S * w + vv * kk;
        const float t0 = v * kr + (pdy[0] + pdy[1]);
        const float da = row32_sum(pda[0] + pda[1]);
        const f32x2 dd = {da, da};
        S = dd * bb + u;
        yb[s * (RS_ROWS * RS_YP)] = (bf16)(__builtin_bit_cast(unsigned, da * br + t0) >> 16);
      }
    }
    LDS_BARRIER();
  }
  if (wave >= 4) RS_YOUT(NCH - 1);
  __syncthreads();
#undef RS_YOUT
}
__device__ __forceinline__ void rwkv_post_row(const Params& p, int l, int row, int lane) {
  asm volatile("" ::: "memory");
  asm volatile("" : "+v"(lane));
  unsigned char* ws = p.ws;
  const f32x4 y = ((const f32x4*)((const float*)(ws + RW_Y) + (size_t)row * G))[lane];
  float s = y[0] + y[1] + y[2] + y[3];
  s += __shfl_xor(s, 1); s += __shfl_xor(s, 2); s += __shfl_xor(s, 4); s += __shfl_xor(s, 8);
  const float mu = s * (1.f / 64.f); const f32x4 d = y - mu;
  float q = d[0] * d[0] + d[1] * d[1] + d[2] * d[2] + d[3] * d[3];
  q += __shfl_xor(q, 1); q += __shfl_xor(q, 2); q += __shfl_xor(q, 4); q += __shfl_xor(q, 8);
  const float rstd = rsqrtf(q * (1.f / 64.f) + 64e-5f);
  const f32x4 gw = ((const f32x4*)(p.in[28] + (size_t)l * G))[lane], gb = ((const f32x4*)(p.in[29] + (size_t)l * G))[lane];
  const u32x2 vv = ((const u32x2*)((const bf16*)(ws + RW_V) + (size_t)row * G))[lane], gg = ((const u32x2*)((const bf16*)(ws + RW_G) + (size_t)row * G))[lane];
  const float rk = ((const float*)(ws + SM_RK))[(size_t)row * 4 + (lane >> 4)];
  const float v[4] = {bflo(vv.x), bfhi(vv.x), bflo(vv.y), bfhi(vv.y)}, gt[4] = {bflo(gg.x), bfhi(gg.x), bflo(gg.y), bfhi(gg.y)};
  float o[4];
#pragma unroll
  for (int e = 0; e < 4; ++e) o[e] = (d[e] * rstd * gw[e] + gb[e] + rk * v[e]) * gt[e];
  u32x2 w; w.x = pk2(o[0], o[1]); w.y = pk2(o[2], o[3]);
  ((u32x2*)((bf16*)(ws + WS_P) + (size_t)row * PW + C_RWR))[lane] = w;
}

__device__ __forceinline__ void lru_unit(const Params& p, int l, float* lds, int unit) {
  asm volatile("" ::: "memory");
  unsigned char* ws = p.ws; bf16* proj = (bf16*)(ws + WS_P);
  int tid = threadIdx.x; asm volatile("" : "+v"(tid)); const int wave = __builtin_amdgcn_readfirstlane(tid >> 6), lane = tid & 63, li = lane & 15, g = lane >> 4;
  const int b = unit >> 2, h = unit & 3;
  float* XB = lds;
  float* XC = XB + 67 * 64;
  float* AA = XC + 64 * 65;
  float* UU = AA + 64 * 65;
  float* HH = UU + 64 * 65;
  bf16* XCb = (bf16*)(HH + 64 * 65);
  const float* cw = p.in[12] + (size_t)l * 4 * G + h * 64; const float* cb = p.in[13] + (size_t)l * G + h * 64;
  const float* rab = p.in[15] + (size_t)l * G + h * 64; const float* rib = p.in[17] + (size_t)l * G + h * 64; const float* lam = p.in[18] + (size_t)l * G + h * 64;
  const int mt = wave & 3, ntp = wave >> 2;
  bf16x8 br_[2][2], bi_[2][2]; float lsl[2], rb[2], ib[2];
  { const bf16* rat = (const bf16*)(ws + WS_RAT) + h * 4096; const bf16* rit = (const bf16*)(ws + WS_RIT) + h * 4096;
#pragma unroll
    for (int n = 0; n < 2; ++n) { const int col = (2 * ntp + n) * 16 + li; lsl[n] = log_sigmoid_acc(lam[col]); rb[n] = rab[col]; ib[n] = rib[col];
#pragma unroll
      for (int ks = 0; ks < 2; ++ks) { br_[n][ks] = *(const bf16x8*)(rat + col * 64 + ks * 32 + 8 * g); bi_[n][ks] = *(const bf16x8*)(rit + col * 64 + ks * 32 + 8 * g); } } }
  float hcur = 0.f;
  const int tok = tid >> 3, ch8 = (tid & 7) * 8;
  u32x4 nx0 = {0u, 0u, 0u, 0u}, nx1 = {0u, 0u, 0u, 0u}, ny;
  const int r1 = (tid + NTHREADS) >> 3;
  { const int pos0 = -3 + tok; if (pos0 >= 0) nx0 = *(const u32x4*)(proj + ((size_t)b * SEQ + pos0) * PW + C_LRUX + h * 64 + ch8);
    if (tid < 24) nx1 = *(const u32x4*)(proj + ((size_t)b * SEQ + (-3 + r1)) * PW + C_LRUX + h * 64 + ch8);
    ny = *(const u32x4*)(proj + ((size_t)b * SEQ + tok) * PW + C_LRUY + h * 64 + ch8); }
  for (int c = 0; c < SEQ / 64; ++c) {
    const int t0 = c * 64;
    { float f8[8]; unpack8(nx0, f8);
#pragma unroll
      for (int e = 0; e < 8; ++e) XB[tok * 64 + ch8 + e] = f8[e];
      if (tid < 24) { unpack8(nx1, f8);
#pragma unroll
        for (int e = 0; e < 8; ++e) XB[r1 * 64 + ch8 + e] = f8[e]; } }
    const u32x4 ycur = ny;
    if (c + 1 < SEQ / 64) { const int tn = t0 + 64;
      nx0 = *(const u32x4*)(proj + ((size_t)b * SEQ + tn - 3 + tok) * PW + C_LRUX + h * 64 + ch8);
      if (tid < 24) nx1 = *(const u32x4*)(proj + ((size_t)b * SEQ + tn - 3 + r1) * PW + C_LRUX + h * 64 + ch8);
      ny = *(const u32x4*)(proj + ((size_t)b * SEQ + tn + tok) * PW + C_LRUY + h * 64 + ch8); }
    LDS_BARRIER();
    { float xc[8];
#pragma unroll
      for (int e = 0; e < 8; ++e) { float v = cb[ch8 + e];
#pragma unroll
        for (int j = 0; j < 4; ++j) v += XB[(tok + j) * 64 + ch8 + e] * cw[j * G + ch8 + e];
        xc[e] = v; XC[tok * 65 + ch8 + e] = v; }
      *(u32x4*)(XCb + tok * 72 + ch8) = pack8(xc); }
    LDS_BARRIER();
    { bf16x8 af[2];
#pragma unroll
      for (int ks = 0; ks < 2; ++ks) af[ks] = *(const bf16x8*)(XCb + (mt * 16 + li) * 72 + ks * 32 + 8 * g);
#pragma unroll
      for (int n = 0; n < 2; ++n) { f32x4 cr = {0.f, 0.f, 0.f, 0.f}, ci = {0.f, 0.f, 0.f, 0.f};
#pragma unroll
        for (int ks = 0; ks < 2; ++ks) { cr = MFMA16(af[ks], br_[n][ks], cr); ci = MFMA16(af[ks], bi_[n][ks], ci); }
        const int col = (2 * ntp + n) * 16 + li;
#pragma unroll
        for (int j = 0; j < 4; ++j) { const int tk = mt * 16 + 4 * g + j; const float r = sigmoidf_(cr[j] + rb[n]), ig = sigmoidf_(ci[j] + ib[n]);
          const float log_a = 8.f * r * lsl[n]; const float a = __expf(log_a); const float mult = sqrtf(fmaxf(1.f - a * a, 0.f));
          AA[tk * 65 + col] = a; UU[tk * 65 + col] = mult * (ig * XC[tk * 65 + col]); } } }
    LDS_BARRIER();
    if (wave == 0) {
#pragma unroll 8
      for (int s = 0; s < 64; ++s) { hcur = AA[s * 65 + lane] * hcur + UU[s * 65 + lane]; HH[s * 65 + lane] = hcur; } }
    LDS_BARRIER();
    { bf16* yp = proj + ((size_t)b * SEQ + t0 + tok) * PW + C_LRUY + h * 64 + ch8; float y[8]; unpack8(ycur, y);
#pragma unroll
      for (int e = 0; e < 8; ++e) y[e] = HH[tok * 65 + ch8 + e] * gelu_tanh(y[e]);
      *(u32x4*)yp = pack8(y); }
  }
  __syncthreads();
}

constexpr int KS_P = 72, VS_P = 136;
constexpr int AT_KS = 0, AT_VS = 128 * KS_P * 2, AT_CS = AT_VS + 64 * VS_P * 2, AT_BUF = AT_CS + 512;
struct AtRegs { u32x4 k0, k1, v0, v1; float c; };
__device__ __forceinline__ void at_issue(AtRegs& r, const bf16* Kg  , const bf16* VTg  , const float* cumg, int tid) {
  { const int id = tid, row = id >> 3, ch = id & 7; r.k0 = *(const u32x4*)(Kg + (size_t)row * PW + ch * 8); }
  { const int id = tid + 512, row = id >> 3, ch = id & 7; r.k1 = *(const u32x4*)(Kg + (size_t)row * PW + ch * 8); }
  { const int id = tid, row = id >> 4, ch = id & 15; r.v0 = *(const u32x4*)(VTg + (size_t)row * SEQ + ch * 8); }
  { const int id = tid + 512, row = id >> 4, ch = id & 15; r.v1 = *(const u32x4*)(VTg + (size_t)row * SEQ + ch * 8); }
  r.c = (cumg && tid < 128) ? -cumg[tid] : 0.f;
}
__device__ __forceinline__ void at_commit(const AtRegs& r, unsigned char* buf, int tid) {
  bf16* Ks = (bf16*)(buf + AT_KS); bf16* Vs = (bf16*)(buf + AT_VS); float* Cs = (float*)(buf + AT_CS);
  { const int id = tid, row = id >> 3, ch = id & 7; *(u32x4*)(Ks + row * KS_P + ch * 8) = r.k0; }
  { const int id = tid + 512, row = id >> 3, ch = id & 7; *(u32x4*)(Ks + row * KS_P + ch * 8) = r.k1; }
  { const int id = tid, row = id >> 4, ch = id & 15; *(u32x4*)(Vs + row * VS_P + ch * 8) = r.v0; }
  { const int id = tid + 512, row = id >> 4, ch = id & 15; *(u32x4*)(Vs + row * VS_P + ch * 8) = r.v1; }
  if (tid < 128) Cs[tid] = r.c;
}
__device__ __forceinline__ bf16x8 vfrag(const bf16* Vs, int d, int key0, int g) {
  const u32x2 lo = *(const u32x2*)(Vs + d * VS_P + key0 + 4 * g), hi = *(const u32x2*)(Vs + d * VS_P + key0 + 16 + 4 * g);
  const u32x4 w = {lo.x, lo.y, hi.x, hi.y}; return __builtin_bit_cast(bf16x8, w);
}
__device__ __forceinline__ float grp4_max(float x) {
  const auto a = __builtin_amdgcn_permlane16_swap(__builtin_bit_cast(unsigned, x), __builtin_bit_cast(unsigned, x), false, false);
  x = fmaxf(__builtin_bit_cast(float, (unsigned)a[0]), __builtin_bit_cast(float, (unsigned)a[1]));
  const auto b = __builtin_amdgcn_permlane32_swap(__builtin_bit_cast(unsigned, x), __builtin_bit_cast(unsigned, x), false, false);
  return fmaxf(__builtin_bit_cast(float, (unsigned)b[0]), __builtin_bit_cast(float, (unsigned)b[1]));
}
__device__ __forceinline__ float grp4_sum(float x) {
  const auto a = __builtin_amdgcn_permlane16_swap(__builtin_bit_cast(unsigned, x), __builtin_bit_cast(unsigned, x), false, false);
  x = __builtin_bit_cast(float, (unsigned)a[0]) + __builtin_bit_cast(float, (unsigned)a[1]);
  const auto b = __builtin_amdgcn_permlane32_swap(__builtin_bit_cast(unsigned, x), __builtin_bit_cast(unsigned, x), false, false);
  return __builtin_bit_cast(float, (unsigned)b[0]) + __builtin_bit_cast(float, (unsigned)b[1]);
}
__device__ __forceinline__ void fox_unit(const Params& p, unsigned char* lds, int b, int h, int qb) {
  asm volatile("" ::: "memory");
  unsigned char* ws = p.ws; bf16* proj = (bf16*)(ws + WS_P);
  int tid = threadIdx.x; asm volatile("" : "+v"(tid)); const int wave = __builtin_amdgcn_readfirstlane(tid >> 6), lane = tid & 63, li = lane & 15, g = lane >> 4;
  const int bh = b * 4 + h; const int qrel = wave * 16 + li; const size_t qrow = (size_t)b * SEQ + qb * 128 + qrel;
  const float* cum = (const float*)(ws + SM_CUM) + (size_t)bh * SEQ;
  const bf16* Kbase = proj + (size_t)b * SEQ * PW + C_FOXK + h * 64; const bf16* VTbase = (const bf16*)(ws + P_FOXVT) + (size_t)bh * 64 * SEQ;
  bf16x8 qf[2];
#pragma unroll
  for (int ks = 0; ks < 2; ++ks) qf[ks] = *(const bf16x8*)(proj + qrow * PW + C_FOXQ + h * 64 + ks * 32 + 8 * g);
  const float SC = 0.125f * LOG2E;
  f32x4 o[4];
#pragma unroll
  for (int dt = 0; dt < 4; ++dt) o[dt] = (f32x4){0.f, 0.f, 0.f, 0.f};
  float m = -INFINITY, lsum = 0.f;
  AtRegs rg; at_issue(rg, Kbase, VTbase, cum, tid);
  __syncthreads();
  at_commit(rg, lds, tid);
  if (qb > 0) at_issue(rg, Kbase + (size_t)128 * PW, VTbase + 128, cum + 128, tid);
  LDS_BARRIER();
  for (int kb = 0; kb <= qb; ++kb) {
    unsigned char* buf = lds + (kb & 1) * AT_BUF; const bf16* Ks = (const bf16*)(buf + AT_KS); const bf16* Vs = (const bf16*)(buf + AT_VS); const float* Cs = (const float*)(buf + AT_CS);
    const bool diag = kb == qb; const int nst = diag ? (wave >> 1) + 1 : 4;
    for (int st = 0; st < nst; ++st) {
      f32x4 s0 = {0.f, 0.f, 0.f, 0.f}, s1 = {0.f, 0.f, 0.f, 0.f};
#pragma unroll
      for (int ks = 0; ks < 2; ++ks) { const bf16x8 a0 = *(const bf16x8*)(Ks + (st * 32 + li) * KS_P + ks * 32 + 8 * g), a1 = *(const bf16x8*)(Ks + (st * 32 + 16 + li) * KS_P + ks * 32 + 8 * g);
        s0 = MFMA16(a0, qf[ks], s0); s1 = MFMA16(a1, qf[ks], s1); }
      const f32x4 c0 = *(const f32x4*)(Cs + st * 32 + 4 * g), c1 = *(const f32x4*)(Cs + st * 32 + 16 + 4 * g);
      float x[8];
#pragma unroll
      for (int j = 0; j < 4; ++j) { x[j] = s0[j] * SC + c0[j]; x[4 + j] = s1[j] * SC + c1[j]; }
      if (diag) {
#pragma unroll
        for (int j = 0; j < 4; ++j) { if (st * 32 + 4 * g + j > qrel) x[j] = -INFINITY; if (st * 32 + 16 + 4 * g + j > qrel) x[4 + j] = -INFINITY; }
      }
      float mx = fmaxf(fmaxf(fmaxf(x[0], x[1]), fmaxf(x[2], x[3])), fmaxf(fmaxf(x[4], x[5]), fmaxf(x[6], x[7])));
      mx = grp4_max(mx);
      const float mn = fmaxf(m, mx);
      const bool grew = __any(mn > m);
      float ps = 0.f;
#pragma unroll
      for (int j = 0; j < 8; ++j) { x[j] = ex2(x[j] - mn); ps += x[j]; }
      if (grew) { const float f = ex2(m - mn); lsum *= f;
#pragma unroll
        for (int dt = 0; dt < 4; ++dt) o[dt] = o[dt] * f;
        m = mn; }
      lsum += ps;
      const bf16x8 pb = pack_frag(x);
#pragma unroll
      for (int dt = 0; dt < 4; ++dt) o[dt] = MFMA16(vfrag(Vs, dt * 16 + li, st * 32, g), pb, o[dt]);
    }
    if (kb < qb) {
      at_commit(rg, lds + ((kb + 1) & 1) * AT_BUF, tid);
      if (kb + 2 <= qb) at_issue(rg, Kbase + (size_t)(kb + 2) * 128 * PW, VTbase + (kb + 2) * 128, cum + (kb + 2) * 128, tid);
      LDS_BARRIER();
    }
  }
  lsum = grp4_sum(lsum);
  const float inv = 1.f / lsum;
#pragma unroll
  for (int dt = 0; dt < 4; ++dt) { u32x2 w; w.x = pk2(o[dt][0] * inv, o[dt][1] * inv); w.y = pk2(o[dt][2] * inv, o[dt][3] * inv);
    *(u32x2*)(proj + qrow * PW + C_FOXQ + h * 64 + dt * 16 + 4 * g) = w; }
}
__device__ __forceinline__ void ret_unit(const Params& p, int l, unsigned char* lds, int b, int h, int c) {
  asm volatile("" ::: "memory");
  unsigned char* ws = p.ws; bf16* proj = (bf16*)(ws + WS_P);
  int tid = threadIdx.x; asm volatile("" : "+v"(tid)); const int wave = __builtin_amdgcn_readfirstlane(tid >> 6), lane = tid & 63, li = lane & 15, g = lane >> 4;
  const int bh = b * 4 + h; const int nrel = wave * 16 + li; const size_t qrow = (size_t)b * SEQ + c * 128 + nrel;
  const float lg2 = log2f(1.f - exp2f(-5.f - (float)h));
  bf16* RT = (bf16*)(lds + 2 * AT_BUF);
  AtRegs rg; at_issue(rg, proj + ((size_t)b * SEQ + c * 128) * PW + C_RETK + h * 64, (const bf16*)(ws + P_RETVT) + (size_t)bh * 64 * SEQ + c * 128, nullptr, tid);
  { const float cd = ex2(lg2 * 128.f); const float* KV = (const float*)(ws + P_RETKV) + (size_t)bh * 32 * 4096 + (tid >> 3) * 64 + (tid & 7) * 8;
    f32x4 a0 = {0.f, 0.f, 0.f, 0.f}, a1 = {0.f, 0.f, 0.f, 0.f};
    int cc = 0;
    for (; cc + 4 <= c; cc += 4) { f32x4 k0[4], k1[4];
#pragma unroll
      for (int u = 0; u < 4; ++u) { k0[u] = *(const f32x4*)(KV + (size_t)(cc + u) * 4096); k1[u] = *(const f32x4*)(KV + (size_t)(cc + u) * 4096 + 4); }
#pragma unroll
      for (int u = 0; u < 4; ++u) { a0 = a0 * cd + k0[u]; a1 = a1 * cd + k1[u]; } }
    for (; cc < c; ++cc) { const f32x4 k0 = *(const f32x4*)(KV + (size_t)cc * 4096), k1 = *(const f32x4*)(KV + (size_t)cc * 4096 + 4); a0 = a0 * cd + k0; a1 = a1 * cd + k1; }
    __syncthreads();
    const int d = tid >> 3, e0 = (tid & 7) * 8;
#pragma unroll
    for (int e = 0; e < 4; ++e) { RT[(e0 + e) * KS_P + d] = (bf16)f2bf(a0[e]); RT[(e0 + 4 + e) * KS_P + d] = (bf16)f2bf(a1[e]); } }
  at_commit(rg, lds, tid);
  bf16x8 qf[2];
#pragma unroll
  for (int ks = 0; ks < 2; ++ks) qf[ks] = *(const bf16x8*)(proj + qrow * PW + C_RETQ + h * 64 + ks * 32 + 8 * g);
  __syncthreads();
  const bf16* Ks = (const bf16*)(lds + AT_KS); const bf16* Vs = (const bf16*)(lds + AT_VS);
  f32x4 o[4], cr[4];
#pragma unroll
  for (int et = 0; et < 4; ++et) { o[et] = (f32x4){0.f, 0.f, 0.f, 0.f}; cr[et] = (f32x4){0.f, 0.f, 0.f, 0.f};
#pragma unroll
    for (int ks = 0; ks < 2; ++ks) cr[et] = MFMA16(*(const bf16x8*)(RT + (et * 16 + li) * KS_P + ks * 32 + 8 * g), qf[ks], cr[et]); }
  const int nst = (wave >> 1) + 1;
  for (int st = 0; st < nst; ++st) {
    f32x4 s0 = {0.f, 0.f, 0.f, 0.f}, s1 = {0.f, 0.f, 0.f, 0.f};
#pragma unroll
    for (int ks = 0; ks < 2; ++ks) { const bf16x8 a0 = *(const bf16x8*)(Ks + (st * 32 + li) * KS_P + ks * 32 + 8 * g), a1 = *(const bf16x8*)(Ks + (st * 32 + 16 + li) * KS_P + ks * 32 + 8 * g);
      s0 = MFMA16(a0, qf[ks], s0); s1 = MFMA16(a1, qf[ks], s1); }
    float x[8];
#pragma unroll
    for (int j = 0; j < 4; ++j) { const int m0 = st * 32 + 4 * g + j, m1 = m0 + 16;
      x[j] = (m0 <= nrel) ? s0[j] * ex2(lg2 * (float)(nrel - m0)) : 0.f; x[4 + j] = (m1 <= nrel) ? s1[j] * ex2(lg2 * (float)(nrel - m1)) : 0.f; }
    const bf16x8 pb = pack_frag(x);
#pragma unroll
    for (int et = 0; et < 4; ++et) o[et] = MFMA16(vfrag(Vs, et * 16 + li, st * 32, g), pb, o[et]);
  }
  const float xi = ex2(lg2 * (float)(nrel + 1));
  float ss = 0.f;
#pragma unroll
  for (int et = 0; et < 4; ++et)
#pragma unroll
    for (int j = 0; j < 4; ++j) { o[et][j] += xi * cr[et][j]; ss += o[et][j] * o[et][j]; }
  ss += __shfl_xor(ss, 16); ss += __shfl_xor(ss, 32);
  const float rs = rsqrtf(ss * (1.f / 64.f) + EPS);
  const float* gnw = p.in[33] + (size_t)l * G + h * 64;
#pragma unroll
  for (int et = 0; et < 4; ++et) { const int e0 = et * 16 + 4 * g;
    const u32x2 gg = *(const u32x2*)(proj + qrow * PW + C_RETG + h * 64 + e0); const float gt[4] = {bflo(gg.x), bfhi(gg.x), bflo(gg.y), bfhi(gg.y)};
    float r[4];
#pragma unroll
    for (int j = 0; j < 4; ++j) r[j] = o[et][j] * rs * gnw[e0 + j] * (gt[j] * sigmoidf_(gt[j]));
    u32x2 w; w.x = pk2(r[0], r[1]); w.y = pk2(r[2], r[3]);
    *(u32x2*)(proj + qrow * PW + C_RETQ + h * 64 + e0) = w; }
}

constexpr int XP = 264;
__device__ __forceinline__ void xattn_unit(const Params& p, int l, unsigned char* lds, int unit) {
  asm volatile("" ::: "memory");
  unsigned char* ws = p.ws; bf16* qb = (bf16*)(ws + WS_P);
  int tid = threadIdx.x; asm volatile("" : "+v"(tid)); const int wave = __builtin_amdgcn_readfirstlane(tid >> 6), lane = tid & 63, li = lane & 15, g = lane >> 4;
  const int b = unit >> 6, head = (unit >> 4) & 3, qt = unit & 15;
  bf16* L = (bf16*)lds;
  const bf16* kg = (const bf16*)(ws + WS_KM) + ((size_t)l * 1024 + b * 256) * 1024 + head * 256;
  const bf16* vg = (const bf16*)(ws + WS_VMT) + (size_t)(((l * 4 + b) * 4 + head) * 256) * 256;
  __syncthreads();
#pragma unroll
  for (int i0 = 0; i0 < 16; i0 += 8) { u32x4 t[8];
#pragma unroll
    for (int i = 0; i < 8; ++i) { const int id = tid + 512 * (i0 + i), row = id >> 5, ch = id & 31; t[i] = *(const u32x4*)(kg + (size_t)row * 1024 + ch * 8); }
#pragma unroll
    for (int i = 0; i < 8; ++i) { const int id = tid + 512 * (i0 + i), row = id >> 5, ch = id & 31; *(u32x4*)(L + row * XP + ch * 8) = t[i]; } }
  __syncthreads();
  bf16x8 pb[2][8]; float linv[2];
  const float SC = LOG2E / 16.f;
#pragma unroll
  for (int grp = 0; grp < 2; ++grp) {
    const size_t row = (size_t)b * SEQ + qt * 256 + wave * 32 + grp * 16 + li;
    bf16x8 qf[8];
#pragma unroll
    for (int ks = 0; ks < 8; ++ks) qf[ks] = *(const bf16x8*)(qb + row * 1024 + head * 256 + ks * 32 + 8 * g);
    f32x4 s[16];
#pragma unroll
    for (int kt = 0; kt < 16; ++kt) { s[kt] = (f32x4){0.f, 0.f, 0.f, 0.f};
#pragma unroll
      for (int ks = 0; ks < 8; ++ks) s[kt] = MFMA16(*(const bf16x8*)(L + (kt * 16 + li) * XP + ks * 32 + 8 * g), qf[ks], s[kt]);
      if ((kt & 1) == 1) __builtin_amdgcn_sched_barrier(0); }
    float mx = -INFINITY;
#pragma unroll
    for (int kt = 0; kt < 16; ++kt) mx = fmaxf(mx, fmaxf(fmaxf(s[kt][0], s[kt][1]), fmaxf(s[kt][2], s[kt][3])));
    mx = fmaxf(mx, __shfl_xor(mx, 16)); mx = fmaxf(mx, __shfl_xor(mx, 32));
    float ps = 0.f;
#pragma unroll
    for (int kt = 0; kt < 16; ++kt)
#pragma unroll
      for (int j = 0; j < 4; ++j) { s[kt][j] = ex2((s[kt][j] - mx) * SC); ps += s[kt][j]; }
    ps += __shfl_xor(ps, 16); ps += __shfl_xor(ps, 32);
    linv[grp] = 1.f / ps;
#pragma unroll
    for (int kk = 0; kk < 8; ++kk) { float x[8];
#pragma unroll
      for (int j = 0; j < 4; ++j) { x[j] = s[2 * kk][j]; x[4 + j] = s[2 * kk + 1][j]; }
      pb[grp][kk] = pack_frag(x); }
    __builtin_amdgcn_sched_barrier(0);
  }
  __syncthreads();
#pragma unroll
  for (int i0 = 0; i0 < 16; i0 += 8) { u32x4 t[8];
#pragma unroll
    for (int i = 0; i < 8; ++i) { const int id = tid + 512 * (i0 + i), row = id >> 5, ch = id & 31; t[i] = *(const u32x4*)(vg + (size_t)row * 256 + ch * 8); }
#pragma unroll
    for (int i = 0; i < 8; ++i) { const int id = tid + 512 * (i0 + i), row = id >> 5, ch = id & 31; *(u32x4*)(L + row * XP + ch * 8) = t[i]; } }
  __syncthreads();
#pragma unroll
  for (int grp = 0; grp < 2; ++grp) {
    const size_t row = (size_t)b * SEQ + qt * 256 + wave * 32 + grp * 16 + li;
#pragma unroll
    for (int dt = 0; dt < 16; ++dt) { f32x4 o = {0.f, 0.f, 0.f, 0.f};
#pragma unroll
      for (int kk = 0; kk < 8; ++kk) { const u32x2 lo = *(const u32x2*)(L + (dt * 16 + li) * XP + kk * 32 + 4 * g), hi = *(const u32x2*)(L + (dt * 16 + li) * XP + kk * 32 + 16 + 4 * g);
        const u32x4 w = {lo.x, lo.y, hi.x, hi.y}; o = MFMA16(__builtin_bit_cast(bf16x8, w), pb[grp][kk], o); }
      u32x2 w; w.x = pk2(o[0] * linv[grp], o[1] * linv[grp]); w.y = pk2(o[2] * linv[grp], o[3] * linv[grp]);
      *(u32x2*)(qb + row * 1024 + head * 256 + dt * 16 + 4 * g) = w;
      __builtin_amdgcn_sched_barrier(0); }
  }
}

#define LAS __attribute__((address_space(3)))
#define XB_TMO      128
#define XB_XCNT(j)  (256  + 64 * (j))
#define XB_XSUB(j)  (1280 + 64 * (j))
#define XB_XGEN(j)  (2304 + 64 * (j))
#define XB_TOP      3328
#define XB_TOPGEN   3392
#define XCD_BAR_WORDS 3456
#define XB_SPIN_CAP (1u << 18)

__device__ __forceinline__ unsigned xb_ld(unsigned* p)              { return __hip_atomic_load(p, __ATOMIC_RELAXED, __HIP_MEMORY_SCOPE_AGENT); }
__device__ __forceinline__ unsigned xb_add(unsigned* p, unsigned v) { return __hip_atomic_fetch_add(p, v, __ATOMIC_RELAXED, __HIP_MEMORY_SCOPE_AGENT); }
__device__ __forceinline__ unsigned xb_xcc_id() { return (unsigned)__builtin_amdgcn_s_getreg((3 << 11) | 20) & 0xFu; }
#define XB_SPIN(cond, bar) do { unsigned _sp = 0; while (cond) { __builtin_amdgcn_s_sleep(1); \
    if ((++_sp & 255u) == 0u) { if (xb_ld(&(bar)[XB_TMO])) break; if (_sp > XB_SPIN_CAP) { atomicAdd(&(bar)[XB_TMO], 1u); break; } } } } while (0)

struct XcdBarrier {
    unsigned* bar; unsigned x;
    volatile LAS unsigned* st;
};

__device__ __forceinline__ XcdBarrier xcd_barrier_post(unsigned* bar, volatile LAS unsigned* st) {
    XcdBarrier b; b.bar = bar; b.x = xb_xcc_id(); b.st = st;
    if (threadIdx.x == 0) (void)xb_add(&bar[XB_XCNT(b.x)], 1u);
    return b;
}
__device__ __forceinline__ void xcd_barrier_complete(unsigned* bar, unsigned x, unsigned& nloc, unsigned& nx) {
    const unsigned G = gridDim.x * gridDim.y * gridDim.z;
    unsigned sum, cnt, mine, sp = 0u;
    for (;;) {
        sum = 0u; cnt = 0u; mine = 0u;
#pragma unroll
        for (unsigned j = 0; j < 16; ++j) { const unsigned c = xb_ld(&bar[XB_XCNT(j)]); sum += c; cnt += (c > 0u) ? 1u : 0u; mine = (j == x) ? c : mine; }
        if (sum == G) break;
        __builtin_amdgcn_s_sleep(1);
        if ((++sp & 255u) == 0u) { if (xb_ld(&bar[XB_TMO])) break; if (sp > XB_SPIN_CAP) { atomicAdd(&bar[XB_TMO], 1u); break; } }
    }
    nloc = mine > 0u ? mine : 1u; nx = cnt > 0u ? cnt : 1u;
}

__device__ __forceinline__ void xcd_barrier(const XcdBarrier& b) {
    asm volatile("s_waitcnt vmcnt(0)" ::: "memory");
    __syncthreads();
    if (threadIdx.x == 0) {
        unsigned* bar = b.bar;
        __builtin_amdgcn_s_waitcnt(0);
        unsigned nloc = b.st[0], nx = b.st[1];
        if (nloc == 0u) { xcd_barrier_complete(bar, b.x, nloc, nx); b.st[0] = nloc; b.st[1] = nx; }
        const unsigned old = xb_add(&bar[XB_XSUB(b.x)], 1u);
        const unsigned gen = old / nloc;
        if (old + 1u == (gen + 1u) * nloc) {
            __builtin_amdgcn_fence(__ATOMIC_RELEASE, "agent");
            asm volatile("s_waitcnt vmcnt(0)" ::: "memory");
            const unsigned og = xb_add(&bar[XB_TOP], 1u);
            const unsigned tg = og / nx;
            if (og + 1u == (tg + 1u) * nx) xb_add(&bar[XB_TOPGEN], 1u);
            else XB_SPIN(xb_ld(&bar[XB_TOPGEN]) == tg, bar);
            __builtin_amdgcn_fence(__ATOMIC_ACQUIRE, "agent");
            xb_add(&bar[XB_XGEN(b.x)], 1u);
            asm volatile("s_waitcnt vmcnt(0)" ::: "memory");
        } else {
            XB_SPIN(xb_ld(&bar[XB_XGEN(b.x)]) == gen, bar);
            __builtin_amdgcn_fence(__ATOMIC_ACQUIRE, "agent");
            asm volatile("s_waitcnt vmcnt(0)" ::: "memory");
        }
    }
    __syncthreads();
}


#ifndef DEBUG_LAUNCHES
#define DEBUG_LAUNCHES 0
#endif
constexpr int PH_PER_LAYER = 13, N_PHASES = 1 + PH_PER_LAYER * DEPTH;

__global__ void __launch_bounds__(NTHREADS) mega_fwd(Params p) {
  extern __shared__ __attribute__((aligned(16))) unsigned char lds[];
  cg::grid_group grid = cg::this_grid();
  constexpr int NB = 256, NGW = NB * NWAVES;
  unsigned char* ws = p.ws;
  PG8_LAS unsigned char* glds = (PG8_LAS unsigned char*)lds;
  bf16* Hb = (bf16*)(ws + WS_H); bf16* Ob = (bf16*)(ws + WS_O); bf16* Pb = (bf16*)(ws + WS_P);
  volatile LAS unsigned* xb_st = (volatile LAS unsigned*)((LAS unsigned char*)lds + (LDS_BYTES - 32));
  if (threadIdx.x == 0) { xb_st[0] = 0u; xb_st[1] = 0u; }
  __syncthreads();
  const XcdBarrier xbar = xcd_barrier_post((unsigned*)(ws + SM_BAR), xb_st);
  int ph = 0;
#ifdef DBG_CLR
#define DBG_LDSCLEAR { for (int e_ = threadIdx.x; e_ < LDS_BYTES / 4; e_ += NTHREADS) ((unsigned*)lds)[e_] = 0u; __syncthreads(); }
#else
#define DBG_LDSCLEAR
#endif
#define PHASE_BEGIN if (ph >= p.ph_lo && ph < p.ph_hi) { int tid = threadIdx.x; asm volatile("" : "+v"(tid)); const int lane = tid & 63, wave = __builtin_amdgcn_readfirstlane(tid >> 6), gw = blockIdx.x * NWAVES + wave; (void)lane; (void)gw; DBG_LDSCLEAR
#ifdef TS_PH
#define TS_REC if (blockIdx.x == 0 && threadIdx.x == 0) ((unsigned long long*)(ws + SM_Q + 256))[ph + 1] = __builtin_amdgcn_s_memrealtime();
#else
#define TS_REC
#endif
#define PHASE_END   if (ph + 1 < p.ph_hi) { if (p.ph_lo < 0) grid.sync();   else xcd_barrier(xbar); } TS_REC } ++ph;

  PHASE_BEGIN
    float* scr = (float*)lds + wave * (64 * 33);
    conv_layer_weights(p, 0, scr, gw, NGW, lane);
    { constexpr int I_SQ = (D / 64) * (D / 32);
      for (int it = gw; it < 4 * I_SQ; it += NGW) { const int w = it / I_SQ, r = it % I_SQ, layer = w >> 1, isv = w & 1;
        conv_item<0>(p.in[isv ? 36 : 35] + (size_t)layer * D * D, D, D, D, (bf16*)(ws + WS_WKV) + (size_t)w * D * D, scr, r, lane); } }
    for (int l = 0; l < DEPTH; ++l) { RowArgs a{}; a.xin = p.in[1]; a.g_pre = p.in[6] + (size_t)l * D; a.hout = (bf16*)(ws + WS_MEMN) + (size_t)l * 1024 * 1024; a.rows = 1024; row_phase(a, gw, NGW, lane); }
    { RowArgs a{}; a.xin = p.in[0]; a.g_pre = p.in[2]; a.hout = Hb; a.wf = p.in[9]; a.fbias = p.in[11]; a.logf = (float*)(ws + SM_LOGF); a.rows = T; row_phase(a, gw, NGW, lane); }
#ifdef DBG_FILLG
    for (int e = blockIdx.x * NTHREADS + tid; e < T * G / 2; e += NB * NTHREADS) ((unsigned*)(ws + RW_G))[e] = 0x447A447Au;
#endif
    for (int e = blockIdx.x * NTHREADS + tid; e < SEQ * 32; e += NB * NTHREADS) { const int pos = e >> 5, i = e & 31; const float inv = 1.f / powf(10000.f, (float)i / 31.f); const float ang = (float)pos * inv;
      ((float*)(ws + SM_ROT))[2 * e] = cosf(ang); ((float*)(ws + SM_ROT))[2 * e + 1] = sinf(ang); }
  PHASE_END

  for (int l = 0; l < DEPTH; ++l) {
    PHASE_BEGIN
      { pg8::Gemm g{Hb, (const bf16*)(ws + W_IN), T, NIN, D, D}; pg8::StaticOrder S; S.init(T, NIN, NB, (int)blockIdx.x);
        EpiIn E{Pb, (bf16*)(ws + P_FOXVT), (bf16*)(ws + P_RETKT), (bf16*)(ws + P_RETVT), (const float*)(ws + SM_ROT)};
        pg8::gemm_phase<EpiIn, pg8::StaticOrder, true, true>(glds, g, S, E); }
      if (l == 0) { pg8::Gemm g{(const bf16*)(ws + WS_MEMN), (const bf16*)(ws + WS_WKV), 2048, 4096, D, D}; MemSched S{NB, (int)blockIdx.x - 64};
        EpiMem E{(bf16*)(ws + WS_KM), (bf16*)(ws + WS_VMT)};
        pg8::gemm_phase<EpiMem, MemSched, true, true>(glds, g, S, E); }
    PHASE_END
    PHASE_BEGIN
      float* wl = (float*)lds + wave * (16 * WLP);
      for (int u = gw; u < 4096; u += NGW) rwkv_prep_unit(p, l, u >> 2, u & 3, wl, lane);
      for (int u = gw; u < 512; u += NGW) ret_kv_unit(p, u, lane);
      for (int u = gw; u < 16; u += NGW) fox_cum_unit(p, u, lane);
      if (blockIdx.x == 0 && tid == 0) *(int*)(ws + SM_Q) = 0;
    PHASE_END
    PHASE_BEGIN
#ifndef DBG_P3
#define DBG_P3 15
#endif
      if (blockIdx.x < 128) {
        const int bx_ = blockIdx.x, j_ = bx_ >> 3, su_ = ((2 * (bx_ & 7) + (j_ >> 3)) << 3) | (j_ & 7);
        if (DBG_P3 & 1) rwkv_scan_unit(p, lds, su_);
#ifdef REP_SCAN
        rwkv_scan_unit(p, lds, blockIdx.x);
#endif
      }
      else if (blockIdx.x < 144) { if (DBG_P3 & 2) lru_unit(p, l, (float*)lds, blockIdx.x - 128); }
      int* qword = (int*)(lds + LDS_BYTES - 16);
      for (;;) {
        __syncthreads();
        if (tid == 0) *qword = atomicAdd((int*)(ws + SM_Q), 1);
        __syncthreads();
        const int id = *qword;
        if (id >= 1024) break;
        if (id < 512) { if (DBG_P3 & 4) fox_unit(p, lds, (id & 15) >> 2, id & 3, 31 - (id >> 4)); }
        else if (DBG_P3 & 8) { const int r = id - 512; ret_unit(p, l, lds, r >> 7, (r >> 5) & 3, r & 31); }
      }
    PHASE_END
    PHASE_BEGIN
      for (int row = gw; row < T; row += NGW) rwkv_post_row(p, l, row, lane);
    PHASE_END
    PHASE_BEGIN
      pg8::Gemm g{Pb, (const bf16*)(ws + W_OUT), T, D, D, PW}; pg8::StaticOrder S; S.init(T, D, NB, (int)blockIdx.x);
      EpiPlain E{Ob, D, 0, nullptr};
      pg8::gemm_phase<EpiPlain, pg8::StaticOrder, true, true>(glds, g, S, E);
    PHASE_END
    PHASE_BEGIN
      RowArgs a{}; a.xin = l == 0 ? p.in[0] : p.out; a.O = Ob; a.g_post = p.in[3] + (size_t)l * D; a.xout = p.out; a.g_pre = p.in[4] + (size_t)l * D; a.hout = Hb; a.rows = T;
      row_phase(a, gw, NGW, lane);
    PHASE_END
    PHASE_BEGIN
      pg8::Gemm g{Hb, (const bf16*)(ws + W_Q), T, D, D, D}; pg8::StaticOrder S; S.init(T, D, NB, (int)blockIdx.x);
      EpiPlain E{Pb, D, 0, nullptr};
      pg8::gemm_phase<EpiPlain, pg8::StaticOrder, true, true>(glds, g, S, E);
    PHASE_END
    PHASE_BEGIN
      for (int u = blockIdx.x; u < 256; u += NB) xattn_unit(p, l, lds, u);
    PHASE_END
    PHASE_BEGIN
      pg8::Gemm g{Pb, (const bf16*)(ws + W_O), T, D, D, D}; pg8::StaticOrder S; S.init(T, D, NB, (int)blockIdx.x);
      EpiPlain E{Ob, D, 0, nullptr};
      pg8::gemm_phase<EpiPlain, pg8::StaticOrder, true, true>(glds, g, S, E);
    PHASE_END
    PHASE_BEGIN
      RowArgs a{}; a.xin = p.out; a.O = Ob; a.g_post = p.in[5] + (size_t)l * D; a.xout = p.out; a.g_pre = p.in[7] + (size_t)l * D; a.hout = Hb; a.rows = T;
      row_phase(a, gw, NGW, lane);
    PHASE_END
    PHASE_BEGIN
      pg8::Gemm g{Hb, (const bf16*)(ws + W_1), T, DFF, D, D}; pg8::StaticOrder S; S.init(T, DFF, NB, (int)blockIdx.x);
      EpiPlain E{Pb, DFF, 1, nullptr};
      pg8::gemm_phase<EpiPlain, pg8::StaticOrder, true, true>(glds, g, S, E);
    PHASE_END
    PHASE_BEGIN
      pg8::Gemm g{Pb, (const bf16*)(ws + W_2), T, D, DFF, DFF}; pg8::StaticOrder S; S.init(T, D, NB, (int)blockIdx.x);
      EpiPlain E{Ob, D, 0, nullptr};
      pg8::gemm_phase<EpiPlain, pg8::StaticOrder, true, true>(glds, g, S, E);
    PHASE_END
    PHASE_BEGIN
      RowArgs a{}; a.xin = p.out; a.O = Ob; a.g_post = p.in[8] + (size_t)l * D; a.xout = p.out; a.rows = T;
      if (l + 1 < DEPTH) { a.g_pre = p.in[2] + (size_t)(l + 1) * D; a.hout = Hb; a.wf = p.in[9] + (size_t)(l + 1) * D * INW; a.fbias = p.in[11] + (size_t)(l + 1) * GH; a.logf = (float*)(ws + SM_LOGF); }
      row_phase(a, gw, NGW, lane);
      if (l + 1 < DEPTH) { __syncthreads(); conv_layer_weights(p, l + 1, (float*)lds + wave * (64 * 33), gw, NGW, lane); }
    PHASE_END
  }
#ifdef TS_PH
  grid.sync();
  if (blockIdx.x == 0) { const unsigned long long* ts = (const unsigned long long*)(ws + SM_Q + 256);
#ifdef TS_CONST
    const float dt_us = TS_CONST;
#else
    const float dt_us = (float)(ts[TS_PH + 1] - ts[TS_PH]) * 0.01f;
#endif
    const float delta = 0.01f * sqrtf(dt_us);
    for (int r = threadIdx.x; r < T; r += NTHREADS) p.out[(size_t)r * D] += delta; }
#endif
}


#ifdef DBG_STOP
#ifndef DBG_MASK
#define DBG_MASK 15
#endif
__global__ void dbg_dump(const unsigned char* ws, float* out) {
  const size_t i = (size_t)blockIdx.x * 256 + threadIdx.x; const int row = (int)(i >> 10), c = (int)(i & 1023);
#ifndef DBG_SRC
#define DBG_SRC 0
#endif
#ifndef DBG_COFF
#define DBG_COFF 0
#endif
  const bf16* proj = (const bf16*)(ws + WS_P);
  if (DBG_SRC == 0) out[i] = ((DBG_MASK >> (c >> 8)) & 1) ? bflo((unsigned)proj[(size_t)row * PW + DBG_COFF + c]) : 0.f;
  else if (DBG_SRC == 1) { const bf16* a = (const bf16*)(ws + WS_RW) + (size_t)(c >> 8) * (8u << 19); out[i] = ((DBG_MASK >> (c >> 8)) & 1) ? bflo((unsigned)a[(size_t)row * G + (c & 255)]) : 0.f; }
  else if (DBG_SRC == 2) { const bf16* a = (const bf16*)(ws + RW_K) + (size_t)(c >> 8) * (8u << 19); float v = 0.f; if (c < 768) v = bflo((unsigned)a[(size_t)row * G + (c & 255)]); else if (c < 772) v = ((const float*)(ws + SM_BR))[row * 4 + (c & 3)]; else if (c < 776) v = ((const float*)(ws + SM_KR))[row * 4 + (c & 3)]; else if (c < 780) v = ((const float*)(ws + SM_RK))[row * 4 + (c & 3)];
    out[i] = ((DBG_MASK >> (c >> 8)) & 1) ? v : 0.f; }
  else if (DBG_SRC == 5) { out[i] = c < 256 ? bflo((unsigned)((const bf16*)(ws + RW_G))[(size_t)row * G + c]) : 0.f; }
  else if (DBG_SRC == 4) { out[i] = i < 512 * 1024 ? bflo((unsigned)((const bf16*)(ws + W_SMALL))[i]) : 0.f; }
  else { out[i] = c < 256 ? ((const float*)(ws + RW_Y))[(size_t)row * G + c] : 0.f; }
}
#endif

#ifdef DBG_GCHK
__global__ void dbg_snap(const unsigned char* ws, float* out) { const size_t i = (size_t)blockIdx.x * 256 + threadIdx.x; ((unsigned*)out)[i] = ((const unsigned*)(ws + RW_G))[i]; if (i == 0) *(unsigned*)(ws + SM_Q + 64) = 0u; }
__global__ void dbg_cmp(unsigned char* ws, const float* out) { const size_t i = (size_t)blockIdx.x * 256 + threadIdx.x; const unsigned a = ((const unsigned*)(ws + RW_G))[i], b = ((const unsigned*)out)[i];
  if (a != b) { unsigned f = 1u; if (a == 0x447A447Au) f |= 2u; else f |= 4u; atomicOr((unsigned*)(ws + SM_Q + 64), f); } }
__global__ void dbg_fin(const unsigned char* ws, float* out) { const size_t i = (size_t)blockIdx.x * 256 + threadIdx.x; out[i] = (i == 0) ? 1.0e6f * (float)(*(const unsigned*)(ws + SM_Q + 64)) : 0.f; }
#endif
extern "C" void kernel_launch(void* const* d_in, const int* in_sizes, int n_in, void* d_out, int out_size, void* d_ws, size_t ws_size, hipStream_t stream) {
  static int grid = 0;
  if (grid == 0) {
    if (ws_size < WS_END) { fprintf(stderr, "kernel_launch: workspace too small: %zu < %zu\n", ws_size, (size_t)WS_END); grid = -1; return; }
    int dev = 0, cus = 0, per_cu = 0;
    hipGetDevice(&dev); hipDeviceGetAttribute(&cus, hipDeviceAttributeMultiprocessorCount, dev);
    hipFuncSetAttribute((const void*)mega_fwd, hipFuncAttributeMaxDynamicSharedMemorySize, LDS_BYTES);
    hipOccupancyMaxActiveBlocksPerMultiprocessor(&per_cu, (const void*)mega_fwd, NTHREADS, LDS_BYTES);
    if (per_cu < 1) { fprintf(stderr, "kernel_launch: occupancy query says %d blocks/CU\n", per_cu); per_cu = 1; }
    grid = 256;
    if (cus < 256) { fprintf(stderr, "kernel_launch: needs 256 CUs, device has %d\n", cus); grid = -1; return; }
    (void)hipGetLastError();
  }
  if (grid < 0) return;
  Params p{};
  for (int i = 0; i < 40; ++i) p.in[i] = (const float*)d_in[i];
  p.out = (float*)d_out; p.ws = (unsigned char*)d_ws;
#if DEBUG_LAUNCHES
#ifdef DBG_GCHK
  for (int ph = 0; ph < 3; ++ph) { p.ph_lo = ph; p.ph_hi = ph + 1; hipLaunchKernelGGL(mega_fwd, dim3(grid), dim3(NTHREADS), LDS_BYTES, stream, p); }
  hipLaunchKernelGGL(dbg_snap, dim3(T * G / 2 / 256), dim3(256), 0, stream, (const unsigned char*)d_ws, (float*)d_out);
  p.ph_lo = 3; p.ph_hi = 4; hipLaunchKernelGGL(mega_fwd, dim3(grid), dim3(NTHREADS), LDS_BYTES, stream, p);
  hipLaunchKernelGGL(dbg_cmp, dim3(T * G / 2 / 256), dim3(256), 0, stream, (unsigned char*)d_ws, (const float*)d_out);
  hipLaunchKernelGGL(dbg_fin, dim3(T * 1024 / 256), dim3(256), 0, stream, (const unsigned char*)d_ws, (float*)d_out);
#elif defined(DBG_STOP)
  for (int ph = 0; ph < DBG_STOP; ++ph) { p.ph_lo = ph; p.ph_hi = ph + 1; hipLaunchKernelGGL(mega_fwd, dim3(grid), dim3(NTHREADS), LDS_BYTES, stream, p); }
  hipLaunchKernelGGL(dbg_dump, dim3(T * 1024 / 256), dim3(256), 0, stream, (const unsigned char*)d_ws, (float*)d_out);
#else
#ifndef REP_MASK
#define REP_MASK 0
#endif
  int rewound = 0;
  for (int ph = 0; ph < N_PHASES; ++ph) { p.ph_lo = ph; p.ph_hi = ph + 1; const int rel = ph == 0 ? 0 : 1 + (ph - 1) % PH_PER_LAYER;
    const int reps = ((REP_MASK >> rel) & 1) ? 2 : 1;
    for (int r = 0; r < reps; ++r) hipLaunchKernelGGL(mega_fwd, dim3(grid), dim3(NTHREADS), LDS_BYTES, stream, p);
#ifdef REP_GROUP
    if (rel == 4) { if (!rewound) { rewound = 1; ph -= 4; } else rewound = 0; }
#endif
  }
#endif
#else
  p.ph_lo = 0; p.ph_hi = N_PHASES;
  hipMemsetAsync((unsigned char*)d_ws + SM_BAR, 0, 16384, stream);
  void* args[] = {&p};
  hipError_t e = hipLaunchCooperativeKernel((const void*)mega_fwd, dim3(grid), dim3(NTHREADS), args, LDS_BYTES, stream);
  if (e != hipSuccess) fprintf(stderr, "cooperative launch failed: %s (grid %d)\n", hipGetErrorString(e), grid);
#endif
}
```

```cpp
#include <hip/hip_runtime.h>
#include <hip/hip_cooperative_groups.h>
#include <cstdio>
#include <cstdint>
#include <cmath>
namespace cg = cooperative_groups;
namespace pg8 {
#define PG8_LAS __attribute__((address_space(3)))
typedef unsigned short bf16_t;
typedef short bf16x8 __attribute__((ext_vector_type(8)));
typedef float f32x4 __attribute__((ext_vector_type(4)));
typedef unsigned u32x4 __attribute__((ext_vector_type(4)));
constexpr int BM = 256, BK = 64, HALF = 128, HTB = HALF * BK * 2  , STAGE_BYTES = 8 * HTB, NXCD = 8, WGM = 8;

__host__ __device__ __forceinline__ int lds_byte(int r, int c) { const int st = (r >> 4) * 2 + (c >> 5), rr = r & 15, cc = c & 31, ob = rr * 64 + cc * 2; return st * 1024 + (ob ^ (((ob >> 9) & 1) << 5)); }
__host__ __device__ __forceinline__ void stage_rc(int b, int& R, int& C) { const int st = b / 1024, sb = b % 1024, swz = sb ^ (((sb >> 9) & 1) << 5); R = (st >> 1) * 16 + swz / 64; C = (st & 1) * 32 + (swz % 64) / 2; }
__host__ __device__ __forceinline__ int perm32(int rho) { const int n = rho >> 4, i = rho & 15; return 8 * (i >> 2) + 4 * n + (i & 3); }

struct Unit { int pm, pn; };
struct Gemm { const bf16_t* A; const bf16_t* Bt; int M, N, K, lda; };

struct StaticOrder {
    int nM, nN, nwg, G, c;
    __host__ __device__ void init(int M, int N, int G_, int c_) { nM = M / BM; nN = N / BM; nwg = nM * nN; G = G_; c = c_; }
    __host__ __device__ bool next(int i, Unit& u) const {
        const long L = (long)i * G + c; if (L >= nwg) return false;
        int wgid = (int)L; { const int q = nwg / NXCD, r = nwg % NXCD, xcd = wgid % NXCD, off = wgid / NXCD; wgid = (xcd < r ? xcd * (q + 1) : r * (q + 1) + (xcd - r) * q) + off; }
        const int nig = WGM * nN, gid = wgid / nig, fm = gid * WGM, gsz = (nM - fm) < WGM ? (nM - fm) : WGM;
        u.pm = fm + ((wgid % nig) % gsz); u.pn = (wgid % nig) / gsz; return true;
    }
    __device__ __forceinline__ void a_ready(const Unit&) const {}
    __device__ __forceinline__ void done(const Unit&) const {}
};

__device__ __forceinline__ unsigned cvt_pk_bf16(float lo, float hi) { unsigned r; asm volatile("v_cvt_pk_bf16_f32 %0, %1, %2" : "=v"(r) : "v"(lo), "v"(hi)); return r; }
typedef float f32x2 __attribute__((ext_vector_type(2)));
template <class Epi, class Sched, bool ALIGN_EPI = false, bool SP2 = false>
__device__ __forceinline__ void gemm_phase(PG8_LAS unsigned char* lds, const Gemm g, const Sched& S, const Epi& E) {
    int tid_l = threadIdx.x; asm volatile("" : "+v"(tid_l));
    const int tid = tid_l, wid = __builtin_amdgcn_readfirstlane(tid >> 6), lane = tid & 63, wr = wid >> 2, wc = wid & 3, fr = lane & 15, fq = lane >> 4;
    const int K = g.K, nt = K / BK;
    unsigned voffA[2], voffB[2];
#pragma unroll
    for (int i = 0; i < 2; ++i) { int R, C; stage_rc(tid * 16 + i * 8192, R, C); const int Rb = Epi::PERM ? ((R & ~31) + perm32(R & 31)) : R;
        voffA[i] = (unsigned)(R * g.lda + C) * 2u; voffB[i] = (unsigned)(Rb * K + C) * 2u; }
    const size_t kstep = (size_t)(BK * 2);
    const size_t hstep = (size_t)HALF * K * 2;
    const size_t tstep = 2 * hstep; const size_t hstepA = (size_t)HALF * g.lda * 2; const size_t tstepA = 2 * hstepA;
    const unsigned ldsw = (unsigned)wid * 1024u;
    const int aoff = lds_byte(wr * 64 + fr, fq * 8), boff = lds_byte(wc * 32 + fr, fq * 8);
#define PG8_SA(b, h) (((b) * 2 + (h)) * HTB)
#define PG8_SB(b, h) ((4 + (b) * 2 + (h)) * HTB)
#define PG8_STAGE(bufoff, gbase, voff) do { _Pragma("unroll") for (int _i = 0; _i < 2; ++_i) \
        __builtin_amdgcn_global_load_lds((const unsigned*)((const char*)(gbase) + (voff)[_i]), (PG8_LAS unsigned*)(lds + (bufoff) + ldsw + _i * 8192), 16, 0, 0); } while (0)
#define PG8_LDA(dst, b, h) do { _Pragma("unroll") for (int m = 0; m < 4; ++m) _Pragma("unroll") for (int k = 0; k < 2; ++k) dst[m][k] = *(const PG8_LAS bf16x8*)(lds + PG8_SA(b, h) + aoff + m * 2048 + k * 1024); } while (0)
#define PG8_LDB(dst, b, h) do { _Pragma("unroll") for (int n = 0; n < 2; ++n) _Pragma("unroll") for (int k = 0; k < 2; ++k) dst[n][k] = *(const PG8_LAS bf16x8*)(lds + PG8_SB(b, h) + boff + n * 2048 + k * 1024); } while (0)
#define PG8_MMA(ai, bj, At, Bt) do { __builtin_amdgcn_s_setprio(1); _Pragma("unroll") for (int m = 0; m < 4; ++m) _Pragma("unroll") for (int n = 0; n < 2; ++n) _Pragma("unroll") for (int k = 0; k < 2; ++k) \
        acc[ai][bj][m][n] = __builtin_amdgcn_mfma_f32_16x16x32_bf16(Bt[n][k], At[m][k], acc[ai][bj][m][n], 0, 0, 0); __builtin_amdgcn_s_setprio(0); } while (0)
#define PG8_WAIT_V(n) asm volatile("s_waitcnt vmcnt(" #n ")" ::: "memory")
#define PG8_WAIT_L(n) asm volatile("s_waitcnt lgkmcnt(" #n ")" ::: "memory")
#define PG8_BAR __builtin_amdgcn_s_barrier()
#define PG8_SCHED __builtin_amdgcn_sched_barrier(0)
    Unit cur, nxt; int ui = 0;
    if (!S.next(0, cur)) return;
    f32x4 acc[2][2][4][2];
#pragma unroll
    for (int a = 0; a < 2; ++a)
#pragma unroll
        for (int b = 0; b < 2; ++b)
#pragma unroll
            for (int m = 0; m < 4; ++m)
#pragma unroll
                for (int n = 0; n < 2; ++n) acc[a][b][m][n] = (f32x4){0.f, 0.f, 0.f, 0.f};
    bf16x8 At[4][2], B0[2][2], B1[2][2];
    const char* cA = (const char*)g.A + (size_t)cur.pm * tstepA; const char* cB = (const char*)g.Bt + (size_t)cur.pn * tstep;
    S.a_ready(cur);
    if constexpr (SP2) {
        PG8_STAGE(PG8_SB(0, 0), cB, voffB); PG8_STAGE(PG8_SB(0, 1), cB + hstep, voffB); PG8_STAGE(PG8_SA(0, 0), cA, voffA); PG8_STAGE(PG8_SA(0, 1), cA + hstepA, voffA);
        if (wr == 1) PG8_BAR;
        PG8_WAIT_V(2); PG8_BAR;
        PG8_STAGE(PG8_SB(1, 0), cB + kstep, voffB); PG8_STAGE(PG8_SA(1, 0), cA + kstep, voffA); PG8_STAGE(PG8_SB(1, 1), cB + hstep + kstep, voffB);
        PG8_WAIT_V(6); PG8_BAR;
    } else {
        PG8_STAGE(PG8_SB(0, 0), cB, voffB); PG8_STAGE(PG8_SA(0, 0), cA, voffA); PG8_STAGE(PG8_SB(0, 1), cB + hstep, voffB); PG8_STAGE(PG8_SA(0, 1), cA + hstepA, voffA);
        if (wr == 1) PG8_BAR;
        PG8_WAIT_V(4); PG8_BAR;
        PG8_STAGE(PG8_SB(1, 0), cB + kstep, voffB); PG8_STAGE(PG8_SA(1, 0), cA + kstep, voffA); PG8_STAGE(PG8_SB(1, 1), cB + hstep + kstep, voffB);
        PG8_WAIT_V(6); PG8_BAR;
    }
    for (;;) {
        const bool has_next = S.next(ui + 1, nxt);
        const char* nA = has_next ? (const char*)g.A + (size_t)nxt.pm * tstepA : cA; const char* nB = has_next ? (const char*)g.Bt + (size_t)nxt.pn * tstep : cB;
        for (int t = 0; t < nt; t += 2) {
            const bool last = (t == nt - 2);
            const char* a1 = cA + (size_t)(t + 1) * kstep;
            const char* a2 = last ? nA : cA + (size_t)(t + 2) * kstep; const char* b2 = last ? nB : cB + (size_t)(t + 2) * kstep;
            const char* a3 = a2 + kstep; const char* b3 = b2 + kstep;
            if (last && has_next) S.a_ready(nxt);
            if constexpr (SP2) {
            PG8_LDB(B0, 0, 0); PG8_LDB(B1, 0, 1); PG8_SCHED; PG8_LDA(At, 0, 0); PG8_STAGE(PG8_SA(1, 1), a1 + hstepA, voffA);
            PG8_WAIT_V(8); PG8_WAIT_L(0); PG8_BAR; PG8_MMA(0, 0, At, B0); PG8_MMA(0, 1, At, B1); PG8_BAR; PG8_SCHED;
            PG8_LDA(At, 0, 1); PG8_STAGE(PG8_SB(0, 0), b2, voffB); PG8_STAGE(PG8_SB(0, 1), b2 + hstep, voffB); PG8_STAGE(PG8_SA(0, 0), a2, voffA);
            PG8_WAIT_V(8); PG8_WAIT_L(0); PG8_BAR; PG8_MMA(1, 0, At, B0); PG8_MMA(1, 1, At, B1); PG8_BAR; PG8_SCHED;
            PG8_LDB(B0, 1, 0); PG8_LDB(B1, 1, 1); PG8_SCHED; PG8_LDA(At, 1, 0); PG8_STAGE(PG8_SA(0, 1), a2 + hstepA, voffA);
            PG8_WAIT_V(8); PG8_WAIT_L(0); PG8_BAR; PG8_MMA(0, 0, At, B0); PG8_MMA(0, 1, At, B1); PG8_BAR; PG8_SCHED;
            PG8_LDA(At, 1, 1); PG8_STAGE(PG8_SB(1, 0), b3, voffB); PG8_STAGE(PG8_SB(1, 1), b3 + hstep, voffB); PG8_STAGE(PG8_SA(1, 0), a3, voffA);
            PG8_WAIT_V(8); PG8_WAIT_L(0); PG8_BAR; PG8_MMA(1, 0, At, B0); PG8_MMA(1, 1, At, B1); PG8_BAR; PG8_SCHED;
            } else {
            PG8_LDB(B0, 0, 0); PG8_SCHED; PG8_LDA(At, 0, 0); PG8_STAGE(PG8_SA(1, 1), a1 + hstepA, voffA);
            PG8_WAIT_L(8); PG8_BAR; PG8_WAIT_L(0); PG8_MMA(0, 0, At, B0); PG8_BAR; PG8_SCHED;
            PG8_LDB(B1, 0, 1); PG8_STAGE(PG8_SB(0, 0), b2, voffB);
            PG8_BAR; PG8_WAIT_L(0); PG8_MMA(0, 1, At, B1); PG8_BAR;
            PG8_LDA(At, 0, 1); PG8_STAGE(PG8_SA(0, 0), a2, voffA);
            PG8_BAR; PG8_WAIT_L(0); PG8_MMA(1, 0, At, B0); PG8_BAR; PG8_SCHED;
            PG8_STAGE(PG8_SB(0, 1), b2 + hstep, voffB);
            PG8_WAIT_V(6); PG8_BAR; PG8_MMA(1, 1, At, B1); PG8_BAR;
            PG8_LDB(B0, 1, 0); PG8_SCHED; PG8_LDA(At, 1, 0); PG8_STAGE(PG8_SA(0, 1), a2 + hstepA, voffA);
            PG8_WAIT_L(8); PG8_BAR; PG8_WAIT_L(0); PG8_MMA(0, 0, At, B0); PG8_BAR; PG8_SCHED;
            PG8_LDB(B1, 1, 1); PG8_STAGE(PG8_SB(1, 0), b3, voffB);
            PG8_BAR; PG8_WAIT_L(0); PG8_MMA(0, 1, At, B1); PG8_BAR;
            PG8_LDA(At, 1, 1); PG8_STAGE(PG8_SA(1, 0), a3, voffA);
            PG8_BAR; PG8_WAIT_L(0); PG8_MMA(1, 0, At, B0); PG8_BAR; PG8_SCHED;
            PG8_STAGE(PG8_SB(1, 1), b3 + hstep, voffB);
            PG8_WAIT_V(6); PG8_BAR; PG8_MMA(1, 1, At, B1); PG8_BAR;
            }
        }
        if constexpr (ALIGN_EPI) { if (wr == 0) PG8_BAR; }
        if constexpr (!Epi::AFTER_DRAIN) { E(acc, cur, wr, wc, fr, fq); S.done(cur); }
        if (!has_next) break;
#pragma unroll
        for (int a = 0; a < 2; ++a)
#pragma unroll
            for (int b = 0; b < 2; ++b)
#pragma unroll
                for (int m = 0; m < 4; ++m)
#pragma unroll
                    for (int n = 0; n < 2; ++n) acc[a][b][m][n] = (f32x4){0.f, 0.f, 0.f, 0.f};
        cur = nxt; cA = nA; cB = nB; ++ui;
        if constexpr (ALIGN_EPI) { if (wr == 1) PG8_BAR; }
    }
    PG8_WAIT_V(0);
    if constexpr (!ALIGN_EPI) { if (wr == 0) PG8_BAR; }
    PG8_BAR;
    if constexpr (Epi::AFTER_DRAIN) { E.fused(acc, cur, wr, wc, fr, fq, lds, wid, lane); S.done(cur); }
#undef PG8_SA
#undef PG8_SB
#undef PG8_STAGE
#undef PG8_LDA
#undef PG8_LDB
#undef PG8_MMA
#undef PG8_WAIT_V
#undef PG8_WAIT_L
#undef PG8_BAR
#undef PG8_SCHED
}
}

typedef unsigned short bf16;
typedef short bf16x8 __attribute__((ext_vector_type(8)));
typedef short bf16x4 __attribute__((ext_vector_type(4)));
typedef float f32x4 __attribute__((ext_vector_type(4)));
typedef float f32x2 __attribute__((ext_vector_type(2)));
typedef unsigned u32x4 __attribute__((ext_vector_type(4)));
typedef unsigned u32x2 __attribute__((ext_vector_type(2)));

constexpr int D = 1024, BATCH = 4, SEQ = 4096, DEPTH = 2, T = BATCH * SEQ;
constexpr int MEM = 256;
constexpr int G = 256, HD = 64, GH = 4;
constexpr int INW = 3332, DFF = 4096;
constexpr float EPS = 1e-6f, LOG2E = 1.4426950408889634f;
constexpr int NTHREADS = 512, NWAVES = 8;
constexpr int PW = 2816;
constexpr int C_FOXQ = 0, C_LRUY = 256, C_RWR = 512, C_RETQ = 768, C_FOXK = 1024, C_LRUX = 1280, C_RWK = 1536, C_RWV = 1792, C_RWX = 2048, C_RETK = 2304, C_RETG = 2560;
constexpr int NIN = 3328;
__device__ __constant__ const int kSrcCol[13] = {0, 1028, 1284, 2308, 256, 772, 1540, 1796, 2052, 2564, 3076, 512, 2820};

constexpr size_t MiB = 1u << 20;
constexpr size_t WS_W = 0;
constexpr size_t W_IN = 0, W_OUT = 7 * MiB, W_Q = 9 * MiB, W_O = 11 * MiB, W_1 = 13 * MiB, W_2 = 21 * MiB, W_SMALL = 29 * MiB;
constexpr size_t WS_W2T = W_SMALL, WS_A2T = WS_W2T + 256 * 64 * 2, WS_G2T = WS_A2T + 256 * 64 * 2, WS_V1T = WS_G2T + 256 * 128 * 2, WS_V2T = WS_V1T + 32 * 256 * 2, WS_RAT = WS_V2T + 256 * 32 * 2, WS_RIT = WS_RAT + 4 * 64 * 64 * 2;
constexpr size_t WS_P = 30 * MiB;
constexpr size_t P_FOXVT = WS_P + 88 * MiB, P_RETKT = WS_P + 96 * MiB, P_RETVT = WS_P + 104 * MiB, P_RETKV = WS_P + 112 * MiB;
constexpr size_t WS_RW = 158 * MiB;
constexpr size_t RW_E = WS_RW, RW_WR = WS_RW + 8 * MiB, RW_A = WS_RW + 16 * MiB, RW_B = WS_RW + 24 * MiB, RW_K = WS_RW + 32 * MiB, RW_V = WS_RW + 40 * MiB, RW_G = WS_P + 120 * MiB  , RW_Y = WS_RW + 56 * MiB;
constexpr int RW_REC = 320;
__device__ __forceinline__ size_t rw_off(int tok  , int arr, int col  ) { const int b = tok >> 12, pos = tok & (SEQ - 1), hh = col >> 6; return ((size_t)((b * 4 + hh) * SEQ + pos)) * RW_REC + arr * 64 + (col & 63); }
constexpr size_t WS_O = WS_RW, WS_H = WS_RW + 32 * MiB;
constexpr size_t WS_WKV = WS_RW;
constexpr size_t WS_MEMN = WS_RW + 64 * MiB;
constexpr size_t WS_VF = 230 * MiB;
constexpr size_t WS_KM = 238 * MiB, WS_VMT = 242 * MiB;
constexpr size_t WS_SM = 246 * MiB;
constexpr size_t SM_LOGF = WS_SM, SM_CUM = SM_LOGF + 256 * 1024, SM_BR = SM_CUM + 256 * 1024, SM_KR = SM_BR + 256 * 1024, SM_RK = SM_KR + 256 * 1024,
                 SM_SS = SM_RK + 256 * 1024  , SM_ROT = SM_SS + 256 * 1024  , SM_Q = SM_ROT + MiB  , SM_BAR = SM_Q + 4096  , WS_END = SM_BAR + 16384;
static_assert(WS_END <= 256 * MiB, "workspace map");
constexpr int LDS_BYTES = 147456;

__device__ __forceinline__ unsigned f2bf(float f) { unsigned u = __builtin_bit_cast(unsigned, f); return (u + 0x7fffu + ((u >> 16) & 1u)) >> 16; }
typedef __bf16 bf16x2_t __attribute__((ext_vector_type(2)));
__device__ __forceinline__ unsigned pk2(float lo, float hi) { const f32x2 v = {lo, hi}; const bf16x2_t b = __builtin_convertvector(v, bf16x2_t); return __builtin_bit_cast(unsigned, b); }
__device__ __forceinline__ float bflo(unsigned u) { return __builtin_bit_cast(float, u << 16); }
__device__ __forceinline__ float bfhi(unsigned u) { return __builtin_bit_cast(float, u & 0xffff0000u); }
__device__ __forceinline__ void unpack8(u32x4 w, float* f) { f[0] = bflo(w.x); f[1] = bfhi(w.x); f[2] = bflo(w.y); f[3] = bfhi(w.y); f[4] = bflo(w.z); f[5] = bfhi(w.z); f[6] = bflo(w.w); f[7] = bfhi(w.w); }
__device__ __forceinline__ u32x4 pack8(const float* f) { u32x4 w; w.x = pk2(f[0], f[1]); w.y = pk2(f[2], f[3]); w.z = pk2(f[4], f[5]); w.w = pk2(f[6], f[7]); return w; }
__device__ __forceinline__ float wave_sum(float v) {
#pragma unroll
  for (int o = 1; o < 64; o <<= 1) v += __shfl_xor(v, o);
  return v;
}
__device__ __forceinline__ float ex2(float x) { return __builtin_amdgcn_exp2f(x); }
__device__ __forceinline__ float rcpf_(float x) { return __builtin_amdgcn_rcpf(x); }
__device__ __forceinline__ float sigmoidf_(float x) { return rcpf_(1.f + __expf(-x)); }
__device__ __forceinline__ float lse0_(float x) { return __logf(1.f + __expf(-fabsf(x))); }
__device__ __forceinline__ float log_sigmoidf_(float x) { return fminf(x, 0.f) - lse0_(x); }
__device__ __forceinline__ float log_sigmoid_acc(float x) { return fminf(x, 0.f) - log1pf(__expf(-fabsf(x))); }
__device__ __forceinline__ float softplusf_(float x) { return fmaxf(x, 0.f) + lse0_(x); }
__device__ __forceinline__ float tanhf_(float x) { return 1.f - 2.f * rcpf_(1.f + __expf(2.f * x)); }
__device__ __forceinline__ float gelu_tanh(float x) { return 0.5f * x * (1.f + tanhf_(0.7978845608028654f * (x + 0.044715f * x * x * x))); }
#define WAVE_LDS_FENCE() asm volatile("s_waitcnt lgkmcnt(0)" ::: "memory")
#define LDS_BARRIER() asm volatile("s_waitcnt lgkmcnt(0)\n\ts_barrier" ::: "memory")
#define MFMA16(a, b, c) __builtin_amdgcn_mfma_f32_16x16x32_bf16((a), (b), (c), 0, 0, 0)

struct Params { const float* in[40]; float* out; unsigned char* ws; int ph_lo, ph_hi; };

struct EpiIn {
  static constexpr bool PERM = true, AFTER_DRAIN = false;
  bf16* proj; bf16* foxvT; bf16* retkT; bf16* retvT; const float* rot;
  __device__ __forceinline__ void operator()(const f32x4 (&acc)[2][2][4][2], const pg8::Unit& u, int wr, int wc, int fr, int fq) const {
    const int pn = u.pn;
    const bool rotary = (pn == 3) || (pn == 9);
    const float sc = (pn == 9) ? 0.125f : 1.f;
    bf16* tdst = pn == 9 ? retkT : pn == 11 ? foxvT : pn == 12 ? retvT : nullptr;
    const bool rowmajor = pn <= 10;
#pragma unroll
    for (int ai = 0; ai < 2; ++ai)
#pragma unroll
      for (int m = 0; m < 4; ++m) {
        const int row = u.pm * 256 + ai * 128 + wr * 64 + m * 16 + fr; const int pos = row & (SEQ - 1), b = row >> 12;
#pragma unroll
        for (int bj = 0; bj < 2; ++bj) {
          const int c0 = bj * 128 + wc * 32 + 8 * fq;
          float v[8];
#pragma unroll
          for (int e = 0; e < 4; ++e) { v[e] = acc[ai][bj][m][0][e]; v[4 + e] = acc[ai][bj][m][1][e]; }
          if (rotary) {
            const int i0 = (c0 & 63) >> 1;
            const f32x4 r0 = *(const f32x4*)(rot + ((size_t)pos * 32 + i0) * 2), r1 = *(const f32x4*)(rot + ((size_t)pos * 32 + i0 + 2) * 2);
            const float cs[4] = {r0[0], r0[2], r1[0], r1[2]}, sn[4] = {r0[1], r0[3], r1[1], r1[3]};
#pragma unroll
            for (int p = 0; p < 4; ++p) { const float x1 = v[2 * p], x2 = v[2 * p + 1]; v[2 * p] = x1 * cs[p] - x2 * sn[p]; v[2 * p + 1] = x1 * sn[p] + x2 * cs[p]; }
          }
#pragma unroll
          for (int e = 0; e < 8; ++e) v[e] *= sc;
          const u32x4 w = pack8(v);
          if (rowmajor) *(u32x4*)(proj + (size_t)row * PW + pn * 256 + c0) = w;
          if (tdst) {
            const int hh = c0 >> 6, d0 = c0 & 63; bf16* tp = tdst + ((size_t)((b * 4 + hh) * 64 + d0)) * SEQ + pos;
            const unsigned ww[4] = {w.x, w.y, w.z, w.w};
#pragma unroll
            for (int e = 0; e < 8; ++e) tp[(size_t)e * SEQ] = (bf16)((e & 1) ? (ww[e >> 1] >> 16) : (ww[e >> 1] & 0xffffu));
          }
        }
      }
  }
};
struct EpiPlain {
  static constexpr bool PERM = true, AFTER_DRAIN = false;
  bf16* O; int ldc; int act; float* ss;
  __device__ __forceinline__ void operator()(const f32x4 (&acc)[2][2][4][2], const pg8::Unit& u, int wr, int wc, int fr, int fq) const {
#pragma unroll
    for (int ai = 0; ai < 2; ++ai)
#pragma unroll
      for (int m = 0; m < 4; ++m) {
        const int row = u.pm * 256 + ai * 128 + wr * 64 + m * 16 + fr; float s = 0.f;
#pragma unroll
        for (int bj = 0; bj < 2; ++bj) {
          const int c0 = u.pn * 256 + bj * 128 + wc * 32 + 8 * fq;
          float v[8];
#pragma unroll
          for (int e = 0; e < 4; ++e) { v[e] = acc[ai][bj][m][0][e]; v[4 + e] = acc[ai][bj][m][1][e]; }
          if (act == 1) {
#pragma unroll
            for (int e = 0; e < 8; ++e) { const float r = fmaxf(v[e], 0.f); v[e] = r * r; }
          }
#pragma unroll
          for (int e = 0; e < 8; ++e) s += v[e] * v[e];
          *(u32x4*)(O + (size_t)row * ldc + c0) = pack8(v);
        }
        if (ss) { s += __shfl_xor(s, 16); s += __shfl_xor(s, 32); if (fq == 0) atomicAdd(ss + row, s); }
      }
  }
};
struct EpiMem {
  static constexpr bool PERM = true, AFTER_DRAIN = false;
  bf16* kmem; bf16* vmemT;
  __device__ __forceinline__ void operator()(const f32x4 (&acc)[2][2][4][2], const pg8::Unit& u, int wr, int wc, int fr, int fq) const {
    const int layer = u.pm >> 2, pt = u.pn & 7; const bool isv = pt >= 4; const int head = pt & 3;
#pragma unroll
    for (int ai = 0; ai < 2; ++ai)
#pragma unroll
      for (int m = 0; m < 4; ++m) {
        const int rowl = (u.pm & 3) * 256 + ai * 128 + wr * 64 + m * 16 + fr;
#pragma unroll
        for (int bj = 0; bj < 2; ++bj) {
          const int c0 = bj * 128 + wc * 32 + 8 * fq;
          float v[8];
#pragma unroll
          for (int e = 0; e < 4; ++e) { v[e] = acc[ai][bj][m][0][e]; v[4 + e] = acc[ai][bj][m][1][e]; }
          const u32x4 w = pack8(v);
          if (!isv) *(u32x4*)(kmem + ((size_t)layer * 1024 + rowl) * 1024 + head * 256 + c0) = w;
          else {
            const int b = rowl >> 8, key = rowl & 255; bf16* tp = vmemT + ((size_t)(((layer * 4 + b) * 4 + head) * 256 + c0)) * 256 + key;
            const unsigned ww[4] = {w.x, w.y, w.z, w.w};
#pragma unroll
            for (int e = 0; e < 8; ++e) tp[(size_t)e * 256] = (bf16)((e & 1) ? (ww[e >> 1] >> 16) : (ww[e >> 1] & 0xffffu));
          }
        }
      }
  }
};
struct MemSched {
  int G, c;
  __device__ bool next(int i, pg8::Unit& u) const { const int L = i * G + c; if (c < 0 || L >= 64) return false; const int layer = L >> 5, r = L & 31; u.pm = layer * 4 + (r & 3); u.pn = layer * 8 + (r >> 2); return true; }
  __device__ __forceinline__ void a_ready(const pg8::Unit&) const {}
  __device__ __forceinline__ void done(const pg8::Unit&) const {}
};

template <int MAP> __device__ __forceinline__ int src_col(int n) {
  if (MAP == 0) return n;
  const int tile = n >> 8, j = n & 255; int jj = j;
  if (tile == 3 || tile == 9) { const int hh = j >> 6, l = j & 63; jj = hh * 64 + (l >> 1) + 32 * (l & 1); }
  return kSrcCol[tile] + jj;
}
template <int MAP> __device__ __forceinline__ void conv_item(const float* __restrict__ W, int K, int Nsrc, int N, bf16* WT, float* scr, int item, int lane) {
  const int nblk = N / 32, kb = item / nblk, nb = item % nblk, k0 = 64 * kb, n0 = 32 * nb;
  const int sc = src_col<MAP>(n0 + (lane & 31));
#pragma unroll 8
  for (int i = 0; i < 32; ++i) { const int kk = 2 * i + (lane >> 5); scr[kk * 33 + (lane & 31)] = W[(size_t)(k0 + kk) * Nsrc + sc]; }
  WAVE_LDS_FENCE();
  const int c = lane & 7;
#pragma unroll
  for (int j = 0; j < 4; ++j) { const int n = (lane >> 3) + 8 * j; const float* s = scr + (8 * c) * 33 + n;
    u32x4 o; o.x = pk2(s[0 * 33], s[1 * 33]); o.y = pk2(s[2 * 33], s[3 * 33]); o.z = pk2(s[4 * 33], s[5 * 33]); o.w = pk2(s[6 * 33], s[7 * 33]);
    *(u32x4*)(WT + (size_t)(n0 + n) * K + k0 + 8 * c) = o; }
  WAVE_LDS_FENCE();
}
__device__ __forceinline__ void conv_layer_weights(const Params& p, int l, float* scr, int gw, int NGW, int lane) {
  asm volatile("" ::: "memory");
  asm volatile("" : "+v"(lane));
  unsigned char* ws = p.ws;
  constexpr int I_IN = (D / 64) * (NIN / 32), I_SQ = (D / 64) * (D / 32), I_1 = (D / 64) * (DFF / 32), I_2 = (DFF / 64) * (D / 32);
  constexpr int I_W2 = 1 * 8, I_A2 = 8, I_G2 = 2 * 8, I_V1 = 4 * 1, I_V2 = 8  , I_R = 2 * 4 * 2;
  constexpr int NIT = I_IN + 3 * I_SQ + I_1 + I_2 + I_W2 + I_A2 + I_G2 + I_V1 + I_R;
  for (int it = gw; it < NIT; it += NGW) {
    int r = it;
    if (r < I_IN) { conv_item<1>(p.in[9] + (size_t)l * D * INW, D, INW, NIN, (bf16*)(ws + W_IN), scr, r, lane); continue; } r -= I_IN;
    if (r < I_SQ) { conv_item<0>(p.in[10] + (size_t)l * D * D, D, D, D, (bf16*)(ws + W_OUT), scr, r, lane); continue; } r -= I_SQ;
    if (r < I_SQ) { conv_item<0>(p.in[34] + (size_t)l * D * D, D, D, D, (bf16*)(ws + W_Q), scr, r, lane); continue; } r -= I_SQ;
    if (r < I_SQ) { conv_item<0>(p.in[37] + (size_t)l * D * D, D, D, D, (bf16*)(ws + W_O), scr, r, lane); continue; } r -= I_SQ;
    if (r < I_1) { conv_item<0>(p.in[38] + (size_t)l * D * DFF, D, DFF, DFF, (bf16*)(ws + W_1), scr, r, lane); continue; } r -= I_1;
    if (r < I_2) { conv_item<0>(p.in[39] + (size_t)l * DFF * D, DFF, D, D, (bf16*)(ws + W_2), scr, r, lane); continue; } r -= I_2;
    if (r < I_W2) { conv_item<0>(p.in[21] + (size_t)l * 64 * G, 64, G, G, (bf16*)(ws + WS_W2T), scr, r, lane); continue; } r -= I_W2;
    if (r < I_A2) { conv_item<0>(p.in[23] + (size_t)l * 64 * G, 64, G, G, (bf16*)(ws + WS_A2T), scr, r, lane); continue; } r -= I_A2;
    if (r < I_G2) { conv_item<0>(p.in[24] + (size_t)l * 128 * G, 128, G, G, (bf16*)(ws + WS_G2T), scr, r, lane); continue; } r -= I_G2;
    if (r < I_V1) { if (l > 0) conv_item<0>(p.in[31] + (size_t)(l - 1) * G * 32, G, 32, 32, (bf16*)(ws + WS_V1T), scr, r, lane); continue; } r -= I_V1;
    { const int gate = r >> 3, hh = (r >> 1) & 3, nb = r & 1;
      conv_item<0>(p.in[gate ? 16 : 14] + ((size_t)l * GH + hh) * HD * HD, 64, 64, 64, (bf16*)(ws + (gate ? WS_RIT : WS_RAT)) + hh * 4096, scr, nb, lane); }
  }
  if (l > 0) { const float* v2 = p.in[32] + (size_t)(l - 1) * 32 * G; bf16* v2t = (bf16*)(ws + WS_V2T);
    for (int e = gw * 64 + lane; e < 32 * G; e += NGW * 64) { const int k = e / G, n = e % G; v2t[n * 32 + k] = (bf16)f2bf(v2[e]); } }
}

struct RowArgs { const float* xin; const bf16* O; float* ss; const float* g_post; float* xout; const float* g_pre; bf16* hout; const float* wf; const float* fbias; float* logf; int rows; };
__device__ __forceinline__ void row_phase(const RowArgs& a, int gw, int NGW, int lane) {
  asm volatile("" ::: "memory");
  asm volatile("" : "+v"(lane));
  f32x4 gp[4], gq[4], wfv[4][4];
#pragma unroll
  for (int j = 0; j < 4; ++j) {
    gp[j] = a.O ? ((const f32x4*)a.g_post)[lane + 64 * j] : (f32x4){0.f, 0.f, 0.f, 0.f};
    gq[j] = a.hout ? ((const f32x4*)a.g_pre)[lane + 64 * j] : (f32x4){0.f, 0.f, 0.f, 0.f};
#pragma unroll
    for (int hh = 0; hh < 4; ++hh)
#pragma unroll
      for (int e = 0; e < 4; ++e) wfv[j][hh][e] = a.wf ? a.wf[(size_t)(4 * (lane + 64 * j) + e) * INW + 768 + hh] : 0.f;
  }
  for (int row0 = gw; row0 < a.rows; row0 += 2 * NGW) {
    const int rowv[2] = {row0, row0 + NGW}; const bool val[2] = {true, row0 + NGW < a.rows};
    f32x4 x[2][4]; float ov[2][4][4];
#pragma unroll
    for (int r = 0; r < 2; ++r) if (val[r]) {
#pragma unroll
      for (int j = 0; j < 4; ++j) x[r][j] = ((const f32x4*)(a.xin + (size_t)rowv[r] * D))[lane + 64 * j];
      if (a.O) {
#pragma unroll
        for (int j = 0; j < 4; ++j) { const u32x2 o = ((const u32x2*)(a.O + (size_t)rowv[r] * D))[lane + 64 * j];
          ov[r][j][0] = bflo(o.x); ov[r][j][1] = bfhi(o.x); ov[r][j][2] = bflo(o.y); ov[r][j][3] = bfhi(o.y); }
      }
    }
#pragma unroll
    for (int r = 0; r < 2; ++r) if (val[r]) {
      const int row = rowv[r];
      if (a.O) {
        float so = 0.f;
#pragma unroll
        for (int j = 0; j < 4; ++j) so += ov[r][j][0] * ov[r][j][0] + ov[r][j][1] * ov[r][j][1] + ov[r][j][2] * ov[r][j][2] + ov[r][j][3] * ov[r][j][3];
        so = wave_sum(so);
        const float rs = rsqrtf(so * (1.f / D) + EPS);
#pragma unroll
        for (int j = 0; j < 4; ++j)
#pragma unroll
          for (int e = 0; e < 4; ++e) x[r][j][e] += ov[r][j][e] * rs * gp[j][e];
      }
      if (a.xout) {
#pragma unroll
        for (int j = 0; j < 4; ++j) ((f32x4*)(a.xout + (size_t)row * D))[lane + 64 * j] = x[r][j];
      }
      if (a.hout) {
        float s = 0.f;
#pragma unroll
        for (int j = 0; j < 4; ++j) s += x[r][j][0] * x[r][j][0] + x[r][j][1] * x[r][j][1] + x[r][j][2] * x[r][j][2] + x[r][j][3] * x[r][j][3];
        s = wave_sum(s); const float rs2 = rsqrtf(s * (1.f / D) + EPS);
        float fd[4] = {0.f, 0.f, 0.f, 0.f};
#pragma unroll
        for (int j = 0; j < 4; ++j) {
          f32x4 hv;
#pragma unroll
          for (int e = 0; e < 4; ++e) hv[e] = x[r][j][e] * rs2 * gq[j][e];
          u32x2 o; o.x = pk2(hv[0], hv[1]); o.y = pk2(hv[2], hv[3]);
          ((u32x2*)(a.hout + (size_t)row * D))[lane + 64 * j] = o;
          if (a.wf) {
#pragma unroll
            for (int hh = 0; hh < 4; ++hh) fd[hh] += hv[0] * wfv[j][hh][0] + hv[1] * wfv[j][hh][1] + hv[2] * wfv[j][hh][2] + hv[3] * wfv[j][hh][3];
          }
        }
        if (a.wf) {
#pragma unroll
          for (int hh = 0; hh < 4; ++hh) fd[hh] = wave_sum(fd[hh]);
          if (lane < 4) { const float f = lane == 0 ? fd[0] : lane == 1 ? fd[1] : lane == 2 ? fd[2] : fd[3]; a.logf[(size_t)row * 4 + lane] = log_sigmoidf_(f + a.fbias[lane]); }
        }
      }
    }
  }
}

__device__ __forceinline__ void lerp8(const bf16* __restrict__ proj, const float* __restrict__ mu, int tok, int col, int mucol, float* out) {
  const u32x4 c = *(const u32x4*)(proj + (size_t)tok * PW + col);
  u32x4 pv = {0u, 0u, 0u, 0u};
  if ((tok & (SEQ - 1)) != 0) pv = *(const u32x4*)(proj + (size_t)(tok - 1) * PW + col);
  float cf[8], pf[8]; unpack8(c, cf); unpack8(pv, pf);
  const f32x4 m0 = *(const f32x4*)(mu + mucol), m1 = *(const f32x4*)(mu + mucol + 4);
#pragma unroll
  for (int e = 0; e < 4; ++e) { out[e] = cf[e] + (pf[e] - cf[e]) * m0[e]; out[4 + e] = cf[4 + e] + (pf[4 + e] - cf[4 + e]) * m1[e]; }
}
__device__ __forceinline__ bf16x8 pack_frag(const float* f) { const u32x4 w = pack8(f); return __builtin_bit_cast(bf16x8, w); }
constexpr int WLP = 260;
__device__ __forceinline__ void acc_to_lds(float* wl, const f32x4* acc, int ntiles, int li, int g) {
#pragma unroll
  for (int nt = 0; nt < 16; ++nt) if (nt < ntiles) {
#pragma unroll
    for (int j = 0; j < 4; ++j) wl[(4 * g + j) * WLP + nt * 16 + li] = acc[nt][j];
  }
}
template <int KS> __device__ __forceinline__ void mm16_to_lds(const bf16x8* af, const bf16* __restrict__ wt, int ldw, float* wl, int li, int g) {
#pragma unroll 1
  for (int ng = 0; ng < 4; ++ng) {
    f32x4 a4[4];
#pragma unroll
    for (int n4 = 0; n4 < 4; ++n4) { a4[n4] = (f32x4){0.f, 0.f, 0.f, 0.f};
#pragma unroll
      for (int ks = 0; ks < KS; ++ks) { const bf16x8 bfr = *(const bf16x8*)(wt + (size_t)((ng * 4 + n4) * 16 + li) * ldw + ks * 32 + 8 * g); a4[n4] = MFMA16(af[ks], bfr, a4[n4]); } }
#pragma unroll
    for (int n4 = 0; n4 < 4; ++n4)
#pragma unroll
      for (int j = 0; j < 4; ++j) wl[(4 * g + j) * WLP + (ng * 4 + n4) * 16 + li] = a4[n4][j];
  }
}
__device__ __forceinline__ void rwkv_prep_unit(const Params& p, int l, int unit, int pass, float* wl, int lane) {
  asm volatile("" ::: "memory");
  asm volatile("" : "+v"(lane));
  unsigned char* ws = p.ws;
  const bf16* proj = (const bf16*)(ws + WS_P);
  const float* mu = p.in[19] + (size_t)l * 1024;
  const int li = lane & 15, g = lane >> 4, t0 = unit * 16, ta = t0 + li;
  const int tl = t0 + (lane >> 2), cgp = lane & 3;
  if (pass == 0) {
    bf16x8 af[2];
#pragma unroll
    for (int ks = 0; ks < 2; ++ks) { float f[8]; lerp8(proj, mu, ta, C_RWX + ks * 32 + 8 * g, 768 + ks * 32 + 8 * g, f);
#pragma unroll
      for (int e = 0; e < 8; ++e) f[e] = tanhf_(f[e]);
      af[ks] = pack_frag(f); }
    mm16_to_lds<2>(af, (const bf16*)(ws + WS_W2T), 64, wl, li, g); WAVE_LDS_FENCE();
    const float* w0 = p.in[20] + (size_t)l * G;
#pragma unroll 2
    for (int i = 0; i < 8; ++i) { int col = cgp * 8 + 32 * i; asm volatile("" : "+v"(col)); float r[8], ev[8], wr[8];
      lerp8(proj, mu, tl, C_RWR + col, col, r);
#pragma unroll
      for (int e = 0; e < 8; ++e) { const float wa = wl[(lane >> 2) * WLP + col + e] + w0[col + e]; const float wlog = -softplusf_(-wa) - 0.5f; const float ee = __expf(wlog); ev[e] = ee; wr[e] = __expf(-ee) * r[e]; }
      *(u32x4*)((bf16*)(ws + WS_RW) + rw_off(tl, 0, col)) = pack8(ev); *(u32x4*)((bf16*)(ws + WS_RW) + rw_off(tl, 1, col)) = pack8(wr); }
    WAVE_LDS_FENCE();
  }
  if (pass == 1) {
    bf16x8 af[2];
#pragma unroll
    for (int ks = 0; ks < 2; ++ks) { float f[8]; lerp8(proj, mu, ta, C_RWX + 64 + ks * 32 + 8 * g, 832 + ks * 32 + 8 * g, f); af[ks] = pack_frag(f); }
    mm16_to_lds<2>(af, (const bf16*)(ws + WS_A2T), 64, wl, li, g); WAVE_LDS_FENCE();
    const float* a0 = p.in[22] + (size_t)l * G; const float* k_k = p.in[25] + (size_t)l * G; const float* k_a = p.in[26] + (size_t)l * G; const float* r_k = p.in[27] + (size_t)l * G;
#pragma unroll 1
    for (int hh = 0; hh < 4; ++hh) {
      float av[2][8], kv[2][8], kk[2][8]; float ssq = 0.f;
#pragma unroll
      for (int ii = 0; ii < 2; ++ii) { int col = cgp * 8 + 32 * (2 * hh + ii); asm volatile("" : "+v"(col));
        lerp8(proj, mu, tl, C_RWK + col, 256 + col, kv[ii]);
#pragma unroll
        for (int e = 0; e < 8; ++e) { av[ii][e] = sigmoidf_(a0[col + e] + wl[(lane >> 2) * WLP + col + e]); kk[ii][e] = kv[ii][e] * k_k[col + e]; ssq += kk[ii][e] * kk[ii][e]; } }
      ssq += __shfl_xor(ssq, 1); ssq += __shfl_xor(ssq, 2);
      const float inv = 1.f / fmaxf(sqrtf(ssq), 1e-12f);
      float sbr = 0.f, skr = 0.f, srk = 0.f;
#pragma unroll
      for (int ii = 0; ii < 2; ++ii) { int col = cgp * 8 + 32 * (2 * hh + ii); asm volatile("" : "+v"(col)); float r[8], Av[8], Bv[8], k2[8];
        lerp8(proj, mu, tl, C_RWR + col, col, r);
#pragma unroll
        for (int e = 0; e < 8; ++e) { const float kn = kk[ii][e] * inv; Av[e] = -kn; Bv[e] = kn * av[ii][e]; k2[e] = kv[ii][e] * (1.f + (av[ii][e] - 1.f) * k_a[col + e]);
          const float rb = r[e]; sbr += Bv[e] * rb; skr += k2[e] * rb; srk += rb * k2[e] * r_k[col + e]; }
        *(u32x4*)((bf16*)(ws + WS_RW) + rw_off(tl, 2, col)) = pack8(Av); *(u32x4*)((bf16*)(ws + WS_RW) + rw_off(tl, 3, col)) = pack8(Bv); *(u32x4*)((bf16*)(ws + WS_RW) + rw_off(tl, 4, col)) = pack8(k2); }
      sbr += __shfl_xor(sbr, 1); sbr += __shfl_xor(sbr, 2); skr += __shfl_xor(skr, 1); skr += __shfl_xor(skr, 2); srk += __shfl_xor(srk, 1); srk += __shfl_xor(srk, 2);
      if (cgp == 0) { ((float*)(ws + SM_BR))[(size_t)tl * 4 + hh] = sbr; ((float*)(ws + SM_KR))[(size_t)tl * 4 + hh] = skr; ((float*)(ws + SM_RK))[(size_t)tl * 4 + hh] = srk; }
    }
    WAVE_LDS_FENCE();
  }
  if (pass == 2) {
    bf16x8 af[4];
#pragma unroll
    for (int ks = 0; ks < 4; ++ks) { float f[8]; lerp8(proj, mu, ta, C_RWX + 128 + ks * 32 + 8 * g, 896 + ks * 32 + 8 * g, f);
#pragma unroll
      for (int e = 0; e < 8; ++e) f[e] = sigmoidf_(f[e]);
      af[ks] = pack_frag(f); }
    mm16_to_lds<4>(af, (const bf16*)(ws + WS_G2T), 128, wl, li, g); WAVE_LDS_FENCE();
#pragma unroll 2
    for (int i = 0; i < 8; ++i) { int col = cgp * 8 + 32 * i; asm volatile("" : "+v"(col)); float gv[8];
#pragma unroll
      for (int e = 0; e < 8; ++e) gv[e] = wl[(lane >> 2) * WLP + col + e];
      *(u32x4*)((bf16*)(ws + RW_G) + (size_t)tl * G + col) = pack8(gv); }
    WAVE_LDS_FENCE();
  }
  if (pass != 3) return;
  if (l > 0) {
    f32x4 a1[2] = {(f32x4){0.f, 0.f, 0.f, 0.f}, (f32x4){0.f, 0.f, 0.f, 0.f}};
    const bf16* v1t = (const bf16*)(ws + WS_V1T);
#pragma unroll
    for (int ks = 0; ks < 8; ++ks) { float f[8]; lerp8(proj, mu, ta, C_RWV + ks * 32 + 8 * g, 512 + ks * 32 + 8 * g, f); const bf16x8 af = pack_frag(f);
#pragma unroll
      for (int nt = 0; nt < 2; ++nt) { const bf16x8 bfr = *(const bf16x8*)(v1t + (size_t)(nt * 16 + li) * 256 + ks * 32 + 8 * g); a1[nt] = MFMA16(af, bfr, a1[nt]); } }
#pragma unroll
    for (int nt = 0; nt < 2; ++nt)
#pragma unroll
      for (int j = 0; j < 4; ++j) wl[(4 * g + j) * WLP + nt * 16 + li] = a1[nt][j];
    WAVE_LDS_FENCE();
    float f2[8];
#pragma unroll
    for (int e = 0; e < 8; ++e) f2[e] = wl[li * WLP + 8 * g + e];
    const bf16x8 af2 = pack_frag(f2);
    WAVE_LDS_FENCE();
    mm16_to_lds<1>(&af2, (const bf16*)(ws + WS_V2T), 32, wl, li, g); WAVE_LDS_FENCE();
    const float* v0 = p.in[30] + (size_t)(l - 1) * G;
#pragma unroll 2
    for (int i = 0; i < 8; ++i) { int col = cgp * 8 + 32 * i; asm volatile("" : "+v"(col)); float v[8], vf[8];
      lerp8(proj, mu, tl, C_RWV + col, 512 + col, v);
      unpack8(*(const u32x4*)((const bf16*)(ws + WS_VF) + (size_t)tl * G + col), vf);
#pragma unroll
      for (int e = 0; e < 8; ++e) v[e] = v[e] + (vf[e] - v[e]) * sigmoidf_(v0[col + e] + wl[(lane >> 2) * WLP + col + e]);
      *(u32x4*)((bf16*)(ws + RW_V) + (size_t)tl * G + col) = pack8(v); }
    WAVE_LDS_FENCE();
  } else {
#pragma unroll 2
    for (int i = 0; i < 8; ++i) { int col = cgp * 8 + 32 * i; asm volatile("" : "+v"(col)); float v[8];
      lerp8(proj, mu, tl, C_RWV + col, 512 + col, v);
      const u32x4 w = pack8(v);
      *(u32x4*)((bf16*)(ws + RW_V) + (size_t)tl * G + col) = w; *(u32x4*)((bf16*)(ws + WS_VF) + (size_t)tl * G + col) = w; }
  }
}
__device__ __forceinline__ void ret_kv_unit(const Params& p, int unit, int lane) {
  asm volatile("" ::: "memory");
  asm volatile("" : "+v"(lane));
  unsigned char* ws = p.ws;
  const int bh = unit >> 5, c = unit & 31, h = bh & 3, li = lane & 15, g = lane >> 4;
  const float lg2 = log2f(1.f - exp2f(-5.f - (float)h));
  const bf16* kT = (const bf16*)(ws + P_RETKT) + (size_t)bh * 64 * SEQ + c * 128;
  const bf16* vT = (const bf16*)(ws + P_RETVT) + (size_t)bh * 64 * SEQ + c * 128;
  f32x4 acc[4][4];
#pragma unroll
  for (int a = 0; a < 4; ++a)
#pragma unroll
    for (int b = 0; b < 4; ++b) acc[a][b] = (f32x4){0.f, 0.f, 0.f, 0.f};
#pragma unroll
  for (int ks = 0; ks < 4; ++ks) {
    float z[8];
#pragma unroll
    for (int e = 0; e < 8; ++e) z[e] = ex2(lg2 * (float)(127 - (ks * 32 + 8 * g + e)));
    bf16x8 af[4], bfr[4];
#pragma unroll
    for (int dt = 0; dt < 4; ++dt) { float f[8]; unpack8(*(const u32x4*)(kT + (size_t)(dt * 16 + li) * SEQ + ks * 32 + 8 * g), f);
#pragma unroll
      for (int e = 0; e < 8; ++e) f[e] *= z[e];
      af[dt] = pack_frag(f); }
#pragma unroll
    for (int et = 0; et < 4; ++et) bfr[et] = *(const bf16x8*)(vT + (size_t)(et * 16 + li) * SEQ + ks * 32 + 8 * g);
#pragma unroll
    for (int dt = 0; dt < 4; ++dt)
#pragma unroll
      for (int et = 0; et < 4; ++et) acc[dt][et] = MFMA16(af[dt], bfr[et], acc[dt][et]);
  }
  float* KV = (float*)(ws + P_RETKV) + (size_t)unit * 4096;
#pragma unroll
  for (int dt = 0; dt < 4; ++dt)
#pragma unroll
    for (int et = 0; et < 4; ++et)
#pragma unroll
      for (int j = 0; j < 4; ++j) KV[(dt * 16 + 4 * g + j) * 64 + et * 16 + li] = acc[dt][et][j];
}
__device__ __forceinline__ void fox_cum_unit(const Params& p, int bh, int lane) {
  asm volatile("" ::: "memory");
  asm volatile("" : "+v"(lane));
  const float* logf = (const float*)(p.ws + SM_LOGF); float* cum = (float*)(p.ws + SM_CUM);
  const int b = bh >> 2, h = bh & 3; const size_t base = ((size_t)b * SEQ + lane * 64) * 4 + h;
  float s = 0.f;
#pragma unroll 16
  for (int i = 0; i < 64; ++i) s += logf[base + (size_t)i * 4];
  float incl = s;
#pragma unroll
  for (int o = 1; o < 64; o <<= 1) { const float t = __shfl_up(incl, o); if (lane >= o) incl += t; }
  float run = incl - s;
  for (int i0 = 0; i0 < 64; i0 += 16) { float t[16];
#pragma unroll
    for (int i = 0; i < 16; ++i) t[i] = logf[base + (size_t)(i0 + i) * 4];
#pragma unroll
    for (int i = 0; i < 16; ++i) { run += t[i]; cum[(size_t)bh * SEQ + lane * 64 + i0 + i] = run * LOG2E; } }
}

template <int CTRL> __device__ __forceinline__ float dpp_add(float x) {
  const int y = __builtin_amdgcn_update_dpp(0, __builtin_bit_cast(int, x), CTRL, 0xf, 0xf, true);
  return x + __builtin_bit_cast(float, y);
}
__device__ __forceinline__ float row16_sum(float x) {
  x = dpp_add<0xB1>(x); x = dpp_add<0x4E>(x); x = dpp_add<0x141>(x); x = dpp_add<0x140>(x); return x;
}
constexpr int RS_TSB = 896;
constexpr int RS_CH = 32;
constexpr int RS_BUFB = RS_CH * RS_TSB;
constexpr int RS_ROWS = 8;
constexpr int RS_YP = 40;
constexpr int RS_YBUF = RS_CH * RS_ROWS * RS_YP;
struct RsRegs { u32x4 e, a, b, k, wr, v; float br, kr; };
__device__ __forceinline__ void rs_issue(const Params& p, RsRegs& r, int b, int h, int rq, int c, int lt) {
  unsigned char* ws = p.ws;
  { const int tok = lt >> 3, ch = lt & 7; const bf16* rec = (const bf16*)(ws + WS_RW) + ((size_t)((b * 4 + h) * SEQ + c * RS_CH + tok)) * RW_REC + ch * 8;
    r.e = *(const u32x4*)(rec); r.wr = *(const u32x4*)(rec + 64); r.a = *(const u32x4*)(rec + 128); r.b = *(const u32x4*)(rec + 192); r.k = *(const u32x4*)(rec + 256); }
  { const int t2 = lt & 31; const size_t rr = (size_t)b * SEQ + c * RS_CH + t2;
    r.v = *(const u32x4*)((const bf16*)(ws + RW_V) + rr * G + h * 64 + rq * RS_ROWS);
    r.br = ((const float*)(ws + SM_BR))[rr * 4 + h]; r.kr = ((const float*)(ws + SM_KR))[rr * 4 + h]; }
}
__device__ __forceinline__ void rs_commit(const RsRegs& r, unsigned char* buf, int lt) {
  { const int tok = lt >> 3, ch = lt & 7; unsigned char* rec = buf + tok * RS_TSB; float f[8];
    unpack8(r.e, f);
#pragma unroll
    for (int e = 0; e < 8; ++e) f[e] = ex2(-f[e] * LOG2E);
    *(f32x4*)(rec + ch * 32) = (f32x4){f[0], f[1], f[2], f[3]}; *(f32x4*)(rec + ch * 32 + 16) = (f32x4){f[4], f[5], f[6], f[7]};
    { const unsigned aw[4] = {r.a.x, r.a.y, r.a.z, r.a.w}, bw[4] = {r.b.x, r.b.y, r.b.z, r.b.w}, kw[4] = {r.k.x, r.k.y, r.k.z, r.k.w}, ww[4] = {r.wr.x, r.wr.y, r.wr.z, r.wr.w};
#pragma unroll
      for (int j = 0; j < 4; ++j) *(u32x4*)(rec + 256 + (ch * 4 + j) * 16) = (u32x4){aw[j], bw[j], kw[j], ww[j]}; } }
  if (lt < 32) { float f[8]; unpack8(r.v, f); unsigned char* rec = buf + lt * RS_TSB + 768; const float b32 = r.br * (1.f / 32.f), k32 = r.kr * (1.f / 32.f);
#pragma unroll
    for (int j = 0; j < 8; ++j) *(f32x4*)(rec + 16 * j) = (f32x4){f[j], b32, k32, 0.f}; }
}
__device__ __forceinline__ float row32_sum(float x) {
  x = row16_sum(x);
  const auto rr = __builtin_amdgcn_permlane16_swap(__builtin_bit_cast(unsigned, x), __builtin_bit_cast(unsigned, x), false, false);
  return __builtin_bit_cast(float, (unsigned)rr[0]) + __builtin_bit_cast(float, (unsigned)rr[1]);
}
__device__ __forceinline__ f32x2 bf2x(unsigned u) { return (f32x2){bflo(u), bfhi(u)}; }
__device__ __forceinline__ void rwkv_scan_unit(const Params& p, unsigned char* lds, int unit) {
  asm volatile("" ::: "memory");
  int tid = threadIdx.x; asm volatile("" : "+v"(tid)); const int wave = __builtin_amdgcn_readfirstlane(tid >> 6), lane = tid & 63;
  const int b = unit >> 5, h = (unit >> 3) & 3, rq = unit & 7;
  unsigned char* bufs = lds; bf16* ybuf = (bf16*)(lds + 2 * RS_BUFB);
  float* Y = (float*)(p.ws + RW_Y);
  constexpr int NCH = SEQ / RS_CH;
  const int lt = tid - 256;
  RsRegs rg;
  if (wave >= 4) { rs_issue(p, rg, b, h, rq, 0, lt); rs_commit(rg, bufs, lt); rs_issue(p, rg, b, h, rq, 1, lt); }
  __syncthreads();
  f32x2 S = {0.f, 0.f};
  const int seg = lane & 31, rloc = wave * 2 + (lane >> 5);
#define RS_YOUT(cc) do { const bf16* yp_ = ybuf + ((cc) & 1) * RS_YBUF + lt * RS_YP; float t_ = 0.f; \
    _Pragma("unroll") for (int j_ = 0; j_ < 4; ++j_) { float f_[8]; unpack8(*(const u32x4*)(yp_ + 8 * j_), f_); t_ += ((f_[0] + f_[1]) + (f_[2] + f_[3])) + ((f_[4] + f_[5]) + (f_[6] + f_[7])); } \
    Y[((size_t)b * SEQ + (cc) * RS_CH + (lt >> 3)) * G + h * 64 + rq * RS_ROWS + (lt & 7)] = t_; } while (0)
  for (int c = 0; c < NCH; ++c) {
    if (wave >= 4) {
      if (c + 1 < NCH) rs_commit(rg, bufs + ((c + 1) & 1) * RS_BUFB, lt);
      if (c + 2 < NCH) rs_issue(p, rg, b, h, rq, c + 2, lt);
      if (c > 0) RS_YOUT(c - 1);
    } else {
      const unsigned char* bp = bufs + (c & 1) * RS_BUFB; bf16* yb = ybuf + (c & 1) * RS_YBUF + rloc * RS_YP + seg;
      const unsigned char* pw = bp + seg * 8; const unsigned char* pa = bp + 256 + seg * 16; const unsigned char* pv = bp + 768 + rloc * 16;
      f32x2 nw = *(const f32x2*)(pw); u32x4 nq = *(const u32x4*)(pa); f32x4 nvs = *(const f32x4*)(pv);
#pragma unroll 8
      for (int s = 0; s < RS_CH; ++s) {
        const f32x2 w = nw, a = bf2x(nq.x), bb = bf2x(nq.y), kk = bf2x(nq.z), wr = bf2x(nq.w); const float v = nvs[0], br = nvs[1], kr = nvs[2];
        if (s + 1 < RS_CH) { const int o = (s + 1) * RS_TSB; nw = *(const f32x2*)(pw + o); nq = *(const u32x4*)(pa + o); nvs = *(const f32x4*)(pv + o); }
        const f32x2 pda = S * a, pdy = S * wr;
        const f32x2 vv = {v, v};
        const f32x2 u = S * w + vv * kk;
        const float t0 = v * kr + (pdy[0] + pdy[1]);
        const float da = row32_sum(pda[0] + pda[1]);
        const f32x2 dd = {da, da};
        S = dd * bb + u;
        yb[s * (RS_ROWS * RS_YP)] = (bf16)(__builtin_bit_cast(unsigned, da * br + t0) >> 16);
      }
    }
    LDS_BARRIER();
  }
  if (wave >= 4) RS_YOUT(NCH - 1);
  __syncthreads();
#undef RS_YOUT
}
__device__ __forceinline__ void rwkv_post_row(const Params& p, int l, int row, int lane) {
  asm volatile("" ::: "memory");
  asm volatile("" : "+v"(lane));
  unsigned char* ws = p.ws;
  const f32x4 y = ((const f32x4*)((const float*)(ws + RW_Y) + (size_t)row * G))[lane];
  float s = y[0] + y[1] + y[2] + y[3];
  s += __shfl_xor(s, 1); s += __shfl_xor(s, 2); s += __shfl_xor(s, 4); s += __shfl_xor(s, 8);
  const float mu = s * (1.f / 64.f); const f32x4 d = y - mu;
  float q = d[0] * d[0] + d[1] * d[1] + d[2] * d[2] + d[3] * d[3];
  q += __shfl_xor(q, 1); q += __shfl_xor(q, 2); q += __shfl_xor(q, 4); q += __shfl_xor(q, 8);
  const float rstd = rsqrtf(q * (1.f / 64.f) + 64e-5f);
  const f32x4 gw = ((const f32x4*)(p.in[28] + (size_t)l * G))[lane], gb = ((const f32x4*)(p.in[29] + (size_t)l * G))[lane];
  const u32x2 vv = ((const u32x2*)((const bf16*)(ws + RW_V) + (size_t)row * G))[lane], gg = ((const u32x2*)((const bf16*)(ws + RW_G) + (size_t)row * G))[lane];
  const float rk = ((const float*)(ws + SM_RK))[(size_t)row * 4 + (lane >> 4)];
  const float v[4] = {bflo(vv.x), bfhi(vv.x), bflo(vv.y), bfhi(vv.y)}, gt[4] = {bflo(gg.x), bfhi(gg.x), bflo(gg.y), bfhi(gg.y)};
  float o[4];
#pragma unroll
  for (int e = 0; e < 4; ++e) o[e] = (d[e] * rstd * gw[e] + gb[e] + rk * v[e]) * gt[e];
  u32x2 w; w.x = pk2(o[0], o[1]); w.y = pk2(o[2], o[3]);
  ((u32x2*)((bf16*)(ws + WS_P) + (size_t)row * PW + C_RWR))[lane] = w;
}

__device__ __forceinline__ void lru_unit(const Params& p, int l, float* lds, int unit) {
  asm volatile("" ::: "memory");
  unsigned char* ws = p.ws; bf16* proj = (bf16*)(ws + WS_P);
  int tid = threadIdx.x; asm volatile("" : "+v"(tid)); const int wave = __builtin_amdgcn_readfirstlane(tid >> 6), lane = tid & 63, li = lane & 15, g = lane >> 4;
  const int b = unit >> 2, h = unit & 3;
  float* XB = lds;
  float* XC = XB + 67 * 64;
  float* AA = XC + 64 * 65;
  float* UU = AA + 64 * 65;
  float* HH = UU + 64 * 65;
  bf16* XCb = (bf16*)(HH + 64 * 65);
  const float* cw = p.in[12] + (size_t)l * 4 * G + h * 64; const float* cb = p.in[13] + (size_t)l * G + h * 64;
  const float* rab = p.in[15] + (size_t)l * G + h * 64; const float* rib = p.in[17] + (size_t)l * G + h * 64; const float* lam = p.in[18] + (size_t)l * G + h * 64;
  const int mt = wave & 3, ntp = wave >> 2;
  bf16x8 br_[2][2], bi_[2][2]; float lsl[2], rb[2], ib[2];
  { const bf16* rat = (const bf16*)(ws + WS_RAT) + h * 4096; const bf16* rit = (const bf16*)(ws + WS_RIT) + h * 4096;
#pragma unroll
    for (int n = 0; n < 2; ++n) { const int col = (2 * ntp + n) * 16 + li; lsl[n] = log_sigmoid_acc(lam[col]); rb[n] = rab[col]; ib[n] = rib[col];
#pragma unroll
      for (int ks = 0; ks < 2; ++ks) { br_[n][ks] = *(const bf16x8*)(rat + col * 64 + ks * 32 + 8 * g); bi_[n][ks] = *(const bf16x8*)(rit + col * 64 + ks * 32 + 8 * g); } } }
  float hcur = 0.f;
  const int tok = tid >> 3, ch8 = (tid & 7) * 8;
  u32x4 nx0 = {0u, 0u, 0u, 0u}, nx1 = {0u, 0u, 0u, 0u}, ny;
  const int r1 = (tid + NTHREADS) >> 3;
  { const int pos0 = -3 + tok; if (pos0 >= 0) nx0 = *(const u32x4*)(proj + ((size_t)b * SEQ + pos0) * PW + C_LRUX + h * 64 + ch8);
    if (tid < 24) nx1 = *(const u32x4*)(proj + ((size_t)b * SEQ + (-3 + r1)) * PW + C_LRUX + h * 64 + ch8);
    ny = *(const u32x4*)(proj + ((size_t)b * SEQ + tok) * PW + C_LRUY + h * 64 + ch8); }
  for (int c = 0; c < SEQ / 64; ++c) {
    const int t0 = c * 64;
    { float f8[8]; unpack8(nx0, f8);
#pragma unroll
      for (int e = 0; e < 8; ++e) XB[tok * 64 + ch8 + e] = f8[e];
      if (tid < 24) { unpack8(nx1, f8);
#pragma unroll
        for (int e = 0; e < 8; ++e) XB[r1 * 64 + ch8 + e] = f8[e]; } }
    const u32x4 ycur = ny;
    if (c + 1 < SEQ / 64) { const int tn = t0 + 64;
      nx0 = *(const u32x4*)(proj + ((size_t)b * SEQ + tn - 3 + tok) * PW + C_LRUX + h * 64 + ch8);
      if (tid < 24) nx1 = *(const u32x4*)(proj + ((size_t)b * SEQ + tn - 3 + r1) * PW + C_LRUX + h * 64 + ch8);
      ny = *(const u32x4*)(proj + ((size_t)b * SEQ + tn + tok) * PW + C_LRUY + h * 64 + ch8); }
    LDS_BARRIER();
    { float xc[8];
#pragma unroll
      for (int e = 0; e < 8; ++e) { float v = cb[ch8 + e];
#pragma unroll
        for (int j = 0; j < 4; ++j) v += XB[(tok + j) * 64 + ch8 + e] * cw[j * G + ch8 + e];
        xc[e] = v; XC[tok * 65 + ch8 + e] = v; }
      *(u32x4*)(XCb + tok * 72 + ch8) = pack8(xc); }
    LDS_BARRIER();
    { bf16x8 af[2];
#pragma unroll
      for (int ks = 0; ks < 2; ++ks) af[ks] = *(const bf16x8*)(XCb + (mt * 16 + li) * 72 + ks * 32 + 8 * g);
#pragma unroll
      for (int n = 0; n < 2; ++n) { f32x4 cr = {0.f, 0.f, 0.f, 0.f}, ci = {0.f, 0.f, 0.f, 0.f};
#pragma unroll
        for (int ks = 0; ks < 2; ++ks) { cr = MFMA16(af[ks], br_[n][ks], cr); ci = MFMA16(af[ks], bi_[n][ks], ci); }
        const int col = (2 * ntp + n) * 16 + li;
#pragma unroll
        for (int j = 0; j < 4; ++j) { const int tk = mt * 16 + 4 * g + j; const float r = sigmoidf_(cr[j] + rb[n]), ig = sigmoidf_(ci[j] + ib[n]);
          const float log_a = 8.f * r * lsl[n]; const float a = __expf(log_a); const float mult = sqrtf(fmaxf(1.f - a * a, 0.f));
          AA[tk * 65 + col] = a; UU[tk * 65 + col] = mult * (ig * XC[tk * 65 + col]); } } }
    LDS_BARRIER();
    if (wave == 0) {
#pragma unroll 8
      for (int s = 0; s < 64; ++s) { hcur = AA[s * 65 + lane] * hcur + UU[s * 65 + lane]; HH[s * 65 + lane] = hcur; } }
    LDS_BARRIER();
    { bf16* yp = proj + ((size_t)b * SEQ + t0 + tok) * PW + C_LRUY + h * 64 + ch8; float y[8]; unpack8(ycur, y);
#pragma unroll
      for (int e = 0; e < 8; ++e) y[e] = HH[tok * 65 + ch8 + e] * gelu_tanh(y[e]);
      *(u32x4*)yp = pack8(y); }
  }
  __syncthreads();
}

constexpr int KS_P = 72, VS_P = 136;
constexpr int AT_KS = 0, AT_VS = 128 * KS_P * 2, AT_CS = AT_VS + 64 * VS_P * 2, AT_BUF = AT_CS + 512;
struct AtRegs { u32x4 k0, k1, v0, v1; float c; };
__device__ __forceinline__ void at_issue(AtRegs& r, const bf16* Kg  , const bf16* VTg  , const float* cumg, int tid) {
  { const int id = tid, row = id >> 3, ch = id & 7; r.k0 = *(const u32x4*)(Kg + (size_t)row * PW + ch * 8); }
  { const int id = tid + 512, row = id >> 3, ch = id & 7; r.k1 = *(const u32x4*)(Kg + (size_t)row * PW + ch * 8); }
  { const int id = tid, row = id >> 4, ch = id & 15; r.v0 = *(const u32x4*)(VTg + (size_t)row * SEQ + ch * 8); }
  { const int id = tid + 512, row = id >> 4, ch = id & 15; r.v1 = *(const u32x4*)(VTg + (size_t)row * SEQ + ch * 8); }
  r.c = (cumg && tid < 128) ? -cumg[tid] : 0.f;
}
__device__ __forceinline__ void at_commit(const AtRegs& r, unsigned char* buf, int tid) {
  bf16* Ks = (bf16*)(buf + AT_KS); bf16* Vs = (bf16*)(buf + AT_VS); float* Cs = (float*)(buf + AT_CS);
  { const int id = tid, row = id >> 3, ch = id & 7; *(u32x4*)(Ks + row * KS_P + ch * 8) = r.k0; }
  { const int id = tid + 512, row = id >> 3, ch = id & 7; *(u32x4*)(Ks + row * KS_P + ch * 8) = r.k1; }
  { const int id = tid, row = id >> 4, ch = id & 15; *(u32x4*)(Vs + row * VS_P + ch * 8) = r.v0; }
  { const int id = tid + 512, row = id >> 4, ch = id & 15; *(u32x4*)(Vs + row * VS_P + ch * 8) = r.v1; }
  if (tid < 128) Cs[tid] = r.c;
}
__device__ __forceinline__ bf16x8 vfrag(const bf16* Vs, int d, int key0, int g) {
  const u32x2 lo = *(const u32x2*)(Vs + d * VS_P + key0 + 4 * g), hi = *(const u32x2*)(Vs + d * VS_P + key0 + 16 + 4 * g);
  const u32x4 w = {lo.x, lo.y, hi.x, hi.y}; return __builtin_bit_cast(bf16x8, w);
}
__device__ __forceinline__ float grp4_max(float x) {
  const auto a = __builtin_amdgcn_permlane16_swap(__builtin_bit_cast(unsigned, x), __builtin_bit_cast(unsigned, x), false, false);
  x = fmaxf(__builtin_bit_cast(float, (unsigned)a[0]), __builtin_bit_cast(float, (unsigned)a[1]));
  const auto b = __builtin_amdgcn_permlane32_swap(__builtin_bit_cast(unsigned, x), __builtin_bit_cast(unsigned, x), false, false);
  return fmaxf(__builtin_bit_cast(float, (unsigned)b[0]), __builtin_bit_cast(float, (unsigned)b[1]));
}
__device__ __forceinline__ float grp4_sum(float x) {
  const auto a = __builtin_amdgcn_permlane16_swap(__builtin_bit_cast(unsigned, x), __builtin_bit_cast(unsigned, x), false, false);
  x = __builtin_bit_cast(float, (unsigned)a[0]) + __builtin_bit_cast(float, (unsigned)a[1]);
  const auto b = __builtin_amdgcn_permlane32_swap(__builtin_bit_cast(unsigned, x), __builtin_bit_cast(unsigned, x), false, false);
  return __builtin_bit_cast(float, (unsigned)b[0]) + __builtin_bit_cast(float, (unsigned)b[1]);
}
__device__ __forceinline__ void fox_unit(const Params& p, unsigned char* lds, int b, int h, int qb) {
  asm volatile("" ::: "memory");
  unsigned char* ws = p.ws; bf16* proj = (bf16*)(ws + WS_P);
  int tid = threadIdx.x; asm volatile("" : "+v"(tid)); const int wave = __builtin_amdgcn_readfirstlane(tid >> 6), lane = tid & 63, li = lane & 15, g = lane >> 4;
  const int bh = b * 4 + h; const int qrel = wave * 16 + li; const size_t qrow = (size_t)b * SEQ + qb * 128 + qrel;
  const float* cum = (const float*)(ws + SM_CUM) + (size_t)bh * SEQ;
  const bf16* Kbase = proj + (size_t)b * SEQ * PW + C_FOXK + h * 64; const bf16* VTbase = (const bf16*)(ws + P_FOXVT) + (size_t)bh * 64 * SEQ;
  bf16x8 qf[2];
#pragma unroll
  for (int ks = 0; ks < 2; ++ks) qf[ks] = *(const bf16x8*)(proj + qrow * PW + C_FOXQ + h * 64 + ks * 32 + 8 * g);
  const float SC = 0.125f * LOG2E;
  f32x4 o[4];
#pragma unroll
  for (int dt = 0; dt < 4; ++dt) o[dt] = (f32x4){0.f, 0.f, 0.f, 0.f};
  float m = -INFINITY, lsum = 0.f;
  AtRegs rg; at_issue(rg, Kbase, VTbase, cum, tid);
  __syncthreads();
  at_commit(rg, lds, tid);
  if (qb > 0) at_issue(rg, Kbase + (size_t)128 * PW, VTbase + 128, cum + 128, tid);
  LDS_BARRIER();
  for (int kb = 0; kb <= qb; ++kb) {
    unsigned char* buf = lds + (kb & 1) * AT_BUF; const bf16* Ks = (const bf16*)(buf + AT_KS); const bf16* Vs = (const bf16*)(buf + AT_VS); const float* Cs = (const float*)(buf + AT_CS);
    const bool diag = kb == qb; const int nst = diag ? (wave >> 1) + 1 : 4;
    for (int st = 0; st < nst; ++st) {
      f32x4 s0 = {0.f, 0.f, 0.f, 0.f}, s1 = {0.f, 0.f, 0.f, 0.f};
#pragma unroll
      for (int ks = 0; ks < 2; ++ks) { const bf16x8 a0 = *(const bf16x8*)(Ks + (st * 32 + li) * KS_P + ks * 32 + 8 * g), a1 = *(const bf16x8*)(Ks + (st * 32 + 16 + li) * KS_P + ks * 32 + 8 * g);
        s0 = MFMA16(a0, qf[ks], s0); s1 = MFMA16(a1, qf[ks], s1); }
      const f32x4 c0 = *(const f32x4*)(Cs + st * 32 + 4 * g), c1 = *(const f32x4*)(Cs + st * 32 + 16 + 4 * g);
      float x[8];
#pragma unroll
      for (int j = 0; j < 4; ++j) { x[j] = s0[j] * SC + c0[j]; x[4 + j] = s1[j] * SC + c1[j]; }
      if (diag) {
#pragma unroll
        for (int j = 0; j < 4; ++j) { if (st * 32 + 4 * g + j > qrel) x[j] = -INFINITY; if (st * 32 + 16 + 4 * g + j > qrel) x[4 + j] = -INFINITY; }
      }
      float mx = fmaxf(fmaxf(fmaxf(x[0], x[1]), fmaxf(x[2], x[3])), fmaxf(fmaxf(x[4], x[5]), fmaxf(x[6], x[7])));
      mx = grp4_max(mx);
      const float mn = fmaxf(m, mx);
      const bool grew = __any(mn > m);
      float ps = 0.f;
#pragma unroll
      for (int j = 0; j < 8; ++j) { x[j] = ex2(x[j] - mn); ps += x[j]; }
      if (grew) { const float f = ex2(m - mn); lsum *= f;
#pragma unroll
        for (int dt = 0; dt < 4; ++dt) o[dt] = o[dt] * f;
        m = mn; }
      lsum += ps;
      const bf16x8 pb = pack_frag(x);
#pragma unroll
      for (int dt = 0; dt < 4; ++dt) o[dt] = MFMA16(vfrag(Vs, dt * 16 + li, st * 32, g), pb, o[dt]);
    }
    if (kb < qb) {
      at_commit(rg, lds + ((kb + 1) & 1) * AT_BUF, tid);
      if (kb + 2 <= qb) at_issue(rg, Kbase + (size_t)(kb + 2) * 128 * PW, VTbase + (kb + 2) * 128, cum + (kb + 2) * 128, tid);
      LDS_BARRIER();
    }
  }
  lsum = grp4_sum(lsum);
  const float inv = 1.f / lsum;
#pragma unroll
  for (int dt = 0; dt < 4; ++dt) { u32x2 w; w.x = pk2(o[dt][0] * inv, o[dt][1] * inv); w.y = pk2(o[dt][2] * inv, o[dt][3] * inv);
    *(u32x2*)(proj + qrow * PW + C_FOXQ + h * 64 + dt * 16 + 4 * g) = w; }
}
__device__ __forceinline__ void ret_unit(const Params& p, int l, unsigned char* lds, int b, int h, int c) {
  asm volatile("" ::: "memory");
  unsigned char* ws = p.ws; bf16* proj = (bf16*)(ws + WS_P);
  int tid = threadIdx.x; asm volatile("" : "+v"(tid)); const int wave = __builtin_amdgcn_readfirstlane(tid >> 6), lane = tid & 63, li = lane & 15, g = lane >> 4;
  const int bh = b * 4 + h; const int nrel = wave * 16 + li; const size_t qrow = (size_t)b * SEQ + c * 128 + nrel;
  const float lg2 = log2f(1.f - exp2f(-5.f - (float)h));
  bf16* RT = (bf16*)(lds + 2 * AT_BUF);
  AtRegs rg; at_issue(rg, proj + ((size_t)b * SEQ + c * 128) * PW + C_RETK + h * 64, (const bf16*)(ws + P_RETVT) + (size_t)bh * 64 * SEQ + c * 128, nullptr, tid);
  { const float cd = ex2(lg2 * 128.f); const float* KV = (const float*)(ws + P_RETKV) + (size_t)bh * 32 * 4096 + (tid >> 3) * 64 + (tid & 7) * 8;
    f32x4 a0 = {0.f, 0.f, 0.f, 0.f}, a1 = {0.f, 0.f, 0.f, 0.f};
    int cc = 0;
    for (; cc + 4 <= c; cc += 4) { f32x4 k0[4], k1[4];
#pragma unroll
      for (int u = 0; u < 4; ++u) { k0[u] = *(const f32x4*)(KV + (size_t)(cc + u) * 4096); k1[u] = *(const f32x4*)(KV + (size_t)(cc + u) * 4096 + 4); }
#pragma unroll
      for (int u = 0; u < 4; ++u) { a0 = a0 * cd + k0[u]; a1 = a1 * cd + k1[u]; } }
    for (; cc < c; ++cc) { const f32x4 k0 = *(const f32x4*)(KV + (size_t)cc * 4096), k1 = *(const f32x4*)(KV + (size_t)cc * 4096 + 4); a0 = a0 * cd + k0; a1 = a1 * cd + k1; }
    __syncthreads();
    const int d = tid >> 3, e0 = (tid & 7) * 8;
#pragma unroll
    for (int e = 0; e < 4; ++e) { RT[(e0 + e) * KS_P + d] = (bf16)f2bf(a0[e]); RT[(e0 + 4 + e) * KS_P + d] = (bf16)f2bf(a1[e]); } }
  at_commit(rg, lds, tid);
  bf16x8 qf[2];
#pragma unroll
  for (int ks = 0; ks < 2; ++ks) qf[ks] = *(const bf16x8*)(proj + qrow * PW + C_RETQ + h * 64 + ks * 32 + 8 * g);
  __syncthreads();
  const bf16* Ks = (const bf16*)(lds + AT_KS); const bf16* Vs = (const bf16*)(lds + AT_VS);
  f32x4 o[4], cr[4];
#pragma unroll
  for (int et = 0; et < 4; ++et) { o[et] = (f32x4){0.f, 0.f, 0.f, 0.f}; cr[et] = (f32x4){0.f, 0.f, 0.f, 0.f};
#pragma unroll
    for (int ks = 0; ks < 2; ++ks) cr[et] = MFMA16(*(const bf16x8*)(RT + (et * 16 + li) * KS_P + ks * 32 + 8 * g), qf[ks], cr[et]); }
  const int nst = (wave >> 1) + 1;
  for (int st = 0; st < nst; ++st) {
    f32x4 s0 = {0.f, 0.f, 0.f, 0.f}, s1 = {0.f, 0.f, 0.f, 0.f};
#pragma unroll
    for (int ks = 0; ks < 2; ++ks) { const bf16x8 a0 = *(const bf16x8*)(Ks + (st * 32 + li) * KS_P + ks * 32 + 8 * g), a1 = *(const bf16x8*)(Ks + (st * 32 + 16 + li) * KS_P + ks * 32 + 8 * g);
      s0 = MFMA16(a0, qf[ks], s0); s1 = MFMA16(a1, qf[ks], s1); }
    float x[8];
#pragma unroll
    for (int j = 0; j < 4; ++j) { const int m0 = st * 32 + 4 * g + j, m1 = m0 + 16;
      x[j] = (m0 <= nrel) ? s0[j] * ex2(lg2 * (float)(nrel - m0)) : 0.f; x[4 + j] = (m1 <= nrel) ? s1[j] * ex2(lg2 * (float)(nrel - m1)) : 0.f; }
    const bf16x8 pb = pack_frag(x);
#pragma unroll
    for (int et = 0; et < 4; ++et) o[et] = MFMA16(vfrag(Vs, et * 16 + li, st * 32, g), pb, o[et]);
  }
  const float xi = ex2(lg2 * (float)(nrel + 1));
  float ss = 0.f;
#pragma unroll
  for (int et = 0; et < 4; ++et)
#pragma unroll
    for (int j = 0; j < 4; ++j) { o[et][j] += xi * cr[et][j]; ss += o[et][j] * o[et][j]; }
  ss += __shfl_xor(ss, 16); ss += __shfl_xor(ss, 32);
  const float rs = rsqrtf(ss * (1.f / 64.f) + EPS);
  const float* gnw = p.in[33] + (size_t)l * G + h * 64;
#pragma unroll
  for (int et = 0; et < 4; ++et) { const int e0 = et * 16 + 4 * g;
    const u32x2 gg = *(const u32x2*)(proj + qrow * PW + C_RETG + h * 64 + e0); const float gt[4] = {bflo(gg.x), bfhi(gg.x), bflo(gg.y), bfhi(gg.y)};
    float r[4];
#pragma unroll
    for (int j = 0; j < 4; ++j) r[j] = o[et][j] * rs * gnw[e0 + j] * (gt[j] * sigmoidf_(gt[j]));
    u32x2 w; w.x = pk2(r[0], r[1]); w.y = pk2(r[2], r[3]);
    *(u32x2*)(proj + qrow * PW + C_RETQ + h * 64 + e0) = w; }
}

constexpr int XP = 264;
__device__ __forceinline__ void xattn_unit(const Params& p, int l, unsigned char* lds, int unit) {
  asm volatile("" ::: "memory");
  unsigned char* ws = p.ws; bf16* qb = (bf16*)(ws + WS_P);
  int tid = threadIdx.x; asm volatile("" : "+v"(tid)); const int wave = __builtin_amdgcn_readfirstlane(tid >> 6), lane = tid & 63, li = lane & 15, g = lane >> 4;
  const int b = unit >> 6, head = (unit >> 4) & 3, qt = unit & 15;
  bf16* L = (bf16*)lds;
  const bf16* kg = (const bf16*)(ws + WS_KM) + ((size_t)l * 1024 + b * 256) * 1024 + head * 256;
  const bf16* vg = (const bf16*)(ws + WS_VMT) + (size_t)(((l * 4 + b) * 4 + head) * 256) * 256;
  __syncthreads();
#pragma unroll
  for (int i0 = 0; i0 < 16; i0 += 8) { u32x4 t[8];
#pragma unroll
    for (int i = 0; i < 8; ++i) { const int id = tid + 512 * (i0 + i), row = id >> 5, ch = id & 31; t[i] = *(const u32x4*)(kg + (size_t)row * 1024 + ch * 8); }
#pragma unroll
    for (int i = 0; i < 8; ++i) { const int id = tid + 512 * (i0 + i), row = id >> 5, ch = id & 31; *(u32x4*)(L + row * XP + ch * 8) = t[i]; } }
  __syncthreads();
  bf16x8 pb[2][8]; float linv[2];
  const float SC = LOG2E / 16.f;
#pragma unroll
  for (int grp = 0; grp < 2; ++grp) {
    const size_t row = (size_t)b * SEQ + qt * 256 + wave * 32 + grp * 16 + li;
    bf16x8 qf[8];
#pragma unroll
    for (int ks = 0; ks < 8; ++ks) qf[ks] = *(const bf16x8*)(qb + row * 1024 + head * 256 + ks * 32 + 8 * g);
    f32x4 s[16];
#pragma unroll
    for (int kt = 0; kt < 16; ++kt) { s[kt] = (f32x4){0.f, 0.f, 0.f, 0.f};
#pragma unroll
      for (int ks = 0; ks < 8; ++ks) s[kt] = MFMA16(*(const bf16x8*)(L + (kt * 16 + li) * XP + ks * 32 + 8 * g), qf[ks], s[kt]);
      if ((kt & 1) == 1) __builtin_amdgcn_sched_barrier(0); }
    float mx = -INFINITY;
#pragma unroll
    for (int kt = 0; kt < 16; ++kt) mx = fmaxf(mx, fmaxf(fmaxf(s[kt][0], s[kt][1]), fmaxf(s[kt][2], s[kt][3])));
    mx = fmaxf(mx, __shfl_xor(mx, 16)); mx = fmaxf(mx, __shfl_xor(mx, 32));
    float ps = 0.f;
#pragma unroll
    for (int kt = 0; kt < 16; ++kt)
#pragma unroll
      for (int j = 0; j < 4; ++j) { s[kt][j] = ex2((s[kt][j] - mx) * SC); ps += s[kt][j]; }
    ps += __shfl_xor(ps, 16); ps += __shfl_xor(ps, 32);
    linv[grp] = 1.f / ps;
#pragma unroll
    for (int kk = 0; kk < 8; ++kk) { float x[8];
#pragma unroll
      for (int j = 0; j < 4; ++j) { x[j] = s[2 * kk][j]; x[4 + j] = s[2 * kk + 1][j]; }
      pb[grp][kk] = pack_frag(x); }
    __builtin_amdgcn_sched_barrier(0);
  }
  __syncthreads();
#pragma unroll
  for (int i0 = 0; i0 < 16; i0 += 8) { u32x4 t[8];
#pragma unroll
    for (int i = 0; i < 8; ++i) { const int id = tid + 512 * (i0 + i), row = id >> 5, ch = id & 31; t[i] = *(const u32x4*)(vg + (size_t)row * 256 + ch * 8); }
#pragma unroll
    for (int i = 0; i < 8; ++i) { const int id = tid + 512 * (i0 + i), row = id >> 5, ch = id & 31; *(u32x4*)(L + row * XP + ch * 8) = t[i]; } }
  __syncthreads();
#pragma unroll
  for (int grp = 0; grp < 2; ++grp) {
    const size_t row = (size_t)b * SEQ + qt * 256 + wave * 32 + grp * 16 + li;
#pragma unroll
    for (int dt = 0; dt < 16; ++dt) { f32x4 o = {0.f, 0.f, 0.f, 0.f};
#pragma unroll
      for (int kk = 0; kk < 8; ++kk) { const u32x2 lo = *(const u32x2*)(L + (dt * 16 + li) * XP + kk * 32 + 4 * g), hi = *(const u32x2*)(L + (dt * 16 + li) * XP + kk * 32 + 16 + 4 * g);
        const u32x4 w = {lo.x, lo.y, hi.x, hi.y}; o = MFMA16(__builtin_bit_cast(bf16x8, w), pb[grp][kk], o); }
      u32x2 w; w.x = pk2(o[0] * linv[grp], o[1] * linv[grp]); w.y = pk2(o[2] * linv[grp], o[3] * linv[grp]);
      *(u32x2*)(qb + row * 1024 + head * 256 + dt * 16 + 4 * g) = w;
      __builtin_amdgcn_sched_barrier(0); }
  }
}

#define LAS __attribute__((address_space(3)))
#define XB_TMO      128
#define XB_XCNT(j)  (256  + 64 * (j))
#define XB_XSUB(j)  (1280 + 64 * (j))
#define XB_XGEN(j)  (2304 + 64 * (j))
#define XB_TOP      3328
#define XB_TOPGEN   3392
#define XCD_BAR_WORDS 3456
#define XB_SPIN_CAP (1u << 18)

__device__ __forceinline__ unsigned xb_ld(unsigned* p)              { return __hip_atomic_load(p, __ATOMIC_RELAXED, __HIP_MEMORY_SCOPE_AGENT); }
__device__ __forceinline__ unsigned xb_add(unsigned* p, unsigned v) { return __hip_atomic_fetch_add(p, v, __ATOMIC_RELAXED, __HIP_MEMORY_SCOPE_AGENT); }
__device__ __forceinline__ unsigned xb_xcc_id() { return (unsigned)__builtin_amdgcn_s_getreg((3 << 11) | 20) & 0xFu; }
#define XB_SPIN(cond, bar) do { unsigned _sp = 0; while (cond) { __builtin_amdgcn_s_sleep(1); \
    if ((++_sp & 255u) == 0u) { if (xb_ld(&(bar)[XB_TMO])) break; if (_sp > XB_SPIN_CAP) { atomicAdd(&(bar)[XB_TMO], 1u); break; } } } } while (0)

struct XcdBarrier {
    unsigned* bar; unsigned x;
    volatile LAS unsigned* st;
};

__device__ __forceinline__ XcdBarrier xcd_barrier_post(unsigned* bar, volatile LAS unsigned* st) {
    XcdBarrier b; b.bar = bar; b.x = xb_xcc_id(); b.st = st;
    if (threadIdx.x == 0) (void)xb_add(&bar[XB_XCNT(b.x)], 1u);
    return b;
}
__device__ __forceinline__ void xcd_barrier_complete(unsigned* bar, unsigned x, unsigned& nloc, unsigned& nx) {
    const unsigned G = gridDim.x * gridDim.y * gridDim.z;
    unsigned sum, cnt, mine, sp = 0u;
    for (;;) {
        sum = 0u; cnt = 0u; mine = 0u;
#pragma unroll
        for (unsigned j = 0; j < 16; ++j) { const unsigned c = xb_ld(&bar[XB_XCNT(j)]); sum += c; cnt += (c > 0u) ? 1u : 0u; mine = (j == x) ? c : mine; }
        if (sum == G) break;
        __builtin_amdgcn_s_sleep(1);
        if ((++sp & 255u) == 0u) { if (xb_ld(&bar[XB_TMO])) break; if (sp > XB_SPIN_CAP) { atomicAdd(&bar[XB_TMO], 1u); break; } }
    }
    nloc = mine > 0u ? mine : 1u; nx = cnt > 0u ? cnt : 1u;
}

__device__ __forceinline__ void xcd_barrier(const XcdBarrier& b) {
    asm volatile("s_waitcnt vmcnt(0)" ::: "memory");
    __syncthreads();
    if (threadIdx.x == 0) {
        unsigned* bar = b.bar;
        __builtin_amdgcn_s_waitcnt(0);
        unsigned nloc = b.st[0], nx = b.st[1];
        if (nloc == 0u) { xcd_barrier_complete(bar, b.x, nloc, nx); b.st[0] = nloc; b.st[1] = nx; }
        const unsigned old = xb_add(&bar[XB_XSUB(b.x)], 1u);
        const unsigned gen = old / nloc;
        if (old + 1u == (gen + 1u) * nloc) {
            __builtin_amdgcn_fence(__ATOMIC_RELEASE, "agent");
            asm volatile("s_waitcnt vmcnt(0)" ::: "memory");
            const unsigned og = xb_add(&bar[XB_TOP], 1u);
            const unsigned tg = og / nx;
            if (og + 1u == (tg + 1u) * nx) xb_add(&bar[XB_TOPGEN], 1u);
            else XB_SPIN(xb_ld(&bar[XB_TOPGEN]) == tg, bar);
            __builtin_amdgcn_fence(__ATOMIC_ACQUIRE, "agent");
            xb_add(&bar[XB_XGEN(b.x)], 1u);
            asm volatile("s_waitcnt vmcnt(0)" ::: "memory");
        } else {
            XB_SPIN(xb_ld(&bar[XB_XGEN(b.x)]) == gen, bar);
            __builtin_amdgcn_fence(__ATOMIC_ACQUIRE, "agent");
            asm volatile("s_waitcnt vmcnt(0)" ::: "memory");
        }
    }
    __syncthreads();
}


#ifndef DEBUG_LAUNCHES
#define DEBUG_LAUNCHES 0
#endif
constexpr int PH_PER_LAYER = 13, N_PHASES = 1 + PH_PER_LAYER * DEPTH;

__global__ void __launch_bounds__(NTHREADS) mega_fwd(Params p) {
  extern __shared__ __attribute__((aligned(16))) unsigned char lds[];
  cg::grid_group grid = cg::this_grid();
  constexpr int NB = 256, NGW = NB * NWAVES;
  unsigned char* ws = p.ws;
  PG8_LAS unsigned char* glds = (PG8_LAS unsigned char*)lds;
  bf16* Hb = (bf16*)(ws + WS_H); bf16* Ob = (bf16*)(ws + WS_O); bf16* Pb = (bf16*)(ws + WS_P);
  volatile LAS unsigned* xb_st = (volatile LAS unsigned*)((LAS unsigned char*)lds + (LDS_BYTES - 32));
  if (threadIdx.x == 0) { xb_st[0] = 0u; xb_st[1] = 0u; }
  __syncthreads();
  const XcdBarrier xbar = xcd_barrier_post((unsigned*)(ws + SM_BAR), xb_st);
  int ph = 0;
#ifdef DBG_CLR
#define DBG_LDSCLEAR { for (int e_ = threadIdx.x; e_ < LDS_BYTES / 4; e_ += NTHREADS) ((unsigned*)lds)[e_] = 0u; __syncthreads(); }
#else
#define DBG_LDSCLEAR
#endif
#define PHASE_BEGIN if (ph >= p.ph_lo && ph < p.ph_hi) { int tid = threadIdx.x; asm volatile("" : "+v"(tid)); const int lane = tid & 63, wave = __builtin_amdgcn_readfirstlane(tid >> 6), gw = blockIdx.x * NWAVES + wave; (void)lane; (void)gw; DBG_LDSCLEAR
#ifdef TS_PH
#define TS_REC if (blockIdx.x == 0 && threadIdx.x == 0) ((unsigned long long*)(ws + SM_Q + 256))[ph + 1] = __builtin_amdgcn_s_memrealtime();
#else
#define TS_REC
#endif
#define PHASE_END   if (ph + 1 < p.ph_hi) { if (p.ph_lo < 0) grid.sync();   else xcd_barrier(xbar); } TS_REC } ++ph;

  PHASE_BEGIN
    float* scr = (float*)lds + wave * (64 * 33);
    conv_layer_weights(p, 0, scr, gw, NGW, lane);
    { constexpr int I_SQ = (D / 64) * (D / 32);
      for (int it = gw; it < 4 * I_SQ; it += NGW) { const int w = it / I_SQ, r = it % I_SQ, layer = w >> 1, isv = w & 1;
        conv_item<0>(p.in[isv ? 36 : 35] + (size_t)layer * D * D, D, D, D, (bf16*)(ws + WS_WKV) + (size_t)w * D * D, scr, r, lane); } }
    for (int l = 0; l < DEPTH; ++l) { RowArgs a{}; a.xin = p.in[1]; a.g_pre = p.in[6] + (size_t)l * D; a.hout = (bf16*)(ws + WS_MEMN) + (size_t)l * 1024 * 1024; a.rows = 1024; row_phase(a, gw, NGW, lane); }
    { RowArgs a{}; a.xin = p.in[0]; a.g_pre = p.in[2]; a.hout = Hb; a.wf = p.in[9]; a.fbias = p.in[11]; a.logf = (float*)(ws + SM_LOGF); a.rows = T; row_phase(a, gw, NGW, lane); }
#ifdef DBG_FILLG
    for (int e = blockIdx.x * NTHREADS + tid; e < T * G / 2; e += NB * NTHREADS) ((unsigned*)(ws + RW_G))[e] = 0x447A447Au;
#endif
    for (int e = blockIdx.x * NTHREADS + tid; e < SEQ * 32; e += NB * NTHREADS) { const int pos = e >> 5, i = e & 31; const float inv = 1.f / powf(10000.f, (float)i / 31.f); const float ang = (float)pos * inv;
      ((float*)(ws + SM_ROT))[2 * e] = cosf(ang); ((float*)(ws + SM_ROT))[2 * e + 1] = sinf(ang); }
  PHASE_END

  for (int l = 0; l < DEPTH; ++l) {
    PHASE_BEGIN
      { pg8::Gemm g{Hb, (const bf16*)(ws + W_IN), T, NIN, D, D}; pg8::StaticOrder S; S.init(T, NIN, NB, (int)blockIdx.x);
        EpiIn E{Pb, (bf16*)(ws + P_FOXVT), (bf16*)(ws + P_RETKT), (bf16*)(ws + P_RETVT), (const float*)(ws + SM_ROT)};
        pg8::gemm_phase<EpiIn, pg8::StaticOrder, true, true>(glds, g, S, E); }
      if (l == 0) { pg8::Gemm g{(const bf16*)(ws + WS_MEMN), (const bf16*)(ws + WS_WKV), 2048, 4096, D, D}; MemSched S{NB, (int)blockIdx.x - 64};
        EpiMem E{(bf16*)(ws + WS_KM), (bf16*)(ws + WS_VMT)};
        pg8::gemm_phase<EpiMem, MemSched, true, true>(glds, g, S, E); }
    PHASE_END
    PHASE_BEGIN
      float* wl = (float*)lds + wave * (16 * WLP);
      for (int u = gw; u < 4096; u += NGW) rwkv_prep_unit(p, l, u >> 2, u & 3, wl, lane);
      for (int u = gw; u < 512; u += NGW) ret_kv_unit(p, u, lane);
      if (gw >= 1024 && gw < 1040) fox_cum_unit(p, gw - 1024, lane);
      if (blockIdx.x == 0 && tid == 0) *(int*)(ws + SM_Q) = 0;
    PHASE_END
    PHASE_BEGIN
#ifndef DBG_P3
#define DBG_P3 15
#endif
      if (blockIdx.x < 128) {
        const int bx_ = blockIdx.x, j_ = bx_ >> 3, su_ = ((2 * (bx_ & 7) + (j_ >> 3)) << 3) | (j_ & 7);
        if (DBG_P3 & 1) rwkv_scan_unit(p, lds, su_);
#ifdef REP_SCAN
        rwkv_scan_unit(p, lds, blockIdx.x);
#endif
      }
      else if (blockIdx.x < 144) { if (DBG_P3 & 2) lru_unit(p, l, (float*)lds, blockIdx.x - 128); }
      int* qword = (int*)(lds + LDS_BYTES - 16);
      for (;;) {
        __syncthreads();
        if (tid == 0) *qword = atomicAdd((int*)(ws + SM_Q), 1);
        __syncthreads();
        const int id = *qword;
        if (id >= 1024) break;
        if (id < 512) { if (DBG_P3 & 4) fox_unit(p, lds, (id & 15) >> 2, id & 3, 31 - (id >> 4)); }
        else if (DBG_P3 & 8) { const int r = id - 512; ret_unit(p, l, lds, r >> 7, (r >> 5) & 3, r & 31); }
      }
    PHASE_END
    PHASE_BEGIN
      for (int row = gw; row < T; row += NGW) rwkv_post_row(p, l, row, lane);
    PHASE_END
    PHASE_BEGIN
      pg8::Gemm g{Pb, (const bf16*)(ws + W_OUT), T, D, D, PW}; pg8::StaticOrder S; S.init(T, D, NB, (int)blockIdx.x);
      EpiPlain E{Ob, D, 0, nullptr};
      pg8::gemm_phase<EpiPlain, pg8::StaticOrder, true, true>(glds, g, S, E);
    PHASE_END
    PHASE_BEGIN
      RowArgs a{}; a.xin = l == 0 ? p.in[0] : p.out; a.O = Ob; a.g_post = p.in[3] + (size_t)l * D; a.xout = p.out; a.g_pre = p.in[4] + (size_t)l * D; a.hout = Hb; a.rows = T;
      row_phase(a, gw, NGW, lane);
    PHASE_END
    PHASE_BEGIN
      pg8::Gemm g{Hb, (const bf16*)(ws + W_Q), T, D, D, D}; pg8::StaticOrder S; S.init(T, D, NB, (int)blockIdx.x);
      EpiPlain E{Pb, D, 0, nullptr};
      pg8::gemm_phase<EpiPlain, pg8::StaticOrder, true, true>(glds, g, S, E);
    PHASE_END
    PHASE_BEGIN
      for (int u = blockIdx.x; u < 256; u += NB) xattn_unit(p, l, lds, u);
    PHASE_END
    PHASE_BEGIN
      pg8::Gemm g{Pb, (const bf16*)(ws + W_O), T, D, D, D}; pg8::StaticOrder S; S.init(T, D, NB, (int)blockIdx.x);
      EpiPlain E{Ob, D, 0, nullptr};
      pg8::gemm_phase<EpiPlain, pg8::StaticOrder, true, true>(glds, g, S, E);
    PHASE_END
    PHASE_BEGIN
      RowArgs a{}; a.xin = p.out; a.O = Ob; a.g_post = p.in[5] + (size_t)l * D; a.xout = p.out; a.g_pre = p.in[7] + (size_t)l * D; a.hout = Hb; a.rows = T;
      row_phase(a, gw, NGW, lane);
    PHASE_END
    PHASE_BEGIN
      pg8::Gemm g{Hb, (const bf16*)(ws + W_1), T, DFF, D, D}; pg8::StaticOrder S; S.init(T, DFF, NB, (int)blockIdx.x);
      EpiPlain E{Pb, DFF, 1, nullptr};
      pg8::gemm_phase<EpiPlain, pg8::StaticOrder, true, true>(glds, g, S, E);
    PHASE_END
    PHASE_BEGIN
      pg8::Gemm g{Pb, (const bf16*)(ws + W_2), T, D, DFF, DFF}; pg8::StaticOrder S; S.init(T, D, NB, (int)blockIdx.x);
      EpiPlain E{Ob, D, 0, nullptr};
      pg8::gemm_phase<EpiPlain, pg8::StaticOrder, true, true>(glds, g, S, E);
    PHASE_END
    PHASE_BEGIN
      RowArgs a{}; a.xin = p.out; a.O = Ob; a.g_post = p.in[8] + (size_t)l * D; a.xout = p.out; a.rows = T;
      if (l + 1 < DEPTH) { a.g_pre = p.in[2] + (size_t)(l + 1) * D; a.hout = Hb; a.wf = p.in[9] + (size_t)(l + 1) * D * INW; a.fbias = p.in[11] + (size_t)(l + 1) * GH; a.logf = (float*)(ws + SM_LOGF); }
      row_phase(a, gw, NGW, lane);
      if (l + 1 < DEPTH) { __syncthreads(); conv_layer_weights(p, l + 1, (float*)lds + wave * (64 * 33), gw, NGW, lane); }
    PHASE_END
  }
#ifdef TS_PH
  grid.sync();
  if (blockIdx.x == 0) { const unsigned long long* ts = (const unsigned long long*)(ws + SM_Q + 256);
#ifdef TS_CONST
    const float dt_us = TS_CONST;
#else
    const float dt_us = (float)(ts[TS_PH + 1] - ts[TS_PH]) * 0.01f;
#endif
    const float delta = 0.01f * sqrtf(dt_us);
    for (int r = threadIdx.x; r < T; r += NTHREADS) p.out[(size_t)r * D] += delta; }
#endif
}


#ifdef DBG_STOP
#ifndef DBG_MASK
#define DBG_MASK 15
#endif
__global__ void dbg_dump(const unsigned char* ws, float* out) {
  const size_t i = (size_t)blockIdx.x * 256 + threadIdx.x; const int row = (int)(i >> 10), c = (int)(i & 1023);
#ifndef DBG_SRC
#define DBG_SRC 0
#endif
#ifndef DBG_COFF
#define DBG_COFF 0
#endif
  const bf16* proj = (const bf16*)(ws + WS_P);
  if (DBG_SRC == 0) out[i] = ((DBG_MASK >> (c >> 8)) & 1) ? bflo((unsigned)proj[(size_t)row * PW + DBG_COFF + c]) : 0.f;
  else if (DBG_SRC == 1) { const bf16* a = (const bf16*)(ws + WS_RW) + (size_t)(c >> 8) * (8u << 19); out[i] = ((DBG_MASK >> (c >> 8)) & 1) ? bflo((unsigned)a[(size_t)row * G + (c & 255)]) : 0.f; }
  else if (DBG_SRC == 2) { const bf16* a = (const bf16*)(ws + RW_K) + (size_t)(c >> 8) * (8u << 19); float v = 0.f; if (c < 768) v = bflo((unsigned)a[(size_t)row * G + (c & 255)]); else if (c < 772) v = ((const float*)(ws + SM_BR))[row * 4 + (c & 3)]; else if (c < 776) v = ((const float*)(ws + SM_KR))[row * 4 + (c & 3)]; else if (c < 780) v = ((const float*)(ws + SM_RK))[row * 4 + (c & 3)];
    out[i] = ((DBG_MASK >> (c >> 8)) & 1) ? v : 0.f; }
  else if (DBG_SRC == 5) { out[i] = c < 256 ? bflo((unsigned)((const bf16*)(ws + RW_G))[(size_t)row * G + c]) : 0.f; }
  else if (DBG_SRC == 4) { out[i] = i < 512 * 1024 ? bflo((unsigned)((const bf16*)(ws + W_SMALL))[i]) : 0.f; }
  else { out[i] = c < 256 ? ((const float*)(ws + RW_Y))[(size_t)row * G + c] : 0.f; }
}
#endif

#ifdef DBG_GCHK
__global__ void dbg_snap(const unsigned char* ws, float* out) { const size_t i = (size_t)blockIdx.x * 256 + threadIdx.x; ((unsigned*)out)[i] = ((const unsigned*)(ws + RW_G))[i]; if (i == 0) *(unsigned*)(ws + SM_Q + 64) = 0u; }
__global__ void dbg_cmp(unsigned char* ws, const float* out) { const size_t i = (size_t)blockIdx.x * 256 + threadIdx.x; const unsigned a = ((const unsigned*)(ws + RW_G))[i], b = ((const unsigned*)out)[i];
  if (a != b) { unsigned f = 1u; if (a == 0x447A447Au) f |= 2u; else f |= 4u; atomicOr((unsigned*)(ws + SM_Q + 64), f); } }
__global__ void dbg_fin(const unsigned char* ws, float* out) { const size_t i = (size_t)blockIdx.x * 256 + threadIdx.x; out[i] = (i == 0) ? 1.0e6f * (float)(*(const unsigned*)(ws + SM_Q + 64)) : 0.f; }
#endif
extern "C" void kernel_launch(void* const* d_in, const int* in_sizes, int n_in, void* d_out, int out_size, void* d_ws, size_t ws_size, hipStream_t stream) {
  static int grid = 0;
  if (grid == 0) {
    if (ws_size < WS_END) { fprintf(stderr, "kernel_launch: workspace too small: %zu < %zu\n", ws_size, (size_t)WS_END); grid = -1; return; }
    int dev = 0, cus = 0, per_cu = 0;
    hipGetDevice(&dev); hipDeviceGetAttribute(&cus, hipDeviceAttributeMultiprocessorCount, dev);
    hipFuncSetAttribute((const void*)mega_fwd, hipFuncAttributeMaxDynamicSharedMemorySize, LDS_BYTES);
    hipOccupancyMaxActiveBlocksPerMultiprocessor(&per_cu, (const void*)mega_fwd, NTHREADS, LDS_BYTES);
    if (per_cu < 1) { fprintf(stderr, "kernel_launch: occupancy query says %d blocks/CU\n", per_cu); per_cu = 1; }
    grid = 256;
    if (cus < 256) { fprintf(stderr, "kernel_launch: needs 256 CUs, device has %d\n", cus); grid = -1; return; }
    (void)hipGetLastError();
  }
  if (grid < 0) return;
  Params p{};
  for (int i = 0; i < 40; ++i) p.in[i] = (const float*)d_in[i];
  p.out = (float*)d_out; p.ws = (unsigned char*)d_ws;
#if DEBUG_LAUNCHES
#ifdef DBG_GCHK
  for (int ph = 0; ph < 3; ++ph) { p.ph_lo = ph; p.ph_hi = ph + 1; hipLaunchKernelGGL(mega_fwd, dim3(grid), dim3(NTHREADS), LDS_BYTES, stream, p); }
  hipLaunchKernelGGL(dbg_snap, dim3(T * G / 2 / 256), dim3(256), 0, stream, (const unsigned char*)d_ws, (float*)d_out);
  p.ph_lo = 3; p.ph_hi = 4; hipLaunchKernelGGL(mega_fwd, dim3(grid), dim3(NTHREADS), LDS_BYTES, stream, p);
  hipLaunchKernelGGL(dbg_cmp, dim3(T * G / 2 / 256), dim3(256), 0, stream, (unsigned char*)d_ws, (const float*)d_out);
  hipLaunchKernelGGL(dbg_fin, dim3(T * 1024 / 256), dim3(256), 0, stream, (const unsigned char*)d_ws, (float*)d_out);
#elif defined(DBG_STOP)
  for (int ph = 0; ph < DBG_STOP; ++ph) { p.ph_lo = ph; p.ph_hi = ph + 1; hipLaunchKernelGGL(mega_fwd, dim3(grid), dim3(NTHREADS), LDS_BYTES, stream, p); }
  hipLaunchKernelGGL(dbg_dump, dim3(T * 1024 / 256), dim3(256), 0, stream, (const unsigned char*)d_ws, (float*)d_out);
#else
#ifndef REP_MASK
#define REP_MASK 0
#endif
  int rewound = 0;
  for (int ph = 0; ph < N_PHASES; ++ph) { p.ph_lo = ph; p.ph_hi = ph + 1; const int rel = ph == 0 ? 0 : 1 + (ph - 1) % PH_PER_LAYER;
    const int reps = ((REP_MASK >> rel) & 1) ? 2 : 1;
    for (int r = 0; r < reps; ++r) hipLaunchKernelGGL(mega_fwd, dim3(grid), dim3(NTHREADS), LDS_BYTES, stream, p);
#ifdef REP_GROUP
    if (rel == 4) { if (!rewound) { rewound = 1; ph -= 4; } else rewound = 0; }
#endif
  }
#endif
#else
  p.ph_lo = 0; p.ph_hi = N_PHASES;
  hipMemsetAsync((unsigned char*)d_ws + SM_BAR, 0, 16384, stream);
  void* args[] = {&p};
  hipError_t e = hipLaunchCooperativeKernel((const void*)mega_fwd, dim3(grid), dim3(NTHREADS), args, LDS_BYTES, stream);
  if (e != hipSuccess) fprintf(stderr, "cooperative launch failed: %s (grid %d)\n", hipGetErrorString(e), grid);
#endif
}
```

```cpp
#include <hip/hip_runtime.h>
#include <hip/hip_cooperative_groups.h>
#include <cstdio>
#include <cstdint>
#include <cmath>
namespace cg = cooperative_groups;
namespace pg8 {
#define PG8_LAS __attribute__((address_space(3)))
typedef unsigned short bf16_t;
typedef short bf16x8 __attribute__((ext_vector_type(8)));
typedef float f32x4 __attribute__((ext_vector_type(4)));
typedef unsigned u32x4 __attribute__((ext_vector_type(4)));
constexpr int BM = 256, BK = 64, HALF = 128, HTB = HALF * BK * 2  , STAGE_BYTES = 8 * HTB, NXCD = 8, WGM = 8;

__host__ __device__ __forceinline__ int lds_byte(int r, int c) { const int st = (r >> 4) * 2 + (c >> 5), rr = r & 15, cc = c & 31, ob = rr * 64 + cc * 2; return st * 1024 + (ob ^ (((ob >> 9) & 1) << 5)); }
__host__ __device__ __forceinline__ void stage_rc(int b, int& R, int& C) { const int st = b / 1024, sb = b % 1024, swz = sb ^ (((sb >> 9) & 1) << 5); R = (st >> 1) * 16 + swz / 64; C = (st & 1) * 32 + (swz % 64) / 2; }
__host__ __device__ __forceinline__ int perm32(int rho) { const int n = rho >> 4, i = rho & 15; return 8 * (i >> 2) + 4 * n + (i & 3); }

struct Unit { int pm, pn; };
struct Gemm { const bf16_t* A; const bf16_t* Bt; int M, N, K, lda; };

struct StaticOrder {
    int nM, nN, nwg, G, c;
    __host__ __device__ void init(int M, int N, int G_, int c_) { nM = M / BM; nN = N / BM; nwg = nM * nN; G = G_; c = c_; }
    __host__ __device__ bool next(int i, Unit& u) const {
        const long L = (long)i * G + c; if (L >= nwg) return false;
        int wgid = (int)L; { const int q = nwg / NXCD, r = nwg % NXCD, xcd = wgid % NXCD, off = wgid / NXCD; wgid = (xcd < r ? xcd * (q + 1) : r * (q + 1) + (xcd - r) * q) + off; }
        const int nig = WGM * nN, gid = wgid / nig, fm = gid * WGM, gsz = (nM - fm) < WGM ? (nM - fm) : WGM;
        u.pm = fm + ((wgid % nig) % gsz); u.pn = (wgid % nig) / gsz; return true;
    }
    __device__ __forceinline__ void a_ready(const Unit&) const {}
    __device__ __forceinline__ void done(const Unit&) const {}
};

__device__ __forceinline__ unsigned cvt_pk_bf16(float lo, float hi) { unsigned r; asm volatile("v_cvt_pk_bf16_f32 %0, %1, %2" : "=v"(r) : "v"(lo), "v"(hi)); return r; }
typedef float f32x2 __attribute__((ext_vector_type(2)));
template <class Epi, class Sched, bool ALIGN_EPI = false, bool SP2 = false>
__device__ __forceinline__ void gemm_phase(PG8_LAS unsigned char* lds, const Gemm g, const Sched& S, const Epi& E) {
    int tid_l = threadIdx.x; asm volatile("" : "+v"(tid_l));
    const int tid = tid_l, wid = __builtin_amdgcn_readfirstlane(tid >> 6), lane = tid & 63, wr = wid >> 2, wc = wid & 3, fr = lane & 15, fq = lane >> 4;
    const int K = g.K, nt = K / BK;
    unsigned voffA[2], voffB[2];
#pragma unroll
    for (int i = 0; i < 2; ++i) { int R, C; stage_rc(tid * 16 + i * 8192, R, C); const int Rb = Epi::PERM ? ((R & ~31) + perm32(R & 31)) : R;
        voffA[i] = (unsigned)(R * g.lda + C) * 2u; voffB[i] = (unsigned)(Rb * K + C) * 2u; }
    const size_t kstep = (size_t)(BK * 2);
    const size_t hstep = (size_t)HALF * K * 2;
    const size_t tstep = 2 * hstep; const size_t hstepA = (size_t)HALF * g.lda * 2; const size_t tstepA = 2 * hstepA;
    const unsigned ldsw = (unsigned)wid * 1024u;
    const int aoff = lds_byte(wr * 64 + fr, fq * 8), boff = lds_byte(wc * 32 + fr, fq * 8);
#define PG8_SA(b, h) (((b) * 2 + (h)) * HTB)
#define PG8_SB(b, h) ((4 + (b) * 2 + (h)) * HTB)
#define PG8_STAGE(bufoff, gbase, voff) do { _Pragma("unroll") for (int _i = 0; _i < 2; ++_i) \
        __builtin_amdgcn_global_load_lds((const unsigned*)((const char*)(gbase) + (voff)[_i]), (PG8_LAS unsigned*)(lds + (bufoff) + ldsw + _i * 8192), 16, 0, 0); } while (0)
#define PG8_LDA(dst, b, h) do { _Pragma("unroll") for (int m = 0; m < 4; ++m) _Pragma("unroll") for (int k = 0; k < 2; ++k) dst[m][k] = *(const PG8_LAS bf16x8*)(lds + PG8_SA(b, h) + aoff + m * 2048 + k * 1024); } while (0)
#define PG8_LDB(dst, b, h) do { _Pragma("unroll") for (int n = 0; n < 2; ++n) _Pragma("unroll") for (int k = 0; k < 2; ++k) dst[n][k] = *(const PG8_LAS bf16x8*)(lds + PG8_SB(b, h) + boff + n * 2048 + k * 1024); } while (0)
#define PG8_MMA(ai, bj, At, Bt) do { __builtin_amdgcn_s_setprio(1); _Pragma("unroll") for (int m = 0; m < 4; ++m) _Pragma("unroll") for (int n = 0; n < 2; ++n) _Pragma("unroll") for (int k = 0; k < 2; ++k) \
        acc[ai][bj][m][n] = __builtin_amdgcn_mfma_f32_16x16x32_bf16(Bt[n][k], At[m][k], acc[ai][bj][m][n], 0, 0, 0); __builtin_amdgcn_s_setprio(0); } while (0)
#define PG8_WAIT_V(n) asm volatile("s_waitcnt vmcnt(" #n ")" ::: "memory")
#define PG8_WAIT_L(n) asm volatile("s_waitcnt lgkmcnt(" #n ")" ::: "memory")
#define PG8_BAR __builtin_amdgcn_s_barrier()
#define PG8_SCHED __builtin_amdgcn_sched_barrier(0)
    Unit cur, nxt; int ui = 0;
    if (!S.next(0, cur)) return;
    f32x4 acc[2][2][4][2];
#pragma unroll
    for (int a = 0; a < 2; ++a)
#pragma unroll
        for (int b = 0; b < 2; ++b)
#pragma unroll
            for (int m = 0; m < 4; ++m)
#pragma unroll
                for (int n = 0; n < 2; ++n) acc[a][b][m][n] = (f32x4){0.f, 0.f, 0.f, 0.f};
    bf16x8 At[4][2], B0[2][2], B1[2][2];
    const char* cA = (const char*)g.A + (size_t)cur.pm * tstepA; const char* cB = (const char*)g.Bt + (size_t)cur.pn * tstep;
    S.a_ready(cur);
    if constexpr (SP2) {
        PG8_STAGE(PG8_SB(0, 0), cB, voffB); PG8_STAGE(PG8_SB(0, 1), cB + hstep, voffB); PG8_STAGE(PG8_SA(0, 0), cA, voffA); PG8_STAGE(PG8_SA(0, 1), cA + hstepA, voffA);
        if (wr == 1) PG8_BAR;
        PG8_WAIT_V(2); PG8_BAR;
        PG8_STAGE(PG8_SB(1, 0), cB + kstep, voffB); PG8_STAGE(PG8_SA(1, 0), cA + kstep, voffA); PG8_STAGE(PG8_SB(1, 1), cB + hstep + kstep, voffB);
        PG8_WAIT_V(6); PG8_BAR;
    } else {
        PG8_STAGE(PG8_SB(0, 0), cB, voffB); PG8_STAGE(PG8_SA(0, 0), cA, voffA); PG8_STAGE(PG8_SB(0, 1), cB + hstep, voffB); PG8_STAGE(PG8_SA(0, 1), cA + hstepA, voffA);
        if (wr == 1) PG8_BAR;
        PG8_WAIT_V(4); PG8_BAR;
        PG8_STAGE(PG8_SB(1, 0), cB + kstep, voffB); PG8_STAGE(PG8_SA(1, 0), cA + kstep, voffA); PG8_STAGE(PG8_SB(1, 1), cB + hstep + kstep, voffB);
        PG8_WAIT_V(6); PG8_BAR;
    }
    for (;;) {
        const bool has_next = S.next(ui + 1, nxt);
        const char* nA = has_next ? (const char*)g.A + (size_t)nxt.pm * tstepA : cA; const char* nB = has_next ? (const char*)g.Bt + (size_t)nxt.pn * tstep : cB;
        for (int t = 0; t < nt; t += 2) {
            const bool last = (t == nt - 2);
            const char* a1 = cA + (size_t)(t + 1) * kstep;
            const char* a2 = last ? nA : cA + (size_t)(t + 2) * kstep; const char* b2 = last ? nB : cB + (size_t)(t + 2) * kstep;
            const char* a3 = a2 + kstep; const char* b3 = b2 + kstep;
            if (last && has_next) S.a_ready(nxt);
            if constexpr (SP2) {
            PG8_LDB(B0, 0, 0); PG8_LDB(B1, 0, 1); PG8_SCHED; PG8_LDA(At, 0, 0); PG8_STAGE(PG8_SA(1, 1), a1 + hstepA, voffA);
            PG8_WAIT_V(8); PG8_WAIT_L(0); PG8_BAR; PG8_MMA(0, 0, At, B0); PG8_MMA(0, 1, At, B1); PG8_BAR; PG8_SCHED;
            PG8_LDA(At, 0, 1); PG8_STAGE(PG8_SB(0, 0), b2, voffB); PG8_STAGE(PG8_SB(0, 1), b2 + hstep, voffB); PG8_STAGE(PG8_SA(0, 0), a2, voffA);
            PG8_WAIT_V(8); PG8_WAIT_L(0); PG8_BAR; PG8_MMA(1, 0, At, B0); PG8_MMA(1, 1, At, B1); PG8_BAR; PG8_SCHED;
            PG8_LDB(B0, 1, 0); PG8_LDB(B1, 1, 1); PG8_SCHED; PG8_LDA(At, 1, 0); PG8_STAGE(PG8_SA(0, 1), a2 + hstepA, voffA);
            PG8_WAIT_V(8); PG8_WAIT_L(0); PG8_BAR; PG8_MMA(0, 0, At, B0); PG8_MMA(0, 1, At, B1); PG8_BAR; PG8_SCHED;
            PG8_LDA(At, 1, 1); PG8_STAGE(PG8_SB(1, 0), b3, voffB); PG8_STAGE(PG8_SB(1, 1), b3 + hstep, voffB); PG8_STAGE(PG8_SA(1, 0), a3, voffA);
            PG8_WAIT_V(8); PG8_WAIT_L(0); PG8_BAR; PG8_MMA(1, 0, At, B0); PG8_MMA(1, 1, At, B1); PG8_BAR; PG8_SCHED;
            } else {
            PG8_LDB(B0, 0, 0); PG8_SCHED; PG8_LDA(At, 0, 0); PG8_STAGE(PG8_SA(1, 1), a1 + hstepA, voffA);
            PG8_WAIT_L(8); PG8_BAR; PG8_WAIT_L(0); PG8_MMA(0, 0, At, B0); PG8_BAR; PG8_SCHED;
            PG8_LDB(B1, 0, 1); PG8_STAGE(PG8_SB(0, 0), b2, voffB);
            PG8_BAR; PG8_WAIT_L(0); PG8_MMA(0, 1, At, B1); PG8_BAR;
            PG8_LDA(At, 0, 1); PG8_STAGE(PG8_SA(0, 0), a2, voffA);
            PG8_BAR; PG8_WAIT_L(0); PG8_MMA(1, 0, At, B0); PG8_BAR; PG8_SCHED;
            PG8_STAGE(PG8_SB(0, 1), b2 + hstep, voffB);
            PG8_WAIT_V(6); PG8_BAR; PG8_MMA(1, 1, At, B1); PG8_BAR;
            PG8_LDB(B0, 1, 0); PG8_SCHED; PG8_LDA(At, 1, 0); PG8_STAGE(PG8_SA(0, 1), a2 + hstepA, voffA);
            PG8_WAIT_L(8); PG8_BAR; PG8_WAIT_L(0); PG8_MMA(0, 0, At, B0); PG8_BAR; PG8_SCHED;
            PG8_LDB(B1, 1, 1); PG8_STAGE(PG8_SB(1, 0), b3, voffB);
            PG8_BAR; PG8_WAIT_L(0); PG8_MMA(0, 1, At, B1); PG8_BAR;
            PG8_LDA(At, 1, 1); PG8_STAGE(PG8_SA(1, 0), a3, voffA);
            PG8_BAR; PG8_WAIT_L(0); PG8_MMA(1, 0, At, B0); PG8_BAR; PG8_SCHED;
            PG8_STAGE(PG8_SB(1, 1), b3 + hstep, voffB);
            PG8_WAIT_V(6); PG8_BAR; PG8_MMA(1, 1, At, B1); PG8_BAR;
            }
        }
        if constexpr (ALIGN_EPI) { if (wr == 0) PG8_BAR; }
        if constexpr (!Epi::AFTER_DRAIN) { E(acc, cur, wr, wc, fr, fq); S.done(cur); }
        if (!has_next) break;
#pragma unroll
        for (int a = 0; a < 2; ++a)
#pragma unroll
            for (int b = 0; b < 2; ++b)
#pragma unroll
                for (int m = 0; m < 4; ++m)
#pragma unroll
                    for (int n = 0; n < 2; ++n) acc[a][b][m][n] = (f32x4){0.f, 0.f, 0.f, 0.f};
        cur = nxt; cA = nA; cB = nB; ++ui;
        if constexpr (ALIGN_EPI) { if (wr == 1) PG8_BAR; }
    }
    PG8_WAIT_V(0);
    if constexpr (!ALIGN_EPI) { if (wr == 0) PG8_BAR; }
    PG8_BAR;
    if constexpr (Epi::AFTER_DRAIN) { E.fused(acc, cur, wr, wc, fr, fq, lds, wid, lane); S.done(cur); }
#undef PG8_SA
#undef PG8_SB
#undef PG8_STAGE
#undef PG8_LDA
#undef PG8_LDB
#undef PG8_MMA
#undef PG8_WAIT_V
#undef PG8_WAIT_L
#undef PG8_BAR
#undef PG8_SCHED
}
}

typedef unsigned short bf16;
typedef short bf16x8 __attribute__((ext_vector_type(8)));
typedef short bf16x4 __attribute__((ext_vector_type(4)));
typedef float f32x4 __attribute__((ext_vector_type(4)));
typedef float f32x2 __attribute__((ext_vector_type(2)));
typedef unsigned u32x4 __attribute__((ext_vector_type(4)));
typedef unsigned u32x2 __attribute__((ext_vector_type(2)));

constexpr int D = 1024, BATCH = 4, SEQ = 4096, DEPTH = 2, T = BATCH * SEQ;
constexpr int MEM = 256;
constexpr int G = 256, HD = 64, GH = 4;
constexpr int INW = 3332, DFF = 4096;
constexpr float EPS = 1e-6f, LOG2E = 1.4426950408889634f;
constexpr int NTHREADS = 512, NWAVES = 8;
constexpr int PW = 2816;
constexpr int C_FOXQ = 0, C_LRUY = 256, C_RWR = 512, C_RETQ = 768, C_FOXK = 1024, C_LRUX = 1280, C_RWK = 1536, C_RWV = 1792, C_RWX = 2048, C_RETK = 2304, C_RETG = 2560;
constexpr int NIN = 3328;
__device__ __constant__ const int kSrcCol[13] = {0, 1028, 1284, 2308, 256, 772, 1540, 1796, 2052, 2564, 3076, 512, 2820};

constexpr size_t MiB = 1u << 20;
constexpr size_t WS_W = 0;
constexpr size_t W_IN = 0, W_OUT = 7 * MiB, W_Q = 9 * MiB, W_O = 11 * MiB, W_1 = 13 * MiB, W_2 = 21 * MiB, W_SMALL = 29 * MiB;
constexpr size_t WS_W2T = W_SMALL, WS_A2T = WS_W2T + 256 * 64 * 2, WS_G2T = WS_A2T + 256 * 64 * 2, WS_V1T = WS_G2T + 256 * 128 * 2, WS_V2T = WS_V1T + 32 * 256 * 2, WS_RAT = WS_V2T + 256 * 32 * 2, WS_RIT = WS_RAT + 4 * 64 * 64 * 2;
constexpr size_t WS_P = 30 * MiB;
constexpr size_t P_FOXVT = WS_P + 88 * MiB, P_RETKT = WS_P + 96 * MiB, P_RETVT = WS_P + 104 * MiB, P_RETKV = WS_P + 112 * MiB;
constexpr size_t WS_RW = 158 * MiB;
constexpr size_t RW_E = WS_RW, RW_WR = WS_RW + 8 * MiB, RW_A = WS_RW + 16 * MiB, RW_B = WS_RW + 24 * MiB, RW_K = WS_RW + 32 * MiB, RW_V = WS_RW + 40 * MiB, RW_G = WS_P + 120 * MiB  , RW_Y = WS_RW + 56 * MiB;
constexpr int RW_REC = 320;
__device__ __forceinline__ size_t rw_off(int tok  , int arr, int col  ) { const int b = tok >> 12, pos = tok & (SEQ - 1), hh = col >> 6; return ((size_t)((b * 4 + hh) * SEQ + pos)) * RW_REC + arr * 64 + (col & 63); }
constexpr size_t WS_O = WS_RW, WS_H = WS_RW + 32 * MiB;
constexpr size_t WS_WKV = WS_RW;
constexpr size_t WS_MEMN = WS_RW + 64 * MiB;
constexpr size_t WS_VF = 230 * MiB;
constexpr size_t WS_KM = 238 * MiB, WS_VMT = 242 * MiB;
constexpr size_t WS_SM = 246 * MiB;
constexpr size_t SM_LOGF = WS_SM, SM_CUM = SM_LOGF + 256 * 1024, SM_BR = SM_CUM + 256 * 1024, SM_KR = SM_BR + 256 * 1024, SM_RK = SM_KR + 256 * 1024,
                 SM_SS = SM_RK + 256 * 1024  , SM_ROT = SM_SS + 256 * 1024  , SM_Q = SM_ROT + MiB  , SM_BAR = SM_Q + 4096  , WS_END = SM_BAR + 16384;
static_assert(WS_END <= 256 * MiB, "workspace map");
constexpr int LDS_BYTES = 147456;

__device__ __forceinline__ unsigned f2bf(float f) { unsigned u = __builtin_bit_cast(unsigned, f); return (u + 0x7fffu + ((u >> 16) & 1u)) >> 16; }
typedef __bf16 bf16x2_t __attribute__((ext_vector_type(2)));
__device__ __forceinline__ unsigned pk2(float lo, float hi) { const f32x2 v = {lo, hi}; const bf16x2_t b = __builtin_convertvector(v, bf16x2_t); return __builtin_bit_cast(unsigned, b); }
__device__ __forceinline__ float bflo(unsigned u) { return __builtin_bit_cast(float, u << 16); }
__device__ __forceinline__ float bfhi(unsigned u) { return __builtin_bit_cast(float, u & 0xffff0000u); }
__device__ __forceinline__ void unpack8(u32x4 w, float* f) { f[0] = bflo(w.x); f[1] = bfhi(w.x); f[2] = bflo(w.y); f[3] = bfhi(w.y); f[4] = bflo(w.z); f[5] = bfhi(w.z); f[6] = bflo(w.w); f[7] = bfhi(w.w); }
__device__ __forceinline__ u32x4 pack8(const float* f) { u32x4 w; w.x = pk2(f[0], f[1]); w.y = pk2(f[2], f[3]); w.z = pk2(f[4], f[5]); w.w = pk2(f[6], f[7]); return w; }
__device__ __forceinline__ float wave_sum(float v) {
#pragma unroll
  for (int o = 1; o < 64; o <<= 1) v += __shfl_xor(v, o);
  return v;
}
__device__ __forceinline__ float ex2(float x) { return __builtin_amdgcn_exp2f(x); }
__device__ __forceinline__ float rcpf_(float x) { return __builtin_amdgcn_rcpf(x); }
__device__ __forceinline__ float sigmoidf_(float x) { return rcpf_(1.f + __expf(-x)); }
__device__ __forceinline__ float lse0_(float x) { return __logf(1.f + __expf(-fabsf(x))); }
__device__ __forceinline__ float log_sigmoidf_(float x) { return fminf(x, 0.f) - lse0_(x); }
__device__ __forceinline__ float log_sigmoid_acc(float x) { return fminf(x, 0.f) - log1pf(__expf(-fabsf(x))); }
__device__ __forceinline__ float softplusf_(float x) { return fmaxf(x, 0.f) + lse0_(x); }
__device__ __forceinline__ float tanhf_(float x) { return 1.f - 2.f * rcpf_(1.f + __expf(2.f * x)); }
__device__ __forceinline__ float gelu_tanh(float x) { return 0.5f * x * (1.f + tanhf_(0.7978845608028654f * (x + 0.044715f * x * x * x))); }
#define WAVE_LDS_FENCE() asm volatile("s_waitcnt lgkmcnt(0)" ::: "memory")
#define LDS_BARRIER() asm volatile("s_waitcnt lgkmcnt(0)\n\ts_barrier" ::: "memory")
#define MFMA16(a, b, c) __builtin_amdgcn_mfma_f32_16x16x32_bf16((a), (b), (c), 0, 0, 0)

struct Params { const float* in[40]; float* out; unsigned char* ws; int ph_lo, ph_hi; };

struct EpiIn {
  static constexpr bool PERM = true, AFTER_DRAIN = false;
  bf16* proj; bf16* foxvT; bf16* retkT; bf16* retvT; const float* rot;
  __device__ __forceinline__ void operator()(const f32x4 (&acc)[2][2][4][2], const pg8::Unit& u, int wr, int wc, int fr, int fq) const {
    const int pn = u.pn;
    const bool rotary = (pn == 3) || (pn == 9);
    const float sc = (pn == 9) ? 0.125f : 1.f;
    bf16* tdst = pn == 9 ? retkT : pn == 11 ? foxvT : pn == 12 ? retvT : nullptr;
    const bool rowmajor = pn <= 10;
#pragma unroll
    for (int ai = 0; ai < 2; ++ai)
#pragma unroll
      for (int m = 0; m < 4; ++m) {
        const int row = u.pm * 256 + ai * 128 + wr * 64 + m * 16 + fr; const int pos = row & (SEQ - 1), b = row >> 12;
#pragma unroll
        for (int bj = 0; bj < 2; ++bj) {
          const int c0 = bj * 128 + wc * 32 + 8 * fq;
          float v[8];
#pragma unroll
          for (int e = 0; e < 4; ++e) { v[e] = acc[ai][bj][m][0][e]; v[4 + e] = acc[ai][bj][m][1][e]; }
          if (rotary) {
            const int i0 = (c0 & 63) >> 1;
            const f32x4 r0 = *(const f32x4*)(rot + ((size_t)pos * 32 + i0) * 2), r1 = *(const f32x4*)(rot + ((size_t)pos * 32 + i0 + 2) * 2);
            const float cs[4] = {r0[0], r0[2], r1[0], r1[2]}, sn[4] = {r0[1], r0[3], r1[1], r1[3]};
#pragma unroll
            for (int p = 0; p < 4; ++p) { const float x1 = v[2 * p], x2 = v[2 * p + 1]; v[2 * p] = x1 * cs[p] - x2 * sn[p]; v[2 * p + 1] = x1 * sn[p] + x2 * cs[p]; }
          }
#pragma unroll
          for (int e = 0; e < 8; ++e) v[e] *= sc;
          const u32x4 w = pack8(v);
          if (rowmajor) *(u32x4*)(proj + (size_t)row * PW + pn * 256 + c0) = w;
          if (tdst) {
            const int hh = c0 >> 6, d0 = c0 & 63; bf16* tp = tdst + ((size_t)((b * 4 + hh) * 64 + d0)) * SEQ + pos;
            const unsigned ww[4] = {w.x, w.y, w.z, w.w};
#pragma unroll
            for (int e = 0; e < 8; ++e) tp[(size_t)e * SEQ] = (bf16)((e & 1) ? (ww[e >> 1] >> 16) : (ww[e >> 1] & 0xffffu));
          }
        }
      }
  }
};
struct EpiPlain {
  static constexpr bool PERM = true, AFTER_DRAIN = false;
  bf16* O; int ldc; int act; float* ss;
  __device__ __forceinline__ void operator()(const f32x4 (&acc)[2][2][4][2], const pg8::Unit& u, int wr, int wc, int fr, int fq) const {
#pragma unroll
    for (int ai = 0; ai < 2; ++ai)
#pragma unroll
      for (int m = 0; m < 4; ++m) {
        const int row = u.pm * 256 + ai * 128 + wr * 64 + m * 16 + fr; float s = 0.f;
#pragma unroll
        for (int bj = 0; bj < 2; ++bj) {
          const int c0 = u.pn * 256 + bj * 128 + wc * 32 + 8 * fq;
          float v[8];
#pragma unroll
          for (int e = 0; e < 4; ++e) { v[e] = acc[ai][bj][m][0][e]; v[4 + e] = acc[ai][bj][m][1][e]; }
          if (act == 1) {
#pragma unroll
            for (int e = 0; e < 8; ++e) { const float r = fmaxf(v[e], 0.f); v[e] = r * r; }
          }
#pragma unroll
          for (int e = 0; e < 8; ++e) s += v[e] * v[e];
          *(u32x4*)(O + (size_t)row * ldc + c0) = pack8(v);
        }
        if (ss) { s += __shfl_xor(s, 16); s += __shfl_xor(s, 32); if (fq == 0) atomicAdd(ss + row, s); }
      }
  }
};
struct EpiMem {
  static constexpr bool PERM = true, AFTER_DRAIN = false;
  bf16* kmem; bf16* vmemT;
  __device__ __forceinline__ void operator()(const f32x4 (&acc)[2][2][4][2], const pg8::Unit& u, int wr, int wc, int fr, int fq) const {
    const int layer = u.pm >> 2, pt = u.pn & 7; const bool isv = pt >= 4; const int head = pt & 3;
#pragma unroll
    for (int ai = 0; ai < 2; ++ai)
#pragma unroll
      for (int m = 0; m < 4; ++m) {
        const int rowl = (u.pm & 3) * 256 + ai * 128 + wr * 64 + m * 16 + fr;
#pragma unroll
        for (int bj = 0; bj < 2; ++bj) {
          const int c0 = bj * 128 + wc * 32 + 8 * fq;
          float v[8];
#pragma unroll
          for (int e = 0; e < 4; ++e) { v[e] = acc[ai][bj][m][0][e]; v[4 + e] = acc[ai][bj][m][1][e]; }
          const u32x4 w = pack8(v);
          if (!isv) *(u32x4*)(kmem + ((size_t)layer * 1024 + rowl) * 1024 + head * 256 + c0) = w;
          else {
            const int b = rowl >> 8, key = rowl & 255; bf16* tp = vmemT + ((size_t)(((layer * 4 + b) * 4 + head) * 256 + c0)) * 256 + key;
            const unsigned ww[4] = {w.x, w.y, w.z, w.w};
#pragma unroll
            for (int e = 0; e < 8; ++e) tp[(size_t)e * 256] = (bf16)((e & 1) ? (ww[e >> 1] >> 16) : (ww[e >> 1] & 0xffffu));
          }
        }
      }
  }
};
struct MemSched {
  int G, c;
  __device__ bool next(int i, pg8::Unit& u) const { const int L = i * G + c; if (c < 0 || L >= 64) return false; const int layer = L >> 5, r = L & 31; u.pm = layer * 4 + (r & 3); u.pn = layer * 8 + (r >> 2); return true; }
  __device__ __forceinline__ void a_ready(const pg8::Unit&) const {}
  __device__ __forceinline__ void done(const pg8::Unit&) const {}
};

template <int MAP> __device__ __forceinline__ int src_col(int n) {
  if (MAP == 0) return n;
  const int tile = n >> 8, j = n & 255; int jj = j;
  if (tile == 3 || tile == 9) { const int hh = j >> 6, l = j & 63; jj = hh * 64 + (l >> 1) + 32 * (l & 1); }
  return kSrcCol[tile] + jj;
}
template <int MAP> __device__ __forceinline__ void conv_item(const float* __restrict__ W, int K, int Nsrc, int N, bf16* WT, float* scr, int item, int lane) {
  const int nblk = N / 32, kb = item / nblk, nb = item % nblk, k0 = 64 * kb, n0 = 32 * nb;
  const int sc = src_col<MAP>(n0 + (lane & 31));
#pragma unroll 8
  for (int i = 0; i < 32; ++i) { const int kk = 2 * i + (lane >> 5); scr[kk * 33 + (lane & 31)] = W[(size_t)(k0 + kk) * Nsrc + sc]; }
  WAVE_LDS_FENCE();
  const int c = lane & 7;
#pragma unroll
  for (int j = 0; j < 4; ++j) { const int n = (lane >> 3) + 8 * j; const float* s = scr + (8 * c) * 33 + n;
    u32x4 o; o.x = pk2(s[0 * 33], s[1 * 33]); o.y = pk2(s[2 * 33], s[3 * 33]); o.z = pk2(s[4 * 33], s[5 * 33]); o.w = pk2(s[6 * 33], s[7 * 33]);
    *(u32x4*)(WT + (size_t)(n0 + n) * K + k0 + 8 * c) = o; }
  WAVE_LDS_FENCE();
}
__device__ __forceinline__ void conv_layer_weights(const Params& p, int l, float* scr, int gw, int NGW, int lane) {
  asm volatile("" ::: "memory");
  asm volatile("" : "+v"(lane));
  unsigned char* ws = p.ws;
  constexpr int I_IN = (D / 64) * (NIN / 32), I_SQ = (D / 64) * (D / 32), I_1 = (D / 64) * (DFF / 32), I_2 = (DFF / 64) * (D / 32);
  constexpr int I_W2 = 1 * 8, I_A2 = 8, I_G2 = 2 * 8, I_V1 = 4 * 1, I_V2 = 8  , I_R = 2 * 4 * 2;
  constexpr int NIT = I_IN + 3 * I_SQ + I_1 + I_2 + I_W2 + I_A2 + I_G2 + I_V1 + I_R;
  for (int it = gw; it < NIT; it += NGW) {
    int r = it;
    if (r < I_IN) { conv_item<1>(p.in[9] + (size_t)l * D * INW, D, INW, NIN, (bf16*)(ws + W_IN), scr, r, lane); continue; } r -= I_IN;
    if (r < I_SQ) { conv_item<0>(p.in[10] + (size_t)l * D * D, D, D, D, (bf16*)(ws + W_OUT), scr, r, lane); continue; } r -= I_SQ;
    if (r < I_SQ) { conv_item<0>(p.in[34] + (size_t)l * D * D, D, D, D, (bf16*)(ws + W_Q), scr, r, lane); continue; } r -= I_SQ;
    if (r < I_SQ) { conv_item<0>(p.in[37] + (size_t)l * D * D, D, D, D, (bf16*)(ws + W_O), scr, r, lane); continue; } r -= I_SQ;
    if (r < I_1) { conv_item<0>(p.in[38] + (size_t)l * D * DFF, D, DFF, DFF, (bf16*)(ws + W_1), scr, r, lane); continue; } r -= I_1;
    if (r < I_2) { conv_item<0>(p.in[39] + (size_t)l * DFF * D, DFF, D, D, (bf16*)(ws + W_2), scr, r, lane); continue; } r -= I_2;
    if (r < I_W2) { conv_item<0>(p.in[21] + (size_t)l * 64 * G, 64, G, G, (bf16*)(ws + WS_W2T), scr, r, lane); continue; } r -= I_W2;
    if (r < I_A2) { conv_item<0>(p.in[23] + (size_t)l * 64 * G, 64, G, G, (bf16*)(ws + WS_A2T), scr, r, lane); continue; } r -= I_A2;
    if (r < I_G2) { conv_item<0>(p.in[24] + (size_t)l * 128 * G, 128, G, G, (bf16*)(ws + WS_G2T), scr, r, lane); continue; } r -= I_G2;
    if (r < I_V1) { if (l > 0) conv_item<0>(p.in[31] + (size_t)(l - 1) * G * 32, G, 32, 32, (bf16*)(ws + WS_V1T), scr, r, lane); continue; } r -= I_V1;
    { const int gate = r >> 3, hh = (r >> 1) & 3, nb = r & 1;
      conv_item<0>(p.in[gate ? 16 : 14] + ((size_t)l * GH + hh) * HD * HD, 64, 64, 64, (bf16*)(ws + (gate ? WS_RIT : WS_RAT)) + hh * 4096, scr, nb, lane); }
  }
  if (l > 0) { const float* v2 = p.in[32] + (size_t)(l - 1) * 32 * G; bf16* v2t = (bf16*)(ws + WS_V2T);
    for (int e = gw * 64 + lane; e < 32 * G; e += NGW * 64) { const int k = e / G, n = e % G; v2t[n * 32 + k] = (bf16)f2bf(v2[e]); } }
}

struct RowArgs { const float* xin; const bf16* O; float* ss; const float* g_post; float* xout; const float* g_pre; bf16* hout; const float* wf; const float* fbias; float* logf; int rows; };
__device__ __forceinline__ void row_phase(const RowArgs& a, int gw, int NGW, int lane) {
  asm volatile("" ::: "memory");
  asm volatile("" : "+v"(lane));
  f32x4 gp[4], gq[4], wfv[4][4];
#pragma unroll
  for (int j = 0; j < 4; ++j) {
    gp[j] = a.O ? ((const f32x4*)a.g_post)[lane + 64 * j] : (f32x4){0.f, 0.f, 0.f, 0.f};
    gq[j] = a.hout ? ((const f32x4*)a.g_pre)[lane + 64 * j] : (f32x4){0.f, 0.f, 0.f, 0.f};
#pragma unroll
    for (int hh = 0; hh < 4; ++hh)
#pragma unroll
      for (int e = 0; e < 4; ++e) wfv[j][hh][e] = a.wf ? a.wf[(size_t)(4 * (lane + 64 * j) + e) * INW + 768 + hh] : 0.f;
  }
  for (int row0 = gw; row0 < a.rows; row0 += 2 * NGW) {
    const int rowv[2] = {row0, row0 + NGW}; const bool val[2] = {true, row0 + NGW < a.rows};
    f32x4 x[2][4]; float ov[2][4][4];
#pragma unroll
    for (int r = 0; r < 2; ++r) if (val[r]) {
#pragma unroll
      for (int j = 0; j < 4; ++j) x[r][j] = ((const f32x4*)(a.xin + (size_t)rowv[r] * D))[lane + 64 * j];
      if (a.O) {
#pragma unroll
        for (int j = 0; j < 4; ++j) { const u32x2 o = ((const u32x2*)(a.O + (size_t)rowv[r] * D))[lane + 64 * j];
          ov[r][j][0] = bflo(o.x); ov[r][j][1] = bfhi(o.x); ov[r][j][2] = bflo(o.y); ov[r][j][3] = bfhi(o.y); }
      }
    }
#pragma unroll
    for (int r = 0; r < 2; ++r) if (val[r]) {
      const int row = rowv[r];
      if (a.O) {
        float so = 0.f;
#pragma unroll
        for (int j = 0; j < 4; ++j) so += ov[r][j][0] * ov[r][j][0] + ov[r][j][1] * ov[r][j][1] + ov[r][j][2] * ov[r][j][2] + ov[r][j][3] * ov[r][j][3];
        so = wave_sum(so);
        const float rs = rsqrtf(so * (1.f / D) + EPS);
#pragma unroll
        for (int j = 0; j < 4; ++j)
#pragma unroll
          for (int e = 0; e < 4; ++e) x[r][j][e] += ov[r][j][e] * rs * gp[j][e];
      }
      if (a.xout) {
#pragma unroll
        for (int j = 0; j < 4; ++j) ((f32x4*)(a.xout + (size_t)row * D))[lane + 64 * j] = x[r][j];
      }
      if (a.hout) {
        float s = 0.f;
#pragma unroll
        for (int j = 0; j < 4; ++j) s += x[r][j][0] * x[r][j][0] + x[r][j][1] * x[r][j][1] + x[r][j][2] * x[r][j][2] + x[r][j][3] * x[r][j][3];
        s = wave_sum(s); const float rs2 = rsqrtf(s * (1.f / D) + EPS);
        float fd[4] = {0.f, 0.f, 0.f, 0.f};
#pragma unroll
        for (int j = 0; j < 4; ++j) {
          f32x4 hv;
#pragma unroll
          for (int e = 0; e < 4; ++e) hv[e] = x[r][j][e] * rs2 * gq[j][e];
          u32x2 o; o.x = pk2(hv[0], hv[1]); o.y = pk2(hv[2], hv[3]);
          ((u32x2*)(a.hout + (size_t)row * D))[lane + 64 * j] = o;
          if (a.wf) {
#pragma unroll
            for (int hh = 0; hh < 4; ++hh) fd[hh] += hv[0] * wfv[j][hh][0] + hv[1] * wfv[j][hh][1] + hv[2] * wfv[j][hh][2] + hv[3] * wfv[j][hh][3];
          }
        }
        if (a.wf) {
#pragma unroll
          for (int hh = 0; hh < 4; ++hh) fd[hh] = wave_sum(fd[hh]);
          if (lane < 4) { const float f = lane == 0 ? fd[0] : lane == 1 ? fd[1] : lane == 2 ? fd[2] : fd[3]; a.logf[(size_t)row * 4 + lane] = log_sigmoidf_(f + a.fbias[lane]); }
        }
      }
    }
  }
}

__device__ __forceinline__ void lerp8(const bf16* __restrict__ proj, const float* __restrict__ mu, int tok, int col, int mucol, float* out) {
  const u32x4 c = *(const u32x4*)(proj + (size_t)tok * PW + col);
  u32x4 pv = {0u, 0u, 0u, 0u};
  if ((tok & (SEQ - 1)) != 0) pv = *(const u32x4*)(proj + (size_t)(tok - 1) * PW + col);
  float cf[8], pf[8]; unpack8(c, cf); unpack8(pv, pf);
  const f32x4 m0 = *(const f32x4*)(mu + mucol), m1 = *(const f32x4*)(mu + mucol + 4);
#pragma unroll
  for (int e = 0; e < 4; ++e) { out[e] = cf[e] + (pf[e] - cf[e]) * m0[e]; out[4 + e] = cf[4 + e] + (pf[4 + e] - cf[4 + e]) * m1[e]; }
}
__device__ __forceinline__ bf16x8 pack_frag(const float* f) { const u32x4 w = pack8(f); return __builtin_bit_cast(bf16x8, w); }
constexpr int WLP = 260;
__device__ __forceinline__ void acc_to_lds(float* wl, const f32x4* acc, int ntiles, int li, int g) {
#pragma unroll
  for (int nt = 0; nt < 16; ++nt) if (nt < ntiles) {
#pragma unroll
    for (int j = 0; j < 4; ++j) wl[(4 * g + j) * WLP + nt * 16 + li] = acc[nt][j];
  }
}
template <int KS> __device__ __forceinline__ void mm16_to_lds(const bf16x8* af, const bf16* __restrict__ wt, int ldw, float* wl, int li, int g) {
#pragma unroll 1
  for (int ng = 0; ng < 4; ++ng) {
    f32x4 a4[4];
#pragma unroll
    for (int n4 = 0; n4 < 4; ++n4) { a4[n4] = (f32x4){0.f, 0.f, 0.f, 0.f};
#pragma unroll
      for (int ks = 0; ks < KS; ++ks) { const bf16x8 bfr = *(const bf16x8*)(wt + (size_t)((ng * 4 + n4) * 16 + li) * ldw + ks * 32 + 8 * g); a4[n4] = MFMA16(af[ks], bfr, a4[n4]); } }
#pragma unroll
    for (int n4 = 0; n4 < 4; ++n4)
#pragma unroll
      for (int j = 0; j < 4; ++j) wl[(4 * g + j) * WLP + (ng * 4 + n4) * 16 + li] = a4[n4][j];
  }
}
__device__ __forceinline__ void rwkv_prep_unit(const Params& p, int l, int unit, int pass, float* wl, int lane) {
  asm volatile("" ::: "memory");
  asm volatile("" : "+v"(lane));
  unsigned char* ws = p.ws;
  const bf16* proj = (const bf16*)(ws + WS_P);
  const float* mu = p.in[19] + (size_t)l * 1024;
  const int li = lane & 15, g = lane >> 4, t0 = unit * 16, ta = t0 + li;
  const int tl = t0 + (lane >> 2), cgp = lane & 3;
  if (pass == 0) {
    bf16x8 af[2];
#pragma unroll
    for (int ks = 0; ks < 2; ++ks) { float f[8]; lerp8(proj, mu, ta, C_RWX + ks * 32 + 8 * g, 768 + ks * 32 + 8 * g, f);
#pragma unroll
      for (int e = 0; e < 8; ++e) f[e] = tanhf_(f[e]);
      af[ks] = pack_frag(f); }
    mm16_to_lds<2>(af, (const bf16*)(ws + WS_W2T), 64, wl, li, g); WAVE_LDS_FENCE();
    const float* w0 = p.in[20] + (size_t)l * G;
#pragma unroll 2
    for (int i = 0; i < 8; ++i) { int col = cgp * 8 + 32 * i; asm volatile("" : "+v"(col)); float r[8], ev[8], wr[8];
      lerp8(proj, mu, tl, C_RWR + col, col, r);
#pragma unroll
      for (int e = 0; e < 8; ++e) { const float wa = wl[(lane >> 2) * WLP + col + e] + w0[col + e]; const float wlog = -softplusf_(-wa) - 0.5f; const float ee = __expf(wlog); ev[e] = ee; wr[e] = __expf(-ee) * r[e]; }
      *(u32x4*)((bf16*)(ws + WS_RW) + rw_off(tl, 0, col)) = pack8(ev); *(u32x4*)((bf16*)(ws + WS_RW) + rw_off(tl, 1, col)) = pack8(wr); }
    WAVE_LDS_FENCE();
  }
  if (pass == 1) {
    bf16x8 af[2];
#pragma unroll
    for (int ks = 0; ks < 2; ++ks) { float f[8]; lerp8(proj, mu, ta, C_RWX + 64 + ks * 32 + 8 * g, 832 + ks * 32 + 8 * g, f); af[ks] = pack_frag(f); }
    mm16_to_lds<2>(af, (const bf16*)(ws + WS_A2T), 64, wl, li, g); WAVE_LDS_FENCE();
    const float* a0 = p.in[22] + (size_t)l * G; const float* k_k = p.in[25] + (size_t)l * G; const float* k_a = p.in[26] + (size_t)l * G; const float* r_k = p.in[27] + (size_t)l * G;
#pragma unroll 1
    for (int hh = 0; hh < 4; ++hh) {
      float av[2][8], kv[2][8], kk[2][8]; float ssq = 0.f;
#pragma unroll
      for (int ii = 0; ii < 2; ++ii) { int col = cgp * 8 + 32 * (2 * hh + ii); asm volatile("" : "+v"(col));
        lerp8(proj, mu, tl, C_RWK + col, 256 + col, kv[ii]);
#pragma unroll
        for (int e = 0; e < 8; ++e) { av[ii][e] = sigmoidf_(a0[col + e] + wl[(lane >> 2) * WLP + col + e]); kk[ii][e] = kv[ii][e] * k_k[col + e]; ssq += kk[ii][e] * kk[ii][e]; } }
      ssq += __shfl_xor(ssq, 1); ssq += __shfl_xor(ssq, 2);
      const float inv = 1.f / fmaxf(sqrtf(ssq), 1e-12f);
      float sbr = 0.f, skr = 0.f, srk = 0.f;
#pragma unroll
      for (int ii = 0; ii < 2; ++ii) { int col = cgp * 8 + 32 * (2 * hh + ii); asm volatile("" : "+v"(col)); float r[8], Av[8], Bv[8], k2[8];
        lerp8(proj, mu, tl, C_RWR + col, col, r);
#pragma unroll
        for (int e = 0; e < 8; ++e) { const float kn = kk[ii][e] * inv; Av[e] = -kn; Bv[e] = kn * av[ii][e]; k2[e] = kv[ii][e] * (1.f + (av[ii][e] - 1.f) * k_a[col + e]);
          const float rb = r[e]; sbr += Bv[e] * rb; skr += k2[e] * rb; srk += rb * k2[e] * r_k[col + e]; }
        *(u32x4*)((bf16*)(ws + WS_RW) + rw_off(tl, 2, col)) = pack8(Av); *(u32x4*)((bf16*)(ws + WS_RW) + rw_off(tl, 3, col)) = pack8(Bv); *(u32x4*)((bf16*)(ws + WS_RW) + rw_off(tl, 4, col)) = pack8(k2); }
      sbr += __shfl_xor(sbr, 1); sbr += __shfl_xor(sbr, 2); skr += __shfl_xor(skr, 1); skr += __shfl_xor(skr, 2); srk += __shfl_xor(srk, 1); srk += __shfl_xor(srk, 2);
      if (cgp == 0) { ((float*)(ws + SM_BR))[(size_t)tl * 4 + hh] = sbr; ((float*)(ws + SM_KR))[(size_t)tl * 4 + hh] = skr; ((float*)(ws + SM_RK))[(size_t)tl * 4 + hh] = srk; }
    }
    WAVE_LDS_FENCE();
  }
  if (pass == 2) {
    bf16x8 af[4];
#pragma unroll
    for (int ks = 0; ks < 4; ++ks) { float f[8]; lerp8(proj, mu, ta, C_RWX + 128 + ks * 32 + 8 * g, 896 + ks * 32 + 8 * g, f);
#pragma unroll
      for (int e = 0; e < 8; ++e) f[e] = sigmoidf_(f[e]);
      af[ks] = pack_frag(f); }
    mm16_to_lds<4>(af, (const bf16*)(ws + WS_G2T), 128, wl, li, g); WAVE_LDS_FENCE();
#pragma unroll 2
    for (int i = 0; i < 8; ++i) { int col = cgp * 8 + 32 * i; asm volatile("" : "+v"(col)); float gv[8];
#pragma unroll
      for (int e = 0; e < 8; ++e) gv[e] = wl[(lane >> 2) * WLP + col + e];
      *(u32x4*)((bf16*)(ws + RW_G) + (size_t)tl * G + col) = pack8(gv); }
    WAVE_LDS_FENCE();
  }
  if (pass != 3) return;
  if (l > 0) {
    f32x4 a1[2] = {(f32x4){0.f, 0.f, 0.f, 0.f}, (f32x4){0.f, 0.f, 0.f, 0.f}};
    const bf16* v1t = (const bf16*)(ws + WS_V1T);
#pragma unroll
    for (int ks = 0; ks < 8; ++ks) { float f[8]; lerp8(proj, mu, ta, C_RWV + ks * 32 + 8 * g, 512 + ks * 32 + 8 * g, f); const bf16x8 af = pack_frag(f);
#pragma unroll
      for (int nt = 0; nt < 2; ++nt) { const bf16x8 bfr = *(const bf16x8*)(v1t + (size_t)(nt * 16 + li) * 256 + ks * 32 + 8 * g); a1[nt] = MFMA16(af, bfr, a1[nt]); } }
#pragma unroll
    for (int nt = 0; nt < 2; ++nt)
#pragma unroll
      for (int j = 0; j < 4; ++j) wl[(4 * g + j) * WLP + nt * 16 + li] = a1[nt][j];
    WAVE_LDS_FENCE();
    float f2[8];
#pragma unroll
    for (int e = 0; e < 8; ++e) f2[e] = wl[li * WLP + 8 * g + e];
    const bf16x8 af2 = pack_frag(f2);
    WAVE_LDS_FENCE();
    mm16_to_lds<1>(&af2, (const bf16*)(ws + WS_V2T), 32, wl, li, g); WAVE_LDS_FENCE();
    const float* v0 = p.in[30] + (size_t)(l - 1) * G;
#pragma unroll 2
    for (int i = 0; i < 8; ++i) { int col = cgp * 8 + 32 * i; asm volatile("" : "+v"(col)); float v[8], vf[8];
      lerp8(proj, mu, tl, C_RWV + col, 512 + col, v);
      unpack8(*(const u32x4*)((const bf16*)(ws + WS_VF) + (size_t)tl * G + col), vf);
#pragma unroll
      for (int e = 0; e < 8; ++e) v[e] = v[e] + (vf[e] - v[e]) * sigmoidf_(v0[col + e] + wl[(lane >> 2) * WLP + col + e]);
      *(u32x4*)((bf16*)(ws + RW_V) + (size_t)tl * G + col) = pack8(v); }
    WAVE_LDS_FENCE();
  } else {
#pragma unroll 2
    for (int i = 0; i < 8; ++i) { int col = cgp * 8 + 32 * i; asm volatile("" : "+v"(col)); float v[8];
      lerp8(proj, mu, tl, C_RWV + col, 512 + col, v);
      const u32x4 w = pack8(v);
      *(u32x4*)((bf16*)(ws + RW_V) + (size_t)tl * G + col) = w; *(u32x4*)((bf16*)(ws + WS_VF) + (size_t)tl * G + col) = w; }
  }
}
__device__ __forceinline__ void ret_kv_unit(const Params& p, int unit, int lane) {
  asm volatile("" ::: "memory");
  asm volatile("" : "+v"(lane));
  unsigned char* ws = p.ws;
  const int bh = unit >> 5, c = unit & 31, h = bh & 3, li = lane & 15, g = lane >> 4;
  const float lg2 = log2f(1.f - exp2f(-5.f - (float)h));
  const bf16* kT = (const bf16*)(ws + P_RETKT) + (size_t)bh * 64 * SEQ + c * 128;
  const bf16* vT = (const bf16*)(ws + P_RETVT) + (size_t)bh * 64 * SEQ + c * 128;
  f32x4 acc[4][4];
#pragma unroll
  for (int a = 0; a < 4; ++a)
#pragma unroll
    for (int b = 0; b < 4; ++b) acc[a][b] = (f32x4){0.f, 0.f, 0.f, 0.f};
#pragma unroll
  for (int ks = 0; ks < 4; ++ks) {
    float z[8];
#pragma unroll
    for (int e = 0; e < 8; ++e) z[e] = ex2(lg2 * (float)(127 - (ks * 32 + 8 * g + e)));
    bf16x8 af[4], bfr[4];
#pragma unroll
    for (int dt = 0; dt < 4; ++dt) { float f[8]; unpack8(*(const u32x4*)(kT + (size_t)(dt * 16 + li) * SEQ + ks * 32 + 8 * g), f);
#pragma unroll
      for (int e = 0; e < 8; ++e) f[e] *= z[e];
      af[dt] = pack_frag(f); }
#pragma unroll
    for (int et = 0; et < 4; ++et) bfr[et] = *(const bf16x8*)(vT + (size_t)(et * 16 + li) * SEQ + ks * 32 + 8 * g);
#pragma unroll
    for (int dt = 0; dt < 4; ++dt)
#pragma unroll
      for (int et = 0; et < 4; ++et) acc[dt][et] = MFMA16(af[dt], bfr[et], acc[dt][et]);
  }
  float* KV = (float*)(ws + P_RETKV) + (size_t)unit * 4096;
#pragma unroll
  for (int dt = 0; dt < 4; ++dt)
#pragma unroll
    for (int et = 0; et < 4; ++et)
#pragma unroll
      for (int j = 0; j < 4; ++j) KV[(dt * 16 + 4 * g + j) * 64 + et * 16 + li] = acc[dt][et][j];
}
__device__ __forceinline__ void fox_cum_unit(const Params& p, int bh, int lane) {
  asm volatile("" ::: "memory");
  asm volatile("" : "+v"(lane));
  const float* logf = (const float*)(p.ws + SM_LOGF); float* cum = (float*)(p.ws + SM_CUM);
  const int b = bh >> 2, h = bh & 3; const size_t base = ((size_t)b * SEQ + lane * 64) * 4 + h;
  float s = 0.f;
#pragma unroll 16
  for (int i = 0; i < 64; ++i) s += logf[base + (size_t)i * 4];
  float incl = s;
#pragma unroll
  for (int o = 1; o < 64; o <<= 1) { const float t = __shfl_up(incl, o); if (lane >= o) incl += t; }
  float run = incl - s;
  for (int i0 = 0; i0 < 64; i0 += 16) { float t[16];
#pragma unroll
    for (int i = 0; i < 16; ++i) t[i] = logf[base + (size_t)(i0 + i) * 4];
#pragma unroll
    for (int i = 0; i < 16; ++i) { run += t[i]; cum[(size_t)bh * SEQ + lane * 64 + i0 + i] = run * LOG2E; } }
}

template <int CTRL> __device__ __forceinline__ float dpp_add(float x) {
  const int y = __builtin_amdgcn_update_dpp(0, __builtin_bit_cast(int, x), CTRL, 0xf, 0xf, true);
  return x + __builtin_bit_cast(float, y);
}
__device__ __forceinline__ float row16_sum(float x) {
  x = dpp_add<0xB1>(x); x = dpp_add<0x4E>(x); x = dpp_add<0x141>(x); x = dpp_add<0x140>(x); return x;
}
constexpr int RS_TSB = 896;
constexpr int RS_CH = 32;
constexpr int RS_BUFB = RS_CH * RS_TSB;
constexpr int RS_ROWS = 8;
constexpr int RS_YP = 40;
constexpr int RS_YBUF = RS_CH * RS_ROWS * RS_YP;
struct RsRegs { u32x4 e, a, b, k, wr, v; float br, kr; };
__device__ __forceinline__ void rs_issue(const Params& p, RsRegs& r, int b, int h, int rq, int c, int lt) {
  unsigned char* ws = p.ws;
  { const int tok = lt >> 3, ch = lt & 7; const bf16* rec = (const bf16*)(ws + WS_RW) + ((size_t)((b * 4 + h) * SEQ + c * RS_CH + tok)) * RW_REC + ch * 8;
    r.e = *(const u32x4*)(rec); r.wr = *(const u32x4*)(rec + 64); r.a = *(const u32x4*)(rec + 128); r.b = *(const u32x4*)(rec + 192); r.k = *(const u32x4*)(rec + 256); }
  { const int t2 = lt & 31; const size_t rr = (size_t)b * SEQ + c * RS_CH + t2;
    r.v = *(const u32x4*)((const bf16*)(ws + RW_V) + rr * G + h * 64 + rq * RS_ROWS);
    r.br = ((const float*)(ws + SM_BR))[rr * 4 + h]; r.kr = ((const float*)(ws + SM_KR))[rr * 4 + h]; }
}
__device__ __forceinline__ void rs_commit(const RsRegs& r, unsigned char* buf, int lt) {
  { const int tok = lt >> 3, ch = lt & 7; unsigned char* rec = buf + tok * RS_TSB; float f[8];
    unpack8(r.e, f);
#pragma unroll
    for (int e = 0; e < 8; ++e) f[e] = ex2(-f[e] * LOG2E);
    *(f32x4*)(rec + ch * 32) = (f32x4){f[0], f[1], f[2], f[3]}; *(f32x4*)(rec + ch * 32 + 16) = (f32x4){f[4], f[5], f[6], f[7]};
    { const unsigned aw[4] = {r.a.x, r.a.y, r.a.z, r.a.w}, bw[4] = {r.b.x, r.b.y, r.b.z, r.b.w}, kw[4] = {r.k.x, r.k.y, r.k.z, r.k.w}, ww[4] = {r.wr.x, r.wr.y, r.wr.z, r.wr.w};
#pragma unroll
      for (int j = 0; j < 4; ++j) *(u32x4*)(rec + 256 + (ch * 4 + j) * 16) = (u32x4){aw[j], bw[j], kw[j], ww[j]}; } }
  if (lt < 32) { float f[8]; unpack8(r.v, f); unsigned char* rec = buf + lt * RS_TSB + 768; const float b32 = r.br * (1.f / 32.f), k32 = r.kr * (1.f / 32.f);
#pragma unroll
    for (int j = 0; j < 8; ++j) *(f32x4*)(rec + 16 * j) = (f32x4){f[j], b32, k32, 0.f}; }
}
__device__ __forceinline__ float row32_sum(float x) {
  x = row16_sum(x);
  const auto rr = __builtin_amdgcn_permlane16_swap(__builtin_bit_cast(unsigned, x), __builtin_bit_cast(unsigned, x), false, false);
  return __builtin_bit_cast(float, (unsigned)rr[0]) + __builtin_bit_cast(float, (unsigned)rr[1]);
}
__device__ __forceinline__ f32x2 bf2x(unsigned u) { return (f32x2){bflo(u), bfhi(u)}; }
__device__ __forceinline__ void rwkv_scan_unit(const Params& p, unsigned char* lds, int unit) {
  asm volatile("" ::: "memory");
  int tid = threadIdx.x; asm volatile("" : "+v"(tid)); const int wave = __builtin_amdgcn_readfirstlane(tid >> 6), lane = tid & 63;
  const int b = unit >> 5, h = (unit >> 3) & 3, rq = unit & 7;
  unsigned char* bufs = lds; bf16* ybuf = (bf16*)(lds + 2 * RS_BUFB);
  float* Y = (float*)(p.ws + RW_Y);
  constexpr int NCH = SEQ / RS_CH;
  const int lt = tid - 256;
  RsRegs rg;
  if (wave >= 4) { rs_issue(p, rg, b, h, rq, 0, lt); rs_commit(rg, bufs, lt); rs_issue(p, rg, b, h, rq, 1, lt); }
  __syncthreads();
  f32x2 S = {0.f, 0.f};
  const int seg = lane & 31, rloc = wave * 2 + (lane >> 5);
#define RS_YOUT(cc) do { const bf16* yp_ = ybuf + ((cc) & 1) * RS_YBUF + lt * RS_YP; float t_ = 0.f; \
    _Pragma("unroll") for (int j_ = 0; j_ < 4; ++j_) { float f_[8]; unpack8(*(const u32x4*)(yp_ + 8 * j_), f_); t_ += ((f_[0] + f_[1]) + (f_[2] + f_[3])) + ((f_[4] + f_[5]) + (f_[6] + f_[7])); } \
    Y[((size_t)b * SEQ + (cc) * RS_CH + (lt >> 3)) * G + h * 64 + rq * RS_ROWS + (lt & 7)] = t_; } while (0)
  for (int c = 0; c < NCH; ++c) {
    if (wave >= 4) {
      if (c + 1 < NCH) rs_commit(rg, bufs + ((c + 1) & 1) * RS_BUFB, lt);
      if (c + 2 < NCH) rs_issue(p, rg, b, h, rq, c + 2, lt);
      if (c > 0) RS_YOUT(c - 1);
    } else {
      const unsigned char* bp = bufs + (c & 1) * RS_BUFB; bf16* yb = ybuf + (c & 1) * RS_YBUF + rloc * RS_YP + seg;
      const unsigned char* pw = bp + seg * 8; const unsigned char* pa = bp + 256 + seg * 16; const unsigned char* pv = bp + 768 + rloc * 16;
      f32x2 nw = *(const f32x2*)(pw); u32x4 nq = *(const u32x4*)(pa); f32x4 nvs = *(const f32x4*)(pv);
#pragma unroll 8
      for (int s = 0; s < RS_CH; ++s) {
        const f32x2 w = nw, a = bf2x(nq.x), bb = bf2x(nq.y), kk = bf2x(nq.z), wr = bf2x(nq.w); const float v = nvs[0], br = nvs[1], kr = nvs[2];
        if (s + 1 < RS_CH) { const int o = (s + 1) * RS_TSB; nw = *(const f32x2*)(pw + o); nq = *(const u32x4*)(pa + o); nvs = *(const f32x4*)(pv + o); }
        const f32x2 pda = S * a, pdy = S * wr;
        const f32x2 vv = {v, v};
        const f32x2 u = S * w + vv * kk;
        const float t0 = v * kr + (pdy[0] + pdy[1]);
        const float da = row32_sum(pda[0] + pda[1]);
        const f32x2 dd = {da, da};
        S = dd * bb + u;
        yb[s * (RS_ROWS * RS_YP)] = (bf16)(__builtin_bit_cast(unsigned, da * br + t0) >> 16);
      }
    }
    LDS_BARRIER();
  }
  if (wave >= 4) RS_YOUT(NCH - 1);
  __syncthreads();
#undef RS_YOUT
}
__device__ __forceinline__ void rwkv_post_row(const Params& p, int l, int row, int lane) {
  asm volatile("" ::: "memory");
  asm volatile("" : "+v"(lane));
  unsigned char* ws = p.ws;
  const f32x4 y = ((const f32x4*)((const float*)(ws + RW_Y) + (size_t)row * G))[lane];
  float s = y[0] + y[1] + y[2] + y[3];
  s = row16_sum(s);
  const float mu = s * (1.f / 64.f); const f32x4 d = y - mu;
  float q = d[0] * d[0] + d[1] * d[1] + d[2] * d[2] + d[3] * d[3];
  q = row16_sum(q);
  const float rstd = rsqrtf(q * (1.f / 64.f) + 64e-5f);
  const f32x4 gw = ((const f32x4*)(p.in[28] + (size_t)l * G))[lane], gb = ((const f32x4*)(p.in[29] + (size_t)l * G))[lane];
  const u32x2 vv = ((const u32x2*)((const bf16*)(ws + RW_V) + (size_t)row * G))[lane], gg = ((const u32x2*)((const bf16*)(ws + RW_G) + (size_t)row * G))[lane];
  const float rk = ((const float*)(ws + SM_RK))[(size_t)row * 4 + (lane >> 4)];
  const float v[4] = {bflo(vv.x), bfhi(vv.x), bflo(vv.y), bfhi(vv.y)}, gt[4] = {bflo(gg.x), bfhi(gg.x), bflo(gg.y), bfhi(gg.y)};
  float o[4];
#pragma unroll
  for (int e = 0; e < 4; ++e) o[e] = (d[e] * rstd * gw[e] + gb[e] + rk * v[e]) * gt[e];
  u32x2 w; w.x = pk2(o[0], o[1]); w.y = pk2(o[2], o[3]);
  ((u32x2*)((bf16*)(ws + WS_P) + (size_t)row * PW + C_RWR))[lane] = w;
}

__device__ __forceinline__ void lru_unit(const Params& p, int l, float* lds, int unit) {
  asm volatile("" ::: "memory");
  unsigned char* ws = p.ws; bf16* proj = (bf16*)(ws + WS_P);
  int tid = threadIdx.x; asm volatile("" : "+v"(tid)); const int wave = __builtin_amdgcn_readfirstlane(tid >> 6), lane = tid & 63, li = lane & 15, g = lane >> 4;
  const int b = unit >> 2, h = unit & 3;
  float* XB = lds;
  float* XC = XB + 67 * 64;
  float* AA = XC + 64 * 65;
  float* UU = AA + 64 * 65;
  float* HH = UU + 64 * 65;
  bf16* XCb = (bf16*)(HH + 64 * 65);
  const float* cw = p.in[12] + (size_t)l * 4 * G + h * 64; const float* cb = p.in[13] + (size_t)l * G + h * 64;
  const float* rab = p.in[15] + (size_t)l * G + h * 64; const float* rib = p.in[17] + (size_t)l * G + h * 64; const float* lam = p.in[18] + (size_t)l * G + h * 64;
  const int mt = wave & 3, ntp = wave >> 2;
  bf16x8 br_[2][2], bi_[2][2]; float lsl[2], rb[2], ib[2];
  { const bf16* rat = (const bf16*)(ws + WS_RAT) + h * 4096; const bf16* rit = (const bf16*)(ws + WS_RIT) + h * 4096;
#pragma unroll
    for (int n = 0; n < 2; ++n) { const int col = (2 * ntp + n) * 16 + li; lsl[n] = log_sigmoid_acc(lam[col]); rb[n] = rab[col]; ib[n] = rib[col];
#pragma unroll
      for (int ks = 0; ks < 2; ++ks) { br_[n][ks] = *(const bf16x8*)(rat + col * 64 + ks * 32 + 8 * g); bi_[n][ks] = *(const bf16x8*)(rit + col * 64 + ks * 32 + 8 * g); } } }
  float hcur = 0.f;
  const int tok = tid >> 3, ch8 = (tid & 7) * 8;
  u32x4 nx0 = {0u, 0u, 0u, 0u}, nx1 = {0u, 0u, 0u, 0u}, ny;
  const int r1 = (tid + NTHREADS) >> 3;
  { const int pos0 = -3 + tok; if (pos0 >= 0) nx0 = *(const u32x4*)(proj + ((size_t)b * SEQ + pos0) * PW + C_LRUX + h * 64 + ch8);
    if (tid < 24) nx1 = *(const u32x4*)(proj + ((size_t)b * SEQ + (-3 + r1)) * PW + C_LRUX + h * 64 + ch8);
    ny = *(const u32x4*)(proj + ((size_t)b * SEQ + tok) * PW + C_LRUY + h * 64 + ch8); }
  for (int c = 0; c < SEQ / 64; ++c) {
    const int t0 = c * 64;
    { float f8[8]; unpack8(nx0, f8);
#pragma unroll
      for (int e = 0; e < 8; ++e) XB[tok * 64 + ch8 + e] = f8[e];
      if (tid < 24) { unpack8(nx1, f8);
#pragma unroll
        for (int e = 0; e < 8; ++e) XB[r1 * 64 + ch8 + e] = f8[e]; } }
    const u32x4 ycur = ny;
    if (c + 1 < SEQ / 64) { const int tn = t0 + 64;
      nx0 = *(const u32x4*)(proj + ((size_t)b * SEQ + tn - 3 + tok) * PW + C_LRUX + h * 64 + ch8);
      if (tid < 24) nx1 = *(const u32x4*)(proj + ((size_t)b * SEQ + tn - 3 + r1) * PW + C_LRUX + h * 64 + ch8);
      ny = *(const u32x4*)(proj + ((size_t)b * SEQ + tn + tok) * PW + C_LRUY + h * 64 + ch8); }
    LDS_BARRIER();
    { float xc[8];
#pragma unroll
      for (int e = 0; e < 8; ++e) { float v = cb[ch8 + e];
#pragma unroll
        for (int j = 0; j < 4; ++j) v += XB[(tok + j) * 64 + ch8 + e] * cw[j * G + ch8 + e];
        xc[e] = v; XC[tok * 65 + ch8 + e] = v; }
      *(u32x4*)(XCb + tok * 72 + ch8) = pack8(xc); }
    LDS_BARRIER();
    { bf16x8 af[2];
#pragma unroll
      for (int ks = 0; ks < 2; ++ks) af[ks] = *(const bf16x8*)(XCb + (mt * 16 + li) * 72 + ks * 32 + 8 * g);
#pragma unroll
      for (int n = 0; n < 2; ++n) { f32x4 cr = {0.f, 0.f, 0.f, 0.f}, ci = {0.f, 0.f, 0.f, 0.f};
#pragma unroll
        for (int ks = 0; ks < 2; ++ks) { cr = MFMA16(af[ks], br_[n][ks], cr); ci = MFMA16(af[ks], bi_[n][ks], ci); }
        const int col = (2 * ntp + n) * 16 + li;
#pragma unroll
        for (int j = 0; j < 4; ++j) { const int tk = mt * 16 + 4 * g + j; const float r = sigmoidf_(cr[j] + rb[n]), ig = sigmoidf_(ci[j] + ib[n]);
          const float log_a = 8.f * r * lsl[n]; const float a = __expf(log_a); const float mult = sqrtf(fmaxf(1.f - a * a, 0.f));
          AA[tk * 65 + col] = a; UU[tk * 65 + col] = mult * (ig * XC[tk * 65 + col]); } } }
    LDS_BARRIER();
    if (wave == 0) {
#pragma unroll 8
      for (int s = 0; s < 64; ++s) { hcur = AA[s * 65 + lane] * hcur + UU[s * 65 + lane]; HH[s * 65 + lane] = hcur; } }
    LDS_BARRIER();
    { bf16* yp = proj + ((size_t)b * SEQ + t0 + tok) * PW + C_LRUY + h * 64 + ch8; float y[8]; unpack8(ycur, y);
#pragma unroll
      for (int e = 0; e < 8; ++e) y[e] = HH[tok * 65 + ch8 + e] * gelu_tanh(y[e]);
      *(u32x4*)yp = pack8(y); }
  }
  __syncthreads();
}

constexpr int KS_P = 72, VS_P = 136;
constexpr int AT_KS = 0, AT_VS = 128 * KS_P * 2, AT_CS = AT_VS + 64 * VS_P * 2, AT_BUF = AT_CS + 512;
struct AtRegs { u32x4 k0, k1, v0, v1; float c; };
__device__ __forceinline__ void at_issue(AtRegs& r, const bf16* Kg  , const bf16* VTg  , const float* cumg, int tid) {
  { const int id = tid, row = id >> 3, ch = id & 7; r.k0 = *(const u32x4*)(Kg + (size_t)row * PW + ch * 8); }
  { const int id = tid + 512, row = id >> 3, ch = id & 7; r.k1 = *(const u32x4*)(Kg + (size_t)row * PW + ch * 8); }
  { const int id = tid, row = id >> 4, ch = id & 15; r.v0 = *(const u32x4*)(VTg + (size_t)row * SEQ + ch * 8); }
  { const int id = tid + 512, row = id >> 4, ch = id & 15; r.v1 = *(const u32x4*)(VTg + (size_t)row * SEQ + ch * 8); }
  r.c = (cumg && tid < 128) ? -cumg[tid] : 0.f;
}
__device__ __forceinline__ void at_commit(const AtRegs& r, unsigned char* buf, int tid) {
  bf16* Ks = (bf16*)(buf + AT_KS); bf16* Vs = (bf16*)(buf + AT_VS); float* Cs = (float*)(buf + AT_CS);
  { const int id = tid, row = id >> 3, ch = id & 7; *(u32x4*)(Ks + row * KS_P + ch * 8) = r.k0; }
  { const int id = tid + 512, row = id >> 3, ch = id & 7; *(u32x4*)(Ks + row * KS_P + ch * 8) = r.k1; }
  { const int id = tid, row = id >> 4, ch = id & 15; *(u32x4*)(Vs + row * VS_P + ch * 8) = r.v0; }
  { const int id = tid + 512, row = id >> 4, ch = id & 15; *(u32x4*)(Vs + row * VS_P + ch * 8) = r.v1; }
  if (tid < 128) Cs[tid] = r.c;
}
__device__ __forceinline__ bf16x8 vfrag(const bf16* Vs, int d, int key0, int g) {
  const u32x2 lo = *(const u32x2*)(Vs + d * VS_P + key0 + 4 * g), hi = *(const u32x2*)(Vs + d * VS_P + key0 + 16 + 4 * g);
  const u32x4 w = {lo.x, lo.y, hi.x, hi.y}; return __builtin_bit_cast(bf16x8, w);
}
__device__ __forceinline__ float grp4_max(float x) {
  const auto a = __builtin_amdgcn_permlane16_swap(__builtin_bit_cast(unsigned, x), __builtin_bit_cast(unsigned, x), false, false);
  x = fmaxf(__builtin_bit_cast(float, (unsigned)a[0]), __builtin_bit_cast(float, (unsigned)a[1]));
  const auto b = __builtin_amdgcn_permlane32_swap(__builtin_bit_cast(unsigned, x), __builtin_bit_cast(unsigned, x), false, false);
  return fmaxf(__builtin_bit_cast(float, (unsigned)b[0]), __builtin_bit_cast(float, (unsigned)b[1]));
}
__device__ __forceinline__ float grp4_sum(float x) {
  const auto a = __builtin_amdgcn_permlane16_swap(__builtin_bit_cast(unsigned, x), __builtin_bit_cast(unsigned, x), false, false);
  x = __builtin_bit_cast(float, (unsigned)a[0]) + __builtin_bit_cast(float, (unsigned)a[1]);
  const auto b = __builtin_amdgcn_permlane32_swap(__builtin_bit_cast(unsigned, x), __builtin_bit_cast(unsigned, x), false, false);
  return __builtin_bit_cast(float, (unsigned)b[0]) + __builtin_bit_cast(float, (unsigned)b[1]);
}
__device__ __forceinline__ void fox_unit(const Params& p, unsigned char* lds, int b, int h, int qb) {
  asm volatile("" ::: "memory");
  unsigned char* ws = p.ws; bf16* proj = (bf16*)(ws + WS_P);
  int tid = threadIdx.x; asm volatile("" : "+v"(tid)); const int wave = __builtin_amdgcn_readfirstlane(tid >> 6), lane = tid & 63, li = lane & 15, g = lane >> 4;
  const int bh = b * 4 + h; const int qrel = wave * 16 + li; const size_t qrow = (size_t)b * SEQ + qb * 128 + qrel;
  const float* cum = (const float*)(ws + SM_CUM) + (size_t)bh * SEQ;
  const bf16* Kbase = proj + (size_t)b * SEQ * PW + C_FOXK + h * 64; const bf16* VTbase = (const bf16*)(ws + P_FOXVT) + (size_t)bh * 64 * SEQ;
  bf16x8 qf[2];
#pragma unroll
  for (int ks = 0; ks < 2; ++ks) qf[ks] = *(const bf16x8*)(proj + qrow * PW + C_FOXQ + h * 64 + ks * 32 + 8 * g);
  const float SC = 0.125f * LOG2E;
  f32x4 o[4];
#pragma unroll
  for (int dt = 0; dt < 4; ++dt) o[dt] = (f32x4){0.f, 0.f, 0.f, 0.f};
  float m = -INFINITY, lsum = 0.f;
  AtRegs rg; at_issue(rg, Kbase, VTbase, cum, tid);
  __syncthreads();
  at_commit(rg, lds, tid);
  if (qb > 0) at_issue(rg, Kbase + (size_t)128 * PW, VTbase + 128, cum + 128, tid);
  LDS_BARRIER();
  for (int kb = 0; kb <= qb; ++kb) {
    unsigned char* buf = lds + (kb & 1) * AT_BUF; const bf16* Ks = (const bf16*)(buf + AT_KS); const bf16* Vs = (const bf16*)(buf + AT_VS); const float* Cs = (const float*)(buf + AT_CS);
    const bool diag = kb == qb; const int nst = diag ? (wave >> 1) + 1 : 4;
    for (int st = 0; st < nst; ++st) {
      f32x4 s0 = {0.f, 0.f, 0.f, 0.f}, s1 = {0.f, 0.f, 0.f, 0.f};
#pragma unroll
      for (int ks = 0; ks < 2; ++ks) { const bf16x8 a0 = *(const bf16x8*)(Ks + (st * 32 + li) * KS_P + ks * 32 + 8 * g), a1 = *(const bf16x8*)(Ks + (st * 32 + 16 + li) * KS_P + ks * 32 + 8 * g);
        s0 = MFMA16(a0, qf[ks], s0); s1 = MFMA16(a1, qf[ks], s1); }
      const f32x4 c0 = *(const f32x4*)(Cs + st * 32 + 4 * g), c1 = *(const f32x4*)(Cs + st * 32 + 16 + 4 * g);
      float x[8];
#pragma unroll
      for (int j = 0; j < 4; ++j) { x[j] = s0[j] * SC + c0[j]; x[4 + j] = s1[j] * SC + c1[j]; }
      if (diag) {
#pragma unroll
        for (int j = 0; j < 4; ++j) { if (st * 32 + 4 * g + j > qrel) x[j] = -INFINITY; if (st * 32 + 16 + 4 * g + j > qrel) x[4 + j] = -INFINITY; }
      }
      float mx = fmaxf(fmaxf(fmaxf(x[0], x[1]), fmaxf(x[2], x[3])), fmaxf(fmaxf(x[4], x[5]), fmaxf(x[6], x[7])));
      mx = grp4_max(mx);
      const float mn = fmaxf(m, mx);
      const bool grew = __any(mn > m);
      float ps = 0.f;
#pragma unroll
      for (int j = 0; j < 8; ++j) { x[j] = ex2(x[j] - mn); ps += x[j]; }
      if (grew) { const float f = ex2(m - mn); lsum *= f;
#pragma unroll
        for (int dt = 0; dt < 4; ++dt) o[dt] = o[dt] * f;
        m = mn; }
      lsum += ps;
      const bf16x8 pb = pack_frag(x);
#pragma unroll
      for (int dt = 0; dt < 4; ++dt) o[dt] = MFMA16(vfrag(Vs, dt * 16 + li, st * 32, g), pb, o[dt]);
    }
    if (kb < qb) {
      at_commit(rg, lds + ((kb + 1) & 1) * AT_BUF, tid);
      if (kb + 2 <= qb) at_issue(rg, Kbase + (size_t)(kb + 2) * 128 * PW, VTbase + (kb + 2) * 128, cum + (kb + 2) * 128, tid);
      LDS_BARRIER();
    }
  }
  lsum = grp4_sum(lsum);
  const float inv = 1.f / lsum;
#pragma unroll
  for (int dt = 0; dt < 4; ++dt) { u32x2 w; w.x = pk2(o[dt][0] * inv, o[dt][1] * inv); w.y = pk2(o[dt][2] * inv, o[dt][3] * inv);
    *(u32x2*)(proj + qrow * PW + C_FOXQ + h * 64 + dt * 16 + 4 * g) = w; }
}
__device__ __forceinline__ void ret_unit(const Params& p, int l, unsigned char* lds, int b, int h, int c) {
  asm volatile("" ::: "memory");
  unsigned char* ws = p.ws; bf16* proj = (bf16*)(ws + WS_P);
  int tid = threadIdx.x; asm volatile("" : "+v"(tid)); const int wave = __builtin_amdgcn_readfirstlane(tid >> 6), lane = tid & 63, li = lane & 15, g = lane >> 4;
  const int bh = b * 4 + h; const int nrel = wave * 16 + li; const size_t qrow = (size_t)b * SEQ + c * 128 + nrel;
  const float lg2 = log2f(1.f - exp2f(-5.f - (float)h));
  bf16* RT = (bf16*)(lds + 2 * AT_BUF);
  AtRegs rg; at_issue(rg, proj + ((size_t)b * SEQ + c * 128) * PW + C_RETK + h * 64, (const bf16*)(ws + P_RETVT) + (size_t)bh * 64 * SEQ + c * 128, nullptr, tid);
  { const float cd = ex2(lg2 * 128.f); const float* KV = (const float*)(ws + P_RETKV) + (size_t)bh * 32 * 4096 + (tid >> 3) * 64 + (tid & 7) * 8;
    f32x4 a0 = {0.f, 0.f, 0.f, 0.f}, a1 = {0.f, 0.f, 0.f, 0.f};
    int cc = 0;
    for (; cc + 4 <= c; cc += 4) { f32x4 k0[4], k1[4];
#pragma unroll
      for (int u = 0; u < 4; ++u) { k0[u] = *(const f32x4*)(KV + (size_t)(cc + u) * 4096); k1[u] = *(const f32x4*)(KV + (size_t)(cc + u) * 4096 + 4); }
#pragma unroll
      for (int u = 0; u < 4; ++u) { a0 = a0 * cd + k0[u]; a1 = a1 * cd + k1[u]; } }
    for (; cc < c; ++cc) { const f32x4 k0 = *(const f32x4*)(KV + (size_t)cc * 4096), k1 = *(const f32x4*)(KV + (size_t)cc * 4096 + 4); a0 = a0 * cd + k0; a1 = a1 * cd + k1; }
    __syncthreads();
    const int d = tid >> 3, e0 = (tid & 7) * 8;
#pragma unroll
    for (int e = 0; e < 4; ++e) { RT[(e0 + e) * KS_P + d] = (bf16)f2bf(a0[e]); RT[(e0 + 4 + e) * KS_P + d] = (bf16)f2bf(a1[e]); } }
  at_commit(rg, lds, tid);
  bf16x8 qf[2];
#pragma unroll
  for (int ks = 0; ks < 2; ++ks) qf[ks] = *(const bf16x8*)(proj + qrow * PW + C_RETQ + h * 64 + ks * 32 + 8 * g);
  __syncthreads();
  const bf16* Ks = (const bf16*)(lds + AT_KS); const bf16* Vs = (const bf16*)(lds + AT_VS);
  f32x4 o[4], cr[4];
#pragma unroll
  for (int et = 0; et < 4; ++et) { o[et] = (f32x4){0.f, 0.f, 0.f, 0.f}; cr[et] = (f32x4){0.f, 0.f, 0.f, 0.f};
#pragma unroll
    for (int ks = 0; ks < 2; ++ks) cr[et] = MFMA16(*(const bf16x8*)(RT + (et * 16 + li) * KS_P + ks * 32 + 8 * g), qf[ks], cr[et]); }
  const int nst = (wave >> 1) + 1;
  for (int st = 0; st < nst; ++st) {
    f32x4 s0 = {0.f, 0.f, 0.f, 0.f}, s1 = {0.f, 0.f, 0.f, 0.f};
#pragma unroll
    for (int ks = 0; ks < 2; ++ks) { const bf16x8 a0 = *(const bf16x8*)(Ks + (st * 32 + li) * KS_P + ks * 32 + 8 * g), a1 = *(const bf16x8*)(Ks + (st * 32 + 16 + li) * KS_P + ks * 32 + 8 * g);
      s0 = MFMA16(a0, qf[ks], s0); s1 = MFMA16(a1, qf[ks], s1); }
    float x[8];
#pragma unroll
    for (int j = 0; j < 4; ++j) { const int m0 = st * 32 + 4 * g + j, m1 = m0 + 16;
      x[j] = (m0 <= nrel) ? s0[j] * ex2(lg2 * (float)(nrel - m0)) : 0.f; x[4 + j] = (m1 <= nrel) ? s1[j] * ex2(lg2 * (float)(nrel - m1)) : 0.f; }
    const bf16x8 pb = pack_frag(x);
#pragma unroll
    for (int et = 0; et < 4; ++et) o[et] = MFMA16(vfrag(Vs, et * 16 + li, st * 32, g), pb, o[et]);
  }
  const float xi = ex2(lg2 * (float)(nrel + 1));
  float ss = 0.f;
#pragma unroll
  for (int et = 0; et < 4; ++et)
#pragma unroll
    for (int j = 0; j < 4; ++j) { o[et][j] += xi * cr[et][j]; ss += o[et][j] * o[et][j]; }
  ss += __shfl_xor(ss, 16); ss += __shfl_xor(ss, 32);
  const float rs = rsqrtf(ss * (1.f / 64.f) + EPS);
  const float* gnw = p.in[33] + (size_t)l * G + h * 64;
#pragma unroll
  for (int et = 0; et < 4; ++et) { const int e0 = et * 16 + 4 * g;
    const u32x2 gg = *(const u32x2*)(proj + qrow * PW + C_RETG + h * 64 + e0); const float gt[4] = {bflo(gg.x), bfhi(gg.x), bflo(gg.y), bfhi(gg.y)};
    float r[4];
#pragma unroll
    for (int j = 0; j < 4; ++j) r[j] = o[et][j] * rs * gnw[e0 + j] * (gt[j] * sigmoidf_(gt[j]));
    u32x2 w; w.x = pk2(r[0], r[1]); w.y = pk2(r[2], r[3]);
    *(u32x2*)(proj + qrow * PW + C_RETQ + h * 64 + e0) = w; }
}

constexpr int XP = 264;
__device__ __forceinline__ void xattn_unit(const Params& p, int l, unsigned char* lds, int unit) {
  asm volatile("" ::: "memory");
  unsigned char* ws = p.ws; bf16* qb = (bf16*)(ws + WS_P);
  int tid = threadIdx.x; asm volatile("" : "+v"(tid)); const int wave = __builtin_amdgcn_readfirstlane(tid >> 6), lane = tid & 63, li = lane & 15, g = lane >> 4;
  const int b = unit >> 6, head = (unit >> 4) & 3, qt = unit & 15;
  bf16* L = (bf16*)lds;
  const bf16* kg = (const bf16*)(ws + WS_KM) + ((size_t)l * 1024 + b * 256) * 1024 + head * 256;
  const bf16* vg = (const bf16*)(ws + WS_VMT) + (size_t)(((l * 4 + b) * 4 + head) * 256) * 256;
  __syncthreads();
#pragma unroll
  for (int i0 = 0; i0 < 16; i0 += 8) { u32x4 t[8];
#pragma unroll
    for (int i = 0; i < 8; ++i) { const int id = tid + 512 * (i0 + i), row = id >> 5, ch = id & 31; t[i] = *(const u32x4*)(kg + (size_t)row * 1024 + ch * 8); }
#pragma unroll
    for (int i = 0; i < 8; ++i) { const int id = tid + 512 * (i0 + i), row = id >> 5, ch = id & 31; *(u32x4*)(L + row * XP + ch * 8) = t[i]; } }
  __syncthreads();
  bf16x8 pb[2][8]; float linv[2];
  const float SC = LOG2E / 16.f;
#pragma unroll
  for (int grp = 0; grp < 2; ++grp) {
    const size_t row = (size_t)b * SEQ + qt * 256 + wave * 32 + grp * 16 + li;
    bf16x8 qf[8];
#pragma unroll
    for (int ks = 0; ks < 8; ++ks) qf[ks] = *(const bf16x8*)(qb + row * 1024 + head * 256 + ks * 32 + 8 * g);
    f32x4 s[16];
#pragma unroll
    for (int kt = 0; kt < 16; ++kt) { s[kt] = (f32x4){0.f, 0.f, 0.f, 0.f};
#pragma unroll
      for (int ks = 0; ks < 8; ++ks) s[kt] = MFMA16(*(const bf16x8*)(L + (kt * 16 + li) * XP + ks * 32 + 8 * g), qf[ks], s[kt]);
      if ((kt & 1) == 1) __builtin_amdgcn_sched_barrier(0); }
    float mx = -INFINITY;
#pragma unroll
    for (int kt = 0; kt < 16; ++kt) mx = fmaxf(mx, fmaxf(fmaxf(s[kt][0], s[kt][1]), fmaxf(s[kt][2], s[kt][3])));
    mx = fmaxf(mx, __shfl_xor(mx, 16)); mx = fmaxf(mx, __shfl_xor(mx, 32));
    float ps = 0.f;
#pragma unroll
    for (int kt = 0; kt < 16; ++kt)
#pragma unroll
      for (int j = 0; j < 4; ++j) { s[kt][j] = ex2((s[kt][j] - mx) * SC); ps += s[kt][j]; }
    ps += __shfl_xor(ps, 16); ps += __shfl_xor(ps, 32);
    linv[grp] = 1.f / ps;
#pragma unroll
    for (int kk = 0; kk < 8; ++kk) { float x[8];
#pragma unroll
      for (int j = 0; j < 4; ++j) { x[j] = s[2 * kk][j]; x[4 + j] = s[2 * kk + 1][j]; }
      pb[grp][kk] = pack_frag(x); }
    __builtin_amdgcn_sched_barrier(0);
  }
  __syncthreads();
#pragma unroll
  for (int i0 = 0; i0 < 16; i0 += 8) { u32x4 t[8];
#pragma unroll
    for (int i = 0; i < 8; ++i) { const int id = tid + 512 * (i0 + i), row = id >> 5, ch = id & 31; t[i] = *(const u32x4*)(vg + (size_t)row * 256 + ch * 8); }
#pragma unroll
    for (int i = 0; i < 8; ++i) { const int id = tid + 512 * (i0 + i), row = id >> 5, ch = id & 31; *(u32x4*)(L + row * XP + ch * 8) = t[i]; } }
  __syncthreads();
#pragma unroll
  for (int grp = 0; grp < 2; ++grp) {
    const size_t row = (size_t)b * SEQ + qt * 256 + wave * 32 + grp * 16 + li;
#pragma unroll
    for (int dt = 0; dt < 16; ++dt) { f32x4 o = {0.f, 0.f, 0.f, 0.f};
#pragma unroll
      for (int kk = 0; kk < 8; ++kk) { const u32x2 lo = *(const u32x2*)(L + (dt * 16 + li) * XP + kk * 32 + 4 * g), hi = *(const u32x2*)(L + (dt * 16 + li) * XP + kk * 32 + 16 + 4 * g);
        const u32x4 w = {lo.x, lo.y, hi.x, hi.y}; o = MFMA16(__builtin_bit_cast(bf16x8, w), pb[grp][kk], o); }
      u32x2 w; w.x = pk2(o[0] * linv[grp], o[1] * linv[grp]); w.y = pk2(o[2] * linv[grp], o[3] * linv[grp]);
      *(u32x2*)(qb + row * 1024 + head * 256 + dt * 16 + 4 * g) = w;
      __builtin_amdgcn_sched_barrier(0); }
  }
}

#define LAS __attribute__((address_space(3)))
#define XB_TMO      128
#define XB_XCNT(j)  (256  + 64 * (j))
#define XB_XSUB(j)  (1280 + 64 * (j))
#define XB_XGEN(j)  (2304 + 64 * (j))
#define XB_TOP      3328
#define XB_TOPGEN   3392
#define XCD_BAR_WORDS 3456
#define XB_SPIN_CAP (1u << 18)

__device__ __forceinline__ unsigned xb_ld(unsigned* p)              { return __hip_atomic_load(p, __ATOMIC_RELAXED, __HIP_MEMORY_SCOPE_AGENT); }
__device__ __forceinline__ unsigned xb_add(unsigned* p, unsigned v) { return __hip_atomic_fetch_add(p, v, __ATOMIC_RELAXED, __HIP_MEMORY_SCOPE_AGENT); }
__device__ __forceinline__ unsigned xb_xcc_id() { return (unsigned)__builtin_amdgcn_s_getreg((3 << 11) | 20) & 0xFu; }
#define XB_SPIN(cond, bar) do { unsigned _sp = 0; while (cond) { __builtin_amdgcn_s_sleep(1); \
    if ((++_sp & 255u) == 0u) { if (xb_ld(&(bar)[XB_TMO])) break; if (_sp > XB_SPIN_CAP) { atomicAdd(&(bar)[XB_TMO], 1u); break; } } } } while (0)

struct XcdBarrier {
    unsigned* bar; unsigned x;
    volatile LAS unsigned* st;
};

__device__ __forceinline__ XcdBarrier xcd_barrier_post(unsigned* bar, volatile LAS unsigned* st) {
    XcdBarrier b; b.bar = bar; b.x = xb_xcc_id(); b.st = st;
    if (threadIdx.x == 0) (void)xb_add(&bar[XB_XCNT(b.x)], 1u);
    return b;
}
__device__ __forceinline__ void xcd_barrier_complete(unsigned* bar, unsigned x, unsigned& nloc, unsigned& nx) {
    const unsigned G = gridDim.x * gridDim.y * gridDim.z;
    unsigned sum, cnt, mine, sp = 0u;
    for (;;) {
        sum = 0u; cnt = 0u; mine = 0u;
#pragma unroll
        for (unsigned j = 0; j < 16; ++j) { const unsigned c = xb_ld(&bar[XB_XCNT(j)]); sum += c; cnt += (c > 0u) ? 1u : 0u; mine = (j == x) ? c : mine; }
        if (sum == G) break;
        __builtin_amdgcn_s_sleep(1);
        if ((++sp & 255u) == 0u) { if (xb_ld(&bar[XB_TMO])) break; if (sp > XB_SPIN_CAP) { atomicAdd(&bar[XB_TMO], 1u); break; } }
    }
    nloc = mine > 0u ? mine : 1u; nx = cnt > 0u ? cnt : 1u;
}

__device__ __forceinline__ void xcd_barrier(const XcdBarrier& b) {
    asm volatile("s_waitcnt vmcnt(0)" ::: "memory");
    __syncthreads();
    if (threadIdx.x == 0) {
        unsigned* bar = b.bar;
        __builtin_amdgcn_s_waitcnt(0);
        unsigned nloc = b.st[0], nx = b.st[1];
        if (nloc == 0u) { xcd_barrier_complete(bar, b.x, nloc, nx); b.st[0] = nloc; b.st[1] = nx; }
        const unsigned old = xb_add(&bar[XB_XSUB(b.x)], 1u);
        const unsigned gen = old / nloc;
        if (old + 1u == (gen + 1u) * nloc) {
            __builtin_amdgcn_fence(__ATOMIC_RELEASE, "agent");
            asm volatile("s_waitcnt vmcnt(0)" ::: "memory");
            const unsigned og = xb_add(&bar[XB_TOP], 1u);
            const unsigned tg = og / nx;
            if (og + 1u == (tg + 1u) * nx) xb_add(&bar[XB_TOPGEN], 1u);
            else XB_SPIN(xb_ld(&bar[XB_TOPGEN]) == tg, bar);
            __builtin_amdgcn_fence(__ATOMIC_ACQUIRE, "agent");
            xb_add(&bar[XB_XGEN(b.x)], 1u);
            asm volatile("s_waitcnt vmcnt(0)" ::: "memory");
        } else {
            XB_SPIN(xb_ld(&bar[XB_XGEN(b.x)]) == gen, bar);
            __builtin_amdgcn_fence(__ATOMIC_ACQUIRE, "agent");
            asm volatile("s_waitcnt vmcnt(0)" ::: "memory");
        }
    }
    __syncthreads();
}


#ifndef DEBUG_LAUNCHES
#define DEBUG_LAUNCHES 0
#endif
constexpr int PH_PER_LAYER = 13, N_PHASES = 1 + PH_PER_LAYER * DEPTH;

__global__ void __launch_bounds__(NTHREADS) mega_fwd(Params p) {
  extern __shared__ __attribute__((aligned(16))) unsigned char lds[];
  cg::grid_group grid = cg::this_grid();
  constexpr int NB = 256, NGW = NB * NWAVES;
  unsigned char* ws = p.ws;
  PG8_LAS unsigned char* glds = (PG8_LAS unsigned char*)lds;
  bf16* Hb = (bf16*)(ws + WS_H); bf16* Ob = (bf16*)(ws + WS_O); bf16* Pb = (bf16*)(ws + WS_P);
  volatile LAS unsigned* xb_st = (volatile LAS unsigned*)((LAS unsigned char*)lds + (LDS_BYTES - 32));
  if (threadIdx.x == 0) { xb_st[0] = 0u; xb_st[1] = 0u; }
  __syncthreads();
  const XcdBarrier xbar = xcd_barrier_post((unsigned*)(ws + SM_BAR), xb_st);
  int ph = 0;
#ifdef DBG_CLR
#define DBG_LDSCLEAR { for (int e_ = threadIdx.x; e_ < LDS_BYTES / 4; e_ += NTHREADS) ((unsigned*)lds)[e_] = 0u; __syncthreads(); }
#else
#define DBG_LDSCLEAR
#endif
#define PHASE_BEGIN if (ph >= p.ph_lo && ph < p.ph_hi) { int tid = threadIdx.x; asm volatile("" : "+v"(tid)); const int lane = tid & 63, wave = __builtin_amdgcn_readfirstlane(tid >> 6), gw = blockIdx.x * NWAVES + wave; (void)lane; (void)gw; DBG_LDSCLEAR
#ifdef TS_PH
#define TS_REC if (blockIdx.x == 0 && threadIdx.x == 0) ((unsigned long long*)(ws + SM_Q + 256))[ph + 1] = __builtin_amdgcn_s_memrealtime();
#else
#define TS_REC
#endif
#define PHASE_END   if (ph + 1 < p.ph_hi) { if (p.ph_lo < 0) grid.sync();   else xcd_barrier(xbar); } TS_REC } ++ph;

  PHASE_BEGIN
    float* scr = (float*)lds + wave * (64 * 33);
    conv_layer_weights(p, 0, scr, gw, NGW, lane);
    { constexpr int I_SQ = (D / 64) * (D / 32);
      for (int it = gw; it < 4 * I_SQ; it += NGW) { const int w = it / I_SQ, r = it % I_SQ, layer = w >> 1, isv = w & 1;
        conv_item<0>(p.in[isv ? 36 : 35] + (size_t)layer * D * D, D, D, D, (bf16*)(ws + WS_WKV) + (size_t)w * D * D, scr, r, lane); } }
    for (int l = 0; l < DEPTH; ++l) { RowArgs a{}; a.xin = p.in[1]; a.g_pre = p.in[6] + (size_t)l * D; a.hout = (bf16*)(ws + WS_MEMN) + (size_t)l * 1024 * 1024; a.rows = 1024; row_phase(a, gw, NGW, lane); }
    { RowArgs a{}; a.xin = p.in[0]; a.g_pre = p.in[2]; a.hout = Hb; a.wf = p.in[9]; a.fbias = p.in[11]; a.logf = (float*)(ws + SM_LOGF); a.rows = T; row_phase(a, gw, NGW, lane); }
#ifdef DBG_FILLG
    for (int e = blockIdx.x * NTHREADS + tid; e < T * G / 2; e += NB * NTHREADS) ((unsigned*)(ws + RW_G))[e] = 0x447A447Au;
#endif
    for (int e = blockIdx.x * NTHREADS + tid; e < SEQ * 32; e += NB * NTHREADS) { const int pos = e >> 5, i = e & 31; const float inv = 1.f / powf(10000.f, (float)i / 31.f); const float ang = (float)pos * inv;
      ((float*)(ws + SM_ROT))[2 * e] = cosf(ang); ((float*)(ws + SM_ROT))[2 * e + 1] = sinf(ang); }
  PHASE_END

  for (int l = 0; l < DEPTH; ++l) {
    PHASE_BEGIN
      { pg8::Gemm g{Hb, (const bf16*)(ws + W_IN), T, NIN, D, D}; pg8::StaticOrder S; S.init(T, NIN, NB, (int)blockIdx.x);
        EpiIn E{Pb, (bf16*)(ws + P_FOXVT), (bf16*)(ws + P_RETKT), (bf16*)(ws + P_RETVT), (const float*)(ws + SM_ROT)};
        pg8::gemm_phase<EpiIn, pg8::StaticOrder, true, true>(glds, g, S, E); }
      if (l == 0) { pg8::Gemm g{(const bf16*)(ws + WS_MEMN), (const bf16*)(ws + WS_WKV), 2048, 4096, D, D}; MemSched S{NB, (int)blockIdx.x - 64};
        EpiMem E{(bf16*)(ws + WS_KM), (bf16*)(ws + WS_VMT)};
        pg8::gemm_phase<EpiMem, MemSched, true, true>(glds, g, S, E); }
    PHASE_END
    PHASE_BEGIN
      float* wl = (float*)lds + wave * (16 * WLP);
      for (int u = gw; u < 4096; u += NGW) rwkv_prep_unit(p, l, u >> 2, u & 3, wl, lane);
      for (int u = gw; u < 512; u += NGW) ret_kv_unit(p, u, lane);
      if (gw >= 1024 && gw < 1040) fox_cum_unit(p, gw - 1024, lane);
      if (blockIdx.x == 0 && tid == 0) *(int*)(ws + SM_Q) = 0;
    PHASE_END
    PHASE_BEGIN
#ifndef DBG_P3
#define DBG_P3 15
#endif
      if (blockIdx.x < 128) {
        const int bx_ = blockIdx.x, j_ = bx_ >> 3, su_ = ((2 * (bx_ & 7) + (j_ >> 3)) << 3) | (j_ & 7);
        if (DBG_P3 & 1) rwkv_scan_unit(p, lds, su_);
#ifdef REP_SCAN
        rwkv_scan_unit(p, lds, blockIdx.x);
#endif
      }
      else if (blockIdx.x < 144) { if (DBG_P3 & 2) lru_unit(p, l, (float*)lds, blockIdx.x - 128); }
      int* qword = (int*)(lds + LDS_BYTES - 16);
      for (;;) {
        __syncthreads();
        if (tid == 0) *qword = atomicAdd((int*)(ws + SM_Q), 1);
        __syncthreads();
        const int id = *qword;
        if (id >= 1024) break;
        if (id < 512) { if (DBG_P3 & 4) fox_unit(p, lds, (id & 15) >> 2, id & 3, 31 - (id >> 4)); }
        else if (DBG_P3 & 8) { const int r = id - 512; ret_unit(p, l, lds, r >> 7, (r >> 5) & 3, r & 31); }
      }
    PHASE_END
    PHASE_BEGIN
      for (int row = gw; row < T; row += NGW) rwkv_post_row(p, l, row, lane);
    PHASE_END
    PHASE_BEGIN
      pg8::Gemm g{Pb, (const bf16*)(ws + W_OUT), T, D, D, PW}; pg8::StaticOrder S; S.init(T, D, NB, (int)blockIdx.x);
      EpiPlain E{Ob, D, 0, nullptr};
      pg8::gemm_phase<EpiPlain, pg8::StaticOrder, true, true>(glds, g, S, E);
    PHASE_END
    PHASE_BEGIN
      RowArgs a{}; a.xin = l == 0 ? p.in[0] : p.out; a.O = Ob; a.g_post = p.in[3] + (size_t)l * D; a.xout = p.out; a.g_pre = p.in[4] + (size_t)l * D; a.hout = Hb; a.rows = T;
      row_phase(a, gw, NGW, lane);
    PHASE_END
    PHASE_BEGIN
      pg8::Gemm g{Hb, (const bf16*)(ws + W_Q), T, D, D, D}; pg8::StaticOrder S; S.init(T, D, NB, (int)blockIdx.x);
      EpiPlain E{Pb, D, 0, nullptr};
      pg8::gemm_phase<EpiPlain, pg8::StaticOrder, true, true>(glds, g, S, E);
    PHASE_END
    PHASE_BEGIN
      for (int u = blockIdx.x; u < 256; u += NB) xattn_unit(p, l, lds, u);
    PHASE_END
    PHASE_BEGIN
      pg8::Gemm g{Pb, (const bf16*)(ws + W_O), T, D, D, D}; pg8::StaticOrder S; S.init(T, D, NB, (int)blockIdx.x);
      EpiPlain E{Ob, D, 0, nullptr};
      pg8::gemm_phase<EpiPlain, pg8::StaticOrder, true, true>(glds, g, S, E);
    PHASE_END
    PHASE_BEGIN
      RowArgs a{}; a.xin = p.out; a.O = Ob; a.g_post = p.in[5] + (size_t)l * D; a.xout = p.out; a.g_pre = p.in[7] + (size_t)l * D; a.hout = Hb; a.rows = T;
      row_phase(a, gw, NGW, lane);
    PHASE_END
    PHASE_BEGIN
      pg8::Gemm g{Hb, (const bf16*)(ws + W_1), T, DFF, D, D}; pg8::StaticOrder S; S.init(T, DFF, NB, (int)blockIdx.x);
      EpiPlain E{Pb, DFF, 1, nullptr};
      pg8::gemm_phase<EpiPlain, pg8::StaticOrder, true, true>(glds, g, S, E);
    PHASE_END
    PHASE_BEGIN
      pg8::Gemm g{Pb, (const bf16*)(ws + W_2), T, D, DFF, DFF}; pg8::StaticOrder S; S.init(T, D, NB, (int)blockIdx.x);
      EpiPlain E{Ob, D, 0, nullptr};
      pg8::gemm_phase<EpiPlain, pg8::StaticOrder, true, true>(glds, g, S, E);
    PHASE_END
    PHASE_BEGIN
      RowArgs a{}; a.xin = p.out; a.O = Ob; a.g_post = p.in[8] + (size_t)l * D; a.xout = p.out; a.rows = T;
      if (l + 1 < DEPTH) { a.g_pre = p.in[2] + (size_t)(l + 1) * D; a.hout = Hb; a.wf = p.in[9] + (size_t)(l + 1) * D * INW; a.fbias = p.in[11] + (size_t)(l + 1) * GH; a.logf = (float*)(ws + SM_LOGF); }
      row_phase(a, gw, NGW, lane);
      if (l + 1 < DEPTH) { __syncthreads(); conv_layer_weights(p, l + 1, (float*)lds + wave * (64 * 33), gw, NGW, lane); }
    PHASE_END
  }
#ifdef TS_PH
  grid.sync();
  if (blockIdx.x == 0) { const unsigned long long* ts = (const unsigned long long*)(ws + SM_Q + 256);
#ifdef TS_CONST
    const float dt_us = TS_CONST;
#else
    const float dt_us = (float)(ts[TS_PH + 1] - ts[TS_PH]) * 0.01f;
#endif
    const float delta = 0.01f * sqrtf(dt_us);
    for (int r = threadIdx.x; r < T; r += NTHREADS) p.out[(size_t)r * D] += delta; }
#endif
}


#ifdef DBG_STOP
#ifndef DBG_MASK
#define DBG_MASK 15
#endif
__global__ void dbg_dump(const unsigned char* ws, float* out) {
  const size_t i = (size_t)blockIdx.x * 256 + threadIdx.x; const int row = (int)(i >> 10), c = (int)(i & 1023);
#ifndef DBG_SRC
#define DBG_SRC 0
#endif
#ifndef DBG_COFF
#define DBG_COFF 0
#endif
  const bf16* proj = (const bf16*)(ws + WS_P);
  if (DBG_SRC == 0) out[i] = ((DBG_MASK >> (c >> 8)) & 1) ? bflo((unsigned)proj[(size_t)row * PW + DBG_COFF + c]) : 0.f;
  else if (DBG_SRC == 1) { const bf16* a = (const bf16*)(ws + WS_RW) + (size_t)(c >> 8) * (8u << 19); out[i] = ((DBG_MASK >> (c >> 8)) & 1) ? bflo((unsigned)a[(size_t)row * G + (c & 255)]) : 0.f; }
  else if (DBG_SRC == 2) { const bf16* a = (const bf16*)(ws + RW_K) + (size_t)(c >> 8) * (8u << 19); float v = 0.f; if (c < 768) v = bflo((unsigned)a[(size_t)row * G + (c & 255)]); else if (c < 772) v = ((const float*)(ws + SM_BR))[row * 4 + (c & 3)]; else if (c < 776) v = ((const float*)(ws + SM_KR))[row * 4 + (c & 3)]; else if (c < 780) v = ((const float*)(ws + SM_RK))[row * 4 + (c & 3)];
    out[i] = ((DBG_MASK >> (c >> 8)) & 1) ? v : 0.f; }
  else if (DBG_SRC == 5) { out[i] = c < 256 ? bflo((unsigned)((const bf16*)(ws + RW_G))[(size_t)row * G + c]) : 0.f; }
  else if (DBG_SRC == 4) { out[i] = i < 512 * 1024 ? bflo((unsigned)((const bf16*)(ws + W_SMALL))[i]) : 0.f; }
  else { out[i] = c < 256 ? ((const float*)(ws + RW_Y))[(size_t)row * G + c] : 0.f; }
}
#endif

#ifdef DBG_GCHK
__global__ void dbg_snap(const unsigned char* ws, float* out) { const size_t i = (size_t)blockIdx.x * 256 + threadIdx.x; ((unsigned*)out)[i] = ((const unsigned*)(ws + RW_G))[i]; if (i == 0) *(unsigned*)(ws + SM_Q + 64) = 0u; }
__global__ void dbg_cmp(unsigned char* ws, const float* out) { const size_t i = (size_t)blockIdx.x * 256 + threadIdx.x; const unsigned a = ((const unsigned*)(ws + RW_G))[i], b = ((const unsigned*)out)[i];
  if (a != b) { unsigned f = 1u; if (a == 0x447A447Au) f |= 2u; else f |= 4u; atomicOr((unsigned*)(ws + SM_Q + 64), f); } }
__global__ void dbg_fin(const unsigned char* ws, float* out) { const size_t i = (size_t)blockIdx.x * 256 + threadIdx.x; out[i] = (i == 0) ? 1.0e6f * (float)(*(const unsigned*)(ws + SM_Q + 64)) : 0.f; }
#endif
extern "C" void kernel_launch(void* const* d_in, const int* in_sizes, int n_in, void* d_out, int out_size, void* d_ws, size_t ws_size, hipStream_t stream) {
  static int grid = 0;
  if (grid == 0) {
    if (ws_size < WS_END) { fprintf(stderr, "kernel_launch: workspace too small: %zu < %zu\n", ws_size, (size_t)WS_END); grid = -1; return; }
    int dev = 0, cus = 0, per_cu = 0;
    hipGetDevice(&dev); hipDeviceGetAttribute(&cus, hipDeviceAttributeMultiprocessorCount, dev);
    hipFuncSetAttribute((const void*)mega_fwd, hipFuncAttributeMaxDynamicSharedMemorySize, LDS_BYTES);
    hipOccupancyMaxActiveBlocksPerMultiprocessor(&per_cu, (const void*)mega_fwd, NTHREADS, LDS_BYTES);
    if (per_cu < 1) { fprintf(stderr, "kernel_launch: occupancy query says %d blocks/CU\n", per_cu); per_cu = 1; }
    grid = 256;
    if (cus < 256) { fprintf(stderr, "kernel_launch: needs 256 CUs, device has %d\n", cus); grid = -1; return; }
    (void)hipGetLastError();
  }
  if (grid < 0) return;
  Params p{};
  for (int i = 0; i < 40; ++i) p.in[i] = (const float*)d_in[i];
  p.out = (float*)d_out; p.ws = (unsigned char*)d_ws;
#if DEBUG_LAUNCHES
#ifdef DBG_GCHK
  for (int ph = 0; ph < 3; ++ph) { p.ph_lo = ph; p.ph_hi = ph + 1; hipLaunchKernelGGL(mega_fwd, dim3(grid), dim3(NTHREADS), LDS_BYTES, stream, p); }
  hipLaunchKernelGGL(dbg_snap, dim3(T * G / 2 / 256), dim3(256), 0, stream, (const unsigned char*)d_ws, (float*)d_out);
  p.ph_lo = 3; p.ph_hi = 4; hipLaunchKernelGGL(mega_fwd, dim3(grid), dim3(NTHREADS), LDS_BYTES, stream, p);
  hipLaunchKernelGGL(dbg_cmp, dim3(T * G / 2 / 256), dim3(256), 0, stream, (unsigned char*)d_ws, (const float*)d_out);
  hipLaunchKernelGGL(dbg_fin, dim3(T * 1024 / 256), dim3(256), 0, stream, (const unsigned char*)d_ws, (float*)d_out);
#elif defined(DBG_STOP)
  for (int ph = 0; ph < DBG_STOP; ++ph) { p.ph_lo = ph; p.ph_hi = ph + 1; hipLaunchKernelGGL(mega_fwd, dim3(grid), dim3(NTHREADS), LDS_BYTES, stream, p); }
  hipLaunchKernelGGL(dbg_dump, dim3(T * 1024 / 256), dim3(256), 0, stream, (const unsigned char*)d_ws, (float*)d_out);
#else
#ifndef REP_MASK
#define REP_MASK 0
#endif
  int rewound = 0;
  for (int ph = 0; ph < N_PHASES; ++ph) { p.ph_lo = ph; p.ph_hi = ph + 1; const int rel = ph == 0 ? 0 : 1 + (ph - 1) % PH_PER_LAYER;
    const int reps = ((REP_MASK >> rel) & 1) ? 2 : 1;
    for (int r = 0; r < reps; ++r) hipLaunchKernelGGL(mega_fwd, dim3(grid), dim3(NTHREADS), LDS_BYTES, stream, p);
#ifdef REP_GROUP
    if (rel == 4) { if (!rewound) { rewound = 1; ph -= 4; } else rewound = 0; }
#endif
  }
#endif
#else
  p.ph_lo = 0; p.ph_hi = N_PHASES;
  hipMemsetAsync((unsigned char*)d_ws + SM_BAR, 0, 16384, stream);
  void* args[] = {&p};
  hipError_t e = hipLaunchCooperativeKernel((const void*)mega_fwd, dim3(grid), dim3(NTHREADS), args, LDS_BYTES, stream);
  if (e != hipSuccess) fprintf(stderr, "cooperative launch failed: %s (grid %d)\n", hipGetErrorString(e), grid);
#endif
}
```

```cpp
#include <hip/hip_runtime.h>
#include <hip/hip_cooperative_groups.h>
#include <cstdio>
#include <cstdint>
#include <cmath>
namespace cg = cooperative_groups;
namespace pg8 {
#define PG8_LAS __attribute__((address_space(3)))
typedef unsigned short bf16_t;
typedef short bf16x8 __attribute__((ext_vector_type(8)));
typedef float f32x4 __attribute__((ext_vector_type(4)));
typedef unsigned u32x4 __attribute__((ext_vector_type(4)));
constexpr int BM = 256, BK = 64, HALF = 128, HTB = HALF * BK * 2  , STAGE_BYTES = 8 * HTB, NXCD = 8, WGM = 8;

__host__ __device__ __forceinline__ int lds_byte(int r, int c) { const int st = (r >> 4) * 2 + (c >> 5), rr = r & 15, cc = c & 31, ob = rr * 64 + cc * 2; return st * 1024 + (ob ^ (((ob >> 9) & 1) << 5)); }
__host__ __device__ __forceinline__ void stage_rc(int b, int& R, int& C) { const int st = b / 1024, sb = b % 1024, swz = sb ^ (((sb >> 9) & 1) << 5); R = (st >> 1) * 16 + swz / 64; C = (st & 1) * 32 + (swz % 64) / 2; }
__host__ __device__ __forceinline__ int perm32(int rho) { const int n = rho >> 4, i = rho & 15; return 8 * (i >> 2) + 4 * n + (i & 3); }

struct Unit { int pm, pn; };
struct Gemm { const bf16_t* A; const bf16_t* Bt; int M, N, K, lda; };

struct StaticOrder {
    int nM, nN, nwg, G, c;
    __host__ __device__ void init(int M, int N, int G_, int c_) { nM = M / BM; nN = N / BM; nwg = nM * nN; G = G_; c = c_; }
    __host__ __device__ bool next(int i, Unit& u) const {
        const long L = (long)i * G + c; if (L >= nwg) return false;
        int wgid = (int)L; { const int q = nwg / NXCD, r = nwg % NXCD, xcd = wgid % NXCD, off = wgid / NXCD; wgid = (xcd < r ? xcd * (q + 1) : r * (q + 1) + (xcd - r) * q) + off; }
        const int nig = WGM * nN, gid = wgid / nig, fm = gid * WGM, gsz = (nM - fm) < WGM ? (nM - fm) : WGM;
        u.pm = fm + ((wgid % nig) % gsz); u.pn = (wgid % nig) / gsz; return true;
    }
    __device__ __forceinline__ void a_ready(const Unit&) const {}
    __device__ __forceinline__ void done(const Unit&) const {}
};

__device__ __forceinline__ unsigned cvt_pk_bf16(float lo, float hi) { unsigned r; asm volatile("v_cvt_pk_bf16_f32 %0, %1, %2" : "=v"(r) : "v"(lo), "v"(hi)); return r; }
typedef float f32x2 __attribute__((ext_vector_type(2)));
template <class Epi, class Sched, bool ALIGN_EPI = false, bool SP2 = false>
__device__ __forceinline__ void gemm_phase(PG8_LAS unsigned char* lds, const Gemm g, const Sched& S, const Epi& E) {
    int tid_l = threadIdx.x; asm volatile("" : "+v"(tid_l));
    const int tid = tid_l, wid = __builtin_amdgcn_readfirstlane(tid >> 6), lane = tid & 63, wr = wid >> 2, wc = wid & 3, fr = lane & 15, fq = lane >> 4;
    const int K = g.K, nt = K / BK;
    unsigned voffA[2], voffB[2];
#pragma unroll
    for (int i = 0; i < 2; ++i) { int R, C; stage_rc(tid * 16 + i * 8192, R, C); const int Rb = Epi::PERM ? ((R & ~31) + perm32(R & 31)) : R;
        voffA[i] = (unsigned)(R * g.lda + C) * 2u; voffB[i] = (unsigned)(Rb * K + C) * 2u; }
    const size_t kstep = (size_t)(BK * 2);
    const size_t hstep = (size_t)HALF * K * 2;
    const size_t tstep = 2 * hstep; const size_t hstepA = (size_t)HALF * g.lda * 2; const size_t tstepA = 2 * hstepA;
    const unsigned ldsw = (unsigned)wid * 1024u;
    const int aoff = lds_byte(wr * 64 + fr, fq * 8), boff = lds_byte(wc * 32 + fr, fq * 8);
#define PG8_SA(b, h) (((b) * 2 + (h)) * HTB)
#define PG8_SB(b, h) ((4 + (b) * 2 + (h)) * HTB)
#define PG8_STAGE(bufoff, gbase, voff) do { _Pragma("unroll") for (int _i = 0; _i < 2; ++_i) \
        __builtin_amdgcn_global_load_lds((const unsigned*)((const char*)(gbase) + (voff)[_i]), (PG8_LAS unsigned*)(lds + (bufoff) + ldsw + _i * 8192), 16, 0, 0); } while (0)
#define PG8_LDA(dst, b, h) do { _Pragma("unroll") for (int m = 0; m < 4; ++m) _Pragma("unroll") for (int k = 0; k < 2; ++k) dst[m][k] = *(const PG8_LAS bf16x8*)(lds + PG8_SA(b, h) + aoff + m * 2048 + k * 1024); } while (0)
#define PG8_LDB(dst, b, h) do { _Pragma("unroll") for (int n = 0; n < 2; ++n) _Pragma("unroll") for (int k = 0; k < 2; ++k) dst[n][k] = *(const PG8_LAS bf16x8*)(lds + PG8_SB(b, h) + boff + n * 2048 + k * 1024); } while (0)
#define PG8_MMA(ai, bj, At, Bt) do { __builtin_amdgcn_s_setprio(1); _Pragma("unroll") for (int m = 0; m < 4; ++m) _Pragma("unroll") for (int n = 0; n < 2; ++n) _Pragma("unroll") for (int k = 0; k < 2; ++k) \
        acc[ai][bj][m][n] = __builtin_amdgcn_mfma_f32_16x16x32_bf16(Bt[n][k], At[m][k], acc[ai][bj][m][n], 0, 0, 0); __builtin_amdgcn_s_setprio(0); } while (0)
#define PG8_WAIT_V(n) asm volatile("s_waitcnt vmcnt(" #n ")" ::: "memory")
#define PG8_WAIT_L(n) asm volatile("s_waitcnt lgkmcnt(" #n ")" ::: "memory")
#define PG8_BAR __builtin_amdgcn_s_barrier()
#define PG8_SCHED __builtin_amdgcn_sched_barrier(0)
    Unit cur, nxt; int ui = 0;
    if (!S.next(0, cur)) return;
    f32x4 acc[2][2][4][2];
#pragma unroll
    for (int a = 0; a < 2; ++a)
#pragma unroll
        for (int b = 0; b < 2; ++b)
#pragma unroll
            for (int m = 0; m < 4; ++m)
#pragma unroll
                for (int n = 0; n < 2; ++n) acc[a][b][m][n] = (f32x4){0.f, 0.f, 0.f, 0.f};
    bf16x8 At[4][2], B0[2][2], B1[2][2];
    const char* cA = (const char*)g.A + (size_t)cur.pm * tstepA; const char* cB = (const char*)g.Bt + (size_t)cur.pn * tstep;
    S.a_ready(cur);
    if constexpr (SP2) {
        PG8_STAGE(PG8_SB(0, 0), cB, voffB); PG8_STAGE(PG8_SB(0, 1), cB + hstep, voffB); PG8_STAGE(PG8_SA(0, 0), cA, voffA); PG8_STAGE(PG8_SA(0, 1), cA + hstepA, voffA);
        if (wr == 1) PG8_BAR;
        PG8_WAIT_V(2); PG8_BAR;
        PG8_STAGE(PG8_SB(1, 0), cB + kstep, voffB); PG8_STAGE(PG8_SA(1, 0), cA + kstep, voffA); PG8_STAGE(PG8_SB(1, 1), cB + hstep + kstep, voffB);
        PG8_WAIT_V(6); PG8_BAR;
    } else {
        PG8_STAGE(PG8_SB(0, 0), cB, voffB); PG8_STAGE(PG8_SA(0, 0), cA, voffA); PG8_STAGE(PG8_SB(0, 1), cB + hstep, voffB); PG8_STAGE(PG8_SA(0, 1), cA + hstepA, voffA);
        if (wr == 1) PG8_BAR;
        PG8_WAIT_V(4); PG8_BAR;
        PG8_STAGE(PG8_SB(1, 0), cB + kstep, voffB); PG8_STAGE(PG8_SA(1, 0), cA + kstep, voffA); PG8_STAGE(PG8_SB(1, 1), cB + hstep + kstep, voffB);
        PG8_WAIT_V(6); PG8_BAR;
    }
    for (;;) {
        const bool has_next = S.next(ui + 1, nxt);
        const char* nA = has_next ? (const char*)g.A + (size_t)nxt.pm * tstepA : cA; const char* nB = has_next ? (const char*)g.Bt + (size_t)nxt.pn * tstep : cB;
        for (int t = 0; t < nt; t += 2) {
            const bool last = (t == nt - 2);
            const char* a1 = cA + (size_t)(t + 1) * kstep;
            const char* a2 = last ? nA : cA + (size_t)(t + 2) * kstep; const char* b2 = last ? nB : cB + (size_t)(t + 2) * kstep;
            const char* a3 = a2 + kstep; const char* b3 = b2 + kstep;
            if (last && has_next) S.a_ready(nxt);
            if constexpr (SP2) {
            PG8_LDB(B0, 0, 0); PG8_LDB(B1, 0, 1); PG8_SCHED; PG8_LDA(At, 0, 0); PG8_STAGE(PG8_SA(1, 1), a1 + hstepA, voffA);
            PG8_WAIT_V(8); PG8_WAIT_L(0); PG8_BAR; PG8_MMA(0, 0, At, B0); PG8_MMA(0, 1, At, B1); PG8_BAR; PG8_SCHED;
            PG8_LDA(At, 0, 1); PG8_STAGE(PG8_SB(0, 0), b2, voffB); PG8_STAGE(PG8_SB(0, 1), b2 + hstep, voffB); PG8_STAGE(PG8_SA(0, 0), a2, voffA);
            PG8_WAIT_V(8); PG8_WAIT_L(0); PG8_BAR; PG8_MMA(1, 0, At, B0); PG8_MMA(1, 1, At, B1); PG8_BAR; PG8_SCHED;
            PG8_LDB(B0, 1, 0); PG8_LDB(B1, 1, 1); PG8_SCHED; PG8_LDA(At, 1, 0); PG8_STAGE(PG8_SA(0, 1), a2 + hstepA, voffA);
            PG8_WAIT_V(8); PG8_WAIT_L(0); PG8_BAR; PG8_MMA(0, 0, At, B0); PG8_MMA(0, 1, At, B1); PG8_BAR; PG8_SCHED;
            PG8_LDA(At, 1, 1); PG8_STAGE(PG8_SB(1, 0), b3, voffB); PG8_STAGE(PG8_SB(1, 1), b3 + hstep, voffB); PG8_STAGE(PG8_SA(1, 0), a3, voffA);
            PG8_WAIT_V(8); PG8_WAIT_L(0); PG8_BAR; PG8_MMA(1, 0, At, B0); PG8_MMA(1, 1, At, B1); PG8_BAR; PG8_SCHED;
            } else {
            PG8_LDB(B0, 0, 0); PG8_SCHED; PG8_LDA(At, 0, 0); PG8_STAGE(PG8_SA(1, 1), a1 + hstepA, voffA);
            PG8_WAIT_L(8); PG8_BAR; PG8_WAIT_L(0); PG8_MMA(0, 0, At, B0); PG8_BAR; PG8_SCHED;
            PG8_LDB(B1, 0, 1); PG8_STAGE(PG8_SB(0, 0), b2, voffB);
            PG8_BAR; PG8_WAIT_L(0); PG8_MMA(0, 1, At, B1); PG8_BAR;
            PG8_LDA(At, 0, 1); PG8_STAGE(PG8_SA(0, 0), a2, voffA);
            PG8_BAR; PG8_WAIT_L(0); PG8_MMA(1, 0, At, B0); PG8_BAR; PG8_SCHED;
            PG8_STAGE(PG8_SB(0, 1), b2 + hstep, voffB);
            PG8_WAIT_V(6); PG8_BAR; PG8_MMA(1, 1, At, B1); PG8_BAR;
            PG8_LDB(B0, 1, 0); PG8_SCHED; PG8_LDA(At, 1, 0); PG8_STAGE(PG8_SA(0, 1), a2 + hstepA, voffA);
            PG8_WAIT_L(8); PG8_BAR; PG8_WAIT_L(0); PG8_MMA(0, 0, At, B0); PG8_BAR; PG8_SCHED;
            PG8_LDB(B1, 1, 1); PG8_STAGE(PG8_SB(1, 0), b3, voffB);
            PG8_BAR; PG8_WAIT_L(0); PG8_MMA(0, 1, At, B1); PG8_BAR;
            PG8_LDA(At, 1, 1); PG8_STAGE(PG8_SA(1, 0), a3, voffA);
            PG8_BAR; PG8_WAIT_L(0); PG8_MMA(1, 0, At, B0); PG8_BAR; PG8_SCHED;
            PG8_STAGE(PG8_SB(1, 1), b3 + hstep, voffB);
            PG8_WAIT_V(6); PG8_BAR; PG8_MMA(1, 1, At, B1); PG8_BAR;
            }
        }
        if constexpr (ALIGN_EPI) { if (wr == 0) PG8_BAR; }
        if constexpr (!Epi::AFTER_DRAIN) { E(acc, cur, wr, wc, fr, fq); S.done(cur); }
        if (!has_next) break;
#pragma unroll
        for (int a = 0; a < 2; ++a)
#pragma unroll
            for (int b = 0; b < 2; ++b)
#pragma unroll
                for (int m = 0; m < 4; ++m)
#pragma unroll
                    for (int n = 0; n < 2; ++n) acc[a][b][m][n] = (f32x4){0.f, 0.f, 0.f, 0.f};
        cur = nxt; cA = nA; cB = nB; ++ui;
        if constexpr (ALIGN_EPI) { if (wr == 1) PG8_BAR; }
    }
    PG8_WAIT_V(0);
    if constexpr (!ALIGN_EPI) { if (wr == 0) PG8_BAR; }
    PG8_BAR;
    if constexpr (Epi::AFTER_DRAIN) { E.fused(acc, cur, wr, wc, fr, fq, lds, wid, lane); S.done(cur); }
#undef PG8_SA
#undef PG8_SB
#undef PG8_STAGE
#undef PG8_LDA
#undef PG8_LDB
#undef PG8_MMA
#undef PG8_WAIT_V
#undef PG8_WAIT_L
#undef PG8_BAR
#undef PG8_SCHED
}
}

typedef unsigned short bf16;
typedef short bf16x8 __attribute__((ext_vector_type(8)));
typedef short bf16x4 __attribute__((ext_vector_type(4)));
typedef float f32x4 __attribute__((ext_vector_type(4)));
typedef float f32x2 __attribute__((ext_vector_type(2)));
typedef unsigned u32x4 __attribute__((ext_vector_type(4)));
typedef unsigned u32x2 __attribute__((ext_vector_type(2)));

constexpr int D = 1024, BATCH = 4, SEQ = 4096, DEPTH = 2, T = BATCH * SEQ;
constexpr int MEM = 256;
constexpr int G = 256, HD = 64, GH = 4;
constexpr int INW = 3332, DFF = 4096;
constexpr float EPS = 1e-6f, LOG2E = 1.4426950408889634f;
constexpr int NTHREADS = 512, NWAVES = 8;
constexpr int PW = 2816;
constexpr int C_FOXQ = 0, C_LRUY = 256, C_RWR = 512, C_RETQ = 768, C_FOXK = 1024, C_LRUX = 1280, C_RWK = 1536, C_RWV = 1792, C_RWX = 2048, C_RETK = 2304, C_RETG = 2560;
constexpr int NIN = 3328;
__device__ __constant__ const int kSrcCol[13] = {0, 1028, 1284, 2308, 256, 772, 1540, 1796, 2052, 2564, 3076, 512, 2820};

constexpr size_t MiB = 1u << 20;
constexpr size_t WS_W = 0;
constexpr size_t W_IN = 0, W_OUT = 7 * MiB, W_Q = 9 * MiB, W_O = 11 * MiB, W_1 = 13 * MiB, W_2 = 21 * MiB, W_SMALL = 29 * MiB;
constexpr size_t WS_W2T = W_SMALL, WS_A2T = WS_W2T + 256 * 64 * 2, WS_G2T = WS_A2T + 256 * 64 * 2, WS_V1T = WS_G2T + 256 * 128 * 2, WS_V2T = WS_V1T + 32 * 256 * 2, WS_RAT = WS_V2T + 256 * 32 * 2, WS_RIT = WS_RAT + 4 * 64 * 64 * 2;
constexpr size_t WS_P = 30 * MiB;
constexpr size_t P_FOXVT = WS_P + 88 * MiB, P_RETKT = WS_P + 96 * MiB, P_RETVT = WS_P + 104 * MiB, P_RETKV = WS_P + 112 * MiB;
constexpr size_t WS_RW = 158 * MiB;
constexpr size_t RW_E = WS_RW, RW_WR = WS_RW + 8 * MiB, RW_A = WS_RW + 16 * MiB, RW_B = WS_RW + 24 * MiB, RW_K = WS_RW + 32 * MiB, RW_V = WS_RW + 40 * MiB, RW_G = WS_P + 120 * MiB  , RW_Y = WS_RW + 56 * MiB;
constexpr int RW_REC = 320;
__device__ __forceinline__ size_t rw_off(int tok  , int arr, int col  ) { const int b = tok >> 12, pos = tok & (SEQ - 1), hh = col >> 6; return ((size_t)((b * 4 + hh) * SEQ + pos)) * RW_REC + arr * 64 + (col & 63); }
constexpr size_t WS_O = WS_RW, WS_H = WS_RW + 32 * MiB;
constexpr size_t WS_WKV = WS_RW;
constexpr size_t WS_MEMN = WS_RW + 64 * MiB;
constexpr size_t WS_VF = 230 * MiB;
constexpr size_t WS_KM = 238 * MiB, WS_VMT = 242 * MiB;
constexpr size_t WS_SM = 246 * MiB;
constexpr size_t SM_LOGF = WS_SM, SM_CUM = SM_LOGF + 256 * 1024, SM_BR = SM_CUM + 256 * 1024, SM_KR = SM_BR + 256 * 1024, SM_RK = SM_KR + 256 * 1024,
                 SM_SS = SM_RK + 256 * 1024  , SM_ROT = SM_SS + 256 * 1024  , SM_Q = SM_ROT + MiB  , SM_BAR = SM_Q + 4096  , WS_END = SM_BAR + 16384;
static_assert(WS_END <= 256 * MiB, "workspace map");
constexpr int LDS_BYTES = 147456;

__device__ __forceinline__ unsigned f2bf(float f) { unsigned u = __builtin_bit_cast(unsigned, f); return (u + 0x7fffu + ((u >> 16) & 1u)) >> 16; }
typedef __bf16 bf16x2_t __attribute__((ext_vector_type(2)));
__device__ __forceinline__ unsigned pk2(float lo, float hi) { const f32x2 v = {lo, hi}; const bf16x2_t b = __builtin_convertvector(v, bf16x2_t); return __builtin_bit_cast(unsigned, b); }
__device__ __forceinline__ float bflo(unsigned u) { return __builtin_bit_cast(float, u << 16); }
__device__ __forceinline__ float bfhi(unsigned u) { return __builtin_bit_cast(float, u & 0xffff0000u); }
__device__ __forceinline__ void unpack8(u32x4 w, float* f) { f[0] = bflo(w.x); f[1] = bfhi(w.x); f[2] = bflo(w.y); f[3] = bfhi(w.y); f[4] = bflo(w.z); f[5] = bfhi(w.z); f[6] = bflo(w.w); f[7] = bfhi(w.w); }
__device__ __forceinline__ u32x4 pack8(const float* f) { u32x4 w; w.x = pk2(f[0], f[1]); w.y = pk2(f[2], f[3]); w.z = pk2(f[4], f[5]); w.w = pk2(f[6], f[7]); return w; }
__device__ __forceinline__ float wave_sum(float v) {
#pragma unroll
  for (int o = 1; o < 64; o <<= 1) v += __shfl_xor(v, o);
  return v;
}
__device__ __forceinline__ float ex2(float x) { return __builtin_amdgcn_exp2f(x); }
__device__ __forceinline__ float rcpf_(float x) { return __builtin_amdgcn_rcpf(x); }
__device__ __forceinline__ float sigmoidf_(float x) { return rcpf_(1.f + __expf(-x)); }
__device__ __forceinline__ float lse0_(float x) { return __logf(1.f + __expf(-fabsf(x))); }
__device__ __forceinline__ float log_sigmoidf_(float x) { return fminf(x, 0.f) - lse0_(x); }
__device__ __forceinline__ float log_sigmoid_acc(float x) { return fminf(x, 0.f) - log1pf(__expf(-fabsf(x))); }
__device__ __forceinline__ float softplusf_(float x) { return fmaxf(x, 0.f) + lse0_(x); }
__device__ __forceinline__ float tanhf_(float x) { return 1.f - 2.f * rcpf_(1.f + __expf(2.f * x)); }
__device__ __forceinline__ float gelu_tanh(float x) { return 0.5f * x * (1.f + tanhf_(0.7978845608028654f * (x + 0.044715f * x * x * x))); }
#define WAVE_LDS_FENCE() asm volatile("s_waitcnt lgkmcnt(0)" ::: "memory")
#define LDS_BARRIER() asm volatile("s_waitcnt lgkmcnt(0)\n\ts_barrier" ::: "memory")
#define MFMA16(a, b, c) __builtin_amdgcn_mfma_f32_16x16x32_bf16((a), (b), (c), 0, 0, 0)

struct Params { const float* in[40]; float* out; unsigned char* ws; int ph_lo, ph_hi; };

struct EpiIn {
  static constexpr bool PERM = true, AFTER_DRAIN = false;
  bf16* proj; bf16* foxvT; bf16* retkT; bf16* retvT; const float* rot;
  __device__ __forceinline__ void operator()(const f32x4 (&acc)[2][2][4][2], const pg8::Unit& u, int wr, int wc, int fr, int fq) const {
    const int pn = u.pn;
    const bool rotary = (pn == 3) || (pn == 9);
    const float sc = (pn == 9) ? 0.125f : 1.f;
    bf16* tdst = pn == 9 ? retkT : pn == 11 ? foxvT : pn == 12 ? retvT : nullptr;
    const bool rowmajor = pn <= 10;
#pragma unroll
    for (int ai = 0; ai < 2; ++ai)
#pragma unroll
      for (int m = 0; m < 4; ++m) {
        const int row = u.pm * 256 + ai * 128 + wr * 64 + m * 16 + fr; const int pos = row & (SEQ - 1), b = row >> 12;
#pragma unroll
        for (int bj = 0; bj < 2; ++bj) {
          const int c0 = bj * 128 + wc * 32 + 8 * fq;
          float v[8];
#pragma unroll
          for (int e = 0; e < 4; ++e) { v[e] = acc[ai][bj][m][0][e]; v[4 + e] = acc[ai][bj][m][1][e]; }
          if (rotary) {
            const int i0 = (c0 & 63) >> 1;
            const f32x4 r0 = *(const f32x4*)(rot + ((size_t)pos * 32 + i0) * 2), r1 = *(const f32x4*)(rot + ((size_t)pos * 32 + i0 + 2) * 2);
            const float cs[4] = {r0[0], r0[2], r1[0], r1[2]}, sn[4] = {r0[1], r0[3], r1[1], r1[3]};
#pragma unroll
            for (int p = 0; p < 4; ++p) { const float x1 = v[2 * p], x2 = v[2 * p + 1]; v[2 * p] = x1 * cs[p] - x2 * sn[p]; v[2 * p + 1] = x1 * sn[p] + x2 * cs[p]; }
          }
#pragma unroll
          for (int e = 0; e < 8; ++e) v[e] *= sc;
          const u32x4 w = pack8(v);
          if (rowmajor) *(u32x4*)(proj + (size_t)row * PW + pn * 256 + c0) = w;
          if (tdst) {
            const int hh = c0 >> 6, d0 = c0 & 63; bf16* tp = tdst + ((size_t)((b * 4 + hh) * 64 + d0)) * SEQ + pos;
            const unsigned ww[4] = {w.x, w.y, w.z, w.w};
#pragma unroll
            for (int e = 0; e < 8; ++e) tp[(size_t)e * SEQ] = (bf16)((e & 1) ? (ww[e >> 1] >> 16) : (ww[e >> 1] & 0xffffu));
          }
        }
      }
  }
};
struct EpiPlain {
  static constexpr bool PERM = true, AFTER_DRAIN = false;
  bf16* O; int ldc; int act; float* ss;
  __device__ __forceinline__ void operator()(const f32x4 (&acc)[2][2][4][2], const pg8::Unit& u, int wr, int wc, int fr, int fq) const {
#pragma unroll
    for (int ai = 0; ai < 2; ++ai)
#pragma unroll
      for (int m = 0; m < 4; ++m) {
        const int row = u.pm * 256 + ai * 128 + wr * 64 + m * 16 + fr; float s = 0.f;
#pragma unroll
        for (int bj = 0; bj < 2; ++bj) {
          const int c0 = u.pn * 256 + bj * 128 + wc * 32 + 8 * fq;
          float v[8];
#pragma unroll
          for (int e = 0; e < 4; ++e) { v[e] = acc[ai][bj][m][0][e]; v[4 + e] = acc[ai][bj][m][1][e]; }
          if (act == 1) {
#pragma unroll
            for (int e = 0; e < 8; ++e) { const float r = fmaxf(v[e], 0.f); v[e] = r * r; }
          }
#pragma unroll
          for (int e = 0; e < 8; ++e) s += v[e] * v[e];
          *(u32x4*)(O + (size_t)row * ldc + c0) = pack8(v);
        }
        if (ss) { s += __shfl_xor(s, 16); s += __shfl_xor(s, 32); if (fq == 0) atomicAdd(ss + row, s); }
      }
  }
};
struct EpiMem {
  static constexpr bool PERM = true, AFTER_DRAIN = false;
  bf16* kmem; bf16* vmemT;
  __device__ __forceinline__ void operator()(const f32x4 (&acc)[2][2][4][2], const pg8::Unit& u, int wr, int wc, int fr, int fq) const {
    const int layer = u.pm >> 2, pt = u.pn & 7; const bool isv = pt >= 4; const int head = pt & 3;
#pragma unroll
    for (int ai = 0; ai < 2; ++ai)
#pragma unroll
      for (int m = 0; m < 4; ++m) {
        const int rowl = (u.pm & 3) * 256 + ai * 128 + wr * 64 + m * 16 + fr;
#pragma unroll
        for (int bj = 0; bj < 2; ++bj) {
          const int c0 = bj * 128 + wc * 32 + 8 * fq;
          float v[8];
#pragma unroll
          for (int e = 0; e < 4; ++e) { v[e] = acc[ai][bj][m][0][e]; v[4 + e] = acc[ai][bj][m][1][e]; }
          const u32x4 w = pack8(v);
          if (!isv) *(u32x4*)(kmem + ((size_t)layer * 1024 + rowl) * 1024 + head * 256 + c0) = w;
          else {
            const int b = rowl >> 8, key = rowl & 255; bf16* tp = vmemT + ((size_t)(((layer * 4 + b) * 4 + head) * 256 + c0)) * 256 + key;
            const unsigned ww[4] = {w.x, w.y, w.z, w.w};
#pragma unroll
            for (int e = 0; e < 8; ++e) tp[(size_t)e * 256] = (bf16)((e & 1) ? (ww[e >> 1] >> 16) : (ww[e >> 1] & 0xffffu));
          }
        }
      }
  }
};
struct MemSched {
  int G, c;
  __device__ bool next(int i, pg8::Unit& u) const { const int L = i * G + c; if (c < 0 || L >= 64) return false; const int layer = L >> 5, r = L & 31; u.pm = layer * 4 + (r & 3); u.pn = layer * 8 + (r >> 2); return true; }
  __device__ __forceinline__ void a_ready(const pg8::Unit&) const {}
  __device__ __forceinline__ void done(const pg8::Unit&) const {}
};

template <int MAP> __device__ __forceinline__ int src_col(int n) {
  if (MAP == 0) return n;
  const int tile = n >> 8, j = n & 255; int jj = j;
  if (tile == 3 || tile == 9) { const int hh = j >> 6, l = j & 63; jj = hh * 64 + (l >> 1) + 32 * (l & 1); }
  return kSrcCol[tile] + jj;
}
template <int MAP> __device__ __forceinline__ void conv_item(const float* __restrict__ W, int K, int Nsrc, int N, bf16* WT, float* scr, int item, int lane) {
  const int nblk = N / 32, kb = item / nblk, nb = item % nblk, k0 = 64 * kb, n0 = 32 * nb;
  const int sc = src_col<MAP>(n0 + (lane & 31));
#pragma unroll 8
  for (int i = 0; i < 32; ++i) { const int kk = 2 * i + (lane >> 5); scr[kk * 33 + (lane & 31)] = W[(size_t)(k0 + kk) * Nsrc + sc]; }
  WAVE_LDS_FENCE();
  const int c = lane & 7;
#pragma unroll
  for (int j = 0; j < 4; ++j) { const int n = (lane >> 3) + 8 * j; const float* s = scr + (8 * c) * 33 + n;
    u32x4 o; o.x = pk2(s[0 * 33], s[1 * 33]); o.y = pk2(s[2 * 33], s[3 * 33]); o.z = pk2(s[4 * 33], s[5 * 33]); o.w = pk2(s[6 * 33], s[7 * 33]);
    *(u32x4*)(WT + (size_t)(n0 + n) * K + k0 + 8 * c) = o; }
  WAVE_LDS_FENCE();
}
__device__ __forceinline__ void conv_layer_weights(const Params& p, int l, float* scr, int gw, int NGW, int lane) {
  asm volatile("" ::: "memory");
  asm volatile("" : "+v"(lane));
  unsigned char* ws = p.ws;
  constexpr int I_IN = (D / 64) * (NIN / 32), I_SQ = (D / 64) * (D / 32), I_1 = (D / 64) * (DFF / 32), I_2 = (DFF / 64) * (D / 32);
  constexpr int I_W2 = 1 * 8, I_A2 = 8, I_G2 = 2 * 8, I_V1 = 4 * 1, I_V2 = 8  , I_R = 2 * 4 * 2;
  constexpr int NIT = I_IN + 3 * I_SQ + I_1 + I_2 + I_W2 + I_A2 + I_G2 + I_V1 + I_R;
  for (int it = gw; it < NIT; it += NGW) {
    int r = it;
    if (r < I_IN) { conv_item<1>(p.in[9] + (size_t)l * D * INW, D, INW, NIN, (bf16*)(ws + W_IN), scr, r, lane); continue; } r -= I_IN;
    if (r < I_SQ) { conv_item<0>(p.in[10] + (size_t)l * D * D, D, D, D, (bf16*)(ws + W_OUT), scr, r, lane); continue; } r -= I_SQ;
    if (r < I_SQ) { conv_item<0>(p.in[34] + (size_t)l * D * D, D, D, D, (bf16*)(ws + W_Q), scr, r, lane); continue; } r -= I_SQ;
    if (r < I_SQ) { conv_item<0>(p.in[37] + (size_t)l * D * D, D, D, D, (bf16*)(ws + W_O), scr, r, lane); continue; } r -= I_SQ;
    if (r < I_1) { conv_item<0>(p.in[38] + (size_t)l * D * DFF, D, DFF, DFF, (bf16*)(ws + W_1), scr, r, lane); continue; } r -= I_1;
    if (r < I_2) { conv_item<0>(p.in[39] + (size_t)l * DFF * D, DFF, D, D, (bf16*)(ws + W_2), scr, r, lane); continue; } r -= I_2;
    if (r < I_W2) { conv_item<0>(p.in[21] + (size_t)l * 64 * G, 64, G, G, (bf16*)(ws + WS_W2T), scr, r, lane); continue; } r -= I_W2;
    if (r < I_A2) { conv_item<0>(p.in[23] + (size_t)l * 64 * G, 64, G, G, (bf16*)(ws + WS_A2T), scr, r, lane); continue; } r -= I_A2;
    if (r < I_G2) { conv_item<0>(p.in[24] + (size_t)l * 128 * G, 128, G, G, (bf16*)(ws + WS_G2T), scr, r, lane); continue; } r -= I_G2;
    if (r < I_V1) { if (l > 0) conv_item<0>(p.in[31] + (size_t)(l - 1) * G * 32, G, 32, 32, (bf16*)(ws + WS_V1T), scr, r, lane); continue; } r -= I_V1;
    { const int gate = r >> 3, hh = (r >> 1) & 3, nb = r & 1;
      conv_item<0>(p.in[gate ? 16 : 14] + ((size_t)l * GH + hh) * HD * HD, 64, 64, 64, (bf16*)(ws + (gate ? WS_RIT : WS_RAT)) + hh * 4096, scr, nb, lane); }
  }
  if (l > 0) { const float* v2 = p.in[32] + (size_t)(l - 1) * 32 * G; bf16* v2t = (bf16*)(ws + WS_V2T);
    for (int e = gw * 64 + lane; e < 32 * G; e += NGW * 64) { const int k = e / G, n = e % G; v2t[n * 32 + k] = (bf16)f2bf(v2[e]); } }
}

struct RowArgs { const float* xin; const bf16* O; float* ss; const float* g_post; float* xout; const float* g_pre; bf16* hout; const float* wf; const float* fbias; float* logf; int rows; };
__device__ __forceinline__ void row_phase(const RowArgs& a, int gw, int NGW, int lane) {
  asm volatile("" ::: "memory");
  asm volatile("" : "+v"(lane));
  f32x4 gp[4], gq[4], wfv[4][4];
#pragma unroll
  for (int j = 0; j < 4; ++j) {
    gp[j] = a.O ? ((const f32x4*)a.g_post)[lane + 64 * j] : (f32x4){0.f, 0.f, 0.f, 0.f};
    gq[j] = a.hout ? ((const f32x4*)a.g_pre)[lane + 64 * j] : (f32x4){0.f, 0.f, 0.f, 0.f};
#pragma unroll
    for (int hh = 0; hh < 4; ++hh)
#pragma unroll
      for (int e = 0; e < 4; ++e) wfv[j][hh][e] = a.wf ? a.wf[(size_t)(4 * (lane + 64 * j) + e) * INW + 768 + hh] : 0.f;
  }
  for (int row0 = gw; row0 < a.rows; row0 += 2 * NGW) {
    const int rowv[2] = {row0, row0 + NGW}; const bool val[2] = {true, row0 + NGW < a.rows};
    f32x4 x[2][4]; float ov[2][4][4];
#pragma unroll
    for (int r = 0; r < 2; ++r) if (val[r]) {
#pragma unroll
      for (int j = 0; j < 4; ++j) x[r][j] = ((const f32x4*)(a.xin + (size_t)rowv[r] * D))[lane + 64 * j];
      if (a.O) {
#pragma unroll
        for (int j = 0; j < 4; ++j) { const u32x2 o = ((const u32x2*)(a.O + (size_t)rowv[r] * D))[lane + 64 * j];
          ov[r][j][0] = bflo(o.x); ov[r][j][1] = bfhi(o.x); ov[r][j][2] = bflo(o.y); ov[r][j][3] = bfhi(o.y); }
      }
    }
#pragma unroll
    for (int r = 0; r < 2; ++r) if (val[r]) {
      const int row = rowv[r];
      if (a.O) {
        float so = 0.f;
#pragma unroll
        for (int j = 0; j < 4; ++j) so += ov[r][j][0] * ov[r][j][0] + ov[r][j][1] * ov[r][j][1] + ov[r][j][2] * ov[r][j][2] + ov[r][j][3] * ov[r][j][3];
        so = wave_sum(so);
        const float rs = rsqrtf(so * (1.f / D) + EPS);
#pragma unroll
        for (int j = 0; j < 4; ++j)
#pragma unroll
          for (int e = 0; e < 4; ++e) x[r][j][e] += ov[r][j][e] * rs * gp[j][e];
      }
      if (a.xout) {
#pragma unroll
        for (int j = 0; j < 4; ++j) ((f32x4*)(a.xout + (size_t)row * D))[lane + 64 * j] = x[r][j];
      }
      if (a.hout) {
        float s = 0.f;
#pragma unroll
        for (int j = 0; j < 4; ++j) s += x[r][j][0] * x[r][j][0] + x[r][j][1] * x[r][j][1] + x[r][j][2] * x[r][j][2] + x[r][j][3] * x[r][j][3];
        s = wave_sum(s); const float rs2 = rsqrtf(s * (1.f / D) + EPS);
        float fd[4] = {0.f, 0.f, 0.f, 0.f};
#pragma unroll
        for (int j = 0; j < 4; ++j) {
          f32x4 hv;
#pragma unroll
          for (int e = 0; e < 4; ++e) hv[e] = x[r][j][e] * rs2 * gq[j][e];
          u32x2 o; o.x = pk2(hv[0], hv[1]); o.y = pk2(hv[2], hv[3]);
          ((u32x2*)(a.hout + (size_t)row * D))[lane + 64 * j] = o;
          if (a.wf) {
#pragma unroll
            for (int hh = 0; hh < 4; ++hh) fd[hh] += hv[0] * wfv[j][hh][0] + hv[1] * wfv[j][hh][1] + hv[2] * wfv[j][hh][2] + hv[3] * wfv[j][hh][3];
          }
        }
        if (a.wf) {
#pragma unroll
          for (int hh = 0; hh < 4; ++hh) fd[hh] = wave_sum(fd[hh]);
          if (lane < 4) { const float f = lane == 0 ? fd[0] : lane == 1 ? fd[1] : lane == 2 ? fd[2] : fd[3]; a.logf[(size_t)row * 4 + lane] = log_sigmoidf_(f + a.fbias[lane]); }
        }
      }
    }
  }
}

__device__ __forceinline__ void lerp8(const bf16* __restrict__ proj, const float* __restrict__ mu, int tok, int col, int mucol, float* out) {
  const u32x4 c = *(const u32x4*)(proj + (size_t)tok * PW + col);
  u32x4 pv = {0u, 0u, 0u, 0u};
  if ((tok & (SEQ - 1)) != 0) pv = *(const u32x4*)(proj + (size_t)(tok - 1) * PW + col);
  float cf[8], pf[8]; unpack8(c, cf); unpack8(pv, pf);
  const f32x4 m0 = *(const f32x4*)(mu + mucol), m1 = *(const f32x4*)(mu + mucol + 4);
#pragma unroll
  for (int e = 0; e < 4; ++e) { out[e] = cf[e] + (pf[e] - cf[e]) * m0[e]; out[4 + e] = cf[4 + e] + (pf[4 + e] - cf[4 + e]) * m1[e]; }
}
__device__ __forceinline__ bf16x8 pack_frag(const float* f) { const u32x4 w = pack8(f); return __builtin_bit_cast(bf16x8, w); }
constexpr int WLP = 260;
__device__ __forceinline__ void acc_to_lds(float* wl, const f32x4* acc, int ntiles, int li, int g) {
#pragma unroll
  for (int nt = 0; nt < 16; ++nt) if (nt < ntiles) {
#pragma unroll
    for (int j = 0; j < 4; ++j) wl[(4 * g + j) * WLP + nt * 16 + li] = acc[nt][j];
  }
}
template <int KS> __device__ __forceinline__ void mm16_to_lds(const bf16x8* af, const bf16* __restrict__ wt, int ldw, float* wl, int li, int g) {
#pragma unroll 1
  for (int ng = 0; ng < 4; ++ng) {
    f32x4 a4[4];
#pragma unroll
    for (int n4 = 0; n4 < 4; ++n4) { a4[n4] = (f32x4){0.f, 0.f, 0.f, 0.f};
#pragma unroll
      for (int ks = 0; ks < KS; ++ks) { const bf16x8 bfr = *(const bf16x8*)(wt + (size_t)((ng * 4 + n4) * 16 + li) * ldw + ks * 32 + 8 * g); a4[n4] = MFMA16(af[ks], bfr, a4[n4]); } }
#pragma unroll
    for (int n4 = 0; n4 < 4; ++n4)
#pragma unroll
      for (int j = 0; j < 4; ++j) wl[(4 * g + j) * WLP + (ng * 4 + n4) * 16 + li] = a4[n4][j];
  }
}
__device__ __forceinline__ void rwkv_prep_unit(const Params& p, int l, int unit, int pass, float* wl, int lane) {
  asm volatile("" ::: "memory");
  asm volatile("" : "+v"(lane));
  unsigned char* ws = p.ws;
  const bf16* proj = (const bf16*)(ws + WS_P);
  const float* mu = p.in[19] + (size_t)l * 1024;
  const int li = lane & 15, g = lane >> 4, t0 = unit * 16, ta = t0 + li;
  const int tl = t0 + (lane >> 2), cgp = lane & 3;
  if (pass == 0) {
    bf16x8 af[2];
#pragma unroll
    for (int ks = 0; ks < 2; ++ks) { float f[8]; lerp8(proj, mu, ta, C_RWX + ks * 32 + 8 * g, 768 + ks * 32 + 8 * g, f);
#pragma unroll
      for (int e = 0; e < 8; ++e) f[e] = tanhf_(f[e]);
      af[ks] = pack_frag(f); }
    mm16_to_lds<2>(af, (const bf16*)(ws + WS_W2T), 64, wl, li, g); WAVE_LDS_FENCE();
    const float* w0 = p.in[20] + (size_t)l * G;
#pragma unroll 2
    for (int i = 0; i < 8; ++i) { int col = cgp * 8 + 32 * i; asm volatile("" : "+v"(col)); float r[8], ev[8], wr[8];
      lerp8(proj, mu, tl, C_RWR + col, col, r);
#pragma unroll
      for (int e = 0; e < 8; ++e) { const float wa = wl[(lane >> 2) * WLP + col + e] + w0[col + e]; const float wlog = -softplusf_(-wa) - 0.5f; const float ee = __expf(wlog); ev[e] = ee; wr[e] = __expf(-ee) * r[e]; }
      *(u32x4*)((bf16*)(ws + WS_RW) + rw_off(tl, 0, col)) = pack8(ev); *(u32x4*)((bf16*)(ws + WS_RW) + rw_off(tl, 1, col)) = pack8(wr); }
    WAVE_LDS_FENCE();
  }
  if (pass == 1) {
    bf16x8 af[2];
#pragma unroll
    for (int ks = 0; ks < 2; ++ks) { float f[8]; lerp8(proj, mu, ta, C_RWX + 64 + ks * 32 + 8 * g, 832 + ks * 32 + 8 * g, f); af[ks] = pack_frag(f); }
    mm16_to_lds<2>(af, (const bf16*)(ws + WS_A2T), 64, wl, li, g); WAVE_LDS_FENCE();
    const float* a0 = p.in[22] + (size_t)l * G; const float* k_k = p.in[25] + (size_t)l * G; const float* k_a = p.in[26] + (size_t)l * G; const float* r_k = p.in[27] + (size_t)l * G;
#pragma unroll 1
    for (int hh = 0; hh < 4; ++hh) {
      float av[2][8], kv[2][8], kk[2][8]; float ssq = 0.f;
#pragma unroll
      for (int ii = 0; ii < 2; ++ii) { int col = cgp * 8 + 32 * (2 * hh + ii); asm volatile("" : "+v"(col));
        lerp8(proj, mu, tl, C_RWK + col, 256 + col, kv[ii]);
#pragma unroll
        for (int e = 0; e < 8; ++e) { av[ii][e] = sigmoidf_(a0[col + e] + wl[(lane >> 2) * WLP + col + e]); kk[ii][e] = kv[ii][e] * k_k[col + e]; ssq += kk[ii][e] * kk[ii][e]; } }
      ssq += __shfl_xor(ssq, 1); ssq += __shfl_xor(ssq, 2);
      const float inv = 1.f / fmaxf(sqrtf(ssq), 1e-12f);
      float sbr = 0.f, skr = 0.f, srk = 0.f;
#pragma unroll
      for (int ii = 0; ii < 2; ++ii) { int col = cgp * 8 + 32 * (2 * hh + ii); asm volatile("" : "+v"(col)); float r[8], Av[8], Bv[8], k2[8];
        lerp8(proj, mu, tl, C_RWR + col, col, r);
#pragma unroll
        for (int e = 0; e < 8; ++e) { const float kn = kk[ii][e] * inv; Av[e] = -kn; Bv[e] = kn * av[ii][e]; k2[e] = kv[ii][e] * (1.f + (av[ii][e] - 1.f) * k_a[col + e]);
          const float rb = r[e]; sbr += Bv[e] * rb; skr += k2[e] * rb; srk += rb * k2[e] * r_k[col + e]; }
        *(u32x4*)((bf16*)(ws + WS_RW) + rw_off(tl, 2, col)) = pack8(Av); *(u32x4*)((bf16*)(ws + WS_RW) + rw_off(tl, 3, col)) = pack8(Bv); *(u32x4*)((bf16*)(ws + WS_RW) + rw_off(tl, 4, col)) = pack8(k2); }
      sbr += __shfl_xor(sbr, 1); sbr += __shfl_xor(sbr, 2); skr += __shfl_xor(skr, 1); skr += __shfl_xor(skr, 2); srk += __shfl_xor(srk, 1); srk += __shfl_xor(srk, 2);
      if (cgp == 0) { ((float*)(ws + SM_BR))[(size_t)tl * 4 + hh] = sbr; ((float*)(ws + SM_KR))[(size_t)tl * 4 + hh] = skr; ((float*)(ws + SM_RK))[(size_t)tl * 4 + hh] = srk; }
    }
    WAVE_LDS_FENCE();
  }
  if (pass == 2) {
    bf16x8 af[4];
#pragma unroll
    for (int ks = 0; ks < 4; ++ks) { float f[8]; lerp8(proj, mu, ta, C_RWX + 128 + ks * 32 + 8 * g, 896 + ks * 32 + 8 * g, f);
#pragma unroll
      for (int e = 0; e < 8; ++e) f[e] = sigmoidf_(f[e]);
      af[ks] = pack_frag(f); }
    mm16_to_lds<4>(af, (const bf16*)(ws + WS_G2T), 128, wl, li, g); WAVE_LDS_FENCE();
#pragma unroll 2
    for (int i = 0; i < 8; ++i) { int col = cgp * 8 + 32 * i; asm volatile("" : "+v"(col)); float gv[8];
#pragma unroll
      for (int e = 0; e < 8; ++e) gv[e] = wl[(lane >> 2) * WLP + col + e];
      *(u32x4*)((bf16*)(ws + RW_G) + (size_t)tl * G + col) = pack8(gv); }
    WAVE_LDS_FENCE();
  }
  if (pass != 3) return;
  if (l > 0) {
    f32x4 a1[2] = {(f32x4){0.f, 0.f, 0.f, 0.f}, (f32x4){0.f, 0.f, 0.f, 0.f}};
    const bf16* v1t = (const bf16*)(ws + WS_V1T);
#pragma unroll
    for (int ks = 0; ks < 8; ++ks) { float f[8]; lerp8(proj, mu, ta, C_RWV + ks * 32 + 8 * g, 512 + ks * 32 + 8 * g, f); const bf16x8 af = pack_frag(f);
#pragma unroll
      for (int nt = 0; nt < 2; ++nt) { const bf16x8 bfr = *(const bf16x8*)(v1t + (size_t)(nt * 16 + li) * 256 + ks * 32 + 8 * g); a1[nt] = MFMA16(af, bfr, a1[nt]); } }
#pragma unroll
    for (int nt = 0; nt < 2; ++nt)
#pragma unroll
      for (int j = 0; j < 4; ++j) wl[(4 * g + j) * WLP + nt * 16 + li] = a1[nt][j];
    WAVE_LDS_FENCE();
    float f2[8];
#pragma unroll
    for (int e = 0; e < 8; ++e) f2[e] = wl[li * WLP + 8 * g + e];
    const bf16x8 af2 = pack_frag(f2);
    WAVE_LDS_FENCE();
    mm16_to_lds<1>(&af2, (const bf16*)(ws + WS_V2T), 32, wl, li, g); WAVE_LDS_FENCE();
    const float* v0 = p.in[30] + (size_t)(l - 1) * G;
#pragma unroll 2
    for (int i = 0; i < 8; ++i) { int col = cgp * 8 + 32 * i; asm volatile("" : "+v"(col)); float v[8], vf[8];
      lerp8(proj, mu, tl, C_RWV + col, 512 + col, v);
      unpack8(*(const u32x4*)((const bf16*)(ws + WS_VF) + (size_t)tl * G + col), vf);
#pragma unroll
      for (int e = 0; e < 8; ++e) v[e] = v[e] + (vf[e] - v[e]) * sigmoidf_(v0[col + e] + wl[(lane >> 2) * WLP + col + e]);
      *(u32x4*)((bf16*)(ws + RW_V) + (size_t)tl * G + col) = pack8(v); }
    WAVE_LDS_FENCE();
  } else {
#pragma unroll 2
    for (int i = 0; i < 8; ++i) { int col = cgp * 8 + 32 * i; asm volatile("" : "+v"(col)); float v[8];
      lerp8(proj, mu, tl, C_RWV + col, 512 + col, v);
      const u32x4 w = pack8(v);
      *(u32x4*)((bf16*)(ws + RW_V) + (size_t)tl * G + col) = w; *(u32x4*)((bf16*)(ws + WS_VF) + (size_t)tl * G + col) = w; }
  }
}
__device__ __forceinline__ void ret_kv_unit(const Params& p, int unit, int lane) {
  asm volatile("" ::: "memory");
  asm volatile("" : "+v"(lane));
  unsigned char* ws = p.ws;
  const int bh = unit >> 5, c = unit & 31, h = bh & 3, li = lane & 15, g = lane >> 4;
  const float lg2 = log2f(1.f - exp2f(-5.f - (float)h));
  const bf16* kT = (const bf16*)(ws + P_RETKT) + (size_t)bh * 64 * SEQ + c * 128;
  const bf16* vT = (const bf16*)(ws + P_RETVT) + (size_t)bh * 64 * SEQ + c * 128;
  f32x4 acc[4][4];
#pragma unroll
  for (int a = 0; a < 4; ++a)
#pragma unroll
    for (int b = 0; b < 4; ++b) acc[a][b] = (f32x4){0.f, 0.f, 0.f, 0.f};
#pragma unroll
  for (int ks = 0; ks < 4; ++ks) {
    float z[8];
#pragma unroll
    for (int e = 0; e < 8; ++e) z[e] = ex2(lg2 * (float)(127 - (ks * 32 + 8 * g + e)));
    bf16x8 af[4], bfr[4];
#pragma unroll
    for (int dt = 0; dt < 4; ++dt) { float f[8]; unpack8(*(const u32x4*)(kT + (size_t)(dt * 16 + li) * SEQ + ks * 32 + 8 * g), f);
#pragma unroll
      for (int e = 0; e < 8; ++e) f[e] *= z[e];
      af[dt] = pack_frag(f); }
#pragma unroll
    for (int et = 0; et < 4; ++et) bfr[et] = *(const bf16x8*)(vT + (size_t)(et * 16 + li) * SEQ + ks * 32 + 8 * g);
#pragma unroll
    for (int dt = 0; dt < 4; ++dt)
#pragma unroll
      for (int et = 0; et < 4; ++et) acc[dt][et] = MFMA16(af[dt], bfr[et], acc[dt][et]);
  }
  float* KV = (float*)(ws + P_RETKV) + (size_t)unit * 4096;
#pragma unroll
  for (int dt = 0; dt < 4; ++dt)
#pragma unroll
    for (int et = 0; et < 4; ++et)
#pragma unroll
      for (int j = 0; j < 4; ++j) KV[(dt * 16 + 4 * g + j) * 64 + et * 16 + li] = acc[dt][et][j];
}
__device__ __forceinline__ void fox_cum_unit(const Params& p, int bh, int lane) {
  asm volatile("" ::: "memory");
  asm volatile("" : "+v"(lane));
  const float* logf = (const float*)(p.ws + SM_LOGF); float* cum = (float*)(p.ws + SM_CUM);
  const int b = bh >> 2, h = bh & 3; const size_t base = ((size_t)b * SEQ + lane * 64) * 4 + h;
  float s = 0.f;
#pragma unroll 16
  for (int i = 0; i < 64; ++i) s += logf[base + (size_t)i * 4];
  float incl = s;
#pragma unroll
  for (int o = 1; o < 64; o <<= 1) { const float t = __shfl_up(incl, o); if (lane >= o) incl += t; }
  float run = incl - s;
  for (int i0 = 0; i0 < 64; i0 += 16) { float t[16];
#pragma unroll
    for (int i = 0; i < 16; ++i) t[i] = logf[base + (size_t)(i0 + i) * 4];
#pragma unroll
    for (int i = 0; i < 16; ++i) { run += t[i]; cum[(size_t)bh * SEQ + lane * 64 + i0 + i] = run * LOG2E; } }
}

template <int CTRL> __device__ __forceinline__ float dpp_add(float x) {
  const int y = __builtin_amdgcn_update_dpp(0, __builtin_bit_cast(int, x), CTRL, 0xf, 0xf, true);
  return x + __builtin_bit_cast(float, y);
}
__device__ __forceinline__ float row16_sum(float x) {
  x = dpp_add<0xB1>(x); x = dpp_add<0x4E>(x); x = dpp_add<0x141>(x); x = dpp_add<0x140>(x); return x;
}
constexpr int RS_TSB = 896;
constexpr int RS_CH = 32;
constexpr int RS_BUFB = RS_CH * RS_TSB;
constexpr int RS_ROWS = 8;
constexpr int RS_YP = 40;
constexpr int RS_YBUF = RS_CH * RS_ROWS * RS_YP;
struct RsRegs { u32x4 e, a, b, k, wr, v; float br, kr; };
__device__ __forceinline__ void rs_issue(const Params& p, RsRegs& r, int b, int h, int rq, int c, int lt) {
  unsigned char* ws = p.ws;
  { const int tok = lt >> 3, ch = lt & 7; const bf16* rec = (const bf16*)(ws + WS_RW) + ((size_t)((b * 4 + h) * SEQ + c * RS_CH + tok)) * RW_REC + ch * 8;
    r.e = *(const u32x4*)(rec); r.wr = *(const u32x4*)(rec + 64); r.a = *(const u32x4*)(rec + 128); r.b = *(const u32x4*)(rec + 192); r.k = *(const u32x4*)(rec + 256); }
  { const int t2 = lt & 31; const size_t rr = (size_t)b * SEQ + c * RS_CH + t2;
    r.v = *(const u32x4*)((const bf16*)(ws + RW_V) + rr * G + h * 64 + rq * RS_ROWS);
    r.br = ((const float*)(ws + SM_BR))[rr * 4 + h]; r.kr = ((const float*)(ws + SM_KR))[rr * 4 + h]; }
}
__device__ __forceinline__ void rs_commit(const RsRegs& r, unsigned char* buf, int lt) {
  { const int tok = lt >> 3, ch = lt & 7; unsigned char* rec = buf + tok * RS_TSB; float f[8];
    unpack8(r.e, f);
#pragma unroll
    for (int e = 0; e < 8; ++e) f[e] = ex2(-f[e] * LOG2E);
    *(f32x4*)(rec + ch * 32) = (f32x4){f[0], f[1], f[2], f[3]}; *(f32x4*)(rec + ch * 32 + 16) = (f32x4){f[4], f[5], f[6], f[7]};
    { const unsigned aw[4] = {r.a.x, r.a.y, r.a.z, r.a.w}, bw[4] = {r.b.x, r.b.y, r.b.z, r.b.w}, kw[4] = {r.k.x, r.k.y, r.k.z, r.k.w}, ww[4] = {r.wr.x, r.wr.y, r.wr.z, r.wr.w};
#pragma unroll
      for (int j = 0; j < 4; ++j) *(u32x4*)(rec + 256 + (ch * 4 + j) * 16) = (u32x4){aw[j], bw[j], kw[j], ww[j]}; } }
  if (lt < 32) { float f[8]; unpack8(r.v, f); unsigned char* rec = buf + lt * RS_TSB + 768; const float b32 = r.br * (1.f / 32.f), k32 = r.kr * (1.f / 32.f);
#pragma unroll
    for (int j = 0; j < 8; ++j) *(f32x4*)(rec + 16 * j) = (f32x4){f[j], b32, k32, 0.f}; }
}
__device__ __forceinline__ float row32_sum(float x) {
  x = row16_sum(x);
  const auto rr = __builtin_amdgcn_permlane16_swap(__builtin_bit_cast(unsigned, x), __builtin_bit_cast(unsigned, x), false, false);
  return __builtin_bit_cast(float, (unsigned)rr[0]) + __builtin_bit_cast(float, (unsigned)rr[1]);
}
__device__ __forceinline__ f32x2 bf2x(unsigned u) { return (f32x2){bflo(u), bfhi(u)}; }
__device__ __forceinline__ void rwkv_scan_unit(const Params& p, unsigned char* lds, int unit) {
  asm volatile("" ::: "memory");
  int tid = threadIdx.x; asm volatile("" : "+v"(tid)); const int wave = __builtin_amdgcn_readfirstlane(tid >> 6), lane = tid & 63;
  const int b = unit >> 5, h = (unit >> 3) & 3, rq = unit & 7;
  unsigned char* bufs = lds; bf16* ybuf = (bf16*)(lds + 2 * RS_BUFB);
  float* Y = (float*)(p.ws + RW_Y);
  constexpr int NCH = SEQ / RS_CH;
  const int lt = tid - 256;
  RsRegs rg;
  if (wave >= 4) { rs_issue(p, rg, b, h, rq, 0, lt); rs_commit(rg, bufs, lt); rs_issue(p, rg, b, h, rq, 1, lt); }
  __syncthreads();
  f32x2 S = {0.f, 0.f};
  const int seg = lane & 31, rloc = wave * 2 + (lane >> 5);
#define RS_YOUT(cc) do { const bf16* yp_ = ybuf + ((cc) & 1) * RS_YBUF + lt * RS_YP; float t_ = 0.f; \
    _Pragma("unroll") for (int j_ = 0; j_ < 4; ++j_) { float f_[8]; unpack8(*(const u32x4*)(yp_ + 8 * j_), f_); t_ += ((f_[0] + f_[1]) + (f_[2] + f_[3])) + ((f_[4] + f_[5]) + (f_[6] + f_[7])); } \
    Y[((size_t)b * SEQ + (cc) * RS_CH + (lt >> 3)) * G + h * 64 + rq * RS_ROWS + (lt & 7)] = t_; } while (0)
  for (int c = 0; c < NCH; ++c) {
    if (wave >= 4) {
      if (c + 1 < NCH) rs_commit(rg, bufs + ((c + 1) & 1) * RS_BUFB, lt);
      if (c + 2 < NCH) rs_issue(p, rg, b, h, rq, c + 2, lt);
      if (c > 0) RS_YOUT(c - 1);
    } else {
      const unsigned char* bp = bufs + (c & 1) * RS_BUFB; bf16* yb = ybuf + (c & 1) * RS_YBUF + rloc * RS_YP + seg;
      const unsigned char* pw = bp + seg * 8; const unsigned char* pa = bp + 256 + seg * 16; const unsigned char* pv = bp + 768 + rloc * 16;
      f32x2 nw = *(const f32x2*)(pw); u32x4 nq = *(const u32x4*)(pa); f32x4 nvs = *(const f32x4*)(pv);
#pragma unroll 8
      for (int s = 0; s < RS_CH; ++s) {
        const f32x2 w = nw, a = bf2x(nq.x), bb = bf2x(nq.y), kk = bf2x(nq.z), wr = bf2x(nq.w); const float v = nvs[0], br = nvs[1], kr = nvs[2];
        if (s + 1 < RS_CH) { const int o = (s + 1) * RS_TSB; nw = *(const f32x2*)(pw + o); nq = *(const u32x4*)(pa + o); nvs = *(const f32x4*)(pv + o); }
        const f32x2 pda = S * a, pdy = S * wr;
        const f32x2 vv = {v, v};
        const f32x2 u = S * w + vv * kk;
        const float t0 = v * kr + (pdy[0] + pdy[1]);
        const float da = row32_sum(pda[0] + pda[1]);
        const f32x2 dd = {da, da};
        S = dd * bb + u;
        yb[s * (RS_ROWS * RS_YP)] = (bf16)(__builtin_bit_cast(unsigned, da * br + t0) >> 16);
      }
    }
    LDS_BARRIER();
  }
  if (wave >= 4) RS_YOUT(NCH - 1);
  __syncthreads();
#undef RS_YOUT
}
__device__ __forceinline__ void rwkv_post_row(const Params& p, int l, int row, int lane) {
  asm volatile("" ::: "memory");
  asm volatile("" : "+v"(lane));
  unsigned char* ws = p.ws;
  const f32x4 y = ((const f32x4*)((const float*)(ws + RW_Y) + (size_t)row * G))[lane];
  float s = y[0] + y[1] + y[2] + y[3];
  s = row16_sum(s);
  const float mu = s * (1.f / 64.f); const f32x4 d = y - mu;
  float q = d[0] * d[0] + d[1] * d[1] + d[2] * d[2] + d[3] * d[3];
  q = row16_sum(q);
  const float rstd = rsqrtf(q * (1.f / 64.f) + 64e-5f);
  const f32x4 gw = ((const f32x4*)(p.in[28] + (size_t)l * G))[lane], gb = ((const f32x4*)(p.in[29] + (size_t)l * G))[lane];
  const u32x2 vv = ((const u32x2*)((const bf16*)(ws + RW_V) + (size_t)row * G))[lane], gg = ((const u32x2*)((const bf16*)(ws + RW_G) + (size_t)row * G))[lane];
  const float rk = ((const float*)(ws + SM_RK))[(size_t)row * 4 + (lane >> 4)];
  const float v[4] = {bflo(vv.x), bfhi(vv.x), bflo(vv.y), bfhi(vv.y)}, gt[4] = {bflo(gg.x), bfhi(gg.x), bflo(gg.y), bfhi(gg.y)};
  float o[4];
#pragma unroll
  for (int e = 0; e < 4; ++e) o[e] = (d[e] * rstd * gw[e] + gb[e] + rk * v[e]) * gt[e];
  u32x2 w; w.x = pk2(o[0], o[1]); w.y = pk2(o[2], o[3]);
  ((u32x2*)((bf16*)(ws + WS_P) + (size_t)row * PW + C_RWR))[lane] = w;
}

__device__ __forceinline__ void rwkv_post_rows2(const Params& p, int l, int row0, int row1, int lane) {
  asm volatile("" ::: "memory");
  asm volatile("" : "+v"(lane));
  unsigned char* ws = p.ws;
  const int rows[2] = {row0, row1};
  f32x4 y[2]; u32x2 vv[2], gg[2]; float rk[2];
  const f32x4 gw = ((const f32x4*)(p.in[28] + (size_t)l * G))[lane], gb = ((const f32x4*)(p.in[29] + (size_t)l * G))[lane];
#pragma unroll
  for (int r = 0; r < 2; ++r) { const size_t row = (size_t)rows[r];
    y[r] = ((const f32x4*)((const float*)(ws + RW_Y) + row * G))[lane];
    vv[r] = ((const u32x2*)((const bf16*)(ws + RW_V) + row * G))[lane]; gg[r] = ((const u32x2*)((const bf16*)(ws + RW_G) + row * G))[lane];
    rk[r] = ((const float*)(ws + SM_RK))[row * 4 + (lane >> 4)]; }
#pragma unroll
  for (int r = 0; r < 2; ++r) {
    float s = row16_sum(y[r][0] + y[r][1] + y[r][2] + y[r][3]);
    const float mu = s * (1.f / 64.f); const f32x4 d = y[r] - mu;
    const float q = row16_sum(d[0] * d[0] + d[1] * d[1] + d[2] * d[2] + d[3] * d[3]);
    const float rstd = rsqrtf(q * (1.f / 64.f) + 64e-5f);
    const float v[4] = {bflo(vv[r].x), bfhi(vv[r].x), bflo(vv[r].y), bfhi(vv[r].y)}, gt[4] = {bflo(gg[r].x), bfhi(gg[r].x), bflo(gg[r].y), bfhi(gg[r].y)};
    float o[4];
#pragma unroll
    for (int e = 0; e < 4; ++e) o[e] = (d[e] * rstd * gw[e] + gb[e] + rk[r] * v[e]) * gt[e];
    u32x2 w; w.x = pk2(o[0], o[1]); w.y = pk2(o[2], o[3]);
    ((u32x2*)((bf16*)(ws + WS_P) + (size_t)rows[r] * PW + C_RWR))[lane] = w;
  }
}

__device__ __forceinline__ void lru_unit(const Params& p, int l, float* lds, int unit) {
  asm volatile("" ::: "memory");
  unsigned char* ws = p.ws; bf16* proj = (bf16*)(ws + WS_P);
  int tid = threadIdx.x; asm volatile("" : "+v"(tid)); const int wave = __builtin_amdgcn_readfirstlane(tid >> 6), lane = tid & 63, li = lane & 15, g = lane >> 4;
  const int b = unit >> 2, h = unit & 3;
  float* XB = lds;
  float* XC = XB + 67 * 64;
  float* AA = XC + 64 * 65;
  float* UU = AA + 64 * 65;
  float* HH = UU + 64 * 65;
  bf16* XCb = (bf16*)(HH + 64 * 65);
  const float* cw = p.in[12] + (size_t)l * 4 * G + h * 64; const float* cb = p.in[13] + (size_t)l * G + h * 64;
  const float* rab = p.in[15] + (size_t)l * G + h * 64; const float* rib = p.in[17] + (size_t)l * G + h * 64; const float* lam = p.in[18] + (size_t)l * G + h * 64;
  const int mt = wave & 3, ntp = wave >> 2;
  bf16x8 br_[2][2], bi_[2][2]; float lsl[2], rb[2], ib[2];
  { const bf16* rat = (const bf16*)(ws + WS_RAT) + h * 4096; const bf16* rit = (const bf16*)(ws + WS_RIT) + h * 4096;
#pragma unroll
    for (int n = 0; n < 2; ++n) { const int col = (2 * ntp + n) * 16 + li; lsl[n] = log_sigmoid_acc(lam[col]); rb[n] = rab[col]; ib[n] = rib[col];
#pragma unroll
      for (int ks = 0; ks < 2; ++ks) { br_[n][ks] = *(const bf16x8*)(rat + col * 64 + ks * 32 + 8 * g); bi_[n][ks] = *(const bf16x8*)(rit + col * 64 + ks * 32 + 8 * g); } } }
  float hcur = 0.f;
  const int tok = tid >> 3, ch8 = (tid & 7) * 8;
  u32x4 nx0 = {0u, 0u, 0u, 0u}, nx1 = {0u, 0u, 0u, 0u}, ny;
  const int r1 = (tid + NTHREADS) >> 3;
  { const int pos0 = -3 + tok; if (pos0 >= 0) nx0 = *(const u32x4*)(proj + ((size_t)b * SEQ + pos0) * PW + C_LRUX + h * 64 + ch8);
    if (tid < 24) nx1 = *(const u32x4*)(proj + ((size_t)b * SEQ + (-3 + r1)) * PW + C_LRUX + h * 64 + ch8);
    ny = *(const u32x4*)(proj + ((size_t)b * SEQ + tok) * PW + C_LRUY + h * 64 + ch8); }
  for (int c = 0; c < SEQ / 64; ++c) {
    const int t0 = c * 64;
    { float f8[8]; unpack8(nx0, f8);
#pragma unroll
      for (int e = 0; e < 8; ++e) XB[tok * 64 + ch8 + e] = f8[e];
      if (tid < 24) { unpack8(nx1, f8);
#pragma unroll
        for (int e = 0; e < 8; ++e) XB[r1 * 64 + ch8 + e] = f8[e]; } }
    const u32x4 ycur = ny;
    if (c + 1 < SEQ / 64) { const int tn = t0 + 64;
      nx0 = *(const u32x4*)(proj + ((size_t)b * SEQ + tn - 3 + tok) * PW + C_LRUX + h * 64 + ch8);
      if (tid < 24) nx1 = *(const u32x4*)(proj + ((size_t)b * SEQ + tn - 3 + r1) * PW + C_LRUX + h * 64 + ch8);
      ny = *(const u32x4*)(proj + ((size_t)b * SEQ + tn + tok) * PW + C_LRUY + h * 64 + ch8); }
    LDS_BARRIER();
    { float xc[8];
#pragma unroll
      for (int e = 0; e < 8; ++e) { float v = cb[ch8 + e];
#pragma unroll
        for (int j = 0; j < 4; ++j) v += XB[(tok + j) * 64 + ch8 + e] * cw[j * G + ch8 + e];
        xc[e] = v; XC[tok * 65 + ch8 + e] = v; }
      *(u32x4*)(XCb + tok * 72 + ch8) = pack8(xc); }
    LDS_BARRIER();
    { bf16x8 af[2];
#pragma unroll
      for (int ks = 0; ks < 2; ++ks) af[ks] = *(const bf16x8*)(XCb + (mt * 16 + li) * 72 + ks * 32 + 8 * g);
#pragma unroll
      for (int n = 0; n < 2; ++n) { f32x4 cr = {0.f, 0.f, 0.f, 0.f}, ci = {0.f, 0.f, 0.f, 0.f};
#pragma unroll
        for (int ks = 0; ks < 2; ++ks) { cr = MFMA16(af[ks], br_[n][ks], cr); ci = MFMA16(af[ks], bi_[n][ks], ci); }
        const int col = (2 * ntp + n) * 16 + li;
#pragma unroll
        for (int j = 0; j < 4; ++j) { const int tk = mt * 16 + 4 * g + j; const float r = sigmoidf_(cr[j] + rb[n]), ig = sigmoidf_(ci[j] + ib[n]);
          const float log_a = 8.f * r * lsl[n]; const float a = __expf(log_a); const float mult = sqrtf(fmaxf(1.f - a * a, 0.f));
          AA[tk * 65 + col] = a; UU[tk * 65 + col] = mult * (ig * XC[tk * 65 + col]); } } }
    LDS_BARRIER();
    if (wave == 0) {
#pragma unroll 8
      for (int s = 0; s < 64; ++s) { hcur = AA[s * 65 + lane] * hcur + UU[s * 65 + lane]; HH[s * 65 + lane] = hcur; } }
    LDS_BARRIER();
    { bf16* yp = proj + ((size_t)b * SEQ + t0 + tok) * PW + C_LRUY + h * 64 + ch8; float y[8]; unpack8(ycur, y);
#pragma unroll
      for (int e = 0; e < 8; ++e) y[e] = HH[tok * 65 + ch8 + e] * gelu_tanh(y[e]);
      *(u32x4*)yp = pack8(y); }
  }
  __syncthreads();
}

constexpr int KS_P = 72, VS_P = 136;
constexpr int AT_KS = 0, AT_VS = 128 * KS_P * 2, AT_CS = AT_VS + 64 * VS_P * 2, AT_BUF = AT_CS + 512;
struct AtRegs { u32x4 k0, k1, v0, v1; float c; };
__device__ __forceinline__ void at_issue(AtRegs& r, const bf16* Kg  , const bf16* VTg  , const float* cumg, int tid) {
  { const int id = tid, row = id >> 3, ch = id & 7; r.k0 = *(const u32x4*)(Kg + (size_t)row * PW + ch * 8); }
  { const int id = tid + 512, row = id >> 3, ch = id & 7; r.k1 = *(const u32x4*)(Kg + (size_t)row * PW + ch * 8); }
  { const int id = tid, row = id >> 4, ch = id & 15; r.v0 = *(const u32x4*)(VTg + (size_t)row * SEQ + ch * 8); }
  { const int id = tid + 512, row = id >> 4, ch = id & 15; r.v1 = *(const u32x4*)(VTg + (size_t)row * SEQ + ch * 8); }
  r.c = (cumg && tid < 128) ? -cumg[tid] : 0.f;
}
__device__ __forceinline__ void at_commit(const AtRegs& r, unsigned char* buf, int tid) {
  bf16* Ks = (bf16*)(buf + AT_KS); bf16* Vs = (bf16*)(buf + AT_VS); float* Cs = (float*)(buf + AT_CS);
  { const int id = tid, row = id >> 3, ch = id & 7; *(u32x4*)(Ks + row * KS_P + ch * 8) = r.k0; }
  { const int id = tid + 512, row = id >> 3, ch = id & 7; *(u32x4*)(Ks + row * KS_P + ch * 8) = r.k1; }
  { const int id = tid, row = id >> 4, ch = id & 15; *(u32x4*)(Vs + row * VS_P + ch * 8) = r.v0; }
  { const int id = tid + 512, row = id >> 4, ch = id & 15; *(u32x4*)(Vs + row * VS_P + ch * 8) = r.v1; }
  if (tid < 128) Cs[tid] = r.c;
}
__device__ __forceinline__ bf16x8 vfrag(const bf16* Vs, int d, int key0, int g) {
  const u32x2 lo = *(const u32x2*)(Vs + d * VS_P + key0 + 4 * g), hi = *(const u32x2*)(Vs + d * VS_P + key0 + 16 + 4 * g);
  const u32x4 w = {lo.x, lo.y, hi.x, hi.y}; return __builtin_bit_cast(bf16x8, w);
}
__device__ __forceinline__ float grp4_max(float x) {
  const auto a = __builtin_amdgcn_permlane16_swap(__builtin_bit_cast(unsigned, x), __builtin_bit_cast(unsigned, x), false, false);
  x = fmaxf(__builtin_bit_cast(float, (unsigned)a[0]), __builtin_bit_cast(float, (unsigned)a[1]));
  const auto b = __builtin_amdgcn_permlane32_swap(__builtin_bit_cast(unsigned, x), __builtin_bit_cast(unsigned, x), false, false);
  return fmaxf(__builtin_bit_cast(float, (unsigned)b[0]), __builtin_bit_cast(float, (unsigned)b[1]));
}
__device__ __forceinline__ float grp4_sum(float x) {
  const auto a = __builtin_amdgcn_permlane16_swap(__builtin_bit_cast(unsigned, x), __builtin_bit_cast(unsigned, x), false, false);
  x = __builtin_bit_cast(float, (unsigned)a[0]) + __builtin_bit_cast(float, (unsigned)a[1]);
  const auto b = __builtin_amdgcn_permlane32_swap(__builtin_bit_cast(unsigned, x), __builtin_bit_cast(unsigned, x), false, false);
  return __builtin_bit_cast(float, (unsigned)b[0]) + __builtin_bit_cast(float, (unsigned)b[1]);
}
__device__ __forceinline__ void fox_unit(const Params& p, unsigned char* lds, int b, int h, int qb) {
  asm volatile("" ::: "memory");
  unsigned char* ws = p.ws; bf16* proj = (bf16*)(ws + WS_P);
  int tid = threadIdx.x; asm volatile("" : "+v"(tid)); const int wave = __builtin_amdgcn_readfirstlane(tid >> 6), lane = tid & 63, li = lane & 15, g = lane >> 4;
  const int bh = b * 4 + h; const int qrel = wave * 16 + li; const size_t qrow = (size_t)b * SEQ + qb * 128 + qrel;
  const float* cum = (const float*)(ws + SM_CUM) + (size_t)bh * SEQ;
  const bf16* Kbase = proj + (size_t)b * SEQ * PW + C_FOXK + h * 64; const bf16* VTbase = (const bf16*)(ws + P_FOXVT) + (size_t)bh * 64 * SEQ;
  bf16x8 qf[2];
#pragma unroll
  for (int ks = 0; ks < 2; ++ks) qf[ks] = *(const bf16x8*)(proj + qrow * PW + C_FOXQ + h * 64 + ks * 32 + 8 * g);
  const float SC = 0.125f * LOG2E;
  f32x4 o[4];
#pragma unroll
  for (int dt = 0; dt < 4; ++dt) o[dt] = (f32x4){0.f, 0.f, 0.f, 0.f};
  float m = -INFINITY, lsum = 0.f;
  AtRegs rg; at_issue(rg, Kbase, VTbase, cum, tid);
  __syncthreads();
  at_commit(rg, lds, tid);
  if (qb > 0) at_issue(rg, Kbase + (size_t)128 * PW, VTbase + 128, cum + 128, tid);
  LDS_BARRIER();
  for (int kb = 0; kb <= qb; ++kb) {
    unsigned char* buf = lds + (kb & 1) * AT_BUF; const bf16* Ks = (const bf16*)(buf + AT_KS); const bf16* Vs = (const bf16*)(buf + AT_VS); const float* Cs = (const float*)(buf + AT_CS);
    const bool diag = kb == qb; const int nst = diag ? (wave >> 1) + 1 : 4;
    for (int st = 0; st < nst; ++st) {
      f32x4 s0 = {0.f, 0.f, 0.f, 0.f}, s1 = {0.f, 0.f, 0.f, 0.f};
#pragma unroll
      for (int ks = 0; ks < 2; ++ks) { const bf16x8 a0 = *(const bf16x8*)(Ks + (st * 32 + li) * KS_P + ks * 32 + 8 * g), a1 = *(const bf16x8*)(Ks + (st * 32 + 16 + li) * KS_P + ks * 32 + 8 * g);
        s0 = MFMA16(a0, qf[ks], s0); s1 = MFMA16(a1, qf[ks], s1); }
      const f32x4 c0 = *(const f32x4*)(Cs + st * 32 + 4 * g), c1 = *(const f32x4*)(Cs + st * 32 + 16 + 4 * g);
      float x[8];
#pragma unroll
      for (int j = 0; j < 4; ++j) { x[j] = s0[j] * SC + c0[j]; x[4 + j] = s1[j] * SC + c1[j]; }
      if (diag) {
#pragma unroll
        for (int j = 0; j < 4; ++j) { if (st * 32 + 4 * g + j > qrel) x[j] = -INFINITY; if (st * 32 + 16 + 4 * g + j > qrel) x[4 + j] = -INFINITY; }
      }
      float mx = fmaxf(fmaxf(fmaxf(x[0], x[1]), fmaxf(x[2], x[3])), fmaxf(fmaxf(x[4], x[5]), fmaxf(x[6], x[7])));
      mx = grp4_max(mx);
      const float mn = fmaxf(m, mx);
      const bool grew = __any(mn > m);
      float ps = 0.f;
#pragma unroll
      for (int j = 0; j < 8; ++j) { x[j] = ex2(x[j] - mn); ps += x[j]; }
      if (grew) { const float f = ex2(m - mn); lsum *= f;
#pragma unroll
        for (int dt = 0; dt < 4; ++dt) o[dt] = o[dt] * f;
        m = mn; }
      lsum += ps;
      const bf16x8 pb = pack_frag(x);
#pragma unroll
      for (int dt = 0; dt < 4; ++dt) o[dt] = MFMA16(vfrag(Vs, dt * 16 + li, st * 32, g), pb, o[dt]);
    }
    if (kb < qb) {
      at_commit(rg, lds + ((kb + 1) & 1) * AT_BUF, tid);
      if (kb + 2 <= qb) at_issue(rg, Kbase + (size_t)(kb + 2) * 128 * PW, VTbase + (kb + 2) * 128, cum + (kb + 2) * 128, tid);
      LDS_BARRIER();
    }
  }
  lsum = grp4_sum(lsum);
  const float inv = 1.f / lsum;
#pragma unroll
  for (int dt = 0; dt < 4; ++dt) { u32x2 w; w.x = pk2(o[dt][0] * inv, o[dt][1] * inv); w.y = pk2(o[dt][2] * inv, o[dt][3] * inv);
    *(u32x2*)(proj + qrow * PW + C_FOXQ + h * 64 + dt * 16 + 4 * g) = w; }
}
__device__ __forceinline__ void ret_unit(const Params& p, int l, unsigned char* lds, int b, int h, int c) {
  asm volatile("" ::: "memory");
  unsigned char* ws = p.ws; bf16* proj = (bf16*)(ws + WS_P);
  int tid = threadIdx.x; asm volatile("" : "+v"(tid)); const int wave = __builtin_amdgcn_readfirstlane(tid >> 6), lane = tid & 63, li = lane & 15, g = lane >> 4;
  const int bh = b * 4 + h; const int nrel = wave * 16 + li; const size_t qrow = (size_t)b * SEQ + c * 128 + nrel;
  const float lg2 = log2f(1.f - exp2f(-5.f - (float)h));
  bf16* RT = (bf16*)(lds + 2 * AT_BUF);
  AtRegs rg; at_issue(rg, proj + ((size_t)b * SEQ + c * 128) * PW + C_RETK + h * 64, (const bf16*)(ws + P_RETVT) + (size_t)bh * 64 * SEQ + c * 128, nullptr, tid);
  { const float cd = ex2(lg2 * 128.f); const float* KV = (const float*)(ws + P_RETKV) + (size_t)bh * 32 * 4096 + (tid >> 3) * 64 + (tid & 7) * 8;
    f32x4 a0 = {0.f, 0.f, 0.f, 0.f}, a1 = {0.f, 0.f, 0.f, 0.f};
    int cc = 0;
    for (; cc + 4 <= c; cc += 4) { f32x4 k0[4], k1[4];
#pragma unroll
      for (int u = 0; u < 4; ++u) { k0[u] = *(const f32x4*)(KV + (size_t)(cc + u) * 4096); k1[u] = *(const f32x4*)(KV + (size_t)(cc + u) * 4096 + 4); }
#pragma unroll
      for (int u = 0; u < 4; ++u) { a0 = a0 * cd + k0[u]; a1 = a1 * cd + k1[u]; } }
    for (; cc < c; ++cc) { const f32x4 k0 = *(const f32x4*)(KV + (size_t)cc * 4096), k1 = *(const f32x4*)(KV + (size_t)cc * 4096 + 4); a0 = a0 * cd + k0; a1 = a1 * cd + k1; }
    __syncthreads();
    const int d = tid >> 3, e0 = (tid & 7) * 8;
#pragma unroll
    for (int e = 0; e < 4; ++e) { RT[(e0 + e) * KS_P + d] = (bf16)f2bf(a0[e]); RT[(e0 + 4 + e) * KS_P + d] = (bf16)f2bf(a1[e]); } }
  at_commit(rg, lds, tid);
  bf16x8 qf[2];
#pragma unroll
  for (int ks = 0; ks < 2; ++ks) qf[ks] = *(const bf16x8*)(proj + qrow * PW + C_RETQ + h * 64 + ks * 32 + 8 * g);
  __syncthreads();
  const bf16* Ks = (const bf16*)(lds + AT_KS); const bf16* Vs = (const bf16*)(lds + AT_VS);
  f32x4 o[4], cr[4];
#pragma unroll
  for (int et = 0; et < 4; ++et) { o[et] = (f32x4){0.f, 0.f, 0.f, 0.f}; cr[et] = (f32x4){0.f, 0.f, 0.f, 0.f};
#pragma unroll
    for (int ks = 0; ks < 2; ++ks) cr[et] = MFMA16(*(const bf16x8*)(RT + (et * 16 + li) * KS_P + ks * 32 + 8 * g), qf[ks], cr[et]); }
  const int nst = (wave >> 1) + 1;
  for (int st = 0; st < nst; ++st) {
    f32x4 s0 = {0.f, 0.f, 0.f, 0.f}, s1 = {0.f, 0.f, 0.f, 0.f};
#pragma unroll
    for (int ks = 0; ks < 2; ++ks) { const bf16x8 a0 = *(const bf16x8*)(Ks + (st * 32 + li) * KS_P + ks * 32 + 8 * g), a1 = *(const bf16x8*)(Ks + (st * 32 + 16 + li) * KS_P + ks * 32 + 8 * g);
      s0 = MFMA16(a0, qf[ks], s0); s1 = MFMA16(a1, qf[ks], s1); }
    float x[8];
#pragma unroll
    for (int j = 0; j < 4; ++j) { const int m0 = st * 32 + 4 * g + j, m1 = m0 + 16;
      x[j] = (m0 <= nrel) ? s0[j] * ex2(lg2 * (float)(nrel - m0)) : 0.f; x[4 + j] = (m1 <= nrel) ? s1[j] * ex2(lg2 * (float)(nrel - m1)) : 0.f; }
    const bf16x8 pb = pack_frag(x);
#pragma unroll
    for (int et = 0; et < 4; ++et) o[et] = MFMA16(vfrag(Vs, et * 16 + li, st * 32, g), pb, o[et]);
  }
  const float xi = ex2(lg2 * (float)(nrel + 1));
  float ss = 0.f;
#pragma unroll
  for (int et = 0; et < 4; ++et)
#pragma unroll
    for (int j = 0; j < 4; ++j) { o[et][j] += xi * cr[et][j]; ss += o[et][j] * o[et][j]; }
  ss += __shfl_xor(ss, 16); ss += __shfl_xor(ss, 32);
  const float rs = rsqrtf(ss * (1.f / 64.f) + EPS);
  const float* gnw = p.in[33] + (size_t)l * G + h * 64;
#pragma unroll
  for (int et = 0; et < 4; ++et) { const int e0 = et * 16 + 4 * g;
    const u32x2 gg = *(const u32x2*)(proj + qrow * PW + C_RETG + h * 64 + e0); const float gt[4] = {bflo(gg.x), bfhi(gg.x), bflo(gg.y), bfhi(gg.y)};
    float r[4];
#pragma unroll
    for (int j = 0; j < 4; ++j) r[j] = o[et][j] * rs * gnw[e0 + j] * (gt[j] * sigmoidf_(gt[j]));
    u32x2 w; w.x = pk2(r[0], r[1]); w.y = pk2(r[2], r[3]);
    *(u32x2*)(proj + qrow * PW + C_RETQ + h * 64 + e0) = w; }
}

constexpr int XP = 264;
__device__ __forceinline__ void xattn_unit(const Params& p, int l, unsigned char* lds, int unit) {
  asm volatile("" ::: "memory");
  unsigned char* ws = p.ws; bf16* qb = (bf16*)(ws + WS_P);
  int tid = threadIdx.x; asm volatile("" : "+v"(tid)); const int wave = __builtin_amdgcn_readfirstlane(tid >> 6), lane = tid & 63, li = lane & 15, g = lane >> 4;
  const int b = unit >> 6, head = (unit >> 4) & 3, qt = unit & 15;
  bf16* L = (bf16*)lds;
  const bf16* kg = (const bf16*)(ws + WS_KM) + ((size_t)l * 1024 + b * 256) * 1024 + head * 256;
  const bf16* vg = (const bf16*)(ws + WS_VMT) + (size_t)(((l * 4 + b) * 4 + head) * 256) * 256;
  __syncthreads();
#pragma unroll
  for (int i0 = 0; i0 < 16; i0 += 8) { u32x4 t[8];
#pragma unroll
    for (int i = 0; i < 8; ++i) { const int id = tid + 512 * (i0 + i), row = id >> 5, ch = id & 31; t[i] = *(const u32x4*)(kg + (size_t)row * 1024 + ch * 8); }
#pragma unroll
    for (int i = 0; i < 8; ++i) { const int id = tid + 512 * (i0 + i), row = id >> 5, ch = id & 31; *(u32x4*)(L + row * XP + ch * 8) = t[i]; } }
  __syncthreads();
  bf16x8 pb[2][8]; float linv[2];
  const float SC = LOG2E / 16.f;
#pragma unroll
  for (int grp = 0; grp < 2; ++grp) {
    const size_t row = (size_t)b * SEQ + qt * 256 + wave * 32 + grp * 16 + li;
    bf16x8 qf[8];
#pragma unroll
    for (int ks = 0; ks < 8; ++ks) qf[ks] = *(const bf16x8*)(qb + row * 1024 + head * 256 + ks * 32 + 8 * g);
    f32x4 s[16];
#pragma unroll
    for (int kt = 0; kt < 16; ++kt) { s[kt] = (f32x4){0.f, 0.f, 0.f, 0.f};
#pragma unroll
      for (int ks = 0; ks < 8; ++ks) s[kt] = MFMA16(*(const bf16x8*)(L + (kt * 16 + li) * XP + ks * 32 + 8 * g), qf[ks], s[kt]);
      if ((kt & 1) == 1) __builtin_amdgcn_sched_barrier(0); }
    float mx = -INFINITY;
#pragma unroll
    for (int kt = 0; kt < 16; ++kt) mx = fmaxf(mx, fmaxf(fmaxf(s[kt][0], s[kt][1]), fmaxf(s[kt][2], s[kt][3])));
    mx = fmaxf(mx, __shfl_xor(mx, 16)); mx = fmaxf(mx, __shfl_xor(mx, 32));
    float ps = 0.f;
#pragma unroll
    for (int kt = 0; kt < 16; ++kt)
#pragma unroll
      for (int j = 0; j < 4; ++j) { s[kt][j] = ex2((s[kt][j] - mx) * SC); ps += s[kt][j]; }
    ps += __shfl_xor(ps, 16); ps += __shfl_xor(ps, 32);
    linv[grp] = 1.f / ps;
#pragma unroll
    for (int kk = 0; kk < 8; ++kk) { float x[8];
#pragma unroll
      for (int j = 0; j < 4; ++j) { x[j] = s[2 * kk][j]; x[4 + j] = s[2 * kk + 1][j]; }
      pb[grp][kk] = pack_frag(x); }
    __builtin_amdgcn_sched_barrier(0);
  }
  __syncthreads();
#pragma unroll
  for (int i0 = 0; i0 < 16; i0 += 8) { u32x4 t[8];
#pragma unroll
    for (int i = 0; i < 8; ++i) { const int id = tid + 512 * (i0 + i), row = id >> 5, ch = id & 31; t[i] = *(const u32x4*)(vg + (size_t)row * 256 + ch * 8); }
#pragma unroll
    for (int i = 0; i < 8; ++i) { const int id = tid + 512 * (i0 + i), row = id >> 5, ch = id & 31; *(u32x4*)(L + row * XP + ch * 8) = t[i]; } }
  __syncthreads();
#pragma unroll
  for (int grp = 0; grp < 2; ++grp) {
    const size_t row = (size_t)b * SEQ + qt * 256 + wave * 32 + grp * 16 + li;
#pragma unroll
    for (int dt = 0; dt < 16; ++dt) { f32x4 o = {0.f, 0.f, 0.f, 0.f};
#pragma unroll
      for (int kk = 0; kk < 8; ++kk) { const u32x2 lo = *(const u32x2*)(L + (dt * 16 + li) * XP + kk * 32 + 4 * g), hi = *(const u32x2*)(L + (dt * 16 + li) * XP + kk * 32 + 16 + 4 * g);
        const u32x4 w = {lo.x, lo.y, hi.x, hi.y}; o = MFMA16(__builtin_bit_cast(bf16x8, w), pb[grp][kk], o); }
      u32x2 w; w.x = pk2(o[0] * linv[grp], o[1] * linv[grp]); w.y = pk2(o[2] * linv[grp], o[3] * linv[grp]);
      *(u32x2*)(qb + row * 1024 + head * 256 + dt * 16 + 4 * g) = w;
      __builtin_amdgcn_sched_barrier(0); }
  }
}

#define LAS __attribute__((address_space(3)))
#define XB_TMO      128
#define XB_XCNT(j)  (256  + 64 * (j))
#define XB_XSUB(j)  (1280 + 64 * (j))
#define XB_XGEN(j)  (2304 + 64 * (j))
#define XB_TOP      3328
#define XB_TOPGEN   3392
#define XCD_BAR_WORDS 3456
#define XB_SPIN_CAP (1u << 18)

__device__ __forceinline__ unsigned xb_ld(unsigned* p)              { return __hip_atomic_load(p, __ATOMIC_RELAXED, __HIP_MEMORY_SCOPE_AGENT); }
__device__ __forceinline__ unsigned xb_add(unsigned* p, unsigned v) { return __hip_atomic_fetch_add(p, v, __ATOMIC_RELAXED, __HIP_MEMORY_SCOPE_AGENT); }
__device__ __forceinline__ unsigned xb_xcc_id() { return (unsigned)__builtin_amdgcn_s_getreg((3 << 11) | 20) & 0xFu; }
#define XB_SPIN(cond, bar) do { unsigned _sp = 0; while (cond) { __builtin_amdgcn_s_sleep(1); \
    if ((++_sp & 255u) == 0u) { if (xb_ld(&(bar)[XB_TMO])) break; if (_sp > XB_SPIN_CAP) { atomicAdd(&(bar)[XB_TMO], 1u); break; } } } } while (0)

struct XcdBarrier {
    unsigned* bar; unsigned x;
    volatile LAS unsigned* st;
};

__device__ __forceinline__ XcdBarrier xcd_barrier_post(unsigned* bar, volatile LAS unsigned* st) {
    XcdBarrier b; b.bar = bar; b.x = xb_xcc_id(); b.st = st;
    if (threadIdx.x == 0) (void)xb_add(&bar[XB_XCNT(b.x)], 1u);
    return b;
}
__device__ __forceinline__ void xcd_barrier_complete(unsigned* bar, unsigned x, unsigned& nloc, unsigned& nx) {
    const unsigned G = gridDim.x * gridDim.y * gridDim.z;
    unsigned sum, cnt, mine, sp = 0u;
    for (;;) {
        sum = 0u; cnt = 0u; mine = 0u;
#pragma unroll
        for (unsigned j = 0; j < 16; ++j) { const unsigned c = xb_ld(&bar[XB_XCNT(j)]); sum += c; cnt += (c > 0u) ? 1u : 0u; mine = (j == x) ? c : mine; }
        if (sum == G) break;
        __builtin_amdgcn_s_sleep(1);
        if ((++sp & 255u) == 0u) { if (xb_ld(&bar[XB_TMO])) break; if (sp > XB_SPIN_CAP) { atomicAdd(&bar[XB_TMO], 1u); break; } }
    }
    nloc = mine > 0u ? mine : 1u; nx = cnt > 0u ? cnt : 1u;
}

__device__ __forceinline__ void xcd_barrier(const XcdBarrier& b) {
    asm volatile("s_waitcnt vmcnt(0)" ::: "memory");
    __syncthreads();
    if (threadIdx.x == 0) {
        unsigned* bar = b.bar;
        __builtin_amdgcn_s_waitcnt(0);
        unsigned nloc = b.st[0], nx = b.st[1];
        if (nloc == 0u) { xcd_barrier_complete(bar, b.x, nloc, nx); b.st[0] = nloc; b.st[1] = nx; }
        const unsigned old = xb_add(&bar[XB_XSUB(b.x)], 1u);
        const unsigned gen = old / nloc;
        if (old + 1u == (gen + 1u) * nloc) {
            __builtin_amdgcn_fence(__ATOMIC_RELEASE, "agent");
            asm volatile("s_waitcnt vmcnt(0)" ::: "memory");
            const unsigned og = xb_add(&bar[XB_TOP], 1u);
            const unsigned tg = og / nx;
            if (og + 1u == (tg + 1u) * nx) xb_add(&bar[XB_TOPGEN], 1u);
            else XB_SPIN(xb_ld(&bar[XB_TOPGEN]) == tg, bar);
            __builtin_amdgcn_fence(__ATOMIC_ACQUIRE, "agent");
            xb_add(&bar[XB_XGEN(b.x)], 1u);
            asm volatile("s_waitcnt vmcnt(0)" ::: "memory");
        } else {
            XB_SPIN(xb_ld(&bar[XB_XGEN(b.x)]) == gen, bar);
            __builtin_amdgcn_fence(__ATOMIC_ACQUIRE, "agent");
            asm volatile("s_waitcnt vmcnt(0)" ::: "memory");
        }
    }
    __syncthreads();
}


#ifndef DEBUG_LAUNCHES
#define DEBUG_LAUNCHES 0
#endif
constexpr int PH_PER_LAYER = 13, N_PHASES = 1 + PH_PER_LAYER * DEPTH;

__global__ void __launch_bounds__(NTHREADS) mega_fwd(Params p) {
  extern __shared__ __attribute__((aligned(16))) unsigned char lds[];
  cg::grid_group grid = cg::this_grid();
  constexpr int NB = 256, NGW = NB * NWAVES;
  unsigned char* ws = p.ws;
  PG8_LAS unsigned char* glds = (PG8_LAS unsigned char*)lds;
  bf16* Hb = (bf16*)(ws + WS_H); bf16* Ob = (bf16*)(ws + WS_O); bf16* Pb = (bf16*)(ws + WS_P);
  volatile LAS unsigned* xb_st = (volatile LAS unsigned*)((LAS unsigned char*)lds + (LDS_BYTES - 32));
  if (threadIdx.x == 0) { xb_st[0] = 0u; xb_st[1] = 0u; }
  __syncthreads();
  const XcdBarrier xbar = xcd_barrier_post((unsigned*)(ws + SM_BAR), xb_st);
  int ph = 0;
#ifdef DBG_CLR
#define DBG_LDSCLEAR { for (int e_ = threadIdx.x; e_ < LDS_BYTES / 4; e_ += NTHREADS) ((unsigned*)lds)[e_] = 0u; __syncthreads(); }
#else
#define DBG_LDSCLEAR
#endif
#define PHASE_BEGIN if (ph >= p.ph_lo && ph < p.ph_hi) { int tid = threadIdx.x; asm volatile("" : "+v"(tid)); const int lane = tid & 63, wave = __builtin_amdgcn_readfirstlane(tid >> 6), gw = blockIdx.x * NWAVES + wave; (void)lane; (void)gw; DBG_LDSCLEAR
#ifdef TS_PH
#define TS_REC if (blockIdx.x == 0 && threadIdx.x == 0) ((unsigned long long*)(ws + SM_Q + 256))[ph + 1] = __builtin_amdgcn_s_memrealtime();
#else
#define TS_REC
#endif
#define PHASE_END   if (ph + 1 < p.ph_hi) { if (p.ph_lo < 0) grid.sync();   else xcd_barrier(xbar); } TS_REC } ++ph;

  PHASE_BEGIN
    float* scr = (float*)lds + wave * (64 * 33);
    conv_layer_weights(p, 0, scr, gw, NGW, lane);
    { constexpr int I_SQ = (D / 64) * (D / 32);
      for (int it = gw; it < 4 * I_SQ; it += NGW) { const int w = it / I_SQ, r = it % I_SQ, layer = w >> 1, isv = w & 1;
        conv_item<0>(p.in[isv ? 36 : 35] + (size_t)layer * D * D, D, D, D, (bf16*)(ws + WS_WKV) + (size_t)w * D * D, scr, r, lane); } }
    for (int l = 0; l < DEPTH; ++l) { RowArgs a{}; a.xin = p.in[1]; a.g_pre = p.in[6] + (size_t)l * D; a.hout = (bf16*)(ws + WS_MEMN) + (size_t)l * 1024 * 1024; a.rows = 1024; row_phase(a, gw, NGW, lane); }
    { RowArgs a{}; a.xin = p.in[0]; a.g_pre = p.in[2]; a.hout = Hb; a.wf = p.in[9]; a.fbias = p.in[11]; a.logf = (float*)(ws + SM_LOGF); a.rows = T; row_phase(a, gw, NGW, lane); }
#ifdef DBG_FILLG
    for (int e = blockIdx.x * NTHREADS + tid; e < T * G / 2; e += NB * NTHREADS) ((unsigned*)(ws + RW_G))[e] = 0x447A447Au;
#endif
    for (int e = blockIdx.x * NTHREADS + tid; e < SEQ * 32; e += NB * NTHREADS) { const int pos = e >> 5, i = e & 31; const float inv = 1.f / powf(10000.f, (float)i / 31.f); const float ang = (float)pos * inv;
      ((float*)(ws + SM_ROT))[2 * e] = cosf(ang); ((float*)(ws + SM_ROT))[2 * e + 1] = sinf(ang); }
  PHASE_END

  for (int l = 0; l < DEPTH; ++l) {
    PHASE_BEGIN
      { pg8::Gemm g{Hb, (const bf16*)(ws + W_IN), T, NIN, D, D}; pg8::StaticOrder S; S.init(T, NIN, NB, (int)blockIdx.x);
        EpiIn E{Pb, (bf16*)(ws + P_FOXVT), (bf16*)(ws + P_RETKT), (bf16*)(ws + P_RETVT), (const float*)(ws + SM_ROT)};
        pg8::gemm_phase<EpiIn, pg8::StaticOrder, true, true>(glds, g, S, E); }
      if (l == 0) { pg8::Gemm g{(const bf16*)(ws + WS_MEMN), (const bf16*)(ws + WS_WKV), 2048, 4096, D, D}; MemSched S{NB, (int)blockIdx.x - 64};
        EpiMem E{(bf16*)(ws + WS_KM), (bf16*)(ws + WS_VMT)};
        pg8::gemm_phase<EpiMem, MemSched, true, true>(glds, g, S, E); }
    PHASE_END
    PHASE_BEGIN
      float* wl = (float*)lds + wave * (16 * WLP);
      for (int u = gw; u < 4096; u += NGW) rwkv_prep_unit(p, l, u >> 2, u & 3, wl, lane);
      for (int u = gw; u < 512; u += NGW) ret_kv_unit(p, u, lane);
      if (gw >= 1024 && gw < 1040) fox_cum_unit(p, gw - 1024, lane);
      if (blockIdx.x == 0 && tid == 0) *(int*)(ws + SM_Q) = 0;
    PHASE_END
    PHASE_BEGIN
#ifndef DBG_P3
#define DBG_P3 15
#endif
      if (blockIdx.x < 128) {
        const int bx_ = blockIdx.x, j_ = bx_ >> 3, su_ = ((2 * (bx_ & 7) + (j_ >> 3)) << 3) | (j_ & 7);
        if (DBG_P3 & 1) rwkv_scan_unit(p, lds, su_);
#ifdef REP_SCAN
        rwkv_scan_unit(p, lds, blockIdx.x);
#endif
      }
      else if (blockIdx.x < 144) { if (DBG_P3 & 2) lru_unit(p, l, (float*)lds, blockIdx.x - 128); }
      int* qword = (int*)(lds + LDS_BYTES - 16);
      for (;;) {
        __syncthreads();
        if (tid == 0) *qword = atomicAdd((int*)(ws + SM_Q), 1);
        __syncthreads();
        const int id = *qword;
        if (id >= 1024) break;
        if (id < 512) { if (DBG_P3 & 4) fox_unit(p, lds, (id & 15) >> 2, id & 3, 31 - (id >> 4)); }
        else if (DBG_P3 & 8) { const int r = id - 512, bh_ = r & 15; ret_unit(p, l, lds, bh_ >> 2, bh_ & 3, 31 - (r >> 4)); }
      }
    PHASE_END
    PHASE_BEGIN
      for (int row = gw; row < T; row += 2 * NGW) rwkv_post_rows2(p, l, row, row + NGW, lane);
    PHASE_END
    PHASE_BEGIN
      pg8::Gemm g{Pb, (const bf16*)(ws + W_OUT), T, D, D, PW}; pg8::StaticOrder S; S.init(T, D, NB, (int)blockIdx.x);
      EpiPlain E{Ob, D, 0, nullptr};
      pg8::gemm_phase<EpiPlain, pg8::StaticOrder, true, true>(glds, g, S, E);
    PHASE_END
    PHASE_BEGIN
      RowArgs a{}; a.xin = l == 0 ? p.in[0] : p.out; a.O = Ob; a.g_post = p.in[3] + (size_t)l * D; a.xout = p.out; a.g_pre = p.in[4] + (size_t)l * D; a.hout = Hb; a.rows = T;
      row_phase(a, gw, NGW, lane);
    PHASE_END
    PHASE_BEGIN
      pg8::Gemm g{Hb, (const bf16*)(ws + W_Q), T, D, D, D}; pg8::StaticOrder S; S.init(T, D, NB, (int)blockIdx.x);
      EpiPlain E{Pb, D, 0, nullptr};
      pg8::gemm_phase<EpiPlain, pg8::StaticOrder, true, true>(glds, g, S, E);
    PHASE_END
    PHASE_BEGIN
      for (int u = blockIdx.x; u < 256; u += NB) xattn_unit(p, l, lds, u);
    PHASE_END
    PHASE_BEGIN
      pg8::Gemm g{Pb, (const bf16*)(ws + W_O), T, D, D, D}; pg8::StaticOrder S; S.init(T, D, NB, (int)blockIdx.x);
      EpiPlain E{Ob, D, 0, nullptr};
      pg8::gemm_phase<EpiPlain, pg8::StaticOrder, true, true>(glds, g, S, E);
    PHASE_END
    PHASE_BEGIN
      RowArgs a{}; a.xin = p.out; a.O = Ob; a.g_post = p.in[5] + (size_t)l * D; a.xout = p.out; a.g_pre = p.in[7] + (size_t)l * D; a.hout = Hb; a.rows = T;
      row_phase(a, gw, NGW, lane);
    PHASE_END
    PHASE_BEGIN
      pg8::Gemm g{Hb, (const bf16*)(ws + W_1), T, DFF, D, D}; pg8::StaticOrder S; S.init(T, DFF, NB, (int)blockIdx.x);
      EpiPlain E{Pb, DFF, 1, nullptr};
      pg8::gemm_phase<EpiPlain, pg8::StaticOrder, true, true>(glds, g, S, E);
    PHASE_END
    PHASE_BEGIN
      pg8::Gemm g{Pb, (const bf16*)(ws + W_2), T, D, DFF, DFF}; pg8::StaticOrder S; S.init(T, D, NB, (int)blockIdx.x);
      EpiPlain E{Ob, D, 0, nullptr};
      pg8::gemm_phase<EpiPlain, pg8::StaticOrder, true, true>(glds, g, S, E);
    PHASE_END
    PHASE_BEGIN
      RowArgs a{}; a.xin = p.out; a.O = Ob; a.g_post = p.in[8] + (size_t)l * D; a.xout = p.out; a.rows = T;
      if (l + 1 < DEPTH) { a.g_pre = p.in[2] + (size_t)(l + 1) * D; a.hout = Hb; a.wf = p.in[9] + (size_t)(l + 1) * D * INW; a.fbias = p.in[11] + (size_t)(l + 1) * GH; a.logf = (float*)(ws + SM_LOGF); }
      row_phase(a, gw, NGW, lane);
      if (l + 1 < DEPTH) { __syncthreads(); conv_layer_weights(p, l + 1, (float*)lds + wave * (64 * 33), gw, NGW, lane); }
    PHASE_END
  }
#ifdef TS_PH
  grid.sync();
  if (blockIdx.x == 0) { const unsigned long long* ts = (const unsigned long long*)(ws + SM_Q + 256);
#ifdef TS_CONST
    const float dt_us = TS_CONST;
#else
    const float dt_us = (float)(ts[TS_PH + 1] - ts[TS_PH]) * 0.01f;
#endif
    const float delta = 0.01f * sqrtf(dt_us);
    for (int r = threadIdx.x; r < T; r += NTHREADS) p.out[(size_t)r * D] += delta; }
#endif
}


#ifdef DBG_STOP
#ifndef DBG_MASK
#define DBG_MASK 15
#endif
__global__ void dbg_dump(const unsigned char* ws, float* out) {
  const size_t i = (size_t)blockIdx.x * 256 + threadIdx.x; const int row = (int)(i >> 10), c = (int)(i & 1023);
#ifndef DBG_SRC
#define DBG_SRC 0
#endif
#ifndef DBG_COFF
#define DBG_COFF 0
#endif
  const bf16* proj = (const bf16*)(ws + WS_P);
  if (DBG_SRC == 0) out[i] = ((DBG_MASK >> (c >> 8)) & 1) ? bflo((unsigned)proj[(size_t)row * PW + DBG_COFF + c]) : 0.f;
  else if (DBG_SRC == 1) { const bf16* a = (const bf16*)(ws + WS_RW) + (size_t)(c >> 8) * (8u << 19); out[i] = ((DBG_MASK >> (c >> 8)) & 1) ? bflo((unsigned)a[(size_t)row * G + (c & 255)]) : 0.f; }
  else if (DBG_SRC == 2) { const bf16* a = (const bf16*)(ws + RW_K) + (size_t)(c >> 8) * (8u << 19); float v = 0.f; if (c < 768) v = bflo((unsigned)a[(size_t)row * G + (c & 255)]); else if (c < 772) v = ((const float*)(ws + SM_BR))[row * 4 + (c & 3)]; else if (c < 776) v = ((const float*)(ws + SM_KR))[row * 4 + (c & 3)]; else if (c < 780) v = ((const float*)(ws + SM_RK))[row * 4 + (c & 3)];
    out[i] = ((DBG_MASK >> (c >> 8)) & 1) ? v : 0.f; }
  else if (DBG_SRC == 5) { out[i] = c < 256 ? bflo((unsigned)((const bf16*)(ws + RW_G))[(size_t)row * G + c]) : 0.f; }
  else if (DBG_SRC == 4) { out[i] = i < 512 * 1024 ? bflo((unsigned)((const bf16*)(ws + W_SMALL))[i]) : 0.f; }
  else { out[i] = c < 256 ? ((const float*)(ws + RW_Y))[(size_t)row * G + c] : 0.f; }
}
#endif

#ifdef DBG_GCHK
__global__ void dbg_snap(const unsigned char* ws, float* out) { const size_t i = (size_t)blockIdx.x * 256 + threadIdx.x; ((unsigned*)out)[i] = ((const unsigned*)(ws + RW_G))[i]; if (i == 0) *(unsigned*)(ws + SM_Q + 64) = 0u; }
__global__ void dbg_cmp(unsigned char* ws, const float* out) { const size_t i = (size_t)blockIdx.x * 256 + threadIdx.x; const unsigned a = ((const unsigned*)(ws + RW_G))[i], b = ((const unsigned*)out)[i];
  if (a != b) { unsigned f = 1u; if (a == 0x447A447Au) f |= 2u; else f |= 4u; atomicOr((unsigned*)(ws + SM_Q + 64), f); } }
__global__ void dbg_fin(const unsigned char* ws, float* out) { const size_t i = (size_t)blockIdx.x * 256 + threadIdx.x; out[i] = (i == 0) ? 1.0e6f * (float)(*(const unsigned*)(ws + SM_Q + 64)) : 0.f; }
#endif
extern "C" void kernel_launch(void* const* d_in, const int* in_sizes, int n_in, void* d_out, int out_size, void* d_ws, size_t ws_size, hipStream_t stream) {
  static int grid = 0;
  if (grid == 0) {
    if (ws_size < WS_END) { fprintf(stderr, "kernel_launch: workspace too small: %zu < %zu\n", ws_size, (size_t)WS_END); grid = -1; return; }
    int dev = 0, cus = 0, per_cu = 0;
    hipGetDevice(&dev); hipDeviceGetAttribute(&cus, hipDeviceAttributeMultiprocessorCount, dev);
    hipFuncSetAttribute((const void*)mega_fwd, hipFuncAttributeMaxDynamicSharedMemorySize, LDS_BYTES);
    hipOccupancyMaxActiveBlocksPerMultiprocessor(&per_cu, (const void*)mega_fwd, NTHREADS, LDS_BYTES);
    if (per_cu < 1) { fprintf(stderr, "kernel_launch: occupancy query says %d blocks/CU\n", per_cu); per_cu = 1; }
    grid = 256;
    if (cus < 256) { fprintf(stderr, "kernel_launch: needs 256 CUs, device has %d\n", cus); grid = -1; return; }
    (void)hipGetLastError();
  }
  if (grid < 0) return;
  Params p{};
  for (int i = 0; i < 40; ++i) p.in[i] = (const float*)d_in[i];
  p.out = (float*)d_out; p.ws = (unsigned char*)d_ws;
#if DEBUG_LAUNCHES
#ifdef DBG_GCHK
  for (int ph = 0; ph < 3; ++ph) { p.ph_lo = ph; p.ph_hi = ph + 1; hipLaunchKernelGGL(mega_fwd, dim3(grid), dim3(NTHREADS), LDS_BYTES, stream, p); }
  hipLaunchKernelGGL(dbg_snap, dim3(T * G / 2 / 256), dim3(256), 0, stream, (const unsigned char*)d_ws, (float*)d_out);
  p.ph_lo = 3; p.ph_hi = 4; hipLaunchKernelGGL(mega_fwd, dim3(grid), dim3(NTHREADS), LDS_BYTES, stream, p);
  hipLaunchKernelGGL(dbg_cmp, dim3(T * G / 2 / 256), dim3(256), 0, stream, (unsigned char*)d_ws, (const float*)d_out);
  hipLaunchKernelGGL(dbg_fin, dim3(T * 1024 / 256), dim3(256), 0, stream, (const unsigned char*)d_ws, (float*)d_out);
#elif defined(DBG_STOP)
  for (int ph = 0; ph < DBG_STOP; ++ph) { p.ph_lo = ph; p.ph_hi = ph + 1; hipLaunchKernelGGL(mega_fwd, dim3(grid), dim3(NTHREADS), LDS_BYTES, stream, p); }
  hipLaunchKernelGGL(dbg_dump, dim3(T * 1024 / 256), dim3(256), 0, stream, (const unsigned char*)d_ws, (float*)d_out);
#else
#ifndef REP_MASK
#define REP_MASK 0
#endif
  int rewound = 0;
  for (int ph = 0; ph < N_PHASES; ++ph) { p.ph_lo = ph; p.ph_hi = ph + 1; const int rel = ph == 0 ? 0 : 1 + (ph - 1) % PH_PER_LAYER;
    const int reps = ((REP_MASK >> rel) & 1) ? 2 : 1;
    for (int r = 0; r < reps; ++r) hipLaunchKernelGGL(mega_fwd, dim3(grid), dim3(NTHREADS), LDS_BYTES, stream, p);
#ifdef REP_GROUP
    if (rel == 4) { if (!rewound) { rewound = 1; ph -= 4; } else rewound = 0; }
#endif
  }
#endif
#else
  p.ph_lo = 0; p.ph_hi = N_PHASES;
  hipMemsetAsync((unsigned char*)d_ws + SM_BAR, 0, 16384, stream);
  void* args[] = {&p};
  hipError_t e = hipLaunchCooperativeKernel((const void*)mega_fwd, dim3(grid), dim3(NTHREADS), args, LDS_BYTES, stream);
  if (e != hipSuccess) fprintf(stderr, "cooperative launch failed: %s (grid %d)\n", hipGetErrorString(e), grid);
#endif
}
```

```cpp
#include <hip/hip_runtime.h>
#include <hip/hip_cooperative_groups.h>
#include <cstdio>
#include <cstdint>
#include <cmath>
namespace cg = cooperative_groups;
namespace pg8 {
#define PG8_LAS __attribute__((address_space(3)))
typedef unsigned short bf16_t;
typedef short bf16x8 __attribute__((ext_vector_type(8)));
typedef float f32x4 __attribute__((ext_vector_type(4)));
typedef unsigned u32x4 __attribute__((ext_vector_type(4)));
constexpr int BM = 256, BK = 64, HALF = 128, HTB = HALF * BK * 2  , STAGE_BYTES = 8 * HTB, NXCD = 8, WGM = 8;

__host__ __device__ __forceinline__ int lds_byte(int r, int c) { const int st = (r >> 4) * 2 + (c >> 5), rr = r & 15, cc = c & 31, ob = rr * 64 + cc * 2; return st * 1024 + (ob ^ (((ob >> 9) & 1) << 5)); }
__host__ __device__ __forceinline__ void stage_rc(int b, int& R, int& C) { const int st = b / 1024, sb = b % 1024, swz = sb ^ (((sb >> 9) & 1) << 5); R = (st >> 1) * 16 + swz / 64; C = (st & 1) * 32 + (swz % 64) / 2; }
__host__ __device__ __forceinline__ int perm32(int rho) { const int n = rho >> 4, i = rho & 15; return 8 * (i >> 2) + 4 * n + (i & 3); }

struct Unit { int pm, pn; };
struct Gemm { const bf16_t* A; const bf16_t* Bt; int M, N, K, lda; };

struct StaticOrder {
    int nM, nN, nwg, G, c;
    __host__ __device__ void init(int M, int N, int G_, int c_) { nM = M / BM; nN = N / BM; nwg = nM * nN; G = G_; c = c_; }
    __host__ __device__ bool next(int i, Unit& u) const {
        const long L = (long)i * G + c; if (L >= nwg) return false;
        int wgid = (int)L; { const int q = nwg / NXCD, r = nwg % NXCD, xcd = wgid % NXCD, off = wgid / NXCD; wgid = (xcd < r ? xcd * (q + 1) : r * (q + 1) + (xcd - r) * q) + off; }
        const int nig = WGM * nN, gid = wgid / nig, fm = gid * WGM, gsz = (nM - fm) < WGM ? (nM - fm) : WGM;
        u.pm = fm + ((wgid % nig) % gsz); u.pn = (wgid % nig) / gsz; return true;
    }
    __device__ __forceinline__ void a_ready(const Unit&) const {}
    __device__ __forceinline__ void done(const Unit&) const {}
};

__device__ __forceinline__ unsigned cvt_pk_bf16(float lo, float hi) { unsigned r; asm volatile("v_cvt_pk_bf16_f32 %0, %1, %2" : "=v"(r) : "v"(lo), "v"(hi)); return r; }
typedef float f32x2 __attribute__((ext_vector_type(2)));
template <class Epi, class Sched, bool ALIGN_EPI = false, bool SP2 = false>
__device__ __forceinline__ void gemm_phase(PG8_LAS unsigned char* lds, const Gemm g, const Sched& S, const Epi& E) {
    int tid_l = threadIdx.x; asm volatile("" : "+v"(tid_l));
    const int tid = tid_l, wid = __builtin_amdgcn_readfirstlane(tid >> 6), lane = tid & 63, wr = wid >> 2, wc = wid & 3, fr = lane & 15, fq = lane >> 4;
    const int K = g.K, nt = K / BK;
    unsigned voffA[2], voffB[2];
#pragma unroll
    for (int i = 0; i < 2; ++i) { int R, C; stage_rc(tid * 16 + i * 8192, R, C); const int Rb = Epi::PERM ? ((R & ~31) + perm32(R & 31)) : R;
        voffA[i] = (unsigned)(R * g.lda + C) * 2u; voffB[i] = (unsigned)(Rb * K + C) * 2u; }
    const size_t kstep = (size_t)(BK * 2);
    const size_t hstep = (size_t)HALF * K * 2;
    const size_t tstep = 2 * hstep; const size_t hstepA = (size_t)HALF * g.lda * 2; const size_t tstepA = 2 * hstepA;
    const unsigned ldsw = (unsigned)wid * 1024u;
    const int aoff = lds_byte(wr * 64 + fr, fq * 8), boff = lds_byte(wc * 32 + fr, fq * 8);
#define PG8_SA(b, h) (((b) * 2 + (h)) * HTB)
#define PG8_SB(b, h) ((4 + (b) * 2 + (h)) * HTB)
#define PG8_STAGE(bufoff, gbase, voff) do { _Pragma("unroll") for (int _i = 0; _i < 2; ++_i) \
        __builtin_amdgcn_global_load_lds((const unsigned*)((const char*)(gbase) + (voff)[_i]), (PG8_LAS unsigned*)(lds + (bufoff) + ldsw + _i * 8192), 16, 0, 0); } while (0)
#define PG8_LDA(dst, b, h) do { _Pragma("unroll") for (int m = 0; m < 4; ++m) _Pragma("unroll") for (int k = 0; k < 2; ++k) dst[m][k] = *(const PG8_LAS bf16x8*)(lds + PG8_SA(b, h) + aoff + m * 2048 + k * 1024); } while (0)
#define PG8_LDB(dst, b, h) do { _Pragma("unroll") for (int n = 0; n < 2; ++n) _Pragma("unroll") for (int k = 0; k < 2; ++k) dst[n][k] = *(const PG8_LAS bf16x8*)(lds + PG8_SB(b, h) + boff + n * 2048 + k * 1024); } while (0)
#define PG8_MMA(ai, bj, At, Bt) do { __builtin_amdgcn_s_setprio(1); _Pragma("unroll") for (int m = 0; m < 4; ++m) _Pragma("unroll") for (int n = 0; n < 2; ++n) _Pragma("unroll") for (int k = 0; k < 2; ++k) \
        acc[ai][bj][m][n] = __builtin_amdgcn_mfma_f32_16x16x32_bf16(Bt[n][k], At[m][k], acc[ai][bj][m][n], 0, 0, 0); __builtin_amdgcn_s_setprio(0); } while (0)
#define PG8_WAIT_V(n) asm volatile("s_waitcnt vmcnt(" #n ")" ::: "memory")
#define PG8_WAIT_L(n) asm volatile("s_waitcnt lgkmcnt(" #n ")" ::: "memory")
#define PG8_BAR __builtin_amdgcn_s_barrier()
#define PG8_SCHED __builtin_amdgcn_sched_barrier(0)
    Unit cur, nxt; int ui = 0;
    if (!S.next(0, cur)) return;
    f32x4 acc[2][2][4][2];
#pragma unroll
    for (int a = 0; a < 2; ++a)
#pragma unroll
        for (int b = 0; b < 2; ++b)
#pragma unroll
            for (int m = 0; m < 4; ++m)
#pragma unroll
                for (int n = 0; n < 2; ++n) acc[a][b][m][n] = (f32x4){0.f, 0.f, 0.f, 0.f};
    bf16x8 At[4][2], B0[2][2], B1[2][2];
    const char* cA = (const char*)g.A + (size_t)cur.pm * tstepA; const char* cB = (const char*)g.Bt + (size_t)cur.pn * tstep;
    S.a_ready(cur);
    if constexpr (SP2) {
        PG8_STAGE(PG8_SB(0, 0), cB, voffB); PG8_STAGE(PG8_SB(0, 1), cB + hstep, voffB); PG8_STAGE(PG8_SA(0, 0), cA, voffA); PG8_STAGE(PG8_SA(0, 1), cA + hstepA, voffA);
        if (wr == 1) PG8_BAR;
        PG8_WAIT_V(2); PG8_BAR;
        PG8_STAGE(PG8_SB(1, 0), cB + kstep, voffB); PG8_STAGE(PG8_SA(1, 0), cA + kstep, voffA); PG8_STAGE(PG8_SB(1, 1), cB + hstep + kstep, voffB);
        PG8_WAIT_V(6); PG8_BAR;
    } else {
        PG8_STAGE(PG8_SB(0, 0), cB, voffB); PG8_STAGE(PG8_SA(0, 0), cA, voffA); PG8_STAGE(PG8_SB(0, 1), cB + hstep, voffB); PG8_STAGE(PG8_SA(0, 1), cA + hstepA, voffA);
        if (wr == 1) PG8_BAR;
        PG8_WAIT_V(4); PG8_BAR;
        PG8_STAGE(PG8_SB(1, 0), cB + kstep, voffB); PG8_STAGE(PG8_SA(1, 0), cA + kstep, voffA); PG8_STAGE(PG8_SB(1, 1), cB + hstep + kstep, voffB);
        PG8_WAIT_V(6); PG8_BAR;
    }
    for (;;) {
        const bool has_next = S.next(ui + 1, nxt);
        const char* nA = has_next ? (const char*)g.A + (size_t)nxt.pm * tstepA : cA; const char* nB = has_next ? (const char*)g.Bt + (size_t)nxt.pn * tstep : cB;
        for (int t = 0; t < nt; t += 2) {
            const bool last = (t == nt - 2);
            const char* a1 = cA + (size_t)(t + 1) * kstep;
            const char* a2 = last ? nA : cA + (size_t)(t + 2) * kstep; const char* b2 = last ? nB : cB + (size_t)(t + 2) * kstep;
            const char* a3 = a2 + kstep; const char* b3 = b2 + kstep;
            if (last && has_next) S.a_ready(nxt);
            if constexpr (SP2) {
            PG8_LDB(B0, 0, 0); PG8_LDB(B1, 0, 1); PG8_SCHED; PG8_LDA(At, 0, 0); PG8_STAGE(PG8_SA(1, 1), a1 + hstepA, voffA);
            PG8_WAIT_V(8); PG8_WAIT_L(0); PG8_BAR; PG8_MMA(0, 0, At, B0); PG8_MMA(0, 1, At, B1); PG8_BAR; PG8_SCHED;
            PG8_LDA(At, 0, 1); PG8_STAGE(PG8_SB(0, 0), b2, voffB); PG8_STAGE(PG8_SB(0, 1), b2 + hstep, voffB); PG8_STAGE(PG8_SA(0, 0), a2, voffA);
            PG8_WAIT_V(8); PG8_WAIT_L(0); PG8_BAR; PG8_MMA(1, 0, At, B0); PG8_MMA(1, 1, At, B1); PG8_BAR; PG8_SCHED;
            PG8_LDB(B0, 1, 0); PG8_LDB(B1, 1, 1); PG8_SCHED; PG8_LDA(At, 1, 0); PG8_STAGE(PG8_SA(0, 1), a2 + hstepA, voffA);
            PG8_WAIT_V(8); PG8_WAIT_L(0); PG8_BAR; PG8_MMA(0, 0, At, B0); PG8_MMA(0, 1, At, B1); PG8_BAR; PG8_SCHED;
            PG8_LDA(At, 1, 1); PG8_STAGE(PG8_SB(1, 0), b3, voffB); PG8_STAGE(PG8_SB(1, 1), b3 + hstep, voffB); PG8_STAGE(PG8_SA(1, 0), a3, voffA);
            PG8_WAIT_V(8); PG8_WAIT_L(0); PG8_BAR; PG8_MMA(1, 0, At, B0); PG8_MMA(1, 1, At, B1); PG8_BAR; PG8_SCHED;
            } else {
            PG8_LDB(B0, 0, 0); PG8_SCHED; PG8_LDA(At, 0, 0); PG8_STAGE(PG8_SA(1, 1), a1 + hstepA, voffA);
            PG8_WAIT_L(8); PG8_BAR; PG8_WAIT_L(0); PG8_MMA(0, 0, At, B0); PG8_BAR; PG8_SCHED;
            PG8_LDB(B1, 0, 1); PG8_STAGE(PG8_SB(0, 0), b2, voffB);
            PG8_BAR; PG8_WAIT_L(0); PG8_MMA(0, 1, At, B1); PG8_BAR;
            PG8_LDA(At, 0, 1); PG8_STAGE(PG8_SA(0, 0), a2, voffA);
            PG8_BAR; PG8_WAIT_L(0); PG8_MMA(1, 0, At, B0); PG8_BAR; PG8_SCHED;
            PG8_STAGE(PG8_SB(0, 1), b2 + hstep, voffB);
            PG8_WAIT_V(6); PG8_BAR; PG8_MMA(1, 1, At, B1); PG8_BAR;
            PG8_LDB(B0, 1, 0); PG8_SCHED; PG8_LDA(At, 1, 0); PG8_STAGE(PG8_SA(0, 1), a2 + hstepA, voffA);
            PG8_WAIT_L(8); PG8_BAR; PG8_WAIT_L(0); PG8_MMA(0, 0, At, B0); PG8_BAR; PG8_SCHED;
            PG8_LDB(B1, 1, 1); PG8_STAGE(PG8_SB(1, 0), b3, voffB);
            PG8_BAR; PG8_WAIT_L(0); PG8_MMA(0, 1, At, B1); PG8_BAR;
            PG8_LDA(At, 1, 1); PG8_STAGE(PG8_SA(1, 0), a3, voffA);
            PG8_BAR; PG8_WAIT_L(0); PG8_MMA(1, 0, At, B0); PG8_BAR; PG8_SCHED;
            PG8_STAGE(PG8_SB(1, 1), b3 + hstep, voffB);
            PG8_WAIT_V(6); PG8_BAR; PG8_MMA(1, 1, At, B1); PG8_BAR;
            }
        }
        if constexpr (ALIGN_EPI) { if (wr == 0) PG8_BAR; }
        if constexpr (!Epi::AFTER_DRAIN) { E(acc, cur, wr, wc, fr, fq); S.done(cur); }
        if (!has_next) break;
#pragma unroll
        for (int a = 0; a < 2; ++a)
#pragma unroll
            for (int b = 0; b < 2; ++b)
#pragma unroll
                for (int m = 0; m < 4; ++m)
#pragma unroll
                    for (int n = 0; n < 2; ++n) acc[a][b][m][n] = (f32x4){0.f, 0.f, 0.f, 0.f};
        cur = nxt; cA = nA; cB = nB; ++ui;
        if constexpr (ALIGN_EPI) { if (wr == 1) PG8_BAR; }
    }
    PG8_WAIT_V(0);
    if constexpr (!ALIGN_EPI) { if (wr == 0) PG8_BAR; }
    PG8_BAR;
    if constexpr (Epi::AFTER_DRAIN) { E.fused(acc, cur, wr, wc, fr, fq, lds, wid, lane); S.done(cur); }
#undef PG8_SA
#undef PG8_SB
#undef PG8_STAGE
#undef PG8_LDA
#undef PG8_LDB
#undef PG8_MMA
#undef PG8_WAIT_V
#undef PG8_WAIT_L
#undef PG8_BAR
#undef PG8_SCHED
}
}

typedef unsigned short bf16;
typedef short bf16x8 __attribute__((ext_vector_type(8)));
typedef short bf16x4 __attribute__((ext_vector_type(4)));
typedef float f32x4 __attribute__((ext_vector_type(4)));
typedef float f32x2 __attribute__((ext_vector_type(2)));
typedef unsigned u32x4 __attribute__((ext_vector_type(4)));
typedef unsigned u32x2 __attribute__((ext_vector_type(2)));

constexpr int D = 1024, BATCH = 4, SEQ = 4096, DEPTH = 2, T = BATCH * SEQ;
constexpr int MEM = 256;
constexpr int G = 256, HD = 64, GH = 4;
constexpr int INW = 3332, DFF = 4096;
constexpr float EPS = 1e-6f, LOG2E = 1.4426950408889634f;
constexpr int NTHREADS = 512, NWAVES = 8;
constexpr int PW = 2816;
constexpr int C_FOXQ = 0, C_LRUY = 256, C_RWR = 512, C_RETQ = 768, C_FOXK = 1024, C_LRUX = 1280, C_RWK = 1536, C_RWV = 1792, C_RWX = 2048, C_RETK = 2304, C_RETG = 2560;
constexpr int NIN = 3328;
__device__ __constant__ const int kSrcCol[13] = {0, 1028, 1284, 2308, 256, 772, 1540, 1796, 2052, 2564, 3076, 512, 2820};

constexpr size_t MiB = 1u << 20;
constexpr size_t WS_W = 0;
constexpr size_t W_IN = 0, W_OUT = 7 * MiB, W_Q = 9 * MiB, W_O = 11 * MiB, W_1 = 13 * MiB, W_2 = 21 * MiB, W_SMALL = 29 * MiB;
constexpr size_t WS_W2T = W_SMALL, WS_A2T = WS_W2T + 256 * 64 * 2, WS_G2T = WS_A2T + 256 * 64 * 2, WS_V1T = WS_G2T + 256 * 128 * 2, WS_V2T = WS_V1T + 32 * 256 * 2, WS_RAT = WS_V2T + 256 * 32 * 2, WS_RIT = WS_RAT + 4 * 64 * 64 * 2;
constexpr size_t WS_P = 30 * MiB;
constexpr size_t P_FOXVT = WS_P + 88 * MiB, P_RETKT = WS_P + 96 * MiB, P_RETVT = WS_P + 104 * MiB, P_RETKV = WS_P + 112 * MiB;
constexpr size_t WS_RW = 158 * MiB;
constexpr size_t RW_E = WS_RW, RW_WR = WS_RW + 8 * MiB, RW_A = WS_RW + 16 * MiB, RW_B = WS_RW + 24 * MiB, RW_K = WS_RW + 32 * MiB, RW_V = WS_RW + 40 * MiB, RW_G = WS_P + 120 * MiB  , RW_Y = WS_RW + 56 * MiB;
constexpr int RW_REC = 320;
__device__ __forceinline__ size_t rw_off(int tok  , int arr, int col  ) { const int b = tok >> 12, pos = tok & (SEQ - 1), hh = col >> 6; return ((size_t)((b * 4 + hh) * SEQ + pos)) * RW_REC + arr * 64 + (col & 63); }
constexpr size_t WS_O = WS_RW, WS_H = WS_RW + 32 * MiB;
constexpr size_t WS_WKV = WS_RW;
constexpr size_t WS_MEMN = WS_RW + 64 * MiB;
constexpr size_t WS_VF = 230 * MiB;
constexpr size_t WS_KM = 238 * MiB, WS_VMT = 242 * MiB;
constexpr size_t WS_SM = 246 * MiB;
constexpr size_t SM_LOGF = WS_SM, SM_CUM = SM_LOGF + 256 * 1024, SM_BR = SM_CUM + 256 * 1024, SM_KR = SM_BR + 256 * 1024, SM_RK = SM_KR + 256 * 1024,
                 SM_SS = SM_RK + 256 * 1024  , SM_ROT = SM_SS + 256 * 1024  , SM_Q = SM_ROT + MiB  , SM_BAR = SM_Q + 4096  , WS_END = SM_BAR + 16384;
static_assert(WS_END <= 256 * MiB, "workspace map");
constexpr int LDS_BYTES = 147456;

__device__ __forceinline__ unsigned f2bf(float f) { unsigned u = __builtin_bit_cast(unsigned, f); return (u + 0x7fffu + ((u >> 16) & 1u)) >> 16; }
typedef __bf16 bf16x2_t __attribute__((ext_vector_type(2)));
__device__ __forceinline__ unsigned pk2(float lo, float hi) { const f32x2 v = {lo, hi}; const bf16x2_t b = __builtin_convertvector(v, bf16x2_t); return __builtin_bit_cast(unsigned, b); }
__device__ __forceinline__ float bflo(unsigned u) { return __builtin_bit_cast(float, u << 16); }
__device__ __forceinline__ float bfhi(unsigned u) { return __builtin_bit_cast(float, u & 0xffff0000u); }
__device__ __forceinline__ void unpack8(u32x4 w, float* f) { f[0] = bflo(w.x); f[1] = bfhi(w.x); f[2] = bflo(w.y); f[3] = bfhi(w.y); f[4] = bflo(w.z); f[5] = bfhi(w.z); f[6] = bflo(w.w); f[7] = bfhi(w.w); }
__device__ __forceinline__ u32x4 pack8(const float* f) { u32x4 w; w.x = pk2(f[0], f[1]); w.y = pk2(f[2], f[3]); w.z = pk2(f[4], f[5]); w.w = pk2(f[6], f[7]); return w; }
__device__ __forceinline__ float wave_sum(float v) {
#pragma unroll
  for (int o = 1; o < 64; o <<= 1) v += __shfl_xor(v, o);
  return v;
}
__device__ __forceinline__ float ex2(float x) { return __builtin_amdgcn_exp2f(x); }
__device__ __forceinline__ float rcpf_(float x) { return __builtin_amdgcn_rcpf(x); }
__device__ __forceinline__ float sigmoidf_(float x) { return rcpf_(1.f + __expf(-x)); }
__device__ __forceinline__ float lse0_(float x) { return __logf(1.f + __expf(-fabsf(x))); }
__device__ __forceinline__ float log_sigmoidf_(float x) { return fminf(x, 0.f) - lse0_(x); }
__device__ __forceinline__ float log_sigmoid_acc(float x) { return fminf(x, 0.f) - log1pf(__expf(-fabsf(x))); }
__device__ __forceinline__ float softplusf_(float x) { return fmaxf(x, 0.f) + lse0_(x); }
__device__ __forceinline__ float tanhf_(float x) { return 1.f - 2.f * rcpf_(1.f + __expf(2.f * x)); }
__device__ __forceinline__ float gelu_tanh(float x) { return 0.5f * x * (1.f + tanhf_(0.7978845608028654f * (x + 0.044715f * x * x * x))); }
#define WAVE_LDS_FENCE() asm volatile("s_waitcnt lgkmcnt(0)" ::: "memory")
#define LDS_BARRIER() asm volatile("s_waitcnt lgkmcnt(0)\n\ts_barrier" ::: "memory")
#define MFMA16(a, b, c) __builtin_amdgcn_mfma_f32_16x16x32_bf16((a), (b), (c), 0, 0, 0)

struct Params { const float* in[40]; float* out; unsigned char* ws; int ph_lo, ph_hi; };

struct EpiIn {
  static constexpr bool PERM = true, AFTER_DRAIN = false;
  bf16* proj; bf16* foxvT; bf16* retkT; bf16* retvT; const float* rot;
  __device__ __forceinline__ void operator()(const f32x4 (&acc)[2][2][4][2], const pg8::Unit& u, int wr, int wc, int fr, int fq) const {
    const int pn = u.pn;
    const bool rotary = (pn == 3) || (pn == 9);
    const float sc = (pn == 9) ? 0.125f : 1.f;
    bf16* tdst = pn == 9 ? retkT : pn == 11 ? foxvT : pn == 12 ? retvT : nullptr;
    const bool rowmajor = pn <= 10;
#pragma unroll
    for (int ai = 0; ai < 2; ++ai)
#pragma unroll
      for (int m = 0; m < 4; ++m) {
        const int row = u.pm * 256 + ai * 128 + wr * 64 + m * 16 + fr; const int pos = row & (SEQ - 1), b = row >> 12;
#pragma unroll
        for (int bj = 0; bj < 2; ++bj) {
          const int c0 = bj * 128 + wc * 32 + 8 * fq;
          float v[8];
#pragma unroll
          for (int e = 0; e < 4; ++e) { v[e] = acc[ai][bj][m][0][e]; v[4 + e] = acc[ai][bj][m][1][e]; }
          if (rotary) {
            const int i0 = (c0 & 63) >> 1;
            const f32x4 r0 = *(const f32x4*)(rot + ((size_t)pos * 32 + i0) * 2), r1 = *(const f32x4*)(rot + ((size_t)pos * 32 + i0 + 2) * 2);
            const float cs[4] = {r0[0], r0[2], r1[0], r1[2]}, sn[4] = {r0[1], r0[3], r1[1], r1[3]};
#pragma unroll
            for (int p = 0; p < 4; ++p) { const float x1 = v[2 * p], x2 = v[2 * p + 1]; v[2 * p] = x1 * cs[p] - x2 * sn[p]; v[2 * p + 1] = x1 * sn[p] + x2 * cs[p]; }
          }
#pragma unroll
          for (int e = 0; e < 8; ++e) v[e] *= sc;
          const u32x4 w = pack8(v);
          if (rowmajor) *(u32x4*)(proj + (size_t)row * PW + pn * 256 + c0) = w;
          if (tdst) {
            const int hh = c0 >> 6, d0 = c0 & 63; bf16* tp = tdst + ((size_t)((b * 4 + hh) * 64 + d0)) * SEQ + pos;
            const unsigned ww[4] = {w.x, w.y, w.z, w.w};
#pragma unroll
            for (int e = 0; e < 8; ++e) tp[(size_t)e * SEQ] = (bf16)((e & 1) ? (ww[e >> 1] >> 16) : (ww[e >> 1] & 0xffffu));
          }
        }
      }
  }
};
struct EpiPlain {
  static constexpr bool PERM = true, AFTER_DRAIN = false;
  bf16* O; int ldc; int act; float* ss;
  __device__ __forceinline__ void operator()(const f32x4 (&acc)[2][2][4][2], const pg8::Unit& u, int wr, int wc, int fr, int fq) const {
#pragma unroll
    for (int ai = 0; ai < 2; ++ai)
#pragma unroll
      for (int m = 0; m < 4; ++m) {
        const int row = u.pm * 256 + ai * 128 + wr * 64 + m * 16 + fr; float s = 0.f;
#pragma unroll
        for (int bj = 0; bj < 2; ++bj) {
          const int c0 = u.pn * 256 + bj * 128 + wc * 32 + 8 * fq;
          float v[8];
#pragma unroll
          for (int e = 0; e < 4; ++e) { v[e] = acc[ai][bj][m][0][e]; v[4 + e] = acc[ai][bj][m][1][e]; }
          if (act == 1) {
#pragma unroll
            for (int e = 0; e < 8; ++e) { const float r = fmaxf(v[e], 0.f); v[e] = r * r; }
          }
#pragma unroll
          for (int e = 0; e < 8; ++e) s += v[e] * v[e];
          *(u32x4*)(O + (size_t)row * ldc + c0) = pack8(v);
        }
        if (ss) { s += __shfl_xor(s, 16); s += __shfl_xor(s, 32); if (fq == 0) atomicAdd(ss + row, s); }
      }
  }
};
struct EpiMem {
  static constexpr bool PERM = true, AFTER_DRAIN = false;
  bf16* kmem; bf16* vmemT;
  __device__ __forceinline__ void operator()(const f32x4 (&acc)[2][2][4][2], const pg8::Unit& u, int wr, int wc, int fr, int fq) const {
    const int layer = u.pm >> 2, pt = u.pn & 7; const bool isv = pt >= 4; const int head = pt & 3;
#pragma unroll
    for (int ai = 0; ai < 2; ++ai)
#pragma unroll
      for (int m = 0; m < 4; ++m) {
        const int rowl = (u.pm & 3) * 256 + ai * 128 + wr * 64 + m * 16 + fr;
#pragma unroll
        for (int bj = 0; bj < 2; ++bj) {
          const int c0 = bj * 128 + wc * 32 + 8 * fq;
          float v[8];
#pragma unroll
          for (int e = 0; e < 4; ++e) { v[e] = acc[ai][bj][m][0][e]; v[4 + e] = acc[ai][bj][m][1][e]; }
          const u32x4 w = pack8(v);
          if (!isv) *(u32x4*)(kmem + ((size_t)layer * 1024 + rowl) * 1024 + head * 256 + c0) = w;
          else {
            const int b = rowl >> 8, key = rowl & 255; bf16* tp = vmemT + ((size_t)(((layer * 4 + b) * 4 + head) * 256 + c0)) * 256 + key;
            const unsigned ww[4] = {w.x, w.y, w.z, w.w};
#pragma unroll
            for (int e = 0; e < 8; ++e) tp[(size_t)e * 256] = (bf16)((e & 1) ? (ww[e >> 1] >> 16) : (ww[e >> 1] & 0xffffu));
          }
        }
      }
  }
};
struct MemSched {
  int G, c;
  __device__ bool next(int i, pg8::Unit& u) const { const int L = i * G + c; if (c < 0 || L >= 64) return false; const int layer = L >> 5, r = L & 31; u.pm = layer * 4 + (r & 3); u.pn = layer * 8 + (r >> 2); return true; }
  __device__ __forceinline__ void a_ready(const pg8::Unit&) const {}
  __device__ __forceinline__ void done(const pg8::Unit&) const {}
};

template <int MAP> __device__ __forceinline__ int src_col(int n) {
  if (MAP == 0) return n;
  const int tile = n >> 8, j = n & 255; int jj = j;
  if (tile == 3 || tile == 9) { const int hh = j >> 6, l = j & 63; jj = hh * 64 + (l >> 1) + 32 * (l & 1); }
  return kSrcCol[tile] + jj;
}
template <int MAP> __device__ __forceinline__ void conv_item(const float* __restrict__ W, int K, int Nsrc, int N, bf16* WT, float* scr, int item, int lane) {
  const int nblk = N / 32, kb = item / nblk, nb = item % nblk, k0 = 64 * kb, n0 = 32 * nb;
  const int sc = src_col<MAP>(n0 + (lane & 31));
#pragma unroll 8
  for (int i = 0; i < 32; ++i) { const int kk = 2 * i + (lane >> 5); scr[kk * 33 + (lane & 31)] = W[(size_t)(k0 + kk) * Nsrc + sc]; }
  WAVE_LDS_FENCE();
  const int c = lane & 7;
#pragma unroll
  for (int j = 0; j < 4; ++j) { const int n = (lane >> 3) + 8 * j; const float* s = scr + (8 * c) * 33 + n;
    u32x4 o; o.x = pk2(s[0 * 33], s[1 * 33]); o.y = pk2(s[2 * 33], s[3 * 33]); o.z = pk2(s[4 * 33], s[5 * 33]); o.w = pk2(s[6 * 33], s[7 * 33]);
    *(u32x4*)(WT + (size_t)(n0 + n) * K + k0 + 8 * c) = o; }
  WAVE_LDS_FENCE();
}
__device__ __forceinline__ void conv_layer_weights(const Params& p, int l, float* scr, int gw, int NGW, int lane) {
  asm volatile("" ::: "memory");
  asm volatile("" : "+v"(lane));
  unsigned char* ws = p.ws;
  constexpr int I_IN = (D / 64) * (NIN / 32), I_SQ = (D / 64) * (D / 32), I_1 = (D / 64) * (DFF / 32), I_2 = (DFF / 64) * (D / 32);
  constexpr int I_W2 = 1 * 8, I_A2 = 8, I_G2 = 2 * 8, I_V1 = 4 * 1, I_V2 = 8  , I_R = 2 * 4 * 2;
  constexpr int NIT = I_IN + 3 * I_SQ + I_1 + I_2 + I_W2 + I_A2 + I_G2 + I_V1 + I_R;
  for (int it = gw; it < NIT; it += NGW) {
    int r = it;
    if (r < I_IN) { conv_item<1>(p.in[9] + (size_t)l * D * INW, D, INW, NIN, (bf16*)(ws + W_IN), scr, r, lane); continue; } r -= I_IN;
    if (r < I_SQ) { conv_item<0>(p.in[10] + (size_t)l * D * D, D, D, D, (bf16*)(ws + W_OUT), scr, r, lane); continue; } r -= I_SQ;
    if (r < I_SQ) { conv_item<0>(p.in[34] + (size_t)l * D * D, D, D, D, (bf16*)(ws + W_Q), scr, r, lane); continue; } r -= I_SQ;
    if (r < I_SQ) { conv_item<0>(p.in[37] + (size_t)l * D * D, D, D, D, (bf16*)(ws + W_O), scr, r, lane); continue; } r -= I_SQ;
    if (r < I_1) { conv_item<0>(p.in[38] + (size_t)l * D * DFF, D, DFF, DFF, (bf16*)(ws + W_1), scr, r, lane); continue; } r -= I_1;
    if (r < I_2) { conv_item<0>(p.in[39] + (size_t)l * DFF * D, DFF, D, D, (bf16*)(ws + W_2), scr, r, lane); continue; } r -= I_2;
    if (r < I_W2) { conv_item<0>(p.in[21] + (size_t)l * 64 * G, 64, G, G, (bf16*)(ws + WS_W2T), scr, r, lane); continue; } r -= I_W2;
    if (r < I_A2) { conv_item<0>(p.in[23] + (size_t)l * 64 * G, 64, G, G, (bf16*)(ws + WS_A2T), scr, r, lane); continue; } r -= I_A2;
    if (r < I_G2) { conv_item<0>(p.in[24] + (size_t)l * 128 * G, 128, G, G, (bf16*)(ws + WS_G2T), scr, r, lane); continue; } r -= I_G2;
    if (r < I_V1) { if (l > 0) conv_item<0>(p.in[31] + (size_t)(l - 1) * G * 32, G, 32, 32, (bf16*)(ws + WS_V1T), scr, r, lane); continue; } r -= I_V1;
    { const int gate = r >> 3, hh = (r >> 1) & 3, nb = r & 1;
      conv_item<0>(p.in[gate ? 16 : 14] + ((size_t)l * GH + hh) * HD * HD, 64, 64, 64, (bf16*)(ws + (gate ? WS_RIT : WS_RAT)) + hh * 4096, scr, nb, lane); }
  }
  if (l > 0) { const float* v2 = p.in[32] + (size_t)(l - 1) * 32 * G; bf16* v2t = (bf16*)(ws + WS_V2T);
    for (int e = gw * 64 + lane; e < 32 * G; e += NGW * 64) { const int k = e / G, n = e % G; v2t[n * 32 + k] = (bf16)f2bf(v2[e]); } }
}

struct RowArgs { const float* xin; const bf16* O; float* ss; const float* g_post; float* xout; const float* g_pre; bf16* hout; const float* wf; const float* fbias; float* logf; int rows; };
__device__ __forceinline__ void row_phase(const RowArgs& a, int gw, int NGW, int lane) {
  asm volatile("" ::: "memory");
  asm volatile("" : "+v"(lane));
  f32x4 gp[4], gq[4], wfv[4][4];
#pragma unroll
  for (int j = 0; j < 4; ++j) {
    gp[j] = a.O ? ((const f32x4*)a.g_post)[lane + 64 * j] : (f32x4){0.f, 0.f, 0.f, 0.f};
    gq[j] = a.hout ? ((const f32x4*)a.g_pre)[lane + 64 * j] : (f32x4){0.f, 0.f, 0.f, 0.f};
#pragma unroll
    for (int e = 0; e < 4; ++e) {
      const f32x4 t = a.wf ? *(const f32x4*)(a.wf + (size_t)(4 * (lane + 64 * j) + e) * INW + 768) : (f32x4){0.f, 0.f, 0.f, 0.f};
#pragma unroll
      for (int hh = 0; hh < 4; ++hh) wfv[j][hh][e] = t[hh]; }
  }
  for (int row0 = gw; row0 < a.rows; row0 += 2 * NGW) {
    const int rowv[2] = {row0, row0 + NGW}; const bool val[2] = {true, row0 + NGW < a.rows};
    f32x4 x[2][4]; float ov[2][4][4];
#pragma unroll
    for (int r = 0; r < 2; ++r) if (val[r]) {
#pragma unroll
      for (int j = 0; j < 4; ++j) x[r][j] = ((const f32x4*)(a.xin + (size_t)rowv[r] * D))[lane + 64 * j];
      if (a.O) {
#pragma unroll
        for (int j = 0; j < 4; ++j) { const u32x2 o = ((const u32x2*)(a.O + (size_t)rowv[r] * D))[lane + 64 * j];
          ov[r][j][0] = bflo(o.x); ov[r][j][1] = bfhi(o.x); ov[r][j][2] = bflo(o.y); ov[r][j][3] = bfhi(o.y); }
      }
    }
#pragma unroll
    for (int r = 0; r < 2; ++r) if (val[r]) {
      const int row = rowv[r];
      if (a.O) {
        float so = 0.f;
#pragma unroll
        for (int j = 0; j < 4; ++j) so += ov[r][j][0] * ov[r][j][0] + ov[r][j][1] * ov[r][j][1] + ov[r][j][2] * ov[r][j][2] + ov[r][j][3] * ov[r][j][3];
        so = wave_sum(so);
        const float rs = rsqrtf(so * (1.f / D) + EPS);
#pragma unroll
        for (int j = 0; j < 4; ++j)
#pragma unroll
          for (int e = 0; e < 4; ++e) x[r][j][e] += ov[r][j][e] * rs * gp[j][e];
      }
      if (a.xout) {
#pragma unroll
        for (int j = 0; j < 4; ++j) ((f32x4*)(a.xout + (size_t)row * D))[lane + 64 * j] = x[r][j];
      }
      if (a.hout) {
        float s = 0.f;
#pragma unroll
        for (int j = 0; j < 4; ++j) s += x[r][j][0] * x[r][j][0] + x[r][j][1] * x[r][j][1] + x[r][j][2] * x[r][j][2] + x[r][j][3] * x[r][j][3];
        s = wave_sum(s); const float rs2 = rsqrtf(s * (1.f / D) + EPS);
        float fd[4] = {0.f, 0.f, 0.f, 0.f};
#pragma unroll
        for (int j = 0; j < 4; ++j) {
          f32x4 hv;
#pragma unroll
          for (int e = 0; e < 4; ++e) hv[e] = x[r][j][e] * rs2 * gq[j][e];
          u32x2 o; o.x = pk2(hv[0], hv[1]); o.y = pk2(hv[2], hv[3]);
          ((u32x2*)(a.hout + (size_t)row * D))[lane + 64 * j] = o;
          if (a.wf) {
#pragma unroll
            for (int hh = 0; hh < 4; ++hh) fd[hh] += hv[0] * wfv[j][hh][0] + hv[1] * wfv[j][hh][1] + hv[2] * wfv[j][hh][2] + hv[3] * wfv[j][hh][3];
          }
        }
        if (a.wf) {
#pragma unroll
          for (int hh = 0; hh < 4; ++hh) fd[hh] = wave_sum(fd[hh]);
          if (lane < 4) { const float f = lane == 0 ? fd[0] : lane == 1 ? fd[1] : lane == 2 ? fd[2] : fd[3]; a.logf[(size_t)row * 4 + lane] = log_sigmoidf_(f + a.fbias[lane]); }
        }
      }
    }
  }
}

__device__ __forceinline__ void lerp8(const bf16* __restrict__ proj, const float* __restrict__ mu, int tok, int col, int mucol, float* out) {
  const u32x4 c = *(const u32x4*)(proj + (size_t)tok * PW + col);
  u32x4 pv = {0u, 0u, 0u, 0u};
  if ((tok & (SEQ - 1)) != 0) pv = *(const u32x4*)(proj + (size_t)(tok - 1) * PW + col);
  float cf[8], pf[8]; unpack8(c, cf); unpack8(pv, pf);
  const f32x4 m0 = *(const f32x4*)(mu + mucol), m1 = *(const f32x4*)(mu + mucol + 4);
#pragma unroll
  for (int e = 0; e < 4; ++e) { out[e] = cf[e] + (pf[e] - cf[e]) * m0[e]; out[4 + e] = cf[4 + e] + (pf[4 + e] - cf[4 + e]) * m1[e]; }
}
__device__ __forceinline__ bf16x8 pack_frag(const float* f) { const u32x4 w = pack8(f); return __builtin_bit_cast(bf16x8, w); }
constexpr int WLP = 260;
__device__ __forceinline__ void acc_to_lds(float* wl, const f32x4* acc, int ntiles, int li, int g) {
#pragma unroll
  for (int nt = 0; nt < 16; ++nt) if (nt < ntiles) {
#pragma unroll
    for (int j = 0; j < 4; ++j) wl[(4 * g + j) * WLP + nt * 16 + li] = acc[nt][j];
  }
}
template <int KS> __device__ __forceinline__ void mm16_to_lds(const bf16x8* af, const bf16* __restrict__ wt, int ldw, float* wl, int li, int g) {
#pragma unroll 1
  for (int ng = 0; ng < 4; ++ng) {
    f32x4 a4[4];
#pragma unroll
    for (int n4 = 0; n4 < 4; ++n4) { a4[n4] = (f32x4){0.f, 0.f, 0.f, 0.f};
#pragma unroll
      for (int ks = 0; ks < KS; ++ks) { const bf16x8 bfr = *(const bf16x8*)(wt + (size_t)((ng * 4 + n4) * 16 + li) * ldw + ks * 32 + 8 * g); a4[n4] = MFMA16(af[ks], bfr, a4[n4]); } }
#pragma unroll
    for (int n4 = 0; n4 < 4; ++n4)
#pragma unroll
      for (int j = 0; j < 4; ++j) wl[(4 * g + j) * WLP + (ng * 4 + n4) * 16 + li] = a4[n4][j];
  }
}
__device__ __forceinline__ void rwkv_prep_unit(const Params& p, int l, int unit, int pass, float* wl, int lane) {
  asm volatile("" ::: "memory");
  asm volatile("" : "+v"(lane));
  unsigned char* ws = p.ws;
  const bf16* proj = (const bf16*)(ws + WS_P);
  const float* mu = p.in[19] + (size_t)l * 1024;
  const int li = lane & 15, g = lane >> 4, t0 = unit * 16, ta = t0 + li;
  const int tl = t0 + (lane >> 2), cgp = lane & 3;
  if (pass == 0) {
    bf16x8 af[2];
#pragma unroll
    for (int ks = 0; ks < 2; ++ks) { float f[8]; lerp8(proj, mu, ta, C_RWX + ks * 32 + 8 * g, 768 + ks * 32 + 8 * g, f);
#pragma unroll
      for (int e = 0; e < 8; ++e) f[e] = tanhf_(f[e]);
      af[ks] = pack_frag(f); }
    mm16_to_lds<2>(af, (const bf16*)(ws + WS_W2T), 64, wl, li, g); WAVE_LDS_FENCE();
    const float* w0 = p.in[20] + (size_t)l * G;
#pragma unroll 2
    for (int i = 0; i < 8; ++i) { int col = cgp * 8 + 32 * i; asm volatile("" : "+v"(col)); float r[8], ev[8], wr[8];
      lerp8(proj, mu, tl, C_RWR + col, col, r);
#pragma unroll
      for (int e = 0; e < 8; ++e) { const float wa = wl[(lane >> 2) * WLP + col + e] + w0[col + e]; const float wlog = -softplusf_(-wa) - 0.5f; const float ee = __expf(wlog); ev[e] = ee; wr[e] = __expf(-ee) * r[e]; }
      *(u32x4*)((bf16*)(ws + WS_RW) + rw_off(tl, 0, col)) = pack8(ev); *(u32x4*)((bf16*)(ws + WS_RW) + rw_off(tl, 1, col)) = pack8(wr); }
    WAVE_LDS_FENCE();
  }
  if (pass == 1) {
    bf16x8 af[2];
#pragma unroll
    for (int ks = 0; ks < 2; ++ks) { float f[8]; lerp8(proj, mu, ta, C_RWX + 64 + ks * 32 + 8 * g, 832 + ks * 32 + 8 * g, f); af[ks] = pack_frag(f); }
    mm16_to_lds<2>(af, (const bf16*)(ws + WS_A2T), 64, wl, li, g); WAVE_LDS_FENCE();
    const float* a0 = p.in[22] + (size_t)l * G; const float* k_k = p.in[25] + (size_t)l * G; const float* k_a = p.in[26] + (size_t)l * G; const float* r_k = p.in[27] + (size_t)l * G;
#pragma unroll 1
    for (int hh = 0; hh < 4; ++hh) {
      float av[2][8], kv[2][8], kk[2][8]; float ssq = 0.f;
#pragma unroll
      for (int ii = 0; ii < 2; ++ii) { int col = cgp * 8 + 32 * (2 * hh + ii); asm volatile("" : "+v"(col));
        lerp8(proj, mu, tl, C_RWK + col, 256 + col, kv[ii]);
#pragma unroll
        for (int e = 0; e < 8; ++e) { av[ii][e] = sigmoidf_(a0[col + e] + wl[(lane >> 2) * WLP + col + e]); kk[ii][e] = kv[ii][e] * k_k[col + e]; ssq += kk[ii][e] * kk[ii][e]; } }
      ssq += __shfl_xor(ssq, 1); ssq += __shfl_xor(ssq, 2);
      const float inv = 1.f / fmaxf(sqrtf(ssq), 1e-12f);
      float sbr = 0.f, skr = 0.f, srk = 0.f;
#pragma unroll
      for (int ii = 0; ii < 2; ++ii) { int col = cgp * 8 + 32 * (2 * hh + ii); asm volatile("" : "+v"(col)); float r[8], Av[8], Bv[8], k2[8];
        lerp8(proj, mu, tl, C_RWR + col, col, r);
#pragma unroll
        for (int e = 0; e < 8; ++e) { const float kn = kk[ii][e] * inv; Av[e] = -kn; Bv[e] = kn * av[ii][e]; k2[e] = kv[ii][e] * (1.f + (av[ii][e] - 1.f) * k_a[col + e]);
          const float rb = r[e]; sbr += Bv[e] * rb; skr += k2[e] * rb; srk += rb * k2[e] * r_k[col + e]; }
        *(u32x4*)((bf16*)(ws + WS_RW) + rw_off(tl, 2, col)) = pack8(Av); *(u32x4*)((bf16*)(ws + WS_RW) + rw_off(tl, 3, col)) = pack8(Bv); *(u32x4*)((bf16*)(ws + WS_RW) + rw_off(tl, 4, col)) = pack8(k2); }
      sbr += __shfl_xor(sbr, 1); sbr += __shfl_xor(sbr, 2); skr += __shfl_xor(skr, 1); skr += __shfl_xor(skr, 2); srk += __shfl_xor(srk, 1); srk += __shfl_xor(srk, 2);
      if (cgp == 0) { ((float*)(ws + SM_BR))[(size_t)tl * 4 + hh] = sbr; ((float*)(ws + SM_KR))[(size_t)tl * 4 + hh] = skr; ((float*)(ws + SM_RK))[(size_t)tl * 4 + hh] = srk; }
    }
    WAVE_LDS_FENCE();
  }
  if (pass == 2) {
    bf16x8 af[4];
#pragma unroll
    for (int ks = 0; ks < 4; ++ks) { float f[8]; lerp8(proj, mu, ta, C_RWX + 128 + ks * 32 + 8 * g, 896 + ks * 32 + 8 * g, f);
#pragma unroll
      for (int e = 0; e < 8; ++e) f[e] = sigmoidf_(f[e]);
      af[ks] = pack_frag(f); }
    mm16_to_lds<4>(af, (const bf16*)(ws + WS_G2T), 128, wl, li, g); WAVE_LDS_FENCE();
#pragma unroll 2
    for (int i = 0; i < 8; ++i) { int col = cgp * 8 + 32 * i; asm volatile("" : "+v"(col)); float gv[8];
#pragma unroll
      for (int e = 0; e < 8; ++e) gv[e] = wl[(lane >> 2) * WLP + col + e];
      *(u32x4*)((bf16*)(ws + RW_G) + (size_t)tl * G + col) = pack8(gv); }
    WAVE_LDS_FENCE();
  }
  if (pass != 3) return;
  if (l > 0) {
    f32x4 a1[2] = {(f32x4){0.f, 0.f, 0.f, 0.f}, (f32x4){0.f, 0.f, 0.f, 0.f}};
    const bf16* v1t = (const bf16*)(ws + WS_V1T);
#pragma unroll
    for (int ks = 0; ks < 8; ++ks) { float f[8]; lerp8(proj, mu, ta, C_RWV + ks * 32 + 8 * g, 512 + ks * 32 + 8 * g, f); const bf16x8 af = pack_frag(f);
#pragma unroll
      for (int nt = 0; nt < 2; ++nt) { const bf16x8 bfr = *(const bf16x8*)(v1t + (size_t)(nt * 16 + li) * 256 + ks * 32 + 8 * g); a1[nt] = MFMA16(af, bfr, a1[nt]); } }
#pragma unroll
    for (int nt = 0; nt < 2; ++nt)
#pragma unroll
      for (int j = 0; j < 4; ++j) wl[(4 * g + j) * WLP + nt * 16 + li] = a1[nt][j];
    WAVE_LDS_FENCE();
    float f2[8];
#pragma unroll
    for (int e = 0; e < 8; ++e) f2[e] = wl[li * WLP + 8 * g + e];
    const bf16x8 af2 = pack_frag(f2);
    WAVE_LDS_FENCE();
    mm16_to_lds<1>(&af2, (const bf16*)(ws + WS_V2T), 32, wl, li, g); WAVE_LDS_FENCE();
    const float* v0 = p.in[30] + (size_t)(l - 1) * G;
#pragma unroll 2
    for (int i = 0; i < 8; ++i) { int col = cgp * 8 + 32 * i; asm volatile("" : "+v"(col)); float v[8], vf[8];
      lerp8(proj, mu, tl, C_RWV + col, 512 + col, v);
      unpack8(*(const u32x4*)((const bf16*)(ws + WS_VF) + (size_t)tl * G + col), vf);
#pragma unroll
      for (int e = 0; e < 8; ++e) v[e] = v[e] + (vf[e] - v[e]) * sigmoidf_(v0[col + e] + wl[(lane >> 2) * WLP + col + e]);
      *(u32x4*)((bf16*)(ws + RW_V) + (size_t)tl * G + col) = pack8(v); }
    WAVE_LDS_FENCE();
  } else {
#pragma unroll 2
    for (int i = 0; i < 8; ++i) { int col = cgp * 8 + 32 * i; asm volatile("" : "+v"(col)); float v[8];
      lerp8(proj, mu, tl, C_RWV + col, 512 + col, v);
      const u32x4 w = pack8(v);
      *(u32x4*)((bf16*)(ws + RW_V) + (size_t)tl * G + col) = w; *(u32x4*)((bf16*)(ws + WS_VF) + (size_t)tl * G + col) = w; }
  }
}
__device__ __forceinline__ void ret_kv_unit(const Params& p, int unit, int lane) {
  asm volatile("" ::: "memory");
  asm volatile("" : "+v"(lane));
  unsigned char* ws = p.ws;
  const int bh = unit >> 5, c = unit & 31, h = bh & 3, li = lane & 15, g = lane >> 4;
  const float lg2 = log2f(1.f - exp2f(-5.f - (float)h));
  const bf16* kT = (const bf16*)(ws + P_RETKT) + (size_t)bh * 64 * SEQ + c * 128;
  const bf16* vT = (const bf16*)(ws + P_RETVT) + (size_t)bh * 64 * SEQ + c * 128;
  f32x4 acc[4][4];
#pragma unroll
  for (int a = 0; a < 4; ++a)
#pragma unroll
    for (int b = 0; b < 4; ++b) acc[a][b] = (f32x4){0.f, 0.f, 0.f, 0.f};
#pragma unroll
  for (int ks = 0; ks < 4; ++ks) {
    float z[8];
#pragma unroll
    for (int e = 0; e < 8; ++e) z[e] = ex2(lg2 * (float)(127 - (ks * 32 + 8 * g + e)));
    bf16x8 af[4], bfr[4];
#pragma unroll
    for (int dt = 0; dt < 4; ++dt) { float f[8]; unpack8(*(const u32x4*)(kT + (size_t)(dt * 16 + li) * SEQ + ks * 32 + 8 * g), f);
#pragma unroll
      for (int e = 0; e < 8; ++e) f[e] *= z[e];
      af[dt] = pack_frag(f); }
#pragma unroll
    for (int et = 0; et < 4; ++et) bfr[et] = *(const bf16x8*)(vT + (size_t)(et * 16 + li) * SEQ + ks * 32 + 8 * g);
#pragma unroll
    for (int dt = 0; dt < 4; ++dt)
#pragma unroll
      for (int et = 0; et < 4; ++et) acc[dt][et] = MFMA16(af[dt], bfr[et], acc[dt][et]);
  }
  float* KV = (float*)(ws + P_RETKV) + (size_t)unit * 4096;
#pragma unroll
  for (int dt = 0; dt < 4; ++dt)
#pragma unroll
    for (int et = 0; et < 4; ++et)
#pragma unroll
      for (int j = 0; j < 4; ++j) KV[(dt * 16 + 4 * g + j) * 64 + et * 16 + li] = acc[dt][et][j];
}
__device__ __forceinline__ void fox_cum_unit(const Params& p, int bh, int lane) {
  asm volatile("" ::: "memory");
  asm volatile("" : "+v"(lane));
  const float* logf = (const float*)(p.ws + SM_LOGF); float* cum = (float*)(p.ws + SM_CUM);
  const int b = bh >> 2, h = bh & 3; const size_t base = ((size_t)b * SEQ + lane * 64) * 4 + h;
  float s = 0.f;
#pragma unroll 16
  for (int i = 0; i < 64; ++i) s += logf[base + (size_t)i * 4];
  float incl = s;
#pragma unroll
  for (int o = 1; o < 64; o <<= 1) { const float t = __shfl_up(incl, o); if (lane >= o) incl += t; }
  float run = incl - s;
  for (int i0 = 0; i0 < 64; i0 += 16) { float t[16];
#pragma unroll
    for (int i = 0; i < 16; ++i) t[i] = logf[base + (size_t)(i0 + i) * 4];
#pragma unroll
    for (int i = 0; i < 16; ++i) { run += t[i]; cum[(size_t)bh * SEQ + lane * 64 + i0 + i] = run * LOG2E; } }
}

template <int CTRL> __device__ __forceinline__ float dpp_add(float x) {
  const int y = __builtin_amdgcn_update_dpp(0, __builtin_bit_cast(int, x), CTRL, 0xf, 0xf, true);
  return x + __builtin_bit_cast(float, y);
}
__device__ __forceinline__ float row16_sum(float x) {
  x = dpp_add<0xB1>(x); x = dpp_add<0x4E>(x); x = dpp_add<0x141>(x); x = dpp_add<0x140>(x); return x;
}
constexpr int RS_TSB = 896;
constexpr int RS_CH = 32;
constexpr int RS_BUFB = RS_CH * RS_TSB;
constexpr int RS_ROWS = 8;
constexpr int RS_YP = 40;
constexpr int RS_YBUF = RS_CH * RS_ROWS * RS_YP;
struct RsRegs { u32x4 e, a, b, k, wr, v; float br, kr; };
__device__ __forceinline__ void rs_issue(const Params& p, RsRegs& r, int b, int h, int rq, int c, int lt) {
  unsigned char* ws = p.ws;
  { const int tok = lt >> 3, ch = lt & 7; const bf16* rec = (const bf16*)(ws + WS_RW) + ((size_t)((b * 4 + h) * SEQ + c * RS_CH + tok)) * RW_REC + ch * 8;
    r.e = *(const u32x4*)(rec); r.wr = *(const u32x4*)(rec + 64); r.a = *(const u32x4*)(rec + 128); r.b = *(const u32x4*)(rec + 192); r.k = *(const u32x4*)(rec + 256); }
  { const int t2 = lt & 31; const size_t rr = (size_t)b * SEQ + c * RS_CH + t2;
    r.v = *(const u32x4*)((const bf16*)(ws + RW_V) + rr * G + h * 64 + rq * RS_ROWS);
    r.br = ((const float*)(ws + SM_BR))[rr * 4 + h]; r.kr = ((const float*)(ws + SM_KR))[rr * 4 + h]; }
}
__device__ __forceinline__ void rs_commit(const RsRegs& r, unsigned char* buf, int lt) {
  { const int tok = lt >> 3, ch = lt & 7; unsigned char* rec = buf + tok * RS_TSB; float f[8];
    unpack8(r.e, f);
#pragma unroll
    for (int e = 0; e < 8; ++e) f[e] = ex2(-f[e] * LOG2E);
    *(f32x4*)(rec + ch * 32) = (f32x4){f[0], f[1], f[2], f[3]}; *(f32x4*)(rec + ch * 32 + 16) = (f32x4){f[4], f[5], f[6], f[7]};
    { const unsigned aw[4] = {r.a.x, r.a.y, r.a.z, r.a.w}, bw[4] = {r.b.x, r.b.y, r.b.z, r.b.w}, kw[4] = {r.k.x, r.k.y, r.k.z, r.k.w}, ww[4] = {r.wr.x, r.wr.y, r.wr.z, r.wr.w};
#pragma unroll
      for (int j = 0; j < 4; ++j) *(u32x4*)(rec + 256 + (ch * 4 + j) * 16) = (u32x4){aw[j], bw[j], kw[j], ww[j]}; } }
  if (lt < 32) { float f[8]; unpack8(r.v, f); unsigned char* rec = buf + lt * RS_TSB + 768; const float b32 = r.br * (1.f / 32.f), k32 = r.kr * (1.f / 32.f);
#pragma unroll
    for (int j = 0; j < 8; ++j) *(f32x4*)(rec + 16 * j) = (f32x4){f[j], b32, k32, 0.f}; }
}
__device__ __forceinline__ float row32_sum(float x) {
  x = row16_sum(x);
  const auto rr = __builtin_amdgcn_permlane16_swap(__builtin_bit_cast(unsigned, x), __builtin_bit_cast(unsigned, x), false, false);
  return __builtin_bit_cast(float, (unsigned)rr[0]) + __builtin_bit_cast(float, (unsigned)rr[1]);
}
__device__ __forceinline__ f32x2 bf2x(unsigned u) { return (f32x2){bflo(u), bfhi(u)}; }
__device__ __forceinline__ void rwkv_scan_unit(const Params& p, unsigned char* lds, int unit) {
  asm volatile("" ::: "memory");
  int tid = threadIdx.x; asm volatile("" : "+v"(tid)); const int wave = __builtin_amdgcn_readfirstlane(tid >> 6), lane = tid & 63;
  const int b = unit >> 5, h = (unit >> 3) & 3, rq = unit & 7;
  unsigned char* bufs = lds; bf16* ybuf = (bf16*)(lds + 2 * RS_BUFB);
  float* Y = (float*)(p.ws + RW_Y);
  constexpr int NCH = SEQ / RS_CH;
  const int lt = tid - 256;
  RsRegs rg;
  if (wave >= 4) { rs_issue(p, rg, b, h, rq, 0, lt); rs_commit(rg, bufs, lt); rs_issue(p, rg, b, h, rq, 1, lt); }
  __syncthreads();
  f32x2 S = {0.f, 0.f};
  const int seg = lane & 31, rloc = wave * 2 + (lane >> 5);
#define RS_YOUT(cc) do { const bf16* yp_ = ybuf + ((cc) & 1) * RS_YBUF + lt * RS_YP; float t_ = 0.f; \
    _Pragma("unroll") for (int j_ = 0; j_ < 4; ++j_) { float f_[8]; unpack8(*(const u32x4*)(yp_ + 8 * j_), f_); t_ += ((f_[0] + f_[1]) + (f_[2] + f_[3])) + ((f_[4] + f_[5]) + (f_[6] + f_[7])); } \
    Y[((size_t)b * SEQ + (cc) * RS_CH + (lt >> 3)) * G + h * 64 + rq * RS_ROWS + (lt & 7)] = t_; } while (0)
  for (int c = 0; c < NCH; ++c) {
    if (wave >= 4) {
      if (c + 1 < NCH) rs_commit(rg, bufs + ((c + 1) & 1) * RS_BUFB, lt);
      if (c + 2 < NCH) rs_issue(p, rg, b, h, rq, c + 2, lt);
      if (c > 0) RS_YOUT(c - 1);
    } else {
      const unsigned char* bp = bufs + (c & 1) * RS_BUFB; bf16* yb = ybuf + (c & 1) * RS_YBUF + rloc * RS_YP + seg;
      const unsigned char* pw = bp + seg * 8; const unsigned char* pa = bp + 256 + seg * 16; const unsigned char* pv = bp + 768 + rloc * 16;
      f32x2 nw = *(const f32x2*)(pw); u32x4 nq = *(const u32x4*)(pa); f32x4 nvs = *(const f32x4*)(pv);
#pragma unroll 8
      for (int s = 0; s < RS_CH; ++s) {
        const f32x2 w = nw, a = bf2x(nq.x), bb = bf2x(nq.y), kk = bf2x(nq.z), wr = bf2x(nq.w); const float v = nvs[0], br = nvs[1], kr = nvs[2];
        if (s + 1 < RS_CH) { const int o = (s + 1) * RS_TSB; nw = *(const f32x2*)(pw + o); nq = *(const u32x4*)(pa + o); nvs = *(const f32x4*)(pv + o); }
        const f32x2 pda = S * a, pdy = S * wr;
        const f32x2 vv = {v, v};
        const f32x2 u = S * w + vv * kk;
        const float t0 = v * kr + (pdy[0] + pdy[1]);
        const float da = row32_sum(pda[0] + pda[1]);
        const f32x2 dd = {da, da};
        S = dd * bb + u;
        yb[s * (RS_ROWS * RS_YP)] = (bf16)(__builtin_bit_cast(unsigned, da * br + t0) >> 16);
      }
    }
    LDS_BARRIER();
  }
  if (wave >= 4) RS_YOUT(NCH - 1);
  __syncthreads();
#undef RS_YOUT
}
__device__ __forceinline__ void rwkv_post_row(const Params& p, int l, int row, int lane) {
  asm volatile("" ::: "memory");
  asm volatile("" : "+v"(lane));
  unsigned char* ws = p.ws;
  const f32x4 y = ((const f32x4*)((const float*)(ws + RW_Y) + (size_t)row * G))[lane];
  float s = y[0] + y[1] + y[2] + y[3];
  s = row16_sum(s);
  const float mu = s * (1.f / 64.f); const f32x4 d = y - mu;
  float q = d[0] * d[0] + d[1] * d[1] + d[2] * d[2] + d[3] * d[3];
  q = row16_sum(q);
  const float rstd = rsqrtf(q * (1.f / 64.f) + 64e-5f);
  const f32x4 gw = ((const f32x4*)(p.in[28] + (size_t)l * G))[lane], gb = ((const f32x4*)(p.in[29] + (size_t)l * G))[lane];
  const u32x2 vv = ((const u32x2*)((const bf16*)(ws + RW_V) + (size_t)row * G))[lane], gg = ((const u32x2*)((const bf16*)(ws + RW_G) + (size_t)row * G))[lane];
  const float rk = ((const float*)(ws + SM_RK))[(size_t)row * 4 + (lane >> 4)];
  const float v[4] = {bflo(vv.x), bfhi(vv.x), bflo(vv.y), bfhi(vv.y)}, gt[4] = {bflo(gg.x), bfhi(gg.x), bflo(gg.y), bfhi(gg.y)};
  float o[4];
#pragma unroll
  for (int e = 0; e < 4; ++e) o[e] = (d[e] * rstd * gw[e] + gb[e] + rk * v[e]) * gt[e];
  u32x2 w; w.x = pk2(o[0], o[1]); w.y = pk2(o[2], o[3]);
  ((u32x2*)((bf16*)(ws + WS_P) + (size_t)row * PW + C_RWR))[lane] = w;
}

__device__ __forceinline__ void rwkv_post_rows2(const Params& p, int l, int row0, int row1, int lane) {
  asm volatile("" ::: "memory");
  asm volatile("" : "+v"(lane));
  unsigned char* ws = p.ws;
  const int rows[2] = {row0, row1};
  f32x4 y[2]; u32x2 vv[2], gg[2]; float rk[2];
  const f32x4 gw = ((const f32x4*)(p.in[28] + (size_t)l * G))[lane], gb = ((const f32x4*)(p.in[29] + (size_t)l * G))[lane];
#pragma unroll
  for (int r = 0; r < 2; ++r) { const size_t row = (size_t)rows[r];
    y[r] = ((const f32x4*)((const float*)(ws + RW_Y) + row * G))[lane];
    vv[r] = ((const u32x2*)((const bf16*)(ws + RW_V) + row * G))[lane]; gg[r] = ((const u32x2*)((const bf16*)(ws + RW_G) + row * G))[lane];
    rk[r] = ((const float*)(ws + SM_RK))[row * 4 + (lane >> 4)]; }
#pragma unroll
  for (int r = 0; r < 2; ++r) {
    float s = row16_sum(y[r][0] + y[r][1] + y[r][2] + y[r][3]);
    const float mu = s * (1.f / 64.f); const f32x4 d = y[r] - mu;
    const float q = row16_sum(d[0] * d[0] + d[1] * d[1] + d[2] * d[2] + d[3] * d[3]);
    const float rstd = rsqrtf(q * (1.f / 64.f) + 64e-5f);
    const float v[4] = {bflo(vv[r].x), bfhi(vv[r].x), bflo(vv[r].y), bfhi(vv[r].y)}, gt[4] = {bflo(gg[r].x), bfhi(gg[r].x), bflo(gg[r].y), bfhi(gg[r].y)};
    float o[4];
#pragma unroll
    for (int e = 0; e < 4; ++e) o[e] = (d[e] * rstd * gw[e] + gb[e] + rk[r] * v[e]) * gt[e];
    u32x2 w; w.x = pk2(o[0], o[1]); w.y = pk2(o[2], o[3]);
    ((u32x2*)((bf16*)(ws + WS_P) + (size_t)rows[r] * PW + C_RWR))[lane] = w;
  }
}

__device__ __forceinline__ void lru_unit(const Params& p, int l, float* lds, int unit) {
  asm volatile("" ::: "memory");
  unsigned char* ws = p.ws; bf16* proj = (bf16*)(ws + WS_P);
  int tid = threadIdx.x; asm volatile("" : "+v"(tid)); const int wave = __builtin_amdgcn_readfirstlane(tid >> 6), lane = tid & 63, li = lane & 15, g = lane >> 4;
  const int b = unit >> 2, h = unit & 3;
  float* XB = lds;
  float* XC = XB + 67 * 64;
  float* AA = XC + 64 * 65;
  float* UU = AA + 64 * 65;
  float* HH = UU + 64 * 65;
  bf16* XCb = (bf16*)(HH + 64 * 65);
  const float* cw = p.in[12] + (size_t)l * 4 * G + h * 64; const float* cb = p.in[13] + (size_t)l * G + h * 64;
  const float* rab = p.in[15] + (size_t)l * G + h * 64; const float* rib = p.in[17] + (size_t)l * G + h * 64; const float* lam = p.in[18] + (size_t)l * G + h * 64;
  const int mt = wave & 3, ntp = wave >> 2;
  bf16x8 br_[2][2], bi_[2][2]; float lsl[2], rb[2], ib[2];
  { const bf16* rat = (const bf16*)(ws + WS_RAT) + h * 4096; const bf16* rit = (const bf16*)(ws + WS_RIT) + h * 4096;
#pragma unroll
    for (int n = 0; n < 2; ++n) { const int col = (2 * ntp + n) * 16 + li; lsl[n] = log_sigmoid_acc(lam[col]); rb[n] = rab[col]; ib[n] = rib[col];
#pragma unroll
      for (int ks = 0; ks < 2; ++ks) { br_[n][ks] = *(const bf16x8*)(rat + col * 64 + ks * 32 + 8 * g); bi_[n][ks] = *(const bf16x8*)(rit + col * 64 + ks * 32 + 8 * g); } } }
  float hcur = 0.f;
  const int tok = tid >> 3, ch8 = (tid & 7) * 8;
  u32x4 nx0 = {0u, 0u, 0u, 0u}, nx1 = {0u, 0u, 0u, 0u}, ny;
  const int r1 = (tid + NTHREADS) >> 3;
  { const int pos0 = -3 + tok; if (pos0 >= 0) nx0 = *(const u32x4*)(proj + ((size_t)b * SEQ + pos0) * PW + C_LRUX + h * 64 + ch8);
    if (tid < 24) nx1 = *(const u32x4*)(proj + ((size_t)b * SEQ + (-3 + r1)) * PW + C_LRUX + h * 64 + ch8);
    ny = *(const u32x4*)(proj + ((size_t)b * SEQ + tok) * PW + C_LRUY + h * 64 + ch8); }
  for (int c = 0; c < SEQ / 64; ++c) {
    const int t0 = c * 64;
    { float f8[8]; unpack8(nx0, f8);
#pragma unroll
      for (int e = 0; e < 8; ++e) XB[tok * 64 + ch8 + e] = f8[e];
      if (tid < 24) { unpack8(nx1, f8);
#pragma unroll
        for (int e = 0; e < 8; ++e) XB[r1 * 64 + ch8 + e] = f8[e]; } }
    const u32x4 ycur = ny;
    if (c + 1 < SEQ / 64) { const int tn = t0 + 64;
      nx0 = *(const u32x4*)(proj + ((size_t)b * SEQ + tn - 3 + tok) * PW + C_LRUX + h * 64 + ch8);
      if (tid < 24) nx1 = *(const u32x4*)(proj + ((size_t)b * SEQ + tn - 3 + r1) * PW + C_LRUX + h * 64 + ch8);
      ny = *(const u32x4*)(proj + ((size_t)b * SEQ + tn + tok) * PW + C_LRUY + h * 64 + ch8); }
    LDS_BARRIER();
    { float xc[8];
#pragma unroll
      for (int e = 0; e < 8; ++e) { float v = cb[ch8 + e];
#pragma unroll
        for (int j = 0; j < 4; ++j) v += XB[(tok + j) * 64 + ch8 + e] * cw[j * G + ch8 + e];
        xc[e] = v; XC[tok * 65 + ch8 + e] = v; }
      *(u32x4*)(XCb + tok * 72 + ch8) = pack8(xc); }
    LDS_BARRIER();
    { bf16x8 af[2];
#pragma unroll
      for (int ks = 0; ks < 2; ++ks) af[ks] = *(const bf16x8*)(XCb + (mt * 16 + li) * 72 + ks * 32 + 8 * g);
#pragma unroll
      for (int n = 0; n < 2; ++n) { f32x4 cr = {0.f, 0.f, 0.f, 0.f}, ci = {0.f, 0.f, 0.f, 0.f};
#pragma unroll
        for (int ks = 0; ks < 2; ++ks) { cr = MFMA16(af[ks], br_[n][ks], cr); ci = MFMA16(af[ks], bi_[n][ks], ci); }
        const int col = (2 * ntp + n) * 16 + li;
#pragma unroll
        for (int j = 0; j < 4; ++j) { const int tk = mt * 16 + 4 * g + j; const float r = sigmoidf_(cr[j] + rb[n]), ig = sigmoidf_(ci[j] + ib[n]);
          const float log_a = 8.f * r * lsl[n]; const float a = __expf(log_a); const float mult = sqrtf(fmaxf(1.f - a * a, 0.f));
          AA[tk * 65 + col] = a; UU[tk * 65 + col] = mult * (ig * XC[tk * 65 + col]); } } }
    LDS_BARRIER();
    if (wave == 0) {
#pragma unroll 8
      for (int s = 0; s < 64; ++s) { hcur = AA[s * 65 + lane] * hcur + UU[s * 65 + lane]; HH[s * 65 + lane] = hcur; } }
    LDS_BARRIER();
    { bf16* yp = proj + ((size_t)b * SEQ + t0 + tok) * PW + C_LRUY + h * 64 + ch8; float y[8]; unpack8(ycur, y);
#pragma unroll
      for (int e = 0; e < 8; ++e) y[e] = HH[tok * 65 + ch8 + e] * gelu_tanh(y[e]);
      *(u32x4*)yp = pack8(y); }
  }
  __syncthreads();
}

constexpr int KS_P = 72, VS_P = 136;
constexpr int AT_KS = 0, AT_VS = 128 * KS_P * 2, AT_CS = AT_VS + 64 * VS_P * 2, AT_BUF = AT_CS + 512;
struct AtRegs { u32x4 k0, k1, v0, v1; float c; };
__device__ __forceinline__ void at_issue(AtRegs& r, const bf16* Kg  , const bf16* VTg  , const float* cumg, int tid) {
  { const int id = tid, row = id >> 3, ch = id & 7; r.k0 = *(const u32x4*)(Kg + (size_t)row * PW + ch * 8); }
  { const int id = tid + 512, row = id >> 3, ch = id & 7; r.k1 = *(const u32x4*)(Kg + (size_t)row * PW + ch * 8); }
  { const int id = tid, row = id >> 4, ch = id & 15; r.v0 = *(const u32x4*)(VTg + (size_t)row * SEQ + ch * 8); }
  { const int id = tid + 512, row = id >> 4, ch = id & 15; r.v1 = *(const u32x4*)(VTg + (size_t)row * SEQ + ch * 8); }
  r.c = (cumg && tid < 128) ? -cumg[tid] : 0.f;
}
__device__ __forceinline__ void at_commit(const AtRegs& r, unsigned char* buf, int tid) {
  bf16* Ks = (bf16*)(buf + AT_KS); bf16* Vs = (bf16*)(buf + AT_VS); float* Cs = (float*)(buf + AT_CS);
  { const int id = tid, row = id >> 3, ch = id & 7; *(u32x4*)(Ks + row * KS_P + ch * 8) = r.k0; }
  { const int id = tid + 512, row = id >> 3, ch = id & 7; *(u32x4*)(Ks + row * KS_P + ch * 8) = r.k1; }
  { const int id = tid, row = id >> 4, ch = id & 15; *(u32x4*)(Vs + row * VS_P + ch * 8) = r.v0; }
  { const int id = tid + 512, row = id >> 4, ch = id & 15; *(u32x4*)(Vs + row * VS_P + ch * 8) = r.v1; }
  if (tid < 128) Cs[tid] = r.c;
}
__device__ __forceinline__ bf16x8 vfrag(const bf16* Vs, int d, int key0, int g) {
  const u32x2 lo = *(const u32x2*)(Vs + d * VS_P + key0 + 4 * g), hi = *(const u32x2*)(Vs + d * VS_P + key0 + 16 + 4 * g);
  const u32x4 w = {lo.x, lo.y, hi.x, hi.y}; return __builtin_bit_cast(bf16x8, w);
}
__device__ __forceinline__ float grp4_max(float x) {
  const auto a = __builtin_amdgcn_permlane16_swap(__builtin_bit_cast(unsigned, x), __builtin_bit_cast(unsigned, x), false, false);
  x = fmaxf(__builtin_bit_cast(float, (unsigned)a[0]), __builtin_bit_cast(float, (unsigned)a[1]));
  const auto b = __builtin_amdgcn_permlane32_swap(__builtin_bit_cast(unsigned, x), __builtin_bit_cast(unsigned, x), false, false);
  return fmaxf(__builtin_bit_cast(float, (unsigned)b[0]), __builtin_bit_cast(float, (unsigned)b[1]));
}
__device__ __forceinline__ float grp4_sum(float x) {
  const auto a = __builtin_amdgcn_permlane16_swap(__builtin_bit_cast(unsigned, x), __builtin_bit_cast(unsigned, x), false, false);
  x = __builtin_bit_cast(float, (unsigned)a[0]) + __builtin_bit_cast(float, (unsigned)a[1]);
  const auto b = __builtin_amdgcn_permlane32_swap(__builtin_bit_cast(unsigned, x), __builtin_bit_cast(unsigned, x), false, false);
  return __builtin_bit_cast(float, (unsigned)b[0]) + __builtin_bit_cast(float, (unsigned)b[1]);
}
__device__ __forceinline__ void fox_unit(const Params& p, unsigned char* lds, int b, int h, int qb) {
  asm volatile("" ::: "memory");
  unsigned char* ws = p.ws; bf16* proj = (bf16*)(ws + WS_P);
  int tid = threadIdx.x; asm volatile("" : "+v"(tid)); const int wave = __builtin_amdgcn_readfirstlane(tid >> 6), lane = tid & 63, li = lane & 15, g = lane >> 4;
  const int bh = b * 4 + h; const int qrel = wave * 16 + li; const size_t qrow = (size_t)b * SEQ + qb * 128 + qrel;
  const float* cum = (const float*)(ws + SM_CUM) + (size_t)bh * SEQ;
  const bf16* Kbase = proj + (size_t)b * SEQ * PW + C_FOXK + h * 64; const bf16* VTbase = (const bf16*)(ws + P_FOXVT) + (size_t)bh * 64 * SEQ;
  bf16x8 qf[2];
#pragma unroll
  for (int ks = 0; ks < 2; ++ks) qf[ks] = *(const bf16x8*)(proj + qrow * PW + C_FOXQ + h * 64 + ks * 32 + 8 * g);
  const float SC = 0.125f * LOG2E;
  f32x4 o[4];
#pragma unroll
  for (int dt = 0; dt < 4; ++dt) o[dt] = (f32x4){0.f, 0.f, 0.f, 0.f};
  float m = -INFINITY, lsum = 0.f;
  AtRegs rg; at_issue(rg, Kbase, VTbase, cum, tid);
  __syncthreads();
  at_commit(rg, lds, tid);
  if (qb > 0) at_issue(rg, Kbase + (size_t)128 * PW, VTbase + 128, cum + 128, tid);
  LDS_BARRIER();
  for (int kb = 0; kb <= qb; ++kb) {
    unsigned char* buf = lds + (kb & 1) * AT_BUF; const bf16* Ks = (const bf16*)(buf + AT_KS); const bf16* Vs = (const bf16*)(buf + AT_VS); const float* Cs = (const float*)(buf + AT_CS);
    const bool diag = kb == qb; const int nst = diag ? (wave >> 1) + 1 : 4;
    for (int st = 0; st < nst; ++st) {
      f32x4 s0 = {0.f, 0.f, 0.f, 0.f}, s1 = {0.f, 0.f, 0.f, 0.f};
#pragma unroll
      for (int ks = 0; ks < 2; ++ks) { const bf16x8 a0 = *(const bf16x8*)(Ks + (st * 32 + li) * KS_P + ks * 32 + 8 * g), a1 = *(const bf16x8*)(Ks + (st * 32 + 16 + li) * KS_P + ks * 32 + 8 * g);
        s0 = MFMA16(a0, qf[ks], s0); s1 = MFMA16(a1, qf[ks], s1); }
      const f32x4 c0 = *(const f32x4*)(Cs + st * 32 + 4 * g), c1 = *(const f32x4*)(Cs + st * 32 + 16 + 4 * g);
      float x[8];
#pragma unroll
      for (int j = 0; j < 4; ++j) { x[j] = s0[j] * SC + c0[j]; x[4 + j] = s1[j] * SC + c1[j]; }
      if (diag) {
#pragma unroll
        for (int j = 0; j < 4; ++j) { if (st * 32 + 4 * g + j > qrel) x[j] = -INFINITY; if (st * 32 + 16 + 4 * g + j > qrel) x[4 + j] = -INFINITY; }
      }
      float mx = fmaxf(fmaxf(fmaxf(x[0], x[1]), fmaxf(x[2], x[3])), fmaxf(fmaxf(x[4], x[5]), fmaxf(x[6], x[7])));
      mx = grp4_max(mx);
      const float mn = fmaxf(m, mx);
      const bool grew = __any(mn > m);
      float ps = 0.f;
#pragma unroll
      for (int j = 0; j < 8; ++j) { x[j] = ex2(x[j] - mn); ps += x[j]; }
      if (grew) { const float f = ex2(m - mn); lsum *= f;
#pragma unroll
        for (int dt = 0; dt < 4; ++dt) o[dt] = o[dt] * f;
        m = mn; }
      lsum += ps;
      const bf16x8 pb = pack_frag(x);
#pragma unroll
      for (int dt = 0; dt < 4; ++dt) o[dt] = MFMA16(vfrag(Vs, dt * 16 + li, st * 32, g), pb, o[dt]);
    }
    if (kb < qb) {
      at_commit(rg, lds + ((kb + 1) & 1) * AT_BUF, tid);
      if (kb + 2 <= qb) at_issue(rg, Kbase + (size_t)(kb + 2) * 128 * PW, VTbase + (kb + 2) * 128, cum + (kb + 2) * 128, tid);
      LDS_BARRIER();
    }
  }
  lsum = grp4_sum(lsum);
  const float inv = 1.f / lsum;
#pragma unroll
  for (int dt = 0; dt < 4; ++dt) { u32x2 w; w.x = pk2(o[dt][0] * inv, o[dt][1] * inv); w.y = pk2(o[dt][2] * inv, o[dt][3] * inv);
    *(u32x2*)(proj + qrow * PW + C_FOXQ + h * 64 + dt * 16 + 4 * g) = w; }
}
__device__ __forceinline__ void ret_unit(const Params& p, int l, unsigned char* lds, int b, int h, int c) {
  asm volatile("" ::: "memory");
  unsigned char* ws = p.ws; bf16* proj = (bf16*)(ws + WS_P);
  int tid = threadIdx.x; asm volatile("" : "+v"(tid)); const int wave = __builtin_amdgcn_readfirstlane(tid >> 6), lane = tid & 63, li = lane & 15, g = lane >> 4;
  const int bh = b * 4 + h; const int nrel = wave * 16 + li; const size_t qrow = (size_t)b * SEQ + c * 128 + nrel;
  const float lg2 = log2f(1.f - exp2f(-5.f - (float)h));
  bf16* RT = (bf16*)(lds + 2 * AT_BUF);
  AtRegs rg; at_issue(rg, proj + ((size_t)b * SEQ + c * 128) * PW + C_RETK + h * 64, (const bf16*)(ws + P_RETVT) + (size_t)bh * 64 * SEQ + c * 128, nullptr, tid);
  { const float cd = ex2(lg2 * 128.f); const float* KV = (const float*)(ws + P_RETKV) + (size_t)bh * 32 * 4096 + (tid >> 3) * 64 + (tid & 7) * 8;
    f32x4 a0 = {0.f, 0.f, 0.f, 0.f}, a1 = {0.f, 0.f, 0.f, 0.f};
    int cc = 0;
    for (; cc + 4 <= c; cc += 4) { f32x4 k0[4], k1[4];
#pragma unroll
      for (int u = 0; u < 4; ++u) { k0[u] = *(const f32x4*)(KV + (size_t)(cc + u) * 4096); k1[u] = *(const f32x4*)(KV + (size_t)(cc + u) * 4096 + 4); }
#pragma unroll
      for (int u = 0; u < 4; ++u) { a0 = a0 * cd + k0[u]; a1 = a1 * cd + k1[u]; } }
    for (; cc < c; ++cc) { const f32x4 k0 = *(const f32x4*)(KV + (size_t)cc * 4096), k1 = *(const f32x4*)(KV + (size_t)cc * 4096 + 4); a0 = a0 * cd + k0; a1 = a1 * cd + k1; }
    __syncthreads();
    const int d = tid >> 3, e0 = (tid & 7) * 8;
#pragma unroll
    for (int e = 0; e < 4; ++e) { RT[(e0 + e) * KS_P + d] = (bf16)f2bf(a0[e]); RT[(e0 + 4 + e) * KS_P + d] = (bf16)f2bf(a1[e]); } }
  at_commit(rg, lds, tid);
  bf16x8 qf[2];
#pragma unroll
  for (int ks = 0; ks < 2; ++ks) qf[ks] = *(const bf16x8*)(proj + qrow * PW + C_RETQ + h * 64 + ks * 32 + 8 * g);
  __syncthreads();
  const bf16* Ks = (const bf16*)(lds + AT_KS); const bf16* Vs = (const bf16*)(lds + AT_VS);
  f32x4 o[4], cr[4];
#pragma unroll
  for (int et = 0; et < 4; ++et) { o[et] = (f32x4){0.f, 0.f, 0.f, 0.f}; cr[et] = (f32x4){0.f, 0.f, 0.f, 0.f};
#pragma unroll
    for (int ks = 0; ks < 2; ++ks) cr[et] = MFMA16(*(const bf16x8*)(RT + (et * 16 + li) * KS_P + ks * 32 + 8 * g), qf[ks], cr[et]); }
  const int nst = (wave >> 1) + 1;
  for (int st = 0; st < nst; ++st) {
    f32x4 s0 = {0.f, 0.f, 0.f, 0.f}, s1 = {0.f, 0.f, 0.f, 0.f};
#pragma unroll
    for (int ks = 0; ks < 2; ++ks) { const bf16x8 a0 = *(const bf16x8*)(Ks + (st * 32 + li) * KS_P + ks * 32 + 8 * g), a1 = *(const bf16x8*)(Ks + (st * 32 + 16 + li) * KS_P + ks * 32 + 8 * g);
      s0 = MFMA16(a0, qf[ks], s0); s1 = MFMA16(a1, qf[ks], s1); }
    float x[8];
#pragma unroll
    for (int j = 0; j < 4; ++j) { const int m0 = st * 32 + 4 * g + j, m1 = m0 + 16;
      x[j] = (m0 <= nrel) ? s0[j] * ex2(lg2 * (float)(nrel - m0)) : 0.f; x[4 + j] = (m1 <= nrel) ? s1[j] * ex2(lg2 * (float)(nrel - m1)) : 0.f; }
    const bf16x8 pb = pack_frag(x);
#pragma unroll
    for (int et = 0; et < 4; ++et) o[et] = MFMA16(vfrag(Vs, et * 16 + li, st * 32, g), pb, o[et]);
  }
  const float xi = ex2(lg2 * (float)(nrel + 1));
  float ss = 0.f;
#pragma unroll
  for (int et = 0; et < 4; ++et)
#pragma unroll
    for (int j = 0; j < 4; ++j) { o[et][j] += xi * cr[et][j]; ss += o[et][j] * o[et][j]; }
  ss += __shfl_xor(ss, 16); ss += __shfl_xor(ss, 32);
  const float rs = rsqrtf(ss * (1.f / 64.f) + EPS);
  const float* gnw = p.in[33] + (size_t)l * G + h * 64;
#pragma unroll
  for (int et = 0; et < 4; ++et) { const int e0 = et * 16 + 4 * g;
    const u32x2 gg = *(const u32x2*)(proj + qrow * PW + C_RETG + h * 64 + e0); const float gt[4] = {bflo(gg.x), bfhi(gg.x), bflo(gg.y), bfhi(gg.y)};
    float r[4];
#pragma unroll
    for (int j = 0; j < 4; ++j) r[j] = o[et][j] * rs * gnw[e0 + j] * (gt[j] * sigmoidf_(gt[j]));
    u32x2 w; w.x = pk2(r[0], r[1]); w.y = pk2(r[2], r[3]);
    *(u32x2*)(proj + qrow * PW + C_RETQ + h * 64 + e0) = w; }
}

constexpr int XP = 264;
__device__ __forceinline__ void xattn_unit(const Params& p, int l, unsigned char* lds, int unit) {
  asm volatile("" ::: "memory");
  unsigned char* ws = p.ws; bf16* qb = (bf16*)(ws + WS_P);
  int tid = threadIdx.x; asm volatile("" : "+v"(tid)); const int wave = __builtin_amdgcn_readfirstlane(tid >> 6), lane = tid & 63, li = lane & 15, g = lane >> 4;
  const int b = unit >> 6, head = (unit >> 4) & 3, qt = unit & 15;
  bf16* L = (bf16*)lds;
  const bf16* kg = (const bf16*)(ws + WS_KM) + ((size_t)l * 1024 + b * 256) * 1024 + head * 256;
  const bf16* vg = (const bf16*)(ws + WS_VMT) + (size_t)(((l * 4 + b) * 4 + head) * 256) * 256;
  __syncthreads();
#pragma unroll
  for (int i0 = 0; i0 < 16; i0 += 8) { u32x4 t[8];
#pragma unroll
    for (int i = 0; i < 8; ++i) { const int id = tid + 512 * (i0 + i), row = id >> 5, ch = id & 31; t[i] = *(const u32x4*)(kg + (size_t)row * 1024 + ch * 8); }
#pragma unroll
    for (int i = 0; i < 8; ++i) { const int id = tid + 512 * (i0 + i), row = id >> 5, ch = id & 31; *(u32x4*)(L + row * XP + ch * 8) = t[i]; } }
  __syncthreads();
  bf16x8 pb[2][8]; float linv[2];
  const float SC = LOG2E / 16.f;
#pragma unroll
  for (int grp = 0; grp < 2; ++grp) {
    const size_t row = (size_t)b * SEQ + qt * 256 + wave * 32 + grp * 16 + li;
    bf16x8 qf[8];
#pragma unroll
    for (int ks = 0; ks < 8; ++ks) qf[ks] = *(const bf16x8*)(qb + row * 1024 + head * 256 + ks * 32 + 8 * g);
    f32x4 s[16];
#pragma unroll
    for (int kt = 0; kt < 16; ++kt) { s[kt] = (f32x4){0.f, 0.f, 0.f, 0.f};
#pragma unroll
      for (int ks = 0; ks < 8; ++ks) s[kt] = MFMA16(*(const bf16x8*)(L + (kt * 16 + li) * XP + ks * 32 + 8 * g), qf[ks], s[kt]);
      if ((kt & 1) == 1) __builtin_amdgcn_sched_barrier(0); }
    float mx = -INFINITY;
#pragma unroll
    for (int kt = 0; kt < 16; ++kt) mx = fmaxf(mx, fmaxf(fmaxf(s[kt][0], s[kt][1]), fmaxf(s[kt][2], s[kt][3])));
    mx = fmaxf(mx, __shfl_xor(mx, 16)); mx = fmaxf(mx, __shfl_xor(mx, 32));
    float ps = 0.f;
#pragma unroll
    for (int kt = 0; kt < 16; ++kt)
#pragma unroll
      for (int j = 0; j < 4; ++j) { s[kt][j] = ex2((s[kt][j] - mx) * SC); ps += s[kt][j]; }
    ps += __shfl_xor(ps, 16); ps += __shfl_xor(ps, 32);
    linv[grp] = 1.f / ps;
#pragma unroll
    for (int kk = 0; kk < 8; ++kk) { float x[8];
#pragma unroll
      for (int j = 0; j < 4; ++j) { x[j] = s[2 * kk][j]; x[4 + j] = s[2 * kk + 1][j]; }
      pb[grp][kk] = pack_frag(x); }
    __builtin_amdgcn_sched_barrier(0);
  }
  __syncthreads();
#pragma unroll
  for (int i0 = 0; i0 < 16; i0 += 8) { u32x4 t[8];
#pragma unroll
    for (int i = 0; i < 8; ++i) { const int id = tid + 512 * (i0 + i), row = id >> 5, ch = id & 31; t[i] = *(const u32x4*)(vg + (size_t)row * 256 + ch * 8); }
#pragma unroll
    for (int i = 0; i < 8; ++i) { const int id = tid + 512 * (i0 + i), row = id >> 5, ch = id & 31; *(u32x4*)(L + row * XP + ch * 8) = t[i]; } }
  __syncthreads();
#pragma unroll
  for (int grp = 0; grp < 2; ++grp) {
    const size_t row = (size_t)b * SEQ + qt * 256 + wave * 32 + grp * 16 + li;
#pragma unroll
    for (int dt = 0; dt < 16; ++dt) { f32x4 o = {0.f, 0.f, 0.f, 0.f};
#pragma unroll
      for (int kk = 0; kk < 8; ++kk) { const u32x2 lo = *(const u32x2*)(L + (dt * 16 + li) * XP + kk * 32 + 4 * g), hi = *(const u32x2*)(L + (dt * 16 + li) * XP + kk * 32 + 16 + 4 * g);
        const u32x4 w = {lo.x, lo.y, hi.x, hi.y}; o = MFMA16(__builtin_bit_cast(bf16x8, w), pb[grp][kk], o); }
      u32x2 w; w.x = pk2(o[0] * linv[grp], o[1] * linv[grp]); w.y = pk2(o[2] * linv[grp], o[3] * linv[grp]);
      *(u32x2*)(qb + row * 1024 + head * 256 + dt * 16 + 4 * g) = w;
      __builtin_amdgcn_sched_barrier(0); }
  }
}

#define LAS __attribute__((address_space(3)))
#define XB_TMO      128
#define XB_XCNT(j)  (256  + 64 * (j))
#define XB_XSUB(j)  (1280 + 64 * (j))
#define XB_XGEN(j)  (2304 + 64 * (j))
#define XB_TOP      3328
#define XB_TOPGEN   3392
#define XCD_BAR_WORDS 3456
#define XB_SPIN_CAP (1u << 18)

__device__ __forceinline__ unsigned xb_ld(unsigned* p)              { return __hip_atomic_load(p, __ATOMIC_RELAXED, __HIP_MEMORY_SCOPE_AGENT); }
__device__ __forceinline__ unsigned xb_add(unsigned* p, unsigned v) { return __hip_atomic_fetch_add(p, v, __ATOMIC_RELAXED, __HIP_MEMORY_SCOPE_AGENT); }
__device__ __forceinline__ unsigned xb_xcc_id() { return (unsigned)__builtin_amdgcn_s_getreg((3 << 11) | 20) & 0xFu; }
#define XB_SPIN(cond, bar) do { unsigned _sp = 0; while (cond) { __builtin_amdgcn_s_sleep(1); \
    if ((++_sp & 255u) == 0u) { if (xb_ld(&(bar)[XB_TMO])) break; if (_sp > XB_SPIN_CAP) { atomicAdd(&(bar)[XB_TMO], 1u); break; } } } } while (0)

struct XcdBarrier {
    unsigned* bar; unsigned x;
    volatile LAS unsigned* st;
};

__device__ __forceinline__ XcdBarrier xcd_barrier_post(unsigned* bar, volatile LAS unsigned* st) {
    XcdBarrier b; b.bar = bar; b.x = xb_xcc_id(); b.st = st;
    if (threadIdx.x == 0) (void)xb_add(&bar[XB_XCNT(b.x)], 1u);
    return b;
}
__device__ __forceinline__ void xcd_barrier_complete(unsigned* bar, unsigned x, unsigned& nloc, unsigned& nx) {
    const unsigned G = gridDim.x * gridDim.y * gridDim.z;
    unsigned sum, cnt, mine, sp = 0u;
    for (;;) {
        sum = 0u; cnt = 0u; mine = 0u;
#pragma unroll
        for (unsigned j = 0; j < 16; ++j) { const unsigned c = xb_ld(&bar[XB_XCNT(j)]); sum += c; cnt += (c > 0u) ? 1u : 0u; mine = (j == x) ? c : mine; }
        if (sum == G) break;
        __builtin_amdgcn_s_sleep(1);
        if ((++sp & 255u) == 0u) { if (xb_ld(&bar[XB_TMO])) break; if (sp > XB_SPIN_CAP) { atomicAdd(&bar[XB_TMO], 1u); break; } }
    }
    nloc = mine > 0u ? mine : 1u; nx = cnt > 0u ? cnt : 1u;
}

__device__ __forceinline__ void xcd_barrier(const XcdBarrier& b) {
    asm volatile("s_waitcnt vmcnt(0)" ::: "memory");
    __syncthreads();
    if (threadIdx.x == 0) {
        unsigned* bar = b.bar;
        __builtin_amdgcn_s_waitcnt(0);
        unsigned nloc = b.st[0], nx = b.st[1];
        if (nloc == 0u) { xcd_barrier_complete(bar, b.x, nloc, nx); b.st[0] = nloc; b.st[1] = nx; }
        const unsigned old = xb_add(&bar[XB_XSUB(b.x)], 1u);
        const unsigned gen = old / nloc;
        if (old + 1u == (gen + 1u) * nloc) {
            __builtin_amdgcn_fence(__ATOMIC_RELEASE, "agent");
            asm volatile("s_waitcnt vmcnt(0)" ::: "memory");
            const unsigned og = xb_add(&bar[XB_TOP], 1u);
            const unsigned tg = og / nx;
            if (og + 1u == (tg + 1u) * nx) xb_add(&bar[XB_TOPGEN], 1u);
            else XB_SPIN(xb_ld(&bar[XB_TOPGEN]) == tg, bar);
            __builtin_amdgcn_fence(__ATOMIC_ACQUIRE, "agent");
            xb_add(&bar[XB_XGEN(b.x)], 1u);
            asm volatile("s_waitcnt vmcnt(0)" ::: "memory");
        } else {
            XB_SPIN(xb_ld(&bar[XB_XGEN(b.x)]) == gen, bar);
            __builtin_amdgcn_fence(__ATOMIC_ACQUIRE, "agent");
            asm volatile("s_waitcnt vmcnt(0)" ::: "memory");
        }
    }
    __syncthreads();
}


#ifndef DEBUG_LAUNCHES
#define DEBUG_LAUNCHES 0
#endif
constexpr int PH_PER_LAYER = 13, N_PHASES = 1 + PH_PER_LAYER * DEPTH;

__global__ void __launch_bounds__(NTHREADS) mega_fwd(Params p) {
  extern __shared__ __attribute__((aligned(16))) unsigned char lds[];
  cg::grid_group grid = cg::this_grid();
  constexpr int NB = 256, NGW = NB * NWAVES;
  unsigned char* ws = p.ws;
  PG8_LAS unsigned char* glds = (PG8_LAS unsigned char*)lds;
  bf16* Hb = (bf16*)(ws + WS_H); bf16* Ob = (bf16*)(ws + WS_O); bf16* Pb = (bf16*)(ws + WS_P);
  volatile LAS unsigned* xb_st = (volatile LAS unsigned*)((LAS unsigned char*)lds + (LDS_BYTES - 32));
  if (threadIdx.x == 0) { xb_st[0] = 0u; xb_st[1] = 0u; }
  __syncthreads();
  const XcdBarrier xbar = xcd_barrier_post((unsigned*)(ws + SM_BAR), xb_st);
  int ph = 0;
#ifdef DBG_CLR
#define DBG_LDSCLEAR { for (int e_ = threadIdx.x; e_ < LDS_BYTES / 4; e_ += NTHREADS) ((unsigned*)lds)[e_] = 0u; __syncthreads(); }
#else
#define DBG_LDSCLEAR
#endif
#define PHASE_BEGIN if (ph >= p.ph_lo && ph < p.ph_hi) { int tid = threadIdx.x; asm volatile("" : "+v"(tid)); const int lane = tid & 63, wave = __builtin_amdgcn_readfirstlane(tid >> 6), gw = blockIdx.x * NWAVES + wave; (void)lane; (void)gw; DBG_LDSCLEAR
#ifdef TS_PH
#define TS_REC if (blockIdx.x == 0 && threadIdx.x == 0) ((unsigned long long*)(ws + SM_Q + 256))[ph + 1] = __builtin_amdgcn_s_memrealtime();
#else
#define TS_REC
#endif
#define PHASE_END   if (ph + 1 < p.ph_hi) { if (p.ph_lo < 0) grid.sync();   else xcd_barrier(xbar); } TS_REC } ++ph;

  PHASE_BEGIN
    float* scr = (float*)lds + wave * (64 * 33);
    conv_layer_weights(p, 0, scr, gw, NGW, lane);
    { constexpr int I_SQ = (D / 64) * (D / 32);
      for (int it = gw; it < 4 * I_SQ; it += NGW) { const int w = it / I_SQ, r = it % I_SQ, layer = w >> 1, isv = w & 1;
        conv_item<0>(p.in[isv ? 36 : 35] + (size_t)layer * D * D, D, D, D, (bf16*)(ws + WS_WKV) + (size_t)w * D * D, scr, r, lane); } }
    for (int l = 0; l < DEPTH; ++l) { RowArgs a{}; a.xin = p.in[1]; a.g_pre = p.in[6] + (size_t)l * D; a.hout = (bf16*)(ws + WS_MEMN) + (size_t)l * 1024 * 1024; a.rows = 1024; row_phase(a, gw, NGW, lane); }
    { RowArgs a{}; a.xin = p.in[0]; a.g_pre = p.in[2]; a.hout = Hb; a.wf = p.in[9]; a.fbias = p.in[11]; a.logf = (float*)(ws + SM_LOGF); a.rows = T; row_phase(a, gw, NGW, lane); }
#ifdef DBG_FILLG
    for (int e = blockIdx.x * NTHREADS + tid; e < T * G / 2; e += NB * NTHREADS) ((unsigned*)(ws + RW_G))[e] = 0x447A447Au;
#endif
    for (int e = blockIdx.x * NTHREADS + tid; e < SEQ * 32; e += NB * NTHREADS) { const int pos = e >> 5, i = e & 31; const float inv = 1.f / powf(10000.f, (float)i / 31.f); const float ang = (float)pos * inv;
      ((float*)(ws + SM_ROT))[2 * e] = cosf(ang); ((float*)(ws + SM_ROT))[2 * e + 1] = sinf(ang); }
  PHASE_END

  for (int l = 0; l < DEPTH; ++l) {
    PHASE_BEGIN
      { pg8::Gemm g{Hb, (const bf16*)(ws + W_IN), T, NIN, D, D}; pg8::StaticOrder S; S.init(T, NIN, NB, (int)blockIdx.x);
        EpiIn E{Pb, (bf16*)(ws + P_FOXVT), (bf16*)(ws + P_RETKT), (bf16*)(ws + P_RETVT), (const float*)(ws + SM_ROT)};
        pg8::gemm_phase<EpiIn, pg8::StaticOrder, true, true>(glds, g, S, E); }
      if (l == 0) { pg8::Gemm g{(const bf16*)(ws + WS_MEMN), (const bf16*)(ws + WS_WKV), 2048, 4096, D, D}; MemSched S{NB, (int)blockIdx.x - 64};
        EpiMem E{(bf16*)(ws + WS_KM), (bf16*)(ws + WS_VMT)};
        pg8::gemm_phase<EpiMem, MemSched, true, true>(glds, g, S, E); }
    PHASE_END
    PHASE_BEGIN
      float* wl = (float*)lds + wave * (16 * WLP);
      for (int u = gw; u < 4096; u += NGW) rwkv_prep_unit(p, l, u >> 2, u & 3, wl, lane);
      for (int u = gw; u < 512; u += NGW) ret_kv_unit(p, u, lane);
      if (gw >= 1024 && gw < 1040) fox_cum_unit(p, gw - 1024, lane);
      if (blockIdx.x == 0 && tid == 0) *(int*)(ws + SM_Q) = 0;
    PHASE_END
    PHASE_BEGIN
#ifndef DBG_P3
#define DBG_P3 15
#endif
      if (blockIdx.x < 128) {
        const int bx_ = blockIdx.x, j_ = bx_ >> 3, su_ = ((2 * (bx_ & 7) + (j_ >> 3)) << 3) | (j_ & 7);
        if (DBG_P3 & 1) rwkv_scan_unit(p, lds, su_);
#ifdef REP_SCAN
        rwkv_scan_unit(p, lds, blockIdx.x);
#endif
      }
      else if (blockIdx.x < 144) { if (DBG_P3 & 2) lru_unit(p, l, (float*)lds, blockIdx.x - 128); }
      int* qword = (int*)(lds + LDS_BYTES - 16);
      for (;;) {
        __syncthreads();
        if (tid == 0) *qword = atomicAdd((int*)(ws + SM_Q), 1);
        __syncthreads();
        const int id = *qword;
        if (id >= 1024) break;
        if (id < 512) { if (DBG_P3 & 4) fox_unit(p, lds, (id & 15) >> 2, id & 3, 31 - (id >> 4)); }
        else if (DBG_P3 & 8) { const int r = id - 512, bh_ = r & 15; ret_unit(p, l, lds, bh_ >> 2, bh_ & 3, 31 - (r >> 4)); }
      }
    PHASE_END
    PHASE_BEGIN
      for (int row = gw; row < T; row += 2 * NGW) rwkv_post_rows2(p, l, row, row + NGW, lane);
    PHASE_END
    PHASE_BEGIN
      pg8::Gemm g{Pb, (const bf16*)(ws + W_OUT), T, D, D, PW}; pg8::StaticOrder S; S.init(T, D, NB, (int)blockIdx.x);
      EpiPlain E{Ob, D, 0, nullptr};
      pg8::gemm_phase<EpiPlain, pg8::StaticOrder, true, true>(glds, g, S, E);
    PHASE_END
    PHASE_BEGIN
      RowArgs a{}; a.xin = l == 0 ? p.in[0] : p.out; a.O = Ob; a.g_post = p.in[3] + (size_t)l * D; a.xout = p.out; a.g_pre = p.in[4] + (size_t)l * D; a.hout = Hb; a.rows = T;
      row_phase(a, gw, NGW, lane);
    PHASE_END
    PHASE_BEGIN
      pg8::Gemm g{Hb, (const bf16*)(ws + W_Q), T, D, D, D}; pg8::StaticOrder S; S.init(T, D, NB, (int)blockIdx.x);
      EpiPlain E{Pb, D, 0, nullptr};
      pg8::gemm_phase<EpiPlain, pg8::StaticOrder, true, true>(glds, g, S, E);
    PHASE_END
    PHASE_BEGIN
      for (int u = blockIdx.x; u < 256; u += NB) xattn_unit(p, l, lds, u);
    PHASE_END
    PHASE_BEGIN
      pg8::Gemm g{Pb, (const bf16*)(ws + W_O), T, D, D, D}; pg8::StaticOrder S; S.init(T, D, NB, (int)blockIdx.x);
      EpiPlain E{Ob, D, 0, nullptr};
      pg8::gemm_phase<EpiPlain, pg8::StaticOrder, true, true>(glds, g, S, E);
    PHASE_END
    PHASE_BEGIN
      RowArgs a{}; a.xin = p.out; a.O = Ob; a.g_post = p.in[5] + (size_t)l * D; a.xout = p.out; a.g_pre = p.in[7] + (size_t)l * D; a.hout = Hb; a.rows = T;
      row_phase(a, gw, NGW, lane);
    PHASE_END
    PHASE_BEGIN
      pg8::Gemm g{Hb, (const bf16*)(ws + W_1), T, DFF, D, D}; pg8::StaticOrder S; S.init(T, DFF, NB, (int)blockIdx.x);
      EpiPlain E{Pb, DFF, 1, nullptr};
      pg8::gemm_phase<EpiPlain, pg8::StaticOrder, true, true>(glds, g, S, E);
    PHASE_END
    PHASE_BEGIN
      pg8::Gemm g{Pb, (const bf16*)(ws + W_2), T, D, DFF, DFF}; pg8::StaticOrder S; S.init(T, D, NB, (int)blockIdx.x);
      EpiPlain E{Ob, D, 0, nullptr};
      pg8::gemm_phase<EpiPlain, pg8::StaticOrder, true, true>(glds, g, S, E);
    PHASE_END
    PHASE_BEGIN
      RowArgs a{}; a.xin = p.out; a.O = Ob; a.g_post = p.in[8] + (size_t)l * D; a.xout = p.out; a.rows = T;
      if (l + 1 < DEPTH) { a.g_pre = p.in[2] + (size_t)(l + 1) * D; a.hout = Hb; a.wf = p.in[9] + (size_t)(l + 1) * D * INW; a.fbias = p.in[11] + (size_t)(l + 1) * GH; a.logf = (float*)(ws + SM_LOGF); }
      row_phase(a, gw, NGW, lane);
      if (l + 1 < DEPTH) { __syncthreads(); conv_layer_weights(p, l + 1, (float*)lds + wave * (64 * 33), gw, NGW, lane); }
    PHASE_END
  }
#ifdef TS_PH
  grid.sync();
  if (blockIdx.x == 0) { const unsigned long long* ts = (const unsigned long long*)(ws + SM_Q + 256);
#ifdef TS_CONST
    const float dt_us = TS_CONST;
#else
    const float dt_us = (float)(ts[TS_PH + 1] - ts[TS_PH]) * 0.01f;
#endif
    const float delta = 0.01f * sqrtf(dt_us);
    for (int r = threadIdx.x; r < T; r += NTHREADS) p.out[(size_t)r * D] += delta; }
#endif
}


#ifdef DBG_STOP
#ifndef DBG_MASK
#define DBG_MASK 15
#endif
__global__ void dbg_dump(const unsigned char* ws, float* out) {
  const size_t i = (size_t)blockIdx.x * 256 + threadIdx.x; const int row = (int)(i >> 10), c = (int)(i & 1023);
#ifndef DBG_SRC
#define DBG_SRC 0
#endif
#ifndef DBG_COFF
#define DBG_COFF 0
#endif
  const bf16* proj = (const bf16*)(ws + WS_P);
  if (DBG_SRC == 0) out[i] = ((DBG_MASK >> (c >> 8)) & 1) ? bflo((unsigned)proj[(size_t)row * PW + DBG_COFF + c]) : 0.f;
  else if (DBG_SRC == 1) { const bf16* a = (const bf16*)(ws + WS_RW) + (size_t)(c >> 8) * (8u << 19); out[i] = ((DBG_MASK >> (c >> 8)) & 1) ? bflo((unsigned)a[(size_t)row * G + (c & 255)]) : 0.f; }
  else if (DBG_SRC == 2) { const bf16* a = (const bf16*)(ws + RW_K) + (size_t)(c >> 8) * (8u << 19); float v = 0.f; if (c < 768) v = bflo((unsigned)a[(size_t)row * G + (c & 255)]); else if (c < 772) v = ((const float*)(ws + SM_BR))[row * 4 + (c & 3)]; else if (c < 776) v = ((const float*)(ws + SM_KR))[row * 4 + (c & 3)]; else if (c < 780) v = ((const float*)(ws + SM_RK))[row * 4 + (c & 3)];
    out[i] = ((DBG_MASK >> (c >> 8)) & 1) ? v : 0.f; }
  else if (DBG_SRC == 5) { out[i] = c < 256 ? bflo((unsigned)((const bf16*)(ws + RW_G))[(size_t)row * G + c]) : 0.f; }
  else if (DBG_SRC == 4) { out[i] = i < 512 * 1024 ? bflo((unsigned)((const bf16*)(ws + W_SMALL))[i]) : 0.f; }
  else { out[i] = c < 256 ? ((const float*)(ws + RW_Y))[(size_t)row * G + c] : 0.f; }
}
#endif

#ifdef DBG_GCHK
__global__ void dbg_snap(const unsigned char* ws, float* out) { const size_t i = (size_t)blockIdx.x * 256 + threadIdx.x; ((unsigned*)out)[i] = ((const unsigned*)(ws + RW_G))[i]; if (i == 0) *(unsigned*)(ws + SM_Q + 64) = 0u; }
__global__ void dbg_cmp(unsigned char* ws, const float* out) { const size_t i = (size_t)blockIdx.x * 256 + threadIdx.x; const unsigned a = ((const unsigned*)(ws + RW_G))[i], b = ((const unsigned*)out)[i];
  if (a != b) { unsigned f = 1u; if (a == 0x447A447Au) f |= 2u; else f |= 4u; atomicOr((unsigned*)(ws + SM_Q + 64), f); } }
__global__ void dbg_fin(const unsigned char* ws, float* out) { const size_t i = (size_t)blockIdx.x * 256 + threadIdx.x; out[i] = (i == 0) ? 1.0e6f * (float)(*(const unsigned*)(ws + SM_Q + 64)) : 0.f; }
#endif
extern "C" void kernel_launch(void* const* d_in, const int* in_sizes, int n_in, void* d_out, int out_size, void* d_ws, size_t ws_size, hipStream_t stream) {
  static int grid = 0;
  if (grid == 0) {
    if (ws_size < WS_END) { fprintf(stderr, "kernel_launch: workspace too small: %zu < %zu\n", ws_size, (size_t)WS_END); grid = -1; return; }
    int dev = 0, cus = 0, per_cu = 0;
    hipGetDevice(&dev); hipDeviceGetAttribute(&cus, hipDeviceAttributeMultiprocessorCount, dev);
    hipFuncSetAttribute((const void*)mega_fwd, hipFuncAttributeMaxDynamicSharedMemorySize, LDS_BYTES);
    hipOccupancyMaxActiveBlocksPerMultiprocessor(&per_cu, (const void*)mega_fwd, NTHREADS, LDS_BYTES);
    if (per_cu < 1) { fprintf(stderr, "kernel_launch: occupancy query says %d blocks/CU\n", per_cu); per_cu = 1; }
    grid = 256;
    if (cus < 256) { fprintf(stderr, "kernel_launch: needs 256 CUs, device has %d\n", cus); grid = -1; return; }
    (void)hipGetLastError();
  }
  if (grid < 0) return;
  Params p{};
  for (int i = 0; i < 40; ++i) p.in[i] = (const float*)d_in[i];
  p.out = (float*)d_out; p.ws = (unsigned char*)d_ws;
#if DEBUG_LAUNCHES
#ifdef DBG_GCHK
  for (int ph = 0; ph < 3; ++ph) { p.ph_lo = ph; p.ph_hi = ph + 1; hipLaunchKernelGGL(mega_fwd, dim3(grid), dim3(NTHREADS), LDS_BYTES, stream, p); }
  hipLaunchKernelGGL(dbg_snap, dim3(T * G / 2 / 256), dim3(256), 0, stream, (const unsigned char*)d_ws, (float*)d_out);
  p.ph_lo = 3; p.ph_hi = 4; hipLaunchKernelGGL(mega_fwd, dim3(grid), dim3(NTHREADS), LDS_BYTES, stream, p);
  hipLaunchKernelGGL(dbg_cmp, dim3(T * G / 2 / 256), dim3(256), 0, stream, (unsigned char*)d_ws, (const float*)d_out);
  hipLaunchKernelGGL(dbg_fin, dim3(T * 1024 / 256), dim3(256), 0, stream, (const unsigned char*)d_ws, (float*)d_out);
#elif defined(DBG_STOP)
  for (int ph = 0; ph < DBG_STOP; ++ph) { p.ph_lo = ph; p.ph_hi = ph + 1; hipLaunchKernelGGL(mega_fwd, dim3(grid), dim3(NTHREADS), LDS_BYTES, stream, p); }
  hipLaunchKernelGGL(dbg_dump, dim3(T * 1024 / 256), dim3(256), 0, stream, (const unsigned char*)d_ws, (float*)d_out);
#else
#ifndef REP_MASK
#define REP_MASK 0
#endif
  int rewound = 0;
  for (int ph = 0; ph < N_PHASES; ++ph) { p.ph_lo = ph; p.ph_hi = ph + 1; const int rel = ph == 0 ? 0 : 1 + (ph - 1) % PH_PER_LAYER;
    const int reps = ((REP_MASK >> rel) & 1) ? 2 : 1;
    for (int r = 0; r < reps; ++r) hipLaunchKernelGGL(mega_fwd, dim3(grid), dim3(NTHREADS), LDS_BYTES, stream, p);
#ifdef REP_GROUP
    if (rel == 4) { if (!rewound) { rewound = 1; ph -= 4; } else rewound = 0; }
#endif
  }
#endif
#else
  p.ph_lo = 0; p.ph_hi = N_PHASES;
  hipMemsetAsync((unsigned char*)d_ws + SM_BAR, 0, 16384, stream);
  void* args[] = {&p};
  hipError_t e = hipLaunchCooperativeKernel((const void*)mega_fwd, dim3(grid), dim3(NTHREADS), args, LDS_BYTES, stream);
  if (e != hipSuccess) fprintf(stderr, "cooperative launch failed: %s (grid %d)\n", hipGetErrorString(e), grid);
#endif
}
```

```cpp
#include <hip/hip_runtime.h>
#include <hip/hip_cooperative_groups.h>
#include <cstdio>
#include <cstdint>
#include <cmath>
namespace cg = cooperative_groups;
namespace pg8 {
#define PG8_LAS __attribute__((address_space(3)))
typedef unsigned short bf16_t;
typedef short bf16x8 __attribute__((ext_vector_type(8)));
typedef float f32x4 __attribute__((ext_vector_type(4)));
typedef unsigned u32x4 __attribute__((ext_vector_type(4)));
constexpr int BM = 256, BK = 64, HALF = 128, HTB = HALF * BK * 2  , STAGE_BYTES = 8 * HTB, NXCD = 8, WGM = 8;

__host__ __device__ __forceinline__ int lds_byte(int r, int c) { const int st = (r >> 4) * 2 + (c >> 5), rr = r & 15, cc = c & 31, ob = rr * 64 + cc * 2; return st * 1024 + (ob ^ (((ob >> 9) & 1) << 5)); }
__host__ __device__ __forceinline__ void stage_rc(int b, int& R, int& C) { const int st = b / 1024, sb = b % 1024, swz = sb ^ (((sb >> 9) & 1) << 5); R = (st >> 1) * 16 + swz / 64; C = (st & 1) * 32 + (swz % 64) / 2; }
__host__ __device__ __forceinline__ int perm32(int rho) { const int n = rho >> 4, i = rho & 15; return 8 * (i >> 2) + 4 * n + (i & 3); }

struct Unit { int pm, pn; };
struct Gemm { const bf16_t* A; const bf16_t* Bt; int M, N, K, lda; };

struct StaticOrder {
    int nM, nN, nwg, G, c;
    __host__ __device__ void init(int M, int N, int G_, int c_) { nM = M / BM; nN = N / BM; nwg = nM * nN; G = G_; c = c_; }
    __host__ __device__ bool next(int i, Unit& u) const {
        const long L = (long)i * G + c; if (L >= nwg) return false;
        int wgid = (int)L; { const int q = nwg / NXCD, r = nwg % NXCD, xcd = wgid % NXCD, off = wgid / NXCD; wgid = (xcd < r ? xcd * (q + 1) : r * (q + 1) + (xcd - r) * q) + off; }
        const int nig = WGM * nN, gid = wgid / nig, fm = gid * WGM, gsz = (nM - fm) < WGM ? (nM - fm) : WGM;
        u.pm = fm + ((wgid % nig) % gsz); u.pn = (wgid % nig) / gsz; return true;
    }
    __device__ __forceinline__ void a_ready(const Unit&) const {}
    __device__ __forceinline__ void done(const Unit&) const {}
};

__device__ __forceinline__ unsigned cvt_pk_bf16(float lo, float hi) { unsigned r; asm volatile("v_cvt_pk_bf16_f32 %0, %1, %2" : "=v"(r) : "v"(lo), "v"(hi)); return r; }
typedef float f32x2 __attribute__((ext_vector_type(2)));
template <class Epi, class Sched, bool ALIGN_EPI = false, bool SP2 = false>
__device__ __forceinline__ void gemm_phase(PG8_LAS unsigned char* lds, const Gemm g, const Sched& S, const Epi& E) {
    int tid_l = threadIdx.x; asm volatile("" : "+v"(tid_l));
    const int tid = tid_l, wid = __builtin_amdgcn_readfirstlane(tid >> 6), lane = tid & 63, wr = wid >> 2, wc = wid & 3, fr = lane & 15, fq = lane >> 4;
    const int K = g.K, nt = K / BK;
    unsigned voffA[2], voffB[2];
#pragma unroll
    for (int i = 0; i < 2; ++i) { int R, C; stage_rc(tid * 16 + i * 8192, R, C); const int Rb = Epi::PERM ? ((R & ~31) + perm32(R & 31)) : R;
        voffA[i] = (unsigned)(R * g.lda + C) * 2u; voffB[i] = (unsigned)(Rb * K + C) * 2u; }
    const size_t kstep = (size_t)(BK * 2);
    const size_t hstep = (size_t)HALF * K * 2;
    const size_t tstep = 2 * hstep; const size_t hstepA = (size_t)HALF * g.lda * 2; const size_t tstepA = 2 * hstepA;
    const unsigned ldsw = (unsigned)wid * 1024u;
    const int aoff = lds_byte(wr * 64 + fr, fq * 8), boff = lds_byte(wc * 32 + fr, fq * 8);
#define PG8_SA(b, h) (((b) * 2 + (h)) * HTB)
#define PG8_SB(b, h) ((4 + (b) * 2 + (h)) * HTB)
#define PG8_STAGE(bufoff, gbase, voff) do { _Pragma("unroll") for (int _i = 0; _i < 2; ++_i) \
        __builtin_amdgcn_global_load_lds((const unsigned*)((const char*)(gbase) + (voff)[_i]), (PG8_LAS unsigned*)(lds + (bufoff) + ldsw + _i * 8192), 16, 0, 0); } while (0)
#define PG8_LDA(dst, b, h) do { _Pragma("unroll") for (int m = 0; m < 4; ++m) _Pragma("unroll") for (int k = 0; k < 2; ++k) dst[m][k] = *(const PG8_LAS bf16x8*)(lds + PG8_SA(b, h) + aoff + m * 2048 + k * 1024); } while (0)
#define PG8_LDB(dst, b, h) do { _Pragma("unroll") for (int n = 0; n < 2; ++n) _Pragma("unroll") for (int k = 0; k < 2; ++k) dst[n][k] = *(const PG8_LAS bf16x8*)(lds + PG8_SB(b, h) + boff + n * 2048 + k * 1024); } while (0)
#define PG8_MMA(ai, bj, At, Bt) do { __builtin_amdgcn_s_setprio(1); _Pragma("unroll") for (int m = 0; m < 4; ++m) _Pragma("unroll") for (int n = 0; n < 2; ++n) _Pragma("unroll") for (int k = 0; k < 2; ++k) \
        acc[ai][bj][m][n] = __builtin_amdgcn_mfma_f32_16x16x32_bf16(Bt[n][k], At[m][k], acc[ai][bj][m][n], 0, 0, 0); __builtin_amdgcn_s_setprio(0); } while (0)
#define PG8_WAIT_V(n) asm volatile("s_waitcnt vmcnt(" #n ")" ::: "memory")
#define PG8_WAIT_L(n) asm volatile("s_waitcnt lgkmcnt(" #n ")" ::: "memory")
#define PG8_BAR __builtin_amdgcn_s_barrier()
#define PG8_SCHED __builtin_amdgcn_sched_barrier(0)
    Unit cur, nxt; int ui = 0;
    if (!S.next(0, cur)) return;
    f32x4 acc[2][2][4][2];
#pragma unroll
    for (int a = 0; a < 2; ++a)
#pragma unroll
        for (int b = 0; b < 2; ++b)
#pragma unroll
            for (int m = 0; m < 4; ++m)
#pragma unroll
                for (int n = 0; n < 2; ++n) acc[a][b][m][n] = (f32x4){0.f, 0.f, 0.f, 0.f};
    bf16x8 At[4][2], B0[2][2], B1[2][2];
    const char* cA = (const char*)g.A + (size_t)cur.pm * tstepA; const char* cB = (const char*)g.Bt + (size_t)cur.pn * tstep;
    S.a_ready(cur);
    if constexpr (SP2) {
        PG8_STAGE(PG8_SB(0, 0), cB, voffB); PG8_STAGE(PG8_SB(0, 1), cB + hstep, voffB); PG8_STAGE(PG8_SA(0, 0), cA, voffA); PG8_STAGE(PG8_SA(0, 1), cA + hstepA, voffA);
        if (wr == 1) PG8_BAR;
        PG8_WAIT_V(2); PG8_BAR;
        PG8_STAGE(PG8_SB(1, 0), cB + kstep, voffB); PG8_STAGE(PG8_SA(1, 0), cA + kstep, voffA); PG8_STAGE(PG8_SB(1, 1), cB + hstep + kstep, voffB);
        PG8_WAIT_V(6); PG8_BAR;
    } else {
        PG8_STAGE(PG8_SB(0, 0), cB, voffB); PG8_STAGE(PG8_SA(0, 0), cA, voffA); PG8_STAGE(PG8_SB(0, 1), cB + hstep, voffB); PG8_STAGE(PG8_SA(0, 1), cA + hstepA, voffA);
        if (wr == 1) PG8_BAR;
        PG8_WAIT_V(4); PG8_BAR;
        PG8_STAGE(PG8_SB(1, 0), cB + kstep, voffB); PG8_STAGE(PG8_SA(1, 0), cA + kstep, voffA); PG8_STAGE(PG8_SB(1, 1), cB + hstep + kstep, voffB);
        PG8_WAIT_V(6); PG8_BAR;
    }
    for (;;) {
        const bool has_next = S.next(ui + 1, nxt);
        const char* nA = has_next ? (const char*)g.A + (size_t)nxt.pm * tstepA : cA; const char* nB = has_next ? (const char*)g.Bt + (size_t)nxt.pn * tstep : cB;
        for (int t = 0; t < nt; t += 2) {
            const bool last = (t == nt - 2);
            const char* a1 = cA + (size_t)(t + 1) * kstep;
            const char* a2 = last ? nA : cA + (size_t)(t + 2) * kstep; const char* b2 = last ? nB : cB + (size_t)(t + 2) * kstep;
            const char* a3 = a2 + kstep; const char* b3 = b2 + kstep;
            if (last && has_next) S.a_ready(nxt);
            if constexpr (SP2) {
            PG8_LDB(B0, 0, 0); PG8_LDB(B1, 0, 1); PG8_SCHED; PG8_LDA(At, 0, 0); PG8_STAGE(PG8_SA(1, 1), a1 + hstepA, voffA);
            PG8_WAIT_V(8); PG8_WAIT_L(0); PG8_BAR; PG8_MMA(0, 0, At, B0); PG8_MMA(0, 1, At, B1); PG8_BAR; PG8_SCHED;
            PG8_LDA(At, 0, 1); PG8_STAGE(PG8_SB(0, 0), b2, voffB); PG8_STAGE(PG8_SB(0, 1), b2 + hstep, voffB); PG8_STAGE(PG8_SA(0, 0), a2, voffA);
            PG8_WAIT_V(8); PG8_WAIT_L(0); PG8_BAR; PG8_MMA(1, 0, At, B0); PG8_MMA(1, 1, At, B1); PG8_BAR; PG8_SCHED;
            PG8_LDB(B0, 1, 0); PG8_LDB(B1, 1, 1); PG8_SCHED; PG8_LDA(At, 1, 0); PG8_STAGE(PG8_SA(0, 1), a2 + hstepA, voffA);
            PG8_WAIT_V(8); PG8_WAIT_L(0); PG8_BAR; PG8_MMA(0, 0, At, B0); PG8_MMA(0, 1, At, B1); PG8_BAR; PG8_SCHED;
            PG8_LDA(At, 1, 1); PG8_STAGE(PG8_SB(1, 0), b3, voffB); PG8_STAGE(PG8_SB(1, 1), b3 + hstep, voffB); PG8_STAGE(PG8_SA(1, 0), a3, voffA);
            PG8_WAIT_V(8); PG8_WAIT_L(0); PG8_BAR; PG8_MMA(1, 0, At, B0); PG8_MMA(1, 1, At, B1); PG8_BAR; PG8_SCHED;
            } else {
            PG8_LDB(B0, 0, 0); PG8_SCHED; PG8_LDA(At, 0, 0); PG8_STAGE(PG8_SA(1, 1), a1 + hstepA, voffA);
            PG8_WAIT_L(8); PG8_BAR; PG8_WAIT_L(0); PG8_MMA(0, 0, At, B0); PG8_BAR; PG8_SCHED;
            PG8_LDB(B1, 0, 1); PG8_STAGE(PG8_SB(0, 0), b2, voffB);
            PG8_BAR; PG8_WAIT_L(0); PG8_MMA(0, 1, At, B1); PG8_BAR;
            PG8_LDA(At, 0, 1); PG8_STAGE(PG8_SA(0, 0), a2, voffA);
            PG8_BAR; PG8_WAIT_L(0); PG8_MMA(1, 0, At, B0); PG8_BAR; PG8_SCHED;
            PG8_STAGE(PG8_SB(0, 1), b2 + hstep, voffB);
            PG8_WAIT_V(6); PG8_BAR; PG8_MMA(1, 1, At, B1); PG8_BAR;
            PG8_LDB(B0, 1, 0); PG8_SCHED; PG8_LDA(At, 1, 0); PG8_STAGE(PG8_SA(0, 1), a2 + hstepA, voffA);
            PG8_WAIT_L(8); PG8_BAR; PG8_WAIT_L(0); PG8_MMA(0, 0, At, B0); PG8_BAR; PG8_SCHED;
            PG8_LDB(B1, 1, 1); PG8_STAGE(PG8_SB(1, 0), b3, voffB);
            PG8_BAR; PG8_WAIT_L(0); PG8_MMA(0, 1, At, B1); PG8_BAR;
            PG8_LDA(At, 1, 1); PG8_STAGE(PG8_SA(1, 0), a3, voffA);
            PG8_BAR; PG8_WAIT_L(0); PG8_MMA(1, 0, At, B0); PG8_BAR; PG8_SCHED;
            PG8_STAGE(PG8_SB(1, 1), b3 + hstep, voffB);
            PG8_WAIT_V(6); PG8_BAR; PG8_MMA(1, 1, At, B1); PG8_BAR;
            }
        }
        if constexpr (ALIGN_EPI) { if (wr == 0) PG8_BAR; }
        if constexpr (!Epi::AFTER_DRAIN) { E(acc, cur, wr, wc, fr, fq); S.done(cur); }
        if (!has_next) break;
#pragma unroll
        for (int a = 0; a < 2; ++a)
#pragma unroll
            for (int b = 0; b < 2; ++b)
#pragma unroll
                for (int m = 0; m < 4; ++m)
#pragma unroll
                    for (int n = 0; n < 2; ++n) acc[a][b][m][n] = (f32x4){0.f, 0.f, 0.f, 0.f};
        cur = nxt; cA = nA; cB = nB; ++ui;
        if constexpr (ALIGN_EPI) { if (wr == 1) PG8_BAR; }
    }
    PG8_WAIT_V(0);
    if constexpr (!ALIGN_EPI) { if (wr == 0) PG8_BAR; }
    PG8_BAR;
    if constexpr (Epi::AFTER_DRAIN) { E.fused(acc, cur, wr, wc, fr, fq, lds, wid, lane); S.done(cur); }
#undef PG8_SA
#undef PG8_SB
#undef PG8_STAGE
#undef PG8_LDA
#undef PG8_LDB
#undef PG8_MMA
#undef PG8_WAIT_V
#undef PG8_WAIT_L
#undef PG8_BAR
#undef PG8_SCHED
}
}

typedef unsigned short bf16;
typedef short bf16x8 __attribute__((ext_vector_type(8)));
typedef short bf16x4 __attribute__((ext_vector_type(4)));
typedef float f32x4 __attribute__((ext_vector_type(4)));
typedef float f32x2 __attribute__((ext_vector_type(2)));
typedef unsigned u32x4 __attribute__((ext_vector_type(4)));
typedef unsigned u32x2 __attribute__((ext_vector_type(2)));

constexpr int D = 1024, BATCH = 4, SEQ = 4096, DEPTH = 2, T = BATCH * SEQ;
constexpr int MEM = 256;
constexpr int G = 256, HD = 64, GH = 4;
constexpr int INW = 3332, DFF = 4096;
constexpr float EPS = 1e-6f, LOG2E = 1.4426950408889634f;
constexpr int NTHREADS = 512, NWAVES = 8;
constexpr int PW = 2816;
constexpr int C_FOXQ = 0, C_LRUY = 256, C_RWR = 512, C_RETQ = 768, C_FOXK = 1024, C_LRUX = 1280, C_RWK = 1536, C_RWV = 1792, C_RWX = 2048, C_RETK = 2304, C_RETG = 2560;
constexpr int NIN = 3328;
__device__ __constant__ const int kSrcCol[13] = {0, 1028, 1284, 2308, 256, 772, 1540, 1796, 2052, 2564, 3076, 512, 2820};

constexpr size_t MiB = 1u << 20;
constexpr size_t WS_W = 0;
constexpr size_t W_IN = 0, W_OUT = 7 * MiB, W_Q = 9 * MiB, W_O = 11 * MiB, W_1 = 13 * MiB, W_2 = 21 * MiB, W_SMALL = 29 * MiB;
constexpr size_t WS_W2T = W_SMALL, WS_A2T = WS_W2T + 256 * 64 * 2, WS_G2T = WS_A2T + 256 * 64 * 2, WS_V1T = WS_G2T + 256 * 128 * 2, WS_V2T = WS_V1T + 32 * 256 * 2, WS_RAT = WS_V2T + 256 * 32 * 2, WS_RIT = WS_RAT + 4 * 64 * 64 * 2;
constexpr size_t WS_P = 30 * MiB;
constexpr size_t P_FOXVT = WS_P + 88 * MiB, P_RETKT = WS_P + 96 * MiB, P_RETVT = WS_P + 104 * MiB, P_RETKV = WS_P + 112 * MiB;
constexpr size_t WS_RW = 158 * MiB;
constexpr size_t RW_E = WS_RW, RW_WR = WS_RW + 8 * MiB, RW_A = WS_RW + 16 * MiB, RW_B = WS_RW + 24 * MiB, RW_K = WS_RW + 32 * MiB, RW_V = WS_RW + 40 * MiB, RW_G = WS_P + 120 * MiB  , RW_Y = WS_RW + 56 * MiB;
constexpr int RW_REC = 320;
__device__ __forceinline__ size_t rw_off(int tok  , int arr, int col  ) { const int b = tok >> 12, pos = tok & (SEQ - 1), hh = col >> 6; return ((size_t)((b * 4 + hh) * SEQ + pos)) * RW_REC + arr * 64 + (col & 63); }
constexpr size_t WS_O = WS_RW, WS_H = WS_RW + 32 * MiB;
constexpr size_t WS_WKV = WS_RW;
constexpr size_t WS_MEMN = WS_RW + 64 * MiB;
constexpr size_t WS_VF = 230 * MiB;
constexpr size_t WS_KM = 238 * MiB, WS_VMT = 242 * MiB;
constexpr size_t WS_SM = 246 * MiB;
constexpr size_t SM_LOGF = WS_SM, SM_CUM = SM_LOGF + 256 * 1024, SM_BR = SM_CUM + 256 * 1024, SM_KR = SM_BR + 256 * 1024, SM_RK = SM_KR + 256 * 1024,
                 SM_SS = SM_RK + 256 * 1024  , SM_ROT = SM_SS + 256 * 1024  , SM_Q = SM_ROT + MiB  , SM_BAR = SM_Q + 4096  , WS_END = SM_BAR + 16384;
static_assert(WS_END <= 256 * MiB, "workspace map");
constexpr int LDS_BYTES = 147456;

__device__ __forceinline__ unsigned f2bf(float f) { unsigned u = __builtin_bit_cast(unsigned, f); return (u + 0x7fffu + ((u >> 16) & 1u)) >> 16; }
typedef __bf16 bf16x2_t __attribute__((ext_vector_type(2)));
__device__ __forceinline__ unsigned pk2(float lo, float hi) { const f32x2 v = {lo, hi}; const bf16x2_t b = __builtin_convertvector(v, bf16x2_t); return __builtin_bit_cast(unsigned, b); }
__device__ __forceinline__ float bflo(unsigned u) { return __builtin_bit_cast(float, u << 16); }
__device__ __forceinline__ float bfhi(unsigned u) { return __builtin_bit_cast(float, u & 0xffff0000u); }
__device__ __forceinline__ void unpack8(u32x4 w, float* f) { f[0] = bflo(w.x); f[1] = bfhi(w.x); f[2] = bflo(w.y); f[3] = bfhi(w.y); f[4] = bflo(w.z); f[5] = bfhi(w.z); f[6] = bflo(w.w); f[7] = bfhi(w.w); }
__device__ __forceinline__ u32x4 pack8(const float* f) { u32x4 w; w.x = pk2(f[0], f[1]); w.y = pk2(f[2], f[3]); w.z = pk2(f[4], f[5]); w.w = pk2(f[6], f[7]); return w; }
__device__ __forceinline__ float wave_sum(float v) {
#pragma unroll
  for (int o = 1; o < 64; o <<= 1) v += __shfl_xor(v, o);
  return v;
}
__device__ __forceinline__ float ex2(float x) { return __builtin_amdgcn_exp2f(x); }
__device__ __forceinline__ float rcpf_(float x) { return __builtin_amdgcn_rcpf(x); }
__device__ __forceinline__ float sigmoidf_(float x) { return rcpf_(1.f + __expf(-x)); }
__device__ __forceinline__ float lse0_(float x) { return __logf(1.f + __expf(-fabsf(x))); }
__device__ __forceinline__ float log_sigmoidf_(float x) { return fminf(x, 0.f) - lse0_(x); }
__device__ __forceinline__ float log_sigmoid_acc(float x) { return fminf(x, 0.f) - log1pf(__expf(-fabsf(x))); }
__device__ __forceinline__ float softplusf_(float x) { return fmaxf(x, 0.f) + lse0_(x); }
__device__ __forceinline__ float tanhf_(float x) { return 1.f - 2.f * rcpf_(1.f + __expf(2.f * x)); }
__device__ __forceinline__ float gelu_tanh(float x) { return 0.5f * x * (1.f + tanhf_(0.7978845608028654f * (x + 0.044715f * x * x * x))); }
#define WAVE_LDS_FENCE() asm volatile("s_waitcnt lgkmcnt(0)" ::: "memory")
#define LDS_BARRIER() asm volatile("s_waitcnt lgkmcnt(0)\n\ts_barrier" ::: "memory")
#define MFMA16(a, b, c) __builtin_amdgcn_mfma_f32_16x16x32_bf16((a), (b), (c), 0, 0, 0)

struct Params { const float* in[40]; float* out; unsigned char* ws; int ph_lo, ph_hi; };

struct EpiIn {
  static constexpr bool PERM = true, AFTER_DRAIN = false;
  bf16* proj; bf16* foxvT; bf16* retkT; bf16* retvT; const float* rot;
  __device__ __forceinline__ void operator()(const f32x4 (&acc)[2][2][4][2], const pg8::Unit& u, int wr, int wc, int fr, int fq) const {
    const int pn = u.pn;
    const bool rotary = (pn == 3) || (pn == 9);
    const float sc = (pn == 9) ? 0.125f : 1.f;
    bf16* tdst = pn == 9 ? retkT : pn == 11 ? foxvT : pn == 12 ? retvT : nullptr;
    const bool rowmajor = pn <= 10;
#pragma unroll
    for (int ai = 0; ai < 2; ++ai)
#pragma unroll
      for (int m = 0; m < 4; ++m) {
        const int row = u.pm * 256 + ai * 128 + wr * 64 + m * 16 + fr; const int pos = row & (SEQ - 1), b = row >> 12;
#pragma unroll
        for (int bj = 0; bj < 2; ++bj) {
          const int c0 = bj * 128 + wc * 32 + 8 * fq;
          float v[8];
#pragma unroll
          for (int e = 0; e < 4; ++e) { v[e] = acc[ai][bj][m][0][e]; v[4 + e] = acc[ai][bj][m][1][e]; }
          if (rotary) {
            const int i0 = (c0 & 63) >> 1;
            const f32x4 r0 = *(const f32x4*)(rot + ((size_t)pos * 32 + i0) * 2), r1 = *(const f32x4*)(rot + ((size_t)pos * 32 + i0 + 2) * 2);
            const float cs[4] = {r0[0], r0[2], r1[0], r1[2]}, sn[4] = {r0[1], r0[3], r1[1], r1[3]};
#pragma unroll
            for (int p = 0; p < 4; ++p) { const float x1 = v[2 * p], x2 = v[2 * p + 1]; v[2 * p] = x1 * cs[p] - x2 * sn[p]; v[2 * p + 1] = x1 * sn[p] + x2 * cs[p]; }
          }
#pragma unroll
          for (int e = 0; e < 8; ++e) v[e] *= sc;
          const u32x4 w = pack8(v);
          if (rowmajor) *(u32x4*)(proj + (size_t)row * PW + pn * 256 + c0) = w;
          if (tdst) {
            const int hh = c0 >> 6, d0 = c0 & 63; bf16* tp = tdst + ((size_t)((b * 4 + hh) * 64 + d0)) * SEQ + pos;
            const unsigned ww[4] = {w.x, w.y, w.z, w.w};
#pragma unroll
            for (int e = 0; e < 8; ++e) tp[(size_t)e * SEQ] = (bf16)((e & 1) ? (ww[e >> 1] >> 16) : (ww[e >> 1] & 0xffffu));
          }
        }
      }
  }
};
struct EpiPlain {
  static constexpr bool PERM = true, AFTER_DRAIN = false;
  bf16* O; int ldc; int act; float* ss;
  __device__ __forceinline__ void operator()(const f32x4 (&acc)[2][2][4][2], const pg8::Unit& u, int wr, int wc, int fr, int fq) const {
#pragma unroll
    for (int ai = 0; ai < 2; ++ai)
#pragma unroll
      for (int m = 0; m < 4; ++m) {
        const int row = u.pm * 256 + ai * 128 + wr * 64 + m * 16 + fr; float s = 0.f;
#pragma unroll
        for (int bj = 0; bj < 2; ++bj) {
          const int c0 = u.pn * 256 + bj * 128 + wc * 32 + 8 * fq;
          float v[8];
#pragma unroll
          for (int e = 0; e < 4; ++e) { v[e] = acc[ai][bj][m][0][e]; v[4 + e] = acc[ai][bj][m][1][e]; }
          if (act == 1) {
#pragma unroll
            for (int e = 0; e < 8; ++e) { const float r = fmaxf(v[e], 0.f); v[e] = r * r; }
          }
#pragma unroll
          for (int e = 0; e < 8; ++e) s += v[e] * v[e];
          *(u32x4*)(O + (size_t)row * ldc + c0) = pack8(v);
        }
        if (ss) { s += __shfl_xor(s, 16); s += __shfl_xor(s, 32); if (fq == 0) atomicAdd(ss + row, s); }
      }
  }
};
struct EpiMem {
  static constexpr bool PERM = true, AFTER_DRAIN = false;
  bf16* kmem; bf16* vmemT;
  __device__ __forceinline__ void operator()(const f32x4 (&acc)[2][2][4][2], const pg8::Unit& u, int wr, int wc, int fr, int fq) const {
    const int layer = u.pm >> 2, pt = u.pn & 7; const bool isv = pt >= 4; const int head = pt & 3;
#pragma unroll
    for (int ai = 0; ai < 2; ++ai)
#pragma unroll
      for (int m = 0; m < 4; ++m) {
        const int rowl = (u.pm & 3) * 256 + ai * 128 + wr * 64 + m * 16 + fr;
#pragma unroll
        for (int bj = 0; bj < 2; ++bj) {
          const int c0 = bj * 128 + wc * 32 + 8 * fq;
          float v[8];
#pragma unroll
          for (int e = 0; e < 4; ++e) { v[e] = acc[ai][bj][m][0][e]; v[4 + e] = acc[ai][bj][m][1][e]; }
          const u32x4 w = pack8(v);
          if (!isv) *(u32x4*)(kmem + ((size_t)layer * 1024 + rowl) * 1024 + head * 256 + c0) = w;
          else {
            const int b = rowl >> 8, key = rowl & 255; bf16* tp = vmemT + ((size_t)(((layer * 4 + b) * 4 + head) * 256 + c0)) * 256 + key;
            const unsigned ww[4] = {w.x, w.y, w.z, w.w};
#pragma unroll
            for (int e = 0; e < 8; ++e) tp[(size_t)e * 256] = (bf16)((e & 1) ? (ww[e >> 1] >> 16) : (ww[e >> 1] & 0xffffu));
          }
        }
      }
  }
};
struct MemSched {
  int G, c;
  __device__ bool next(int i, pg8::Unit& u) const { const int L = i * G + c; if (c < 0 || L >= 64) return false; const int layer = L >> 5, r = L & 31; u.pm = layer * 4 + (r & 3); u.pn = layer * 8 + (r >> 2); return true; }
  __device__ __forceinline__ void a_ready(const pg8::Unit&) const {}
  __device__ __forceinline__ void done(const pg8::Unit&) const {}
};

template <int MAP> __device__ __forceinline__ int src_col(int n) {
  if (MAP == 0) return n;
  const int tile = n >> 8, j = n & 255; int jj = j;
  if (tile == 3 || tile == 9) { const int hh = j >> 6, l = j & 63; jj = hh * 64 + (l >> 1) + 32 * (l & 1); }
  return kSrcCol[tile] + jj;
}
template <int MAP> __device__ __forceinline__ void conv_item(const float* __restrict__ W, int K, int Nsrc, int N, bf16* WT, float* scr, int item, int lane) {
  const int nblk = N / 32, kb = item / nblk, nb = item % nblk, k0 = 64 * kb, n0 = 32 * nb;
  const int sc = src_col<MAP>(n0 + (lane & 31));
#pragma unroll 8
  for (int i = 0; i < 32; ++i) { const int kk = 2 * i + (lane >> 5); scr[kk * 33 + (lane & 31)] = W[(size_t)(k0 + kk) * Nsrc + sc]; }
  WAVE_LDS_FENCE();
  const int c = lane & 7;
#pragma unroll
  for (int j = 0; j < 4; ++j) { const int n = (lane >> 3) + 8 * j; const float* s = scr + (8 * c) * 33 + n;
    u32x4 o; o.x = pk2(s[0 * 33], s[1 * 33]); o.y = pk2(s[2 * 33], s[3 * 33]); o.z = pk2(s[4 * 33], s[5 * 33]); o.w = pk2(s[6 * 33], s[7 * 33]);
    *(u32x4*)(WT + (size_t)(n0 + n) * K + k0 + 8 * c) = o; }
  WAVE_LDS_FENCE();
}
__device__ __forceinline__ void conv_layer_weights(const Params& p, int l, float* scr, int gw, int NGW, int lane) {
  asm volatile("" ::: "memory");
  asm volatile("" : "+v"(lane));
  unsigned char* ws = p.ws;
  constexpr int I_IN = (D / 64) * (NIN / 32), I_SQ = (D / 64) * (D / 32), I_1 = (D / 64) * (DFF / 32), I_2 = (DFF / 64) * (D / 32);
  constexpr int I_W2 = 1 * 8, I_A2 = 8, I_G2 = 2 * 8, I_V1 = 4 * 1, I_V2 = 8  , I_R = 2 * 4 * 2;
  constexpr int NIT = I_IN + 3 * I_SQ + I_1 + I_2 + I_W2 + I_A2 + I_G2 + I_V1 + I_R;
  for (int it = gw; it < NIT; it += NGW) {
    int r = it;
    if (r < I_IN) { conv_item<1>(p.in[9] + (size_t)l * D * INW, D, INW, NIN, (bf16*)(ws + W_IN), scr, r, lane); continue; } r -= I_IN;
    if (r < I_SQ) { conv_item<0>(p.in[10] + (size_t)l * D * D, D, D, D, (bf16*)(ws + W_OUT), scr, r, lane); continue; } r -= I_SQ;
    if (r < I_SQ) { conv_item<0>(p.in[34] + (size_t)l * D * D, D, D, D, (bf16*)(ws + W_Q), scr, r, lane); continue; } r -= I_SQ;
    if (r < I_SQ) { conv_item<0>(p.in[37] + (size_t)l * D * D, D, D, D, (bf16*)(ws + W_O), scr, r, lane); continue; } r -= I_SQ;
    if (r < I_1) { conv_item<0>(p.in[38] + (size_t)l * D * DFF, D, DFF, DFF, (bf16*)(ws + W_1), scr, r, lane); continue; } r -= I_1;
    if (r < I_2) { conv_item<0>(p.in[39] + (size_t)l * DFF * D, DFF, D, D, (bf16*)(ws + W_2), scr, r, lane); continue; } r -= I_2;
    if (r < I_W2) { conv_item<0>(p.in[21] + (size_t)l * 64 * G, 64, G, G, (bf16*)(ws + WS_W2T), scr, r, lane); continue; } r -= I_W2;
    if (r < I_A2) { conv_item<0>(p.in[23] + (size_t)l * 64 * G, 64, G, G, (bf16*)(ws + WS_A2T), scr, r, lane); continue; } r -= I_A2;
    if (r < I_G2) { conv_item<0>(p.in[24] + (size_t)l * 128 * G, 128, G, G, (bf16*)(ws + WS_G2T), scr, r, lane); continue; } r -= I_G2;
    if (r < I_V1) { if (l > 0) conv_item<0>(p.in[31] + (size_t)(l - 1) * G * 32, G, 32, 32, (bf16*)(ws + WS_V1T), scr, r, lane); continue; } r -= I_V1;
    { const int gate = r >> 3, hh = (r >> 1) & 3, nb = r & 1;
      conv_item<0>(p.in[gate ? 16 : 14] + ((size_t)l * GH + hh) * HD * HD, 64, 64, 64, (bf16*)(ws + (gate ? WS_RIT : WS_RAT)) + hh * 4096, scr, nb, lane); }
  }
  if (l > 0) { const float* v2 = p.in[32] + (size_t)(l - 1) * 32 * G; bf16* v2t = (bf16*)(ws + WS_V2T);
    for (int e = gw * 64 + lane; e < 32 * G; e += NGW * 64) { const int k = e / G, n = e % G; v2t[n * 32 + k] = (bf16)f2bf(v2[e]); } }
}

struct RowArgs { const float* xin; const bf16* O; float* ss; const float* g_post; float* xout; const float* g_pre; bf16* hout; const float* wf; const float* fbias; float* logf; int rows; };
__device__ __forceinline__ void row_phase(const RowArgs& a, int gw, int NGW, int lane) {
  asm volatile("" ::: "memory");
  asm volatile("" : "+v"(lane));
  f32x4 gp[4], gq[4], wfv[4][4];
#pragma unroll
  for (int j = 0; j < 4; ++j) {
    gp[j] = a.O ? ((const f32x4*)a.g_post)[lane + 64 * j] : (f32x4){0.f, 0.f, 0.f, 0.f};
    gq[j] = a.hout ? ((const f32x4*)a.g_pre)[lane + 64 * j] : (f32x4){0.f, 0.f, 0.f, 0.f};
#pragma unroll
    for (int e = 0; e < 4; ++e) {
      const f32x4 t = a.wf ? *(const f32x4*)(a.wf + (size_t)(4 * (lane + 64 * j) + e) * INW + 768) : (f32x4){0.f, 0.f, 0.f, 0.f};
#pragma unroll
      for (int hh = 0; hh < 4; ++hh) wfv[j][hh][e] = t[hh]; }
  }
  for (int row0 = gw; row0 < a.rows; row0 += 2 * NGW) {
    const int rowv[2] = {row0, row0 + NGW}; const bool val[2] = {true, row0 + NGW < a.rows};
    f32x4 x[2][4]; float ov[2][4][4];
#pragma unroll
    for (int r = 0; r < 2; ++r) if (val[r]) {
#pragma unroll
      for (int j = 0; j < 4; ++j) x[r][j] = ((const f32x4*)(a.xin + (size_t)rowv[r] * D))[lane + 64 * j];
      if (a.O) {
#pragma unroll
        for (int j = 0; j < 4; ++j) { const u32x2 o = ((const u32x2*)(a.O + (size_t)rowv[r] * D))[lane + 64 * j];
          ov[r][j][0] = bflo(o.x); ov[r][j][1] = bfhi(o.x); ov[r][j][2] = bflo(o.y); ov[r][j][3] = bfhi(o.y); }
      }
    }
#pragma unroll
    for (int r = 0; r < 2; ++r) if (val[r]) {
      const int row = rowv[r];
      if (a.O) {
        float so = 0.f;
#pragma unroll
        for (int j = 0; j < 4; ++j) so += ov[r][j][0] * ov[r][j][0] + ov[r][j][1] * ov[r][j][1] + ov[r][j][2] * ov[r][j][2] + ov[r][j][3] * ov[r][j][3];
        so = wave_sum(so);
        const float rs = rsqrtf(so * (1.f / D) + EPS);
#pragma unroll
        for (int j = 0; j < 4; ++j)
#pragma unroll
          for (int e = 0; e < 4; ++e) x[r][j][e] += ov[r][j][e] * rs * gp[j][e];
      }
      if (a.xout) {
#pragma unroll
        for (int j = 0; j < 4; ++j) ((f32x4*)(a.xout + (size_t)row * D))[lane + 64 * j] = x[r][j];
      }
      if (a.hout) {
        float s = 0.f;
#pragma unroll
        for (int j = 0; j < 4; ++j) s += x[r][j][0] * x[r][j][0] + x[r][j][1] * x[r][j][1] + x[r][j][2] * x[r][j][2] + x[r][j][3] * x[r][j][3];
        s = wave_sum(s); const float rs2 = rsqrtf(s * (1.f / D) + EPS);
        float fd[4] = {0.f, 0.f, 0.f, 0.f};
#pragma unroll
        for (int j = 0; j < 4; ++j) {
          f32x4 hv;
#pragma unroll
          for (int e = 0; e < 4; ++e) hv[e] = x[r][j][e] * rs2 * gq[j][e];
          u32x2 o; o.x = pk2(hv[0], hv[1]); o.y = pk2(hv[2], hv[3]);
          ((u32x2*)(a.hout + (size_t)row * D))[lane + 64 * j] = o;
          if (a.wf) {
#pragma unroll
            for (int hh = 0; hh < 4; ++hh) fd[hh] += hv[0] * wfv[j][hh][0] + hv[1] * wfv[j][hh][1] + hv[2] * wfv[j][hh][2] + hv[3] * wfv[j][hh][3];
          }
        }
        if (a.wf) {
#pragma unroll
          for (int hh = 0; hh < 4; ++hh) fd[hh] = wave_sum(fd[hh]);
          if (lane < 4) { const float f = lane == 0 ? fd[0] : lane == 1 ? fd[1] : lane == 2 ? fd[2] : fd[3]; a.logf[(size_t)(((row >> 12) * 4 + lane) * SEQ) + (row & (SEQ - 1))] = log_sigmoidf_(f + a.fbias[lane]); }
        }
      }
    }
  }
}

__device__ __forceinline__ void lerp8(const bf16* __restrict__ proj, const float* __restrict__ mu, int tok, int col, int mucol, float* out) {
  const u32x4 c = *(const u32x4*)(proj + (size_t)tok * PW + col);
  u32x4 pv = {0u, 0u, 0u, 0u};
  if ((tok & (SEQ - 1)) != 0) pv = *(const u32x4*)(proj + (size_t)(tok - 1) * PW + col);
  float cf[8], pf[8]; unpack8(c, cf); unpack8(pv, pf);
  const f32x4 m0 = *(const f32x4*)(mu + mucol), m1 = *(const f32x4*)(mu + mucol + 4);
#pragma unroll
  for (int e = 0; e < 4; ++e) { out[e] = cf[e] + (pf[e] - cf[e]) * m0[e]; out[4 + e] = cf[4 + e] + (pf[4 + e] - cf[4 + e]) * m1[e]; }
}
__device__ __forceinline__ bf16x8 pack_frag(const float* f) { const u32x4 w = pack8(f); return __builtin_bit_cast(bf16x8, w); }
constexpr int WLP = 260;
__device__ __forceinline__ void acc_to_lds(float* wl, const f32x4* acc, int ntiles, int li, int g) {
#pragma unroll
  for (int nt = 0; nt < 16; ++nt) if (nt < ntiles) {
#pragma unroll
    for (int j = 0; j < 4; ++j) wl[(4 * g + j) * WLP + nt * 16 + li] = acc[nt][j];
  }
}
template <int KS> __device__ __forceinline__ void mm16_to_lds(const bf16x8* af, const bf16* __restrict__ wt, int ldw, float* wl, int li, int g) {
#pragma unroll 1
  for (int ng = 0; ng < 4; ++ng) {
    f32x4 a4[4];
#pragma unroll
    for (int n4 = 0; n4 < 4; ++n4) { a4[n4] = (f32x4){0.f, 0.f, 0.f, 0.f};
#pragma unroll
      for (int ks = 0; ks < KS; ++ks) { const bf16x8 bfr = *(const bf16x8*)(wt + (size_t)((ng * 4 + n4) * 16 + li) * ldw + ks * 32 + 8 * g); a4[n4] = MFMA16(af[ks], bfr, a4[n4]); } }
#pragma unroll
    for (int n4 = 0; n4 < 4; ++n4)
#pragma unroll
      for (int j = 0; j < 4; ++j) wl[(4 * g + j) * WLP + (ng * 4 + n4) * 16 + li] = a4[n4][j];
  }
}
__device__ __forceinline__ void rwkv_prep_unit(const Params& p, int l, int unit, int pass, float* wl, int lane) {
  asm volatile("" ::: "memory");
  asm volatile("" : "+v"(lane));
  unsigned char* ws = p.ws;
  const bf16* proj = (const bf16*)(ws + WS_P);
  const float* mu = p.in[19] + (size_t)l * 1024;
  const int li = lane & 15, g = lane >> 4, t0 = unit * 16, ta = t0 + li;
  const int tl = t0 + (lane >> 2), cgp = lane & 3;
  if (pass == 0) {
    bf16x8 af[2];
#pragma unroll
    for (int ks = 0; ks < 2; ++ks) { float f[8]; lerp8(proj, mu, ta, C_RWX + ks * 32 + 8 * g, 768 + ks * 32 + 8 * g, f);
#pragma unroll
      for (int e = 0; e < 8; ++e) f[e] = tanhf_(f[e]);
      af[ks] = pack_frag(f); }
    mm16_to_lds<2>(af, (const bf16*)(ws + WS_W2T), 64, wl, li, g); WAVE_LDS_FENCE();
    const float* w0 = p.in[20] + (size_t)l * G;
#pragma unroll 2
    for (int i = 0; i < 8; ++i) { int col = cgp * 8 + 32 * i; asm volatile("" : "+v"(col)); float r[8], ev[8], wr[8];
      lerp8(proj, mu, tl, C_RWR + col, col, r);
#pragma unroll
      for (int e = 0; e < 8; ++e) { const float wa = wl[(lane >> 2) * WLP + col + e] + w0[col + e]; const float wlog = -softplusf_(-wa) - 0.5f; const float ee = __expf(wlog); ev[e] = ee; wr[e] = __expf(-ee) * r[e]; }
      *(u32x4*)((bf16*)(ws + WS_RW) + rw_off(tl, 0, col)) = pack8(ev); *(u32x4*)((bf16*)(ws + WS_RW) + rw_off(tl, 1, col)) = pack8(wr); }
    WAVE_LDS_FENCE();
  }
  if (pass == 1) {
    bf16x8 af[2];
#pragma unroll
    for (int ks = 0; ks < 2; ++ks) { float f[8]; lerp8(proj, mu, ta, C_RWX + 64 + ks * 32 + 8 * g, 832 + ks * 32 + 8 * g, f); af[ks] = pack_frag(f); }
    mm16_to_lds<2>(af, (const bf16*)(ws + WS_A2T), 64, wl, li, g); WAVE_LDS_FENCE();
    const float* a0 = p.in[22] + (size_t)l * G; const float* k_k = p.in[25] + (size_t)l * G; const float* k_a = p.in[26] + (size_t)l * G; const float* r_k = p.in[27] + (size_t)l * G;
#pragma unroll 1
    for (int hh = 0; hh < 4; ++hh) {
      float av[2][8], kv[2][8], kk[2][8]; float ssq = 0.f;
#pragma unroll
      for (int ii = 0; ii < 2; ++ii) { int col = cgp * 8 + 32 * (2 * hh + ii); asm volatile("" : "+v"(col));
        lerp8(proj, mu, tl, C_RWK + col, 256 + col, kv[ii]);
#pragma unroll
        for (int e = 0; e < 8; ++e) { av[ii][e] = sigmoidf_(a0[col + e] + wl[(lane >> 2) * WLP + col + e]); kk[ii][e] = kv[ii][e] * k_k[col + e]; ssq += kk[ii][e] * kk[ii][e]; } }
      ssq += __shfl_xor(ssq, 1); ssq += __shfl_xor(ssq, 2);
      const float inv = 1.f / fmaxf(sqrtf(ssq), 1e-12f);
      float sbr = 0.f, skr = 0.f, srk = 0.f;
#pragma unroll
      for (int ii = 0; ii < 2; ++ii) { int col = cgp * 8 + 32 * (2 * hh + ii); asm volatile("" : "+v"(col)); float r[8], Av[8], Bv[8], k2[8];
        lerp8(proj, mu, tl, C_RWR + col, col, r);
#pragma unroll
        for (int e = 0; e < 8; ++e) { const float kn = kk[ii][e] * inv; Av[e] = -kn; Bv[e] = kn * av[ii][e]; k2[e] = kv[ii][e] * (1.f + (av[ii][e] - 1.f) * k_a[col + e]);
          const float rb = r[e]; sbr += Bv[e] * rb; skr += k2[e] * rb; srk += rb * k2[e] * r_k[col + e]; }
        *(u32x4*)((bf16*)(ws + WS_RW) + rw_off(tl, 2, col)) = pack8(Av); *(u32x4*)((bf16*)(ws + WS_RW) + rw_off(tl, 3, col)) = pack8(Bv); *(u32x4*)((bf16*)(ws + WS_RW) + rw_off(tl, 4, col)) = pack8(k2); }
      sbr += __shfl_xor(sbr, 1); sbr += __shfl_xor(sbr, 2); skr += __shfl_xor(skr, 1); skr += __shfl_xor(skr, 2); srk += __shfl_xor(srk, 1); srk += __shfl_xor(srk, 2);
      if (cgp == 0) { ((float*)(ws + SM_BR))[(size_t)tl * 4 + hh] = sbr; ((float*)(ws + SM_KR))[(size_t)tl * 4 + hh] = skr; ((float*)(ws + SM_RK))[(size_t)tl * 4 + hh] = srk; }
    }
    WAVE_LDS_FENCE();
  }
  if (pass == 2) {
    bf16x8 af[4];
#pragma unroll
    for (int ks = 0; ks < 4; ++ks) { float f[8]; lerp8(proj, mu, ta, C_RWX + 128 + ks * 32 + 8 * g, 896 + ks * 32 + 8 * g, f);
#pragma unroll
      for (int e = 0; e < 8; ++e) f[e] = sigmoidf_(f[e]);
      af[ks] = pack_frag(f); }
    mm16_to_lds<4>(af, (const bf16*)(ws + WS_G2T), 128, wl, li, g); WAVE_LDS_FENCE();
#pragma unroll 2
    for (int i = 0; i < 8; ++i) { int col = cgp * 8 + 32 * i; asm volatile("" : "+v"(col)); float gv[8];
#pragma unroll
      for (int e = 0; e < 8; ++e) gv[e] = wl[(lane >> 2) * WLP + col + e];
      *(u32x4*)((bf16*)(ws + RW_G) + (size_t)tl * G + col) = pack8(gv); }
    WAVE_LDS_FENCE();
  }
  if (pass != 3) return;
  if (l > 0) {
    f32x4 a1[2] = {(f32x4){0.f, 0.f, 0.f, 0.f}, (f32x4){0.f, 0.f, 0.f, 0.f}};
    const bf16* v1t = (const bf16*)(ws + WS_V1T);
#pragma unroll
    for (int ks = 0; ks < 8; ++ks) { float f[8]; lerp8(proj, mu, ta, C_RWV + ks * 32 + 8 * g, 512 + ks * 32 + 8 * g, f); const bf16x8 af = pack_frag(f);
#pragma unroll
      for (int nt = 0; nt < 2; ++nt) { const bf16x8 bfr = *(const bf16x8*)(v1t + (size_t)(nt * 16 + li) * 256 + ks * 32 + 8 * g); a1[nt] = MFMA16(af, bfr, a1[nt]); } }
#pragma unroll
    for (int nt = 0; nt < 2; ++nt)
#pragma unroll
      for (int j = 0; j < 4; ++j) wl[(4 * g + j) * WLP + nt * 16 + li] = a1[nt][j];
    WAVE_LDS_FENCE();
    float f2[8];
#pragma unroll
    for (int e = 0; e < 8; ++e) f2[e] = wl[li * WLP + 8 * g + e];
    const bf16x8 af2 = pack_frag(f2);
    WAVE_LDS_FENCE();
    mm16_to_lds<1>(&af2, (const bf16*)(ws + WS_V2T), 32, wl, li, g); WAVE_LDS_FENCE();
    const float* v0 = p.in[30] + (size_t)(l - 1) * G;
#pragma unroll 2
    for (int i = 0; i < 8; ++i) { int col = cgp * 8 + 32 * i; asm volatile("" : "+v"(col)); float v[8], vf[8];
      lerp8(proj, mu, tl, C_RWV + col, 512 + col, v);
      unpack8(*(const u32x4*)((const bf16*)(ws + WS_VF) + (size_t)tl * G + col), vf);
#pragma unroll
      for (int e = 0; e < 8; ++e) v[e] = v[e] + (vf[e] - v[e]) * sigmoidf_(v0[col + e] + wl[(lane >> 2) * WLP + col + e]);
      *(u32x4*)((bf16*)(ws + RW_V) + (size_t)tl * G + col) = pack8(v); }
    WAVE_LDS_FENCE();
  } else {
#pragma unroll 2
    for (int i = 0; i < 8; ++i) { int col = cgp * 8 + 32 * i; asm volatile("" : "+v"(col)); float v[8];
      lerp8(proj, mu, tl, C_RWV + col, 512 + col, v);
      const u32x4 w = pack8(v);
      *(u32x4*)((bf16*)(ws + RW_V) + (size_t)tl * G + col) = w; *(u32x4*)((bf16*)(ws + WS_VF) + (size_t)tl * G + col) = w; }
  }
}
__device__ __forceinline__ void ret_kv_unit(const Params& p, int unit, int lane) {
  asm volatile("" ::: "memory");
  asm volatile("" : "+v"(lane));
  unsigned char* ws = p.ws;
  const int bh = unit >> 5, c = unit & 31, h = bh & 3, li = lane & 15, g = lane >> 4;
  const float lg2 = log2f(1.f - exp2f(-5.f - (float)h));
  const bf16* kT = (const bf16*)(ws + P_RETKT) + (size_t)bh * 64 * SEQ + c * 128;
  const bf16* vT = (const bf16*)(ws + P_RETVT) + (size_t)bh * 64 * SEQ + c * 128;
  f32x4 acc[4][4];
#pragma unroll
  for (int a = 0; a < 4; ++a)
#pragma unroll
    for (int b = 0; b < 4; ++b) acc[a][b] = (f32x4){0.f, 0.f, 0.f, 0.f};
#pragma unroll
  for (int ks = 0; ks < 4; ++ks) {
    float z[8];
#pragma unroll
    for (int e = 0; e < 8; ++e) z[e] = ex2(lg2 * (float)(127 - (ks * 32 + 8 * g + e)));
    bf16x8 af[4], bfr[4];
#pragma unroll
    for (int dt = 0; dt < 4; ++dt) { float f[8]; unpack8(*(const u32x4*)(kT + (size_t)(dt * 16 + li) * SEQ + ks * 32 + 8 * g), f);
#pragma unroll
      for (int e = 0; e < 8; ++e) f[e] *= z[e];
      af[dt] = pack_frag(f); }
#pragma unroll
    for (int et = 0; et < 4; ++et) bfr[et] = *(const bf16x8*)(vT + (size_t)(et * 16 + li) * SEQ + ks * 32 + 8 * g);
#pragma unroll
    for (int dt = 0; dt < 4; ++dt)
#pragma unroll
      for (int et = 0; et < 4; ++et) acc[dt][et] = MFMA16(af[dt], bfr[et], acc[dt][et]);
  }
  float* KV = (float*)(ws + P_RETKV) + (size_t)unit * 4096;
#pragma unroll
  for (int dt = 0; dt < 4; ++dt)
#pragma unroll
    for (int et = 0; et < 4; ++et)
#pragma unroll
      for (int j = 0; j < 4; ++j) KV[(dt * 16 + 4 * g + j) * 64 + et * 16 + li] = acc[dt][et][j];
}
__device__ __forceinline__ void fox_cum_unit(const Params& p, int bh, int lane) {
  asm volatile("" ::: "memory");
  asm volatile("" : "+v"(lane));
  const float* logf = (const float*)(p.ws + SM_LOGF) + (size_t)bh * SEQ + lane * 64; float* cum = (float*)(p.ws + SM_CUM) + (size_t)bh * SEQ + lane * 64;
  f32x4 t[16]; float s = 0.f;
#pragma unroll
  for (int i = 0; i < 16; ++i) t[i] = ((const f32x4*)logf)[i];
#pragma unroll
  for (int i = 0; i < 16; ++i) s += (t[i][0] + t[i][1]) + (t[i][2] + t[i][3]);
  float incl = s;
#pragma unroll
  for (int o = 1; o < 64; o <<= 1) { const float u = __shfl_up(incl, o); if (lane >= o) incl += u; }
  float run = incl - s;
#pragma unroll
  for (int i = 0; i < 16; ++i) { f32x4 c;
#pragma unroll
    for (int e = 0; e < 4; ++e) { run += t[i][e]; c[e] = run * LOG2E; }
    ((f32x4*)cum)[i] = c; }
}

template <int CTRL> __device__ __forceinline__ float dpp_add(float x) {
  const int y = __builtin_amdgcn_update_dpp(0, __builtin_bit_cast(int, x), CTRL, 0xf, 0xf, true);
  return x + __builtin_bit_cast(float, y);
}
__device__ __forceinline__ float row16_sum(float x) {
  x = dpp_add<0xB1>(x); x = dpp_add<0x4E>(x); x = dpp_add<0x141>(x); x = dpp_add<0x140>(x); return x;
}
constexpr int RS_TSB = 896;
constexpr int RS_CH = 32;
constexpr int RS_BUFB = RS_CH * RS_TSB;
constexpr int RS_ROWS = 8;
constexpr int RS_YP = 40;
constexpr int RS_YBUF = RS_CH * RS_ROWS * RS_YP;
struct RsRegs { u32x4 e, a, b, k, wr, v; float br, kr; };
__device__ __forceinline__ void rs_issue(const Params& p, RsRegs& r, int b, int h, int rq, int c, int lt) {
  unsigned char* ws = p.ws;
  { const int tok = lt >> 3, ch = lt & 7; const bf16* rec = (const bf16*)(ws + WS_RW) + ((size_t)((b * 4 + h) * SEQ + c * RS_CH + tok)) * RW_REC + ch * 8;
    r.e = *(const u32x4*)(rec); r.wr = *(const u32x4*)(rec + 64); r.a = *(const u32x4*)(rec + 128); r.b = *(const u32x4*)(rec + 192); r.k = *(const u32x4*)(rec + 256); }
  { const int t2 = lt & 31; const size_t rr = (size_t)b * SEQ + c * RS_CH + t2;
    r.v = *(const u32x4*)((const bf16*)(ws + RW_V) + rr * G + h * 64 + rq * RS_ROWS);
    r.br = ((const float*)(ws + SM_BR))[rr * 4 + h]; r.kr = ((const float*)(ws + SM_KR))[rr * 4 + h]; }
}
__device__ __forceinline__ void rs_commit(const RsRegs& r, unsigned char* buf, int lt) {
  { const int tok = lt >> 3, ch = lt & 7; unsigned char* rec = buf + tok * RS_TSB; float f[8];
    unpack8(r.e, f);
#pragma unroll
    for (int e = 0; e < 8; ++e) f[e] = ex2(-f[e] * LOG2E);
    *(f32x4*)(rec + ch * 32) = (f32x4){f[0], f[1], f[2], f[3]}; *(f32x4*)(rec + ch * 32 + 16) = (f32x4){f[4], f[5], f[6], f[7]};
    { const unsigned aw[4] = {r.a.x, r.a.y, r.a.z, r.a.w}, bw[4] = {r.b.x, r.b.y, r.b.z, r.b.w}, kw[4] = {r.k.x, r.k.y, r.k.z, r.k.w}, ww[4] = {r.wr.x, r.wr.y, r.wr.z, r.wr.w};
#pragma unroll
      for (int j = 0; j < 4; ++j) *(u32x4*)(rec + 256 + (ch * 4 + j) * 16) = (u32x4){aw[j], bw[j], kw[j], ww[j]}; } }
  if (lt < 32) { float f[8]; unpack8(r.v, f); unsigned char* rec = buf + lt * RS_TSB + 768; const float b32 = r.br * (1.f / 32.f), k32 = r.kr * (1.f / 32.f);
#pragma unroll
    for (int j = 0; j < 8; ++j) *(f32x4*)(rec + 16 * j) = (f32x4){f[j], b32, k32, 0.f}; }
}
__device__ __forceinline__ float row32_sum(float x) {
  x = row16_sum(x);
  const auto rr = __builtin_amdgcn_permlane16_swap(__builtin_bit_cast(unsigned, x), __builtin_bit_cast(unsigned, x), false, false);
  return __builtin_bit_cast(float, (unsigned)rr[0]) + __builtin_bit_cast(float, (unsigned)rr[1]);
}
__device__ __forceinline__ f32x2 bf2x(unsigned u) { return (f32x2){bflo(u), bfhi(u)}; }
__device__ __forceinline__ void rwkv_scan_unit(const Params& p, unsigned char* lds, int unit) {
  asm volatile("" ::: "memory");
  int tid = threadIdx.x; asm volatile("" : "+v"(tid)); const int wave = __builtin_amdgcn_readfirstlane(tid >> 6), lane = tid & 63;
  const int b = unit >> 5, h = (unit >> 3) & 3, rq = unit & 7;
  unsigned char* bufs = lds; bf16* ybuf = (bf16*)(lds + 2 * RS_BUFB);
  float* Y = (float*)(p.ws + RW_Y);
  constexpr int NCH = SEQ / RS_CH;
  const int lt = tid - 256;
  RsRegs rg;
  if (wave >= 4) { rs_issue(p, rg, b, h, rq, 0, lt); rs_commit(rg, bufs, lt); rs_issue(p, rg, b, h, rq, 1, lt); }
  __syncthreads();
  f32x2 S = {0.f, 0.f};
  const int seg = lane & 31, rloc = wave * 2 + (lane >> 5);
#define RS_YOUT(cc) do { const bf16* yp_ = ybuf + ((cc) & 1) * RS_YBUF + lt * RS_YP; float t_ = 0.f; \
    _Pragma("unroll") for (int j_ = 0; j_ < 4; ++j_) { float f_[8]; unpack8(*(const u32x4*)(yp_ + 8 * j_), f_); t_ += ((f_[0] + f_[1]) + (f_[2] + f_[3])) + ((f_[4] + f_[5]) + (f_[6] + f_[7])); } \
    Y[((size_t)b * SEQ + (cc) * RS_CH + (lt >> 3)) * G + h * 64 + rq * RS_ROWS + (lt & 7)] = t_; } while (0)
  for (int c = 0; c < NCH; ++c) {
    if (wave >= 4) {
      if (c + 1 < NCH) rs_commit(rg, bufs + ((c + 1) & 1) * RS_BUFB, lt);
      if (c + 2 < NCH) rs_issue(p, rg, b, h, rq, c + 2, lt);
      if (c > 0) RS_YOUT(c - 1);
    } else {
      const unsigned char* bp = bufs + (c & 1) * RS_BUFB; bf16* yb = ybuf + (c & 1) * RS_YBUF + rloc * RS_YP + seg;
      const unsigned char* pw = bp + seg * 8; const unsigned char* pa = bp + 256 + seg * 16; const unsigned char* pv = bp + 768 + rloc * 16;
      f32x2 nw = *(const f32x2*)(pw); u32x4 nq = *(const u32x4*)(pa); f32x4 nvs = *(const f32x4*)(pv);
#pragma unroll 8
      for (int s = 0; s < RS_CH; ++s) {
        const f32x2 w = nw, a = bf2x(nq.x), bb = bf2x(nq.y), kk = bf2x(nq.z), wr = bf2x(nq.w); const float v = nvs[0], br = nvs[1], kr = nvs[2];
        if (s + 1 < RS_CH) { const int o = (s + 1) * RS_TSB; nw = *(const f32x2*)(pw + o); nq = *(const u32x4*)(pa + o); nvs = *(const f32x4*)(pv + o); }
        const f32x2 pda = S * a, pdy = S * wr;
        const f32x2 vv = {v, v};
        const f32x2 u = S * w + vv * kk;
        const float t0 = v * kr + (pdy[0] + pdy[1]);
        const float da = row32_sum(pda[0] + pda[1]);
        const f32x2 dd = {da, da};
        S = dd * bb + u;
        yb[s * (RS_ROWS * RS_YP)] = (bf16)(__builtin_bit_cast(unsigned, da * br + t0) >> 16);
      }
    }
    LDS_BARRIER();
  }
  if (wave >= 4) RS_YOUT(NCH - 1);
  __syncthreads();
#undef RS_YOUT
}
__device__ __forceinline__ void rwkv_post_row(const Params& p, int l, int row, int lane) {
  asm volatile("" ::: "memory");
  asm volatile("" : "+v"(lane));
  unsigned char* ws = p.ws;
  const f32x4 y = ((const f32x4*)((const float*)(ws + RW_Y) + (size_t)row * G))[lane];
  float s = y[0] + y[1] + y[2] + y[3];
  s = row16_sum(s);
  const float mu = s * (1.f / 64.f); const f32x4 d = y - mu;
  float q = d[0] * d[0] + d[1] * d[1] + d[2] * d[2] + d[3] * d[3];
  q = row16_sum(q);
  const float rstd = rsqrtf(q * (1.f / 64.f) + 64e-5f);
  const f32x4 gw = ((const f32x4*)(p.in[28] + (size_t)l * G))[lane], gb = ((const f32x4*)(p.in[29] + (size_t)l * G))[lane];
  const u32x2 vv = ((const u32x2*)((const bf16*)(ws + RW_V) + (size_t)row * G))[lane], gg = ((const u32x2*)((const bf16*)(ws + RW_G) + (size_t)row * G))[lane];
  const float rk = ((const float*)(ws + SM_RK))[(size_t)row * 4 + (lane >> 4)];
  const float v[4] = {bflo(vv.x), bfhi(vv.x), bflo(vv.y), bfhi(vv.y)}, gt[4] = {bflo(gg.x), bfhi(gg.x), bflo(gg.y), bfhi(gg.y)};
  float o[4];
#pragma unroll
  for (int e = 0; e < 4; ++e) o[e] = (d[e] * rstd * gw[e] + gb[e] + rk * v[e]) * gt[e];
  u32x2 w; w.x = pk2(o[0], o[1]); w.y = pk2(o[2], o[3]);
  ((u32x2*)((bf16*)(ws + WS_P) + (size_t)row * PW + C_RWR))[lane] = w;
}

__device__ __forceinline__ void rwkv_post_rows2(const Params& p, int l, int row0, int row1, int lane) {
  asm volatile("" ::: "memory");
  asm volatile("" : "+v"(lane));
  unsigned char* ws = p.ws;
  const int rows[2] = {row0, row1};
  f32x4 y[2]; u32x2 vv[2], gg[2]; float rk[2];
  const f32x4 gw = ((const f32x4*)(p.in[28] + (size_t)l * G))[lane], gb = ((const f32x4*)(p.in[29] + (size_t)l * G))[lane];
#pragma unroll
  for (int r = 0; r < 2; ++r) { const size_t row = (size_t)rows[r];
    y[r] = ((const f32x4*)((const float*)(ws + RW_Y) + row * G))[lane];
    vv[r] = ((const u32x2*)((const bf16*)(ws + RW_V) + row * G))[lane]; gg[r] = ((const u32x2*)((const bf16*)(ws + RW_G) + row * G))[lane];
    rk[r] = ((const float*)(ws + SM_RK))[row * 4 + (lane >> 4)]; }
#pragma unroll
  for (int r = 0; r < 2; ++r) {
    float s = row16_sum(y[r][0] + y[r][1] + y[r][2] + y[r][3]);
    const float mu = s * (1.f / 64.f); const f32x4 d = y[r] - mu;
    const float q = row16_sum(d[0] * d[0] + d[1] * d[1] + d[2] * d[2] + d[3] * d[3]);
    const float rstd = rsqrtf(q * (1.f / 64.f) + 64e-5f);
    const float v[4] = {bflo(vv[r].x), bfhi(vv[r].x), bflo(vv[r].y), bfhi(vv[r].y)}, gt[4] = {bflo(gg[r].x), bfhi(gg[r].x), bflo(gg[r].y), bfhi(gg[r].y)};
    float o[4];
#pragma unroll
    for (int e = 0; e < 4; ++e) o[e] = (d[e] * rstd * gw[e] + gb[e] + rk[r] * v[e]) * gt[e];
    u32x2 w; w.x = pk2(o[0], o[1]); w.y = pk2(o[2], o[3]);
    ((u32x2*)((bf16*)(ws + WS_P) + (size_t)rows[r] * PW + C_RWR))[lane] = w;
  }
}

__device__ __forceinline__ void lru_unit(const Params& p, int l, float* lds, int unit) {
  asm volatile("" ::: "memory");
  unsigned char* ws = p.ws; bf16* proj = (bf16*)(ws + WS_P);
  int tid = threadIdx.x; asm volatile("" : "+v"(tid)); const int wave = __builtin_amdgcn_readfirstlane(tid >> 6), lane = tid & 63, li = lane & 15, g = lane >> 4;
  const int b = unit >> 2, h = unit & 3;
  float* XB = lds;
  float* XC = XB + 67 * 64;
  float* AA = XC + 64 * 65;
  float* UU = AA + 64 * 65;
  float* HH = UU + 64 * 65;
  bf16* XCb = (bf16*)(HH + 64 * 65);
  const float* cw = p.in[12] + (size_t)l * 4 * G + h * 64; const float* cb = p.in[13] + (size_t)l * G + h * 64;
  const float* rab = p.in[15] + (size_t)l * G + h * 64; const float* rib = p.in[17] + (size_t)l * G + h * 64; const float* lam = p.in[18] + (size_t)l * G + h * 64;
  const int mt = wave & 3, ntp = wave >> 2;
  bf16x8 br_[2][2], bi_[2][2]; float lsl[2], rb[2], ib[2];
  { const bf16* rat = (const bf16*)(ws + WS_RAT) + h * 4096; const bf16* rit = (const bf16*)(ws + WS_RIT) + h * 4096;
#pragma unroll
    for (int n = 0; n < 2; ++n) { const int col = (2 * ntp + n) * 16 + li; lsl[n] = log_sigmoid_acc(lam[col]); rb[n] = rab[col]; ib[n] = rib[col];
#pragma unroll
      for (int ks = 0; ks < 2; ++ks) { br_[n][ks] = *(const bf16x8*)(rat + col * 64 + ks * 32 + 8 * g); bi_[n][ks] = *(const bf16x8*)(rit + col * 64 + ks * 32 + 8 * g); } } }
  float hcur = 0.f;
  const int tok = tid >> 3, ch8 = (tid & 7) * 8;
  u32x4 nx0 = {0u, 0u, 0u, 0u}, nx1 = {0u, 0u, 0u, 0u}, ny;
  const int r1 = (tid + NTHREADS) >> 3;
  { const int pos0 = -3 + tok; if (pos0 >= 0) nx0 = *(const u32x4*)(proj + ((size_t)b * SEQ + pos0) * PW + C_LRUX + h * 64 + ch8);
    if (tid < 24) nx1 = *(const u32x4*)(proj + ((size_t)b * SEQ + (-3 + r1)) * PW + C_LRUX + h * 64 + ch8);
    ny = *(const u32x4*)(proj + ((size_t)b * SEQ + tok) * PW + C_LRUY + h * 64 + ch8); }
  for (int c = 0; c < SEQ / 64; ++c) {
    const int t0 = c * 64;
    { float f8[8]; unpack8(nx0, f8);
#pragma unroll
      for (int e = 0; e < 8; ++e) XB[tok * 64 + ch8 + e] = f8[e];
      if (tid < 24) { unpack8(nx1, f8);
#pragma unroll
        for (int e = 0; e < 8; ++e) XB[r1 * 64 + ch8 + e] = f8[e]; } }
    const u32x4 ycur = ny;
    if (c + 1 < SEQ / 64) { const int tn = t0 + 64;
      nx0 = *(const u32x4*)(proj + ((size_t)b * SEQ + tn - 3 + tok) * PW + C_LRUX + h * 64 + ch8);
      if (tid < 24) nx1 = *(const u32x4*)(proj + ((size_t)b * SEQ + tn - 3 + r1) * PW + C_LRUX + h * 64 + ch8);
      ny = *(const u32x4*)(proj + ((size_t)b * SEQ + tn + tok) * PW + C_LRUY + h * 64 + ch8); }
    LDS_BARRIER();
    { float xc[8];
#pragma unroll
      for (int e = 0; e < 8; ++e) { float v = cb[ch8 + e];
#pragma unroll
        for (int j = 0; j < 4; ++j) v += XB[(tok + j) * 64 + ch8 + e] * cw[j * G + ch8 + e];
        xc[e] = v; XC[tok * 65 + ch8 + e] = v; }
      *(u32x4*)(XCb + tok * 72 + ch8) = pack8(xc); }
    LDS_BARRIER();
    { bf16x8 af[2];
#pragma unroll
      for (int ks = 0; ks < 2; ++ks) af[ks] = *(const bf16x8*)(XCb + (mt * 16 + li) * 72 + ks * 32 + 8 * g);
#pragma unroll
      for (int n = 0; n < 2; ++n) { f32x4 cr = {0.f, 0.f, 0.f, 0.f}, ci = {0.f, 0.f, 0.f, 0.f};
#pragma unroll
        for (int ks = 0; ks < 2; ++ks) { cr = MFMA16(af[ks], br_[n][ks], cr); ci = MFMA16(af[ks], bi_[n][ks], ci); }
        const int col = (2 * ntp + n) * 16 + li;
#pragma unroll
        for (int j = 0; j < 4; ++j) { const int tk = mt * 16 + 4 * g + j; const float r = sigmoidf_(cr[j] + rb[n]), ig = sigmoidf_(ci[j] + ib[n]);
          const float log_a = 8.f * r * lsl[n]; const float a = __expf(log_a); const float mult = sqrtf(fmaxf(1.f - a * a, 0.f));
          AA[tk * 65 + col] = a; UU[tk * 65 + col] = mult * (ig * XC[tk * 65 + col]); } } }
    LDS_BARRIER();
    if (wave == 0) {
#pragma unroll 8
      for (int s = 0; s < 64; ++s) { hcur = AA[s * 65 + lane] * hcur + UU[s * 65 + lane]; HH[s * 65 + lane] = hcur; } }
    LDS_BARRIER();
    { bf16* yp = proj + ((size_t)b * SEQ + t0 + tok) * PW + C_LRUY + h * 64 + ch8; float y[8]; unpack8(ycur, y);
#pragma unroll
      for (int e = 0; e < 8; ++e) y[e] = HH[tok * 65 + ch8 + e] * gelu_tanh(y[e]);
      *(u32x4*)yp = pack8(y); }
  }
  __syncthreads();
}

constexpr int KS_P = 72, VS_P = 136;
constexpr int AT_KS = 0, AT_VS = 128 * KS_P * 2, AT_CS = AT_VS + 64 * VS_P * 2, AT_BUF = AT_CS + 512;
struct AtRegs { u32x4 k0, k1, v0, v1; float c; };
__device__ __forceinline__ void at_issue(AtRegs& r, const bf16* Kg  , const bf16* VTg  , const float* cumg, int tid) {
  { const int id = tid, row = id >> 3, ch = id & 7; r.k0 = *(const u32x4*)(Kg + (size_t)row * PW + ch * 8); }
  { const int id = tid + 512, row = id >> 3, ch = id & 7; r.k1 = *(const u32x4*)(Kg + (size_t)row * PW + ch * 8); }
  { const int id = tid, row = id >> 4, ch = id & 15; r.v0 = *(const u32x4*)(VTg + (size_t)row * SEQ + ch * 8); }
  { const int id = tid + 512, row = id >> 4, ch = id & 15; r.v1 = *(const u32x4*)(VTg + (size_t)row * SEQ + ch * 8); }
  r.c = (cumg && tid < 128) ? -cumg[tid] : 0.f;
}
__device__ __forceinline__ void at_commit(const AtRegs& r, unsigned char* buf, int tid) {
  bf16* Ks = (bf16*)(buf + AT_KS); bf16* Vs = (bf16*)(buf + AT_VS); float* Cs = (float*)(buf + AT_CS);
  { const int id = tid, row = id >> 3, ch = id & 7; *(u32x4*)(Ks + row * KS_P + ch * 8) = r.k0; }
  { const int id = tid + 512, row = id >> 3, ch = id & 7; *(u32x4*)(Ks + row * KS_P + ch * 8) = r.k1; }
  { const int id = tid, row = id >> 4, ch = id & 15; *(u32x4*)(Vs + row * VS_P + ch * 8) = r.v0; }
  { const int id = tid + 512, row = id >> 4, ch = id & 15; *(u32x4*)(Vs + row * VS_P + ch * 8) = r.v1; }
  if (tid < 128) Cs[tid] = r.c;
}
__device__ __forceinline__ bf16x8 vfrag(const bf16* Vs, int d, int key0, int g) {
  const u32x2 lo = *(const u32x2*)(Vs + d * VS_P + key0 + 4 * g), hi = *(const u32x2*)(Vs + d * VS_P + key0 + 16 + 4 * g);
  const u32x4 w = {lo.x, lo.y, hi.x, hi.y}; return __builtin_bit_cast(bf16x8, w);
}
__device__ __forceinline__ float grp4_max(float x) {
  const auto a = __builtin_amdgcn_permlane16_swap(__builtin_bit_cast(unsigned, x), __builtin_bit_cast(unsigned, x), false, false);
  x = fmaxf(__builtin_bit_cast(float, (unsigned)a[0]), __builtin_bit_cast(float, (unsigned)a[1]));
  const auto b = __builtin_amdgcn_permlane32_swap(__builtin_bit_cast(unsigned, x), __builtin_bit_cast(unsigned, x), false, false);
  return fmaxf(__builtin_bit_cast(float, (unsigned)b[0]), __builtin_bit_cast(float, (unsigned)b[1]));
}
__device__ __forceinline__ float grp4_sum(float x) {
  const auto a = __builtin_amdgcn_permlane16_swap(__builtin_bit_cast(unsigned, x), __builtin_bit_cast(unsigned, x), false, false);
  x = __builtin_bit_cast(float, (unsigned)a[0]) + __builtin_bit_cast(float, (unsigned)a[1]);
  const auto b = __builtin_amdgcn_permlane32_swap(__builtin_bit_cast(unsigned, x), __builtin_bit_cast(unsigned, x), false, false);
  return __builtin_bit_cast(float, (unsigned)b[0]) + __builtin_bit_cast(float, (unsigned)b[1]);
}
__device__ __forceinline__ void fox_unit(const Params& p, unsigned char* lds, int b, int h, int qb) {
  asm volatile("" ::: "memory");
  unsigned char* ws = p.ws; bf16* proj = (bf16*)(ws + WS_P);
  int tid = threadIdx.x; asm volatile("" : "+v"(tid)); const int wave = __builtin_amdgcn_readfirstlane(tid >> 6), lane = tid & 63, li = lane & 15, g = lane >> 4;
  const int bh = b * 4 + h; const int qrel = wave * 16 + li; const size_t qrow = (size_t)b * SEQ + qb * 128 + qrel;
  const float* cum = (const float*)(ws + SM_CUM) + (size_t)bh * SEQ;
  const bf16* Kbase = proj + (size_t)b * SEQ * PW + C_FOXK + h * 64; const bf16* VTbase = (const bf16*)(ws + P_FOXVT) + (size_t)bh * 64 * SEQ;
  bf16x8 qf[2];
#pragma unroll
  for (int ks = 0; ks < 2; ++ks) qf[ks] = *(const bf16x8*)(proj + qrow * PW + C_FOXQ + h * 64 + ks * 32 + 8 * g);
  const float SC = 0.125f * LOG2E;
  f32x4 o[4];
#pragma unroll
  for (int dt = 0; dt < 4; ++dt) o[dt] = (f32x4){0.f, 0.f, 0.f, 0.f};
  float m = -INFINITY, lsum = 0.f;
  AtRegs rg; at_issue(rg, Kbase, VTbase, cum, tid);
  __syncthreads();
  at_commit(rg, lds, tid);
  if (qb > 0) at_issue(rg, Kbase + (size_t)128 * PW, VTbase + 128, cum + 128, tid);
  LDS_BARRIER();
  for (int kb = 0; kb <= qb; ++kb) {
    unsigned char* buf = lds + (kb & 1) * AT_BUF; const bf16* Ks = (const bf16*)(buf + AT_KS); const bf16* Vs = (const bf16*)(buf + AT_VS); const float* Cs = (const float*)(buf + AT_CS);
    const bool diag = kb == qb; const int nst = diag ? (wave >> 1) + 1 : 4;
    for (int st = 0; st < nst; ++st) {
      f32x4 s0 = {0.f, 0.f, 0.f, 0.f}, s1 = {0.f, 0.f, 0.f, 0.f};
#pragma unroll
      for (int ks = 0; ks < 2; ++ks) { const bf16x8 a0 = *(const bf16x8*)(Ks + (st * 32 + li) * KS_P + ks * 32 + 8 * g), a1 = *(const bf16x8*)(Ks + (st * 32 + 16 + li) * KS_P + ks * 32 + 8 * g);
        s0 = MFMA16(a0, qf[ks], s0); s1 = MFMA16(a1, qf[ks], s1); }
      const f32x4 c0 = *(const f32x4*)(Cs + st * 32 + 4 * g), c1 = *(const f32x4*)(Cs + st * 32 + 16 + 4 * g);
      float x[8];
#pragma unroll
      for (int j = 0; j < 4; ++j) { x[j] = s0[j] * SC + c0[j]; x[4 + j] = s1[j] * SC + c1[j]; }
      if (diag) {
#pragma unroll
        for (int j = 0; j < 4; ++j) { if (st * 32 + 4 * g + j > qrel) x[j] = -INFINITY; if (st * 32 + 16 + 4 * g + j > qrel) x[4 + j] = -INFINITY; }
      }
      float mx = fmaxf(fmaxf(fmaxf(x[0], x[1]), fmaxf(x[2], x[3])), fmaxf(fmaxf(x[4], x[5]), fmaxf(x[6], x[7])));
      mx = grp4_max(mx);
      const float mn = fmaxf(m, mx);
      const bool grew = __any(mn > m);
      float ps = 0.f;
#pragma unroll
      for (int j = 0; j < 8; ++j) { x[j] = ex2(x[j] - mn); ps += x[j]; }
      if (grew) { const float f = ex2(m - mn); lsum *= f;
#pragma unroll
        for (int dt = 0; dt < 4; ++dt) o[dt] = o[dt] * f;
        m = mn; }
      lsum += ps;
      const bf16x8 pb = pack_frag(x);
#pragma unroll
      for (int dt = 0; dt < 4; ++dt) o[dt] = MFMA16(vfrag(Vs, dt * 16 + li, st * 32, g), pb, o[dt]);
    }
    if (kb < qb) {
      at_commit(rg, lds + ((kb + 1) & 1) * AT_BUF, tid);
      if (kb + 2 <= qb) at_issue(rg, Kbase + (size_t)(kb + 2) * 128 * PW, VTbase + (kb + 2) * 128, cum + (kb + 2) * 128, tid);
      LDS_BARRIER();
    }
  }
  lsum = grp4_sum(lsum);
  const float inv = 1.f / lsum;
#pragma unroll
  for (int dt = 0; dt < 4; ++dt) { u32x2 w; w.x = pk2(o[dt][0] * inv, o[dt][1] * inv); w.y = pk2(o[dt][2] * inv, o[dt][3] * inv);
    *(u32x2*)(proj + qrow * PW + C_FOXQ + h * 64 + dt * 16 + 4 * g) = w; }
}
__device__ __forceinline__ void ret_unit(const Params& p, int l, unsigned char* lds, int b, int h, int c) {
  asm volatile("" ::: "memory");
  unsigned char* ws = p.ws; bf16* proj = (bf16*)(ws + WS_P);
  int tid = threadIdx.x; asm volatile("" : "+v"(tid)); const int wave = __builtin_amdgcn_readfirstlane(tid >> 6), lane = tid & 63, li = lane & 15, g = lane >> 4;
  const int bh = b * 4 + h; const int nrel = wave * 16 + li; const size_t qrow = (size_t)b * SEQ + c * 128 + nrel;
  const float lg2 = log2f(1.f - exp2f(-5.f - (float)h));
  bf16* RT = (bf16*)(lds + 2 * AT_BUF);
  AtRegs rg; at_issue(rg, proj + ((size_t)b * SEQ + c * 128) * PW + C_RETK + h * 64, (const bf16*)(ws + P_RETVT) + (size_t)bh * 64 * SEQ + c * 128, nullptr, tid);
  { const float cd = ex2(lg2 * 128.f); const float* KV = (const float*)(ws + P_RETKV) + (size_t)bh * 32 * 4096 + (tid >> 3) * 64 + (tid & 7) * 8;
    f32x4 a0 = {0.f, 0.f, 0.f, 0.f}, a1 = {0.f, 0.f, 0.f, 0.f};
    int cc = 0;
    for (; cc + 4 <= c; cc += 4) { f32x4 k0[4], k1[4];
#pragma unroll
      for (int u = 0; u < 4; ++u) { k0[u] = *(const f32x4*)(KV + (size_t)(cc + u) * 4096); k1[u] = *(const f32x4*)(KV + (size_t)(cc + u) * 4096 + 4); }
#pragma unroll
      for (int u = 0; u < 4; ++u) { a0 = a0 * cd + k0[u]; a1 = a1 * cd + k1[u]; } }
    for (; cc < c; ++cc) { const f32x4 k0 = *(const f32x4*)(KV + (size_t)cc * 4096), k1 = *(const f32x4*)(KV + (size_t)cc * 4096 + 4); a0 = a0 * cd + k0; a1 = a1 * cd + k1; }
    __syncthreads();
    const int d = tid >> 3, e0 = (tid & 7) * 8;
#pragma unroll
    for (int e = 0; e < 4; ++e) { RT[(e0 + e) * KS_P + d] = (bf16)f2bf(a0[e]); RT[(e0 + 4 + e) * KS_P + d] = (bf16)f2bf(a1[e]); } }
  at_commit(rg, lds, tid);
  bf16x8 qf[2];
#pragma unroll
  for (int ks = 0; ks < 2; ++ks) qf[ks] = *(const bf16x8*)(proj + qrow * PW + C_RETQ + h * 64 + ks * 32 + 8 * g);
  __syncthreads();
  const bf16* Ks = (const bf16*)(lds + AT_KS); const bf16* Vs = (const bf16*)(lds + AT_VS);
  f32x4 o[4], cr[4];
#pragma unroll
  for (int et = 0; et < 4; ++et) { o[et] = (f32x4){0.f, 0.f, 0.f, 0.f}; cr[et] = (f32x4){0.f, 0.f, 0.f, 0.f};
#pragma unroll
    for (int ks = 0; ks < 2; ++ks) cr[et] = MFMA16(*(const bf16x8*)(RT + (et * 16 + li) * KS_P + ks * 32 + 8 * g), qf[ks], cr[et]); }
  const int nst = (wave >> 1) + 1;
  for (int st = 0; st < nst; ++st) {
    f32x4 s0 = {0.f, 0.f, 0.f, 0.f}, s1 = {0.f, 0.f, 0.f, 0.f};
#pragma unroll
    for (int ks = 0; ks < 2; ++ks) { const bf16x8 a0 = *(const bf16x8*)(Ks + (st * 32 + li) * KS_P + ks * 32 + 8 * g), a1 = *(const bf16x8*)(Ks + (st * 32 + 16 + li) * KS_P + ks * 32 + 8 * g);
      s0 = MFMA16(a0, qf[ks], s0); s1 = MFMA16(a1, qf[ks], s1); }
    float x[8];
#pragma unroll
    for (int j = 0; j < 4; ++j) { const int m0 = st * 32 + 4 * g + j, m1 = m0 + 16;
      x[j] = (m0 <= nrel) ? s0[j] * ex2(lg2 * (float)(nrel - m0)) : 0.f; x[4 + j] = (m1 <= nrel) ? s1[j] * ex2(lg2 * (float)(nrel - m1)) : 0.f; }
    const bf16x8 pb = pack_frag(x);
#pragma unroll
    for (int et = 0; et < 4; ++et) o[et] = MFMA16(vfrag(Vs, et * 16 + li, st * 32, g), pb, o[et]);
  }
  const float xi = ex2(lg2 * (float)(nrel + 1));
  float ss = 0.f;
#pragma unroll
  for (int et = 0; et < 4; ++et)
#pragma unroll
    for (int j = 0; j < 4; ++j) { o[et][j] += xi * cr[et][j]; ss += o[et][j] * o[et][j]; }
  ss += __shfl_xor(ss, 16); ss += __shfl_xor(ss, 32);
  const float rs = rsqrtf(ss * (1.f / 64.f) + EPS);
  const float* gnw = p.in[33] + (size_t)l * G + h * 64;
#pragma unroll
  for (int et = 0; et < 4; ++et) { const int e0 = et * 16 + 4 * g;
    const u32x2 gg = *(const u32x2*)(proj + qrow * PW + C_RETG + h * 64 + e0); const float gt[4] = {bflo(gg.x), bfhi(gg.x), bflo(gg.y), bfhi(gg.y)};
    float r[4];
#pragma unroll
    for (int j = 0; j < 4; ++j) r[j] = o[et][j] * rs * gnw[e0 + j] * (gt[j] * sigmoidf_(gt[j]));
    u32x2 w; w.x = pk2(r[0], r[1]); w.y = pk2(r[2], r[3]);
    *(u32x2*)(proj + qrow * PW + C_RETQ + h * 64 + e0) = w; }
}

constexpr int XP = 264;
__device__ __forceinline__ void xattn_unit(const Params& p, int l, unsigned char* lds, int unit) {
  asm volatile("" ::: "memory");
  unsigned char* ws = p.ws; bf16* qb = (bf16*)(ws + WS_P);
  int tid = threadIdx.x; asm volatile("" : "+v"(tid)); const int wave = __builtin_amdgcn_readfirstlane(tid >> 6), lane = tid & 63, li = lane & 15, g = lane >> 4;
  const int b = unit >> 6, head = (unit >> 4) & 3, qt = unit & 15;
  bf16* L = (bf16*)lds;
  const bf16* kg = (const bf16*)(ws + WS_KM) + ((size_t)l * 1024 + b * 256) * 1024 + head * 256;
  const bf16* vg = (const bf16*)(ws + WS_VMT) + (size_t)(((l * 4 + b) * 4 + head) * 256) * 256;
  __syncthreads();
#pragma unroll
  for (int i0 = 0; i0 < 16; i0 += 8) { u32x4 t[8];
#pragma unroll
    for (int i = 0; i < 8; ++i) { const int id = tid + 512 * (i0 + i), row = id >> 5, ch = id & 31; t[i] = *(const u32x4*)(kg + (size_t)row * 1024 + ch * 8); }
#pragma unroll
    for (int i = 0; i < 8; ++i) { const int id = tid + 512 * (i0 + i), row = id >> 5, ch = id & 31; *(u32x4*)(L + row * XP + ch * 8) = t[i]; } }
  __syncthreads();
  bf16x8 pb[2][8]; float linv[2];
  const float SC = LOG2E / 16.f;
#pragma unroll
  for (int grp = 0; grp < 2; ++grp) {
    const size_t row = (size_t)b * SEQ + qt * 256 + wave * 32 + grp * 16 + li;
    bf16x8 qf[8];
#pragma unroll
    for (int ks = 0; ks < 8; ++ks) qf[ks] = *(const bf16x8*)(qb + row * 1024 + head * 256 + ks * 32 + 8 * g);
    f32x4 s[16];
#pragma unroll
    for (int kt = 0; kt < 16; ++kt) { s[kt] = (f32x4){0.f, 0.f, 0.f, 0.f};
#pragma unroll
      for (int ks = 0; ks < 8; ++ks) s[kt] = MFMA16(*(const bf16x8*)(L + (kt * 16 + li) * XP + ks * 32 + 8 * g), qf[ks], s[kt]);
      if ((kt & 1) == 1) __builtin_amdgcn_sched_barrier(0); }
    float mx = -INFINITY;
#pragma unroll
    for (int kt = 0; kt < 16; ++kt) mx = fmaxf(mx, fmaxf(fmaxf(s[kt][0], s[kt][1]), fmaxf(s[kt][2], s[kt][3])));
    mx = fmaxf(mx, __shfl_xor(mx, 16)); mx = fmaxf(mx, __shfl_xor(mx, 32));
    float ps = 0.f;
#pragma unroll
    for (int kt = 0; kt < 16; ++kt)
#pragma unroll
      for (int j = 0; j < 4; ++j) { s[kt][j] = ex2((s[kt][j] - mx) * SC); ps += s[kt][j]; }
    ps += __shfl_xor(ps, 16); ps += __shfl_xor(ps, 32);
    linv[grp] = 1.f / ps;
#pragma unroll
    for (int kk = 0; kk < 8; ++kk) { float x[8];
#pragma unroll
      for (int j = 0; j < 4; ++j) { x[j] = s[2 * kk][j]; x[4 + j] = s[2 * kk + 1][j]; }
      pb[grp][kk] = pack_frag(x); }
    __builtin_amdgcn_sched_barrier(0);
  }
  __syncthreads();
#pragma unroll
  for (int i0 = 0; i0 < 16; i0 += 8) { u32x4 t[8];
#pragma unroll
    for (int i = 0; i < 8; ++i) { const int id = tid + 512 * (i0 + i), row = id >> 5, ch = id & 31; t[i] = *(const u32x4*)(vg + (size_t)row * 256 + ch * 8); }
#pragma unroll
    for (int i = 0; i < 8; ++i) { const int id = tid + 512 * (i0 + i), row = id >> 5, ch = id & 31; *(u32x4*)(L + row * XP + ch * 8) = t[i]; } }
  __syncthreads();
#pragma unroll
  for (int grp = 0; grp < 2; ++grp) {
    const size_t row = (size_t)b * SEQ + qt * 256 + wave * 32 + grp * 16 + li;
#pragma unroll
    for (int dt = 0; dt < 16; ++dt) { f32x4 o = {0.f, 0.f, 0.f, 0.f};
#pragma unroll
      for (int kk = 0; kk < 8; ++kk) { const u32x2 lo = *(const u32x2*)(L + (dt * 16 + li) * XP + kk * 32 + 4 * g), hi = *(const u32x2*)(L + (dt * 16 + li) * XP + kk * 32 + 16 + 4 * g);
        const u32x4 w = {lo.x, lo.y, hi.x, hi.y}; o = MFMA16(__builtin_bit_cast(bf16x8, w), pb[grp][kk], o); }
      u32x2 w; w.x = pk2(o[0] * linv[grp], o[1] * linv[grp]); w.y = pk2(o[2] * linv[grp], o[3] * linv[grp]);
      *(u32x2*)(qb + row * 1024 + head * 256 + dt * 16 + 4 * g) = w;
      __builtin_amdgcn_sched_barrier(0); }
  }
}

#define LAS __attribute__((address_space(3)))
#define XB_TMO      128
#define XB_XCNT(j)  (256  + 64 * (j))
#define XB_XSUB(j)  (1280 + 64 * (j))
#define XB_XGEN(j)  (2304 + 64 * (j))
#define XB_TOP      3328
#define XB_TOPGEN   3392
#define XCD_BAR_WORDS 3456
#define XB_SPIN_CAP (1u << 18)

__device__ __forceinline__ unsigned xb_ld(unsigned* p)              { return __hip_atomic_load(p, __ATOMIC_RELAXED, __HIP_MEMORY_SCOPE_AGENT); }
__device__ __forceinline__ unsigned xb_add(unsigned* p, unsigned v) { return __hip_atomic_fetch_add(p, v, __ATOMIC_RELAXED, __HIP_MEMORY_SCOPE_AGENT); }
__device__ __forceinline__ unsigned xb_xcc_id() { return (unsigned)__builtin_amdgcn_s_getreg((3 << 11) | 20) & 0xFu; }
#define XB_SPIN(cond, bar) do { unsigned _sp = 0; while (cond) { __builtin_amdgcn_s_sleep(1); \
    if ((++_sp & 255u) == 0u) { if (xb_ld(&(bar)[XB_TMO])) break; if (_sp > XB_SPIN_CAP) { atomicAdd(&(bar)[XB_TMO], 1u); break; } } } } while (0)

struct XcdBarrier {
    unsigned* bar; unsigned x;
    volatile LAS unsigned* st;
};

__device__ __forceinline__ XcdBarrier xcd_barrier_post(unsigned* bar, volatile LAS unsigned* st) {
    XcdBarrier b; b.bar = bar; b.x = xb_xcc_id(); b.st = st;
    if (threadIdx.x == 0) (void)xb_add(&bar[XB_XCNT(b.x)], 1u);
    return b;
}
__device__ __forceinline__ void xcd_barrier_complete(unsigned* bar, unsigned x, unsigned& nloc, unsigned& nx) {
    const unsigned G = gridDim.x * gridDim.y * gridDim.z;
    unsigned sum, cnt, mine, sp = 0u;
    for (;;) {
        sum = 0u; cnt = 0u; mine = 0u;
#pragma unroll
        for (unsigned j = 0; j < 16; ++j) { const unsigned c = xb_ld(&bar[XB_XCNT(j)]); sum += c; cnt += (c > 0u) ? 1u : 0u; mine = (j == x) ? c : mine; }
        if (sum == G) break;
        __builtin_amdgcn_s_sleep(1);
        if ((++sp & 255u) == 0u) { if (xb_ld(&bar[XB_TMO])) break; if (sp > XB_SPIN_CAP) { atomicAdd(&bar[XB_TMO], 1u); break; } }
    }
    nloc = mine > 0u ? mine : 1u; nx = cnt > 0u ? cnt : 1u;
}

__device__ __forceinline__ void xcd_barrier(const XcdBarrier& b) {
    asm volatile("s_waitcnt vmcnt(0)" ::: "memory");
    __syncthreads();
    if (threadIdx.x == 0) {
        unsigned* bar = b.bar;
        __builtin_amdgcn_s_waitcnt(0);
        unsigned nloc = b.st[0], nx = b.st[1];
        if (nloc == 0u) { xcd_barrier_complete(bar, b.x, nloc, nx); b.st[0] = nloc; b.st[1] = nx; }
        const unsigned old = xb_add(&bar[XB_XSUB(b.x)], 1u);
        const unsigned gen = old / nloc;
        if (old + 1u == (gen + 1u) * nloc) {
            __builtin_amdgcn_fence(__ATOMIC_RELEASE, "agent");
            asm volatile("s_waitcnt vmcnt(0)" ::: "memory");
            const unsigned og = xb_add(&bar[XB_TOP], 1u);
            const unsigned tg = og / nx;
            if (og + 1u == (tg + 1u) * nx) xb_add(&bar[XB_TOPGEN], 1u);
            else XB_SPIN(xb_ld(&bar[XB_TOPGEN]) == tg, bar);
            __builtin_amdgcn_fence(__ATOMIC_ACQUIRE, "agent");
            xb_add(&bar[XB_XGEN(b.x)], 1u);
            asm volatile("s_waitcnt vmcnt(0)" ::: "memory");
        } else {
            XB_SPIN(xb_ld(&bar[XB_XGEN(b.x)]) == gen, bar);
            __builtin_amdgcn_fence(__ATOMIC_ACQUIRE, "agent");
            asm volatile("s_waitcnt vmcnt(0)" ::: "memory");
        }
    }
    __syncthreads();
}


#ifndef DEBUG_LAUNCHES
#define DEBUG_LAUNCHES 0
#endif
constexpr int PH_PER_LAYER = 13, N_PHASES = 1 + PH_PER_LAYER * DEPTH;

__global__ void __launch_bounds__(NTHREADS) mega_fwd(Params p) {
  extern __shared__ __attribute__((aligned(16))) unsigned char lds[];
  cg::grid_group grid = cg::this_grid();
  constexpr int NB = 256, NGW = NB * NWAVES;
  unsigned char* ws = p.ws;
  PG8_LAS unsigned char* glds = (PG8_LAS unsigned char*)lds;
  bf16* Hb = (bf16*)(ws + WS_H); bf16* Ob = (bf16*)(ws + WS_O); bf16* Pb = (bf16*)(ws + WS_P);
  volatile LAS unsigned* xb_st = (volatile LAS unsigned*)((LAS unsigned char*)lds + (LDS_BYTES - 32));
  if (threadIdx.x == 0) { xb_st[0] = 0u; xb_st[1] = 0u; }
  __syncthreads();
  const XcdBarrier xbar = xcd_barrier_post((unsigned*)(ws + SM_BAR), xb_st);
  int ph = 0;
#ifdef DBG_CLR
#define DBG_LDSCLEAR { for (int e_ = threadIdx.x; e_ < LDS_BYTES / 4; e_ += NTHREADS) ((unsigned*)lds)[e_] = 0u; __syncthreads(); }
#else
#define DBG_LDSCLEAR
#endif
#define PHASE_BEGIN if (ph >= p.ph_lo && ph < p.ph_hi) { int tid = threadIdx.x; asm volatile("" : "+v"(tid)); const int lane = tid & 63, wave = __builtin_amdgcn_readfirstlane(tid >> 6), gw = blockIdx.x * NWAVES + wave; (void)lane; (void)gw; DBG_LDSCLEAR
#ifdef TS_PH
#define TS_REC if (blockIdx.x == 0 && threadIdx.x == 0) ((unsigned long long*)(ws + SM_Q + 256))[ph + 1] = __builtin_amdgcn_s_memrealtime();
#else
#define TS_REC
#endif
#define PHASE_END   if (ph + 1 < p.ph_hi) { if (p.ph_lo < 0) grid.sync();   else xcd_barrier(xbar); } TS_REC } ++ph;

  PHASE_BEGIN
    float* scr = (float*)lds + wave * (64 * 33);
    conv_layer_weights(p, 0, scr, gw, NGW, lane);
    { constexpr int I_SQ = (D / 64) * (D / 32);
      for (int it = gw; it < 4 * I_SQ; it += NGW) { const int w = it / I_SQ, r = it % I_SQ, layer = w >> 1, isv = w & 1;
        conv_item<0>(p.in[isv ? 36 : 35] + (size_t)layer * D * D, D, D, D, (bf16*)(ws + WS_WKV) + (size_t)w * D * D, scr, r, lane); } }
    for (int l = 0; l < DEPTH; ++l) { RowArgs a{}; a.xin = p.in[1]; a.g_pre = p.in[6] + (size_t)l * D; a.hout = (bf16*)(ws + WS_MEMN) + (size_t)l * 1024 * 1024; a.rows = 1024; row_phase(a, gw, NGW, lane); }
    { RowArgs a{}; a.xin = p.in[0]; a.g_pre = p.in[2]; a.hout = Hb; a.wf = p.in[9]; a.fbias = p.in[11]; a.logf = (float*)(ws + SM_LOGF); a.rows = T; row_phase(a, gw, NGW, lane); }
#ifdef DBG_FILLG
    for (int e = blockIdx.x * NTHREADS + tid; e < T * G / 2; e += NB * NTHREADS) ((unsigned*)(ws + RW_G))[e] = 0x447A447Au;
#endif
    for (int e = blockIdx.x * NTHREADS + tid; e < SEQ * 32; e += NB * NTHREADS) { const int pos = e >> 5, i = e & 31; const float inv = 1.f / powf(10000.f, (float)i / 31.f); const float ang = (float)pos * inv;
      ((float*)(ws + SM_ROT))[2 * e] = cosf(ang); ((float*)(ws + SM_ROT))[2 * e + 1] = sinf(ang); }
  PHASE_END

  for (int l = 0; l < DEPTH; ++l) {
    PHASE_BEGIN
      { pg8::Gemm g{Hb, (const bf16*)(ws + W_IN), T, NIN, D, D}; pg8::StaticOrder S; S.init(T, NIN, NB, (int)blockIdx.x);
        EpiIn E{Pb, (bf16*)(ws + P_FOXVT), (bf16*)(ws + P_RETKT), (bf16*)(ws + P_RETVT), (const float*)(ws + SM_ROT)};
        pg8::gemm_phase<EpiIn, pg8::StaticOrder, true, true>(glds, g, S, E); }
      if (l == 0) { pg8::Gemm g{(const bf16*)(ws + WS_MEMN), (const bf16*)(ws + WS_WKV), 2048, 4096, D, D}; MemSched S{NB, (int)blockIdx.x - 64};
        EpiMem E{(bf16*)(ws + WS_KM), (bf16*)(ws + WS_VMT)};
        pg8::gemm_phase<EpiMem, MemSched, true, true>(glds, g, S, E); }
    PHASE_END
    PHASE_BEGIN
      float* wl = (float*)lds + wave * (16 * WLP);
      for (int u = gw; u < 4096; u += NGW) rwkv_prep_unit(p, l, u >> 2, u & 3, wl, lane);
      for (int u = gw; u < 512; u += NGW) ret_kv_unit(p, u, lane);
      if (gw >= 1024 && gw < 1040) fox_cum_unit(p, gw - 1024, lane);
      if (blockIdx.x == 0 && tid == 0) *(int*)(ws + SM_Q) = 0;
    PHASE_END
    PHASE_BEGIN
#ifndef DBG_P3
#define DBG_P3 15
#endif
      if (blockIdx.x < 128) {
        const int bx_ = blockIdx.x, j_ = bx_ >> 3, su_ = ((2 * (bx_ & 7) + (j_ >> 3)) << 3) | (j_ & 7);
        if (DBG_P3 & 1) rwkv_scan_unit(p, lds, su_);
#ifdef REP_SCAN
        rwkv_scan_unit(p, lds, blockIdx.x);
#endif
      }
      else if (blockIdx.x < 144) { if (DBG_P3 & 2) lru_unit(p, l, (float*)lds, blockIdx.x - 128); }
      int* qword = (int*)(lds + LDS_BYTES - 16);
      for (;;) {
        __syncthreads();
        if (tid == 0) *qword = atomicAdd((int*)(ws + SM_Q), 1);
        __syncthreads();
        const int id = *qword;
        if (id >= 1024) break;
        if (id < 512) { if (DBG_P3 & 4) fox_unit(p, lds, (id & 15) >> 2, id & 3, 31 - (id >> 4)); }
        else if (DBG_P3 & 8) { const int r = id - 512, bh_ = r & 15; ret_unit(p, l, lds, bh_ >> 2, bh_ & 3, 31 - (r >> 4)); }
      }
    PHASE_END
    PHASE_BEGIN
      for (int row = gw; row < T; row += 2 * NGW) rwkv_post_rows2(p, l, row, row + NGW, lane);
    PHASE_END
    PHASE_BEGIN
      pg8::Gemm g{Pb, (const bf16*)(ws + W_OUT), T, D, D, PW}; pg8::StaticOrder S; S.init(T, D, NB, (int)blockIdx.x);
      EpiPlain E{Ob, D, 0, nullptr};
      pg8::gemm_phase<EpiPlain, pg8::StaticOrder, true, true>(glds, g, S, E);
    PHASE_END
    PHASE_BEGIN
      RowArgs a{}; a.xin = l == 0 ? p.in[0] : p.out; a.O = Ob; a.g_post = p.in[3] + (size_t)l * D; a.xout = p.out; a.g_pre = p.in[4] + (size_t)l * D; a.hout = Hb; a.rows = T;
      row_phase(a, gw, NGW, lane);
    PHASE_END
    PHASE_BEGIN
      pg8::Gemm g{Hb, (const bf16*)(ws + W_Q), T, D, D, D}; pg8::StaticOrder S; S.init(T, D, NB, (int)blockIdx.x);
      EpiPlain E{Pb, D, 0, nullptr};
      pg8::gemm_phase<EpiPlain, pg8::StaticOrder, true, true>(glds, g, S, E);
    PHASE_END
    PHASE_BEGIN
      for (int u = blockIdx.x; u < 256; u += NB) xattn_unit(p, l, lds, u);
    PHASE_END
    PHASE_BEGIN
      pg8::Gemm g{Pb, (const bf16*)(ws + W_O), T, D, D, D}; pg8::StaticOrder S; S.init(T, D, NB, (int)blockIdx.x);
      EpiPlain E{Ob, D, 0, nullptr};
      pg8::gemm_phase<EpiPlain, pg8::StaticOrder, true, true>(glds, g, S, E);
    PHASE_END
    PHASE_BEGIN
      RowArgs a{}; a.xin = p.out; a.O = Ob; a.g_post = p.in[5] + (size_t)l * D; a.xout = p.out; a.g_pre = p.in[7] + (size_t)l * D; a.hout = Hb; a.rows = T;
      row_phase(a, gw, NGW, lane);
    PHASE_END
    PHASE_BEGIN
      pg8::Gemm g{Hb, (const bf16*)(ws + W_1), T, DFF, D, D}; pg8::StaticOrder S; S.init(T, DFF, NB, (int)blockIdx.x);
      EpiPlain E{Pb, DFF, 1, nullptr};
      pg8::gemm_phase<EpiPlain, pg8::StaticOrder, true, true>(glds, g, S, E);
    PHASE_END
    PHASE_BEGIN
      pg8::Gemm g{Pb, (const bf16*)(ws + W_2), T, D, DFF, DFF}; pg8::StaticOrder S; S.init(T, D, NB, (int)blockIdx.x);
      EpiPlain E{Ob, D, 0, nullptr};
      pg8::gemm_phase<EpiPlain, pg8::StaticOrder, true, true>(glds, g, S, E);
    PHASE_END
    PHASE_BEGIN
      RowArgs a{}; a.xin = p.out; a.O = Ob; a.g_post = p.in[8] + (size_t)l * D; a.xout = p.out; a.rows = T;
      if (l + 1 < DEPTH) { a.g_pre = p.in[2] + (size_t)(l + 1) * D; a.hout = Hb; a.wf = p.in[9] + (size_t)(l + 1) * D * INW; a.fbias = p.in[11] + (size_t)(l + 1) * GH; a.logf = (float*)(ws + SM_LOGF); }
      row_phase(a, gw, NGW, lane);
      if (l + 1 < DEPTH) { __syncthreads(); conv_layer_weights(p, l + 1, (float*)lds + wave * (64 * 33), gw, NGW, lane); }
    PHASE_END
  }
#ifdef TS_PH
  grid.sync();
  if (blockIdx.x == 0) { const unsigned long long* ts = (const unsigned long long*)(ws + SM_Q + 256);
#ifdef TS_CONST
    const float dt_us = TS_CONST;
#else
    const float dt_us = (float)(ts[TS_PH + 1] - ts[TS_PH]) * 0.01f;
#endif
    const float delta = 0.01f * sqrtf(dt_us);
    for (int r = threadIdx.x; r < T; r += NTHREADS) p.out[(size_t)r * D] += delta; }
#endif
}


#ifdef DBG_STOP
#ifndef DBG_MASK
#define DBG_MASK 15
#endif
__global__ void dbg_dump(const unsigned char* ws, float* out) {
  const size_t i = (size_t)blockIdx.x * 256 + threadIdx.x; const int row = (int)(i >> 10), c = (int)(i & 1023);
#ifndef DBG_SRC
#define DBG_SRC 0
#endif
#ifndef DBG_COFF
#define DBG_COFF 0
#endif
  const bf16* proj = (const bf16*)(ws + WS_P);
  if (DBG_SRC == 0) out[i] = ((DBG_MASK >> (c >> 8)) & 1) ? bflo((unsigned)proj[(size_t)row * PW + DBG_COFF + c]) : 0.f;
  else if (DBG_SRC == 1) { const bf16* a = (const bf16*)(ws + WS_RW) + (size_t)(c >> 8) * (8u << 19); out[i] = ((DBG_MASK >> (c >> 8)) & 1) ? bflo((unsigned)a[(size_t)row * G + (c & 255)]) : 0.f; }
  else if (DBG_SRC == 2) { const bf16* a = (const bf16*)(ws + RW_K) + (size_t)(c >> 8) * (8u << 19); float v = 0.f; if (c < 768) v = bflo((unsigned)a[(size_t)row * G + (c & 255)]); else if (c < 772) v = ((const float*)(ws + SM_BR))[row * 4 + (c & 3)]; else if (c < 776) v = ((const float*)(ws + SM_KR))[row * 4 + (c & 3)]; else if (c < 780) v = ((const float*)(ws + SM_RK))[row * 4 + (c & 3)];
    out[i] = ((DBG_MASK >> (c >> 8)) & 1) ? v : 0.f; }
  else if (DBG_SRC == 5) { out[i] = c < 256 ? bflo((unsigned)((const bf16*)(ws + RW_G))[(size_t)row * G + c]) : 0.f; }
  else if (DBG_SRC == 4) { out[i] = i < 512 * 1024 ? bflo((unsigned)((const bf16*)(ws + W_SMALL))[i]) : 0.f; }
  else { out[i] = c < 256 ? ((const float*)(ws + RW_Y))[(size_t)row * G + c] : 0.f; }
}
#endif

#ifdef DBG_GCHK
__global__ void dbg_snap(const unsigned char* ws, float* out) { const size_t i = (size_t)blockIdx.x * 256 + threadIdx.x; ((unsigned*)out)[i] = ((const unsigned*)(ws + RW_G))[i]; if (i == 0) *(unsigned*)(ws + SM_Q + 64) = 0u; }
__global__ void dbg_cmp(unsigned char* ws, const float* out) { const size_t i = (size_t)blockIdx.x * 256 + threadIdx.x; const unsigned a = ((const unsigned*)(ws + RW_G))[i], b = ((const unsigned*)out)[i];
  if (a != b) { unsigned f = 1u; if (a == 0x447A447Au) f |= 2u; else f |= 4u; atomicOr((unsigned*)(ws + SM_Q + 64), f); } }
__global__ void dbg_fin(const unsigned char* ws, float* out) { const size_t i = (size_t)blockIdx.x * 256 + threadIdx.x; out[i] = (i == 0) ? 1.0e6f * (float)(*(const unsigned*)(ws + SM_Q + 64)) : 0.f; }
#endif
extern "C" void kernel_launch(void* const* d_in, const int* in_sizes, int n_in, void* d_out, int out_size, void* d_ws, size_t ws_size, hipStream_t stream) {
  static int grid = 0;
  if (grid == 0) {
    if (ws_size < WS_END) { fprintf(stderr, "kernel_launch: workspace too small: %zu < %zu\n", ws_size, (size_t)WS_END); grid = -1; return; }
    int dev = 0, cus = 0, per_cu = 0;
    hipGetDevice(&dev); hipDeviceGetAttribute(&cus, hipDeviceAttributeMultiprocessorCount, dev);
    hipFuncSetAttribute((const void*)mega_fwd, hipFuncAttributeMaxDynamicSharedMemorySize, LDS_BYTES);
    hipOccupancyMaxActiveBlocksPerMultiprocessor(&per_cu, (const void*)mega_fwd, NTHREADS, LDS_BYTES);
    if (per_cu < 1) { fprintf(stderr, "kernel_launch: occupancy query says %d blocks/CU\n", per_cu); per_cu = 1; }
    grid = 256;
    if (cus < 256) { fprintf(stderr, "kernel_launch: needs 256 CUs, device has %d\n", cus); grid = -1; return; }
    (void)hipGetLastError();
  }
  if (grid < 0) return;
  Params p{};
  for (int i = 0; i < 40; ++i) p.in[i] = (const float*)d_in[i];
  p.out = (float*)d_out; p.ws = (unsigned char*)d_ws;
#if DEBUG_LAUNCHES
#ifdef DBG_GCHK
  for (int ph = 0; ph < 3; ++ph) { p.ph_lo = ph; p.ph_hi = ph + 1; hipLaunchKernelGGL(mega_fwd, dim3(grid), dim3(NTHREADS), LDS_BYTES, stream, p); }
  hipLaunchKernelGGL(dbg_snap, dim3(T * G / 2 / 256), dim3(256), 0, stream, (const unsigned char*)d_ws, (float*)d_out);
  p.ph_lo = 3; p.ph_hi = 4; hipLaunchKernelGGL(mega_fwd, dim3(grid), dim3(NTHREADS), LDS_BYTES, stream, p);
  hipLaunchKernelGGL(dbg_cmp, dim3(T * G / 2 / 256), dim3(256), 0, stream, (unsigned char*)d_ws, (const float*)d_out);
  hipLaunchKernelGGL(dbg_fin, dim3(T * 1024 / 256), dim3(256), 0, stream, (const unsigned char*)d_ws, (float*)d_out);
#elif defined(DBG_STOP)
  for (int ph = 0; ph < DBG_STOP; ++ph) { p.ph_lo = ph; p.ph_hi = ph + 1; hipLaunchKernelGGL(mega_fwd, dim3(grid), dim3(NTHREADS), LDS_BYTES, stream, p); }
  hipLaunchKernelGGL(dbg_dump, dim3(T * 1024 / 256), dim3(256), 0, stream, (const unsigned char*)d_ws, (float*)d_out);
#else
#ifndef REP_MASK
#define REP_MASK 0
#endif
  int rewound = 0;
  for (int ph = 0; ph < N_PHASES; ++ph) { p.ph_lo = ph; p.ph_hi = ph + 1; const int rel = ph == 0 ? 0 : 1 + (ph - 1) % PH_PER_LAYER;
    const int reps = ((REP_MASK >> rel) & 1) ? 2 : 1;
    for (int r = 0; r < reps; ++r) hipLaunchKernelGGL(mega_fwd, dim3(grid), dim3(NTHREADS), LDS_BYTES, stream, p);
#ifdef REP_GROUP
    if (rel == 4) { if (!rewound) { rewound = 1; ph -= 4; } else rewound = 0; }
#endif
  }
#endif
#else
  p.ph_lo = 0; p.ph_hi = N_PHASES;
  hipMemsetAsync((unsigned char*)d_ws + SM_BAR, 0, 16384, stream);
  void* args[] = {&p};
  hipError_t e = hipLaunchCooperativeKernel((const void*)mega_fwd, dim3(grid), dim3(NTHREADS), args, LDS_BYTES, stream);
  if (e != hipSuccess) fprintf(stderr, "cooperative launch failed: %s (grid %d)\n", hipGetErrorString(e), grid);
#endif
}
```
